# Optimizing an MI355X kernel written in HIP

```python
import math
import jax, jax.numpy as jnp
from jax import lax
import numpy as np

D_MODEL = 1024
BATCH = 2
SEQ = 16384
DEPTH = 2

PLE_DIM = 256
EPS = 1e-6
GLA_HEADS = 4
GLA_DK = 64
GLA_DV = 128
GLA_RANK = 16
GLA_TAU = 16.0
GLA_CHUNK = 64
DIFF_HEADS = 4
DIFF_DH = 64
Q_BLOCK = 128
CONV_WIDTH = 512
CONV_K = 3
N_GROUPS = 4
EXPERTS_PER_GROUP = 4
N_EXPERTS = N_GROUPS * EXPERTS_PER_GROUP
TOP_K = 2
D_EXPERT = 512
N_BRANCH = 3

GLA_QK = GLA_HEADS * GLA_DK
GLA_V = GLA_HEADS * GLA_DV
DIFF_QK = DIFF_HEADS * 2 * DIFF_DH
DIFF_V = DIFF_HEADS * 2 * DIFF_DH
IN_SIZES = (GLA_QK, GLA_QK, GLA_V, GLA_V, GLA_RANK,
            DIFF_QK, DIFF_QK, DIFF_V,
            CONV_WIDTH, CONV_WIDTH, CONV_WIDTH,
            N_BRANCH * D_MODEL)
IN_TOTAL = sum(IN_SIZES)

kernel_name = "hybrid_gla_diffattn_shortconv_hiermoe"


def rmsnorm(x, g):
    xf = x.astype(jnp.float32)
    y = xf * lax.rsqrt(jnp.mean(xf * xf, axis=-1, keepdims=True) + EPS)
    return (y * g.astype(jnp.float32)).astype(x.dtype)


def gla_chunked(q, k, v, log_a):
    B_, T, H, dk = q.shape
    dv = v.shape[-1]
    n = T // GLA_CHUNK

    def to_chunks(a):
        return a.astype(jnp.float32).reshape(B_, n, GLA_CHUNK, H, a.shape[-1]).transpose(1, 0, 3, 2, 4)

    qc, kc, vc, ac = to_chunks(q), to_chunks(k), to_chunks(v), to_chunks(log_a)
    causal = jnp.tril(jnp.ones((GLA_CHUNK, GLA_CHUNK), dtype=bool))

    def step(S, inp):
        qi, ki, vi, ai = inp
        b = jnp.cumsum(ai, axis=-2)
        o_inter = jnp.einsum('bhtk,bhkv->bhtv', qi * jnp.exp(b), S)
        rel = b[:, :, :, None, :] - b[:, :, None, :, :]
        decay = jnp.exp(jnp.where(causal[:, :, None], rel, -jnp.inf))
        A = jnp.einsum('bhtk,bhsk,bhtsk->bhts', qi, ki, decay)
        o_intra = jnp.einsum('bhts,bhsv->bhtv', A, vi)
        b_last = b[:, :, -1:, :]
        S = jnp.exp(b_last[:, :, 0, :])[..., None] * S + jnp.einsum(
            'bhsk,bhsv->bhkv', ki * jnp.exp(b_last - b), vi)
        return S, o_inter + o_intra

    S0 = jnp.zeros((B_, H, dk, dv), jnp.float32)
    _, o = lax.scan(step, S0, (qc, kc, vc, ac))
    return o.transpose(1, 0, 3, 2, 4).reshape(B_, T, H, dv).astype(v.dtype)


def diff_attention(q, k, v, lam):
    B_, T, H, _, dh = q.shape
    nb = T // Q_BLOCK
    scale = dh ** -0.5
    slopes = 2.0 ** (-8.0 * (jnp.arange(H, dtype=jnp.float32) + 1.0) / H)
    qb = q.reshape(B_, nb, Q_BLOCK, H, 2, dh).transpose(1, 0, 3, 4, 2, 5)
    kt = k.transpose(0, 2, 3, 1, 4)
    vt = v.transpose(0, 2, 1, 3)
    kpos = jnp.arange(T)

    def block(args):
        qi, bi = args
        qpos = bi * Q_BLOCK + jnp.arange(Q_BLOCK)
        dist = qpos[:, None] - kpos[None, :]
        s = jnp.einsum('bhmqd,bhmkd->bhmqk', qi, kt).astype(jnp.float32) * scale
        s = s - slopes[None, :, None, None, None] * dist.astype(jnp.float32)
        s = jnp.where(dist >= 0, s, -jnp.inf)
        a = jax.nn.softmax(s, axis=-1)
        w = a[:, :, 0] - lam * a[:, :, 1]
        return jnp.einsum('bhqk,bhkv->bhqv', w.astype(v.dtype), vt)

    o = lax.map(block, (qb, jnp.arange(nb)))
    return o.transpose(1, 0, 3, 2, 4).reshape(B_, T, H, 2 * dh)


def short_conv(x_in, b_gate, c_gate, w):
    u = c_gate * x_in
    y = lax.conv_general_dilated(
        u, w.astype(u.dtype)[:, None, :], window_strides=(1,), padding=[(CONV_K - 1, 0)],
        dimension_numbers=('NWC', 'WIO', 'NWC'), feature_group_count=u.shape[-1])
    return b_gate * y


def token_mixer(h, layer, w_in, w_gla_a2, b_gla_a, g_gla_norm, w_o_gla, diff_lam,
                g_diff_norm, w_o_diff, conv_w, w_o_conv, w_out):
    B_, T, _ = h.shape
    z = h @ w_in
    points = np.cumsum(np.array(IN_SIZES))[:-1].tolist()
    (gq, gk, gv, gg, ga, dq, dk, dv, cx, cb, cc, gates) = jnp.split(z, points, axis=-1)

    log_a = jax.nn.log_sigmoid((ga @ w_gla_a2 + b_gla_a).astype(jnp.float32)) / GLA_TAU
    o_a = gla_chunked(gq.reshape(B_, T, GLA_HEADS, GLA_DK) * (GLA_DK ** -0.5),
                      gk.reshape(B_, T, GLA_HEADS, GLA_DK),
                      gv.reshape(B_, T, GLA_HEADS, GLA_DV),
                      log_a.reshape(B_, T, GLA_HEADS, GLA_DK))
    o_a = rmsnorm(o_a, g_gla_norm).reshape(B_, T, GLA_V) * jax.nn.silu(gg)
    y_a = o_a @ w_o_gla

    lam_init = 0.8 - 0.6 * math.exp(-0.3 * layer)
    lp = diff_lam.astype(jnp.float32)
    lam = jnp.exp(jnp.sum(lp[0] * lp[1])) - jnp.exp(jnp.sum(lp[2] * lp[3])) + lam_init
    o_b = diff_attention(dq.reshape(B_, T, DIFF_HEADS, 2, DIFF_DH),
                         dk.reshape(B_, T, DIFF_HEADS, 2, DIFF_DH),
                         dv.reshape(B_, T, DIFF_HEADS, 2 * DIFF_DH), lam)
    o_b = rmsnorm(o_b, g_diff_norm) * (1.0 - lam_init)
    y_b = o_b.reshape(B_, T, DIFF_V) @ w_o_diff

    y_c = short_conv(cx, cb, cc, conv_w) @ w_o_conv

    g = jax.nn.sigmoid(gates.reshape(B_, T, N_BRANCH, D_MODEL))
    merged = g[:, :, 0] * y_a + g[:, :, 1] * y_b + g[:, :, 2] * y_c
    return merged @ w_out


def hier_moe(h, w_rg, b_rg, w_re, b_re, w_gu, w_dn):
    B_, T, D = h.shape
    t = h.reshape(-1, D)
    g_prob = jax.nn.softmax((t @ w_rg).astype(jnp.float32) + b_rg.astype(jnp.float32), axis=-1)
    gp, gi = lax.top_k(g_prob, 1)
    e_logits = ((t @ w_re).astype(jnp.float32) + b_re.astype(jnp.float32)).reshape(
        -1, N_GROUPS, EXPERTS_PER_GROUP)
    within = jnp.take_along_axis(e_logits, gi[:, :, None], axis=1)[:, 0]
    ev, ei = lax.top_k(within, TOP_K)
    ew = jax.nn.softmax(ev, axis=-1) * gp
    eidx = gi * EXPERTS_PER_GROUP + ei
    combine = jnp.sum(jax.nn.one_hot(eidx, N_EXPERTS, dtype=jnp.float32) * ew[..., None],
                      axis=1).astype(t.dtype)
    out = jnp.zeros_like(t)
    for e in range(N_EXPERTS):
        gate, up = jnp.split(t @ w_gu[e], 2, axis=-1)
        out = out + combine[:, e:e + 1] * ((jax.nn.silu(gate) * up) @ w_dn[e])
    return out.reshape(B_, T, D)


def setup_inputs(seed: int = 0) -> dict:
    key = jax.random.key(seed)
    ks = jax.random.split(key, 24)
    f32 = jnp.float32
    nrm = lambda k, shape, s: jax.random.normal(k, shape, f32) * s
    gain = lambda k, shape: 1.0 + 0.02 * jax.random.normal(k, shape, f32)
    L = DEPTH
    return {
        "x": jax.random.normal(ks[0], (BATCH, SEQ, D_MODEL), f32),
        "p": jax.random.normal(ks[1], (DEPTH, BATCH, SEQ, PLE_DIM), f32),
        "g_mix": gain(ks[2], (L, D_MODEL)),
        "w_in": nrm(ks[3], (L, D_MODEL, IN_TOTAL), D_MODEL ** -0.5),
        "w_gla_a2": nrm(ks[4], (L, GLA_RANK, GLA_QK), GLA_RANK ** -0.5),
        "b_gla_a": nrm(ks[5], (L, GLA_QK), 0.1),
        "g_gla_norm": gain(ks[6], (L, GLA_DV)),
        "w_o_gla": nrm(ks[7], (L, GLA_V, D_MODEL), GLA_V ** -0.5),
        "diff_lam": nrm(ks[8], (L, 4, DIFF_DH), 0.1),
        "g_diff_norm": gain(ks[9], (L, 2 * DIFF_DH)),
        "w_o_diff": nrm(ks[10], (L, DIFF_V, D_MODEL), DIFF_V ** -0.5),
        "conv_w": nrm(ks[11], (L, CONV_K, CONV_WIDTH), CONV_K ** -0.5),
        "w_o_conv": nrm(ks[12], (L, CONV_WIDTH, D_MODEL), CONV_WIDTH ** -0.5),
        "w_out": nrm(ks[13], (L, D_MODEL, D_MODEL), D_MODEL ** -0.5),
        "g_ffn": gain(ks[14], (L, D_MODEL)),
        "w_router_group": nrm(ks[15], (L, D_MODEL, N_GROUPS), D_MODEL ** -0.5),
        "b_router_group": nrm(ks[16], (L, N_GROUPS), 0.01),
        "w_router_expert": nrm(ks[17], (L, D_MODEL, N_EXPERTS), D_MODEL ** -0.5),
        "b_router_expert": nrm(ks[18], (L, N_EXPERTS), 0.01),
        "w_expert_gate_up": nrm(ks[19], (L, N_EXPERTS, D_MODEL, 2 * D_EXPERT), D_MODEL ** -0.5),
        "w_expert_down": nrm(ks[20], (L, N_EXPERTS, D_EXPERT, D_MODEL), D_EXPERT ** -0.5),
        "w_ple": nrm(ks[21], (L, PLE_DIM, D_MODEL), PLE_DIM ** -0.5),
        "w_ple_gate": nrm(ks[22], (L, D_MODEL, D_MODEL), D_MODEL ** -0.5),
        "g_final": gain(ks[23], (D_MODEL,)),
    }


def reference(x, p, g_mix, w_in, w_gla_a2, b_gla_a, g_gla_norm, w_o_gla, diff_lam,
              g_diff_norm, w_o_diff, conv_w, w_o_conv, w_out, g_ffn, w_router_group,
              b_router_group, w_router_expert, b_router_expert, w_expert_gate_up,
              w_expert_down, w_ple, w_ple_gate, g_final):
    for i in range(DEPTH):
        h = rmsnorm(x, g_mix[i])
        x = x + token_mixer(h, i, w_in[i], w_gla_a2[i], b_gla_a[i], g_gla_norm[i], w_o_gla[i],
                            diff_lam[i], g_diff_norm[i], w_o_diff[i], conv_w[i], w_o_conv[i],
                            w_out[i])
        h = rmsnorm(x, g_ffn[i])
        x = x + hier_moe(h, w_router_group[i], b_router_group[i], w_router_expert[i],
                         b_router_expert[i], w_expert_gate_up[i], w_expert_down[i])
        x = x + jax.nn.sigmoid(x @ w_ple_gate[i]) * (p[i] @ w_ple[i])
    return rmsnorm(x, g_final)
```

```cpp
#include <hip/hip_runtime.h>
#include <cstdio>
#include <cstdint>

#define LAS __attribute__((address_space(3)))
#define GAS __attribute__((address_space(1)))
typedef unsigned short bf16_t;
typedef short bf16x8 __attribute__((ext_vector_type(8)));
typedef short s16x4 __attribute__((ext_vector_type(4)));
typedef float f32x2 __attribute__((ext_vector_type(2)));
typedef float f32x4 __attribute__((ext_vector_type(4)));
typedef float f32x16 __attribute__((ext_vector_type(16)));
typedef unsigned u32x2 __attribute__((ext_vector_type(2)));
typedef unsigned u32x4 __attribute__((ext_vector_type(4)));
typedef __bf16 bf16x2_t __attribute__((ext_vector_type(2)));

constexpr int NB = 2, T = 16384, NTOK = NB * T, DM = 1024, DEPTH = 2, PLE = 256;
constexpr int INTOT = 7696;
constexpr int ZP = 4864;
constexpr int C_GQ = 0, C_GK = 256, C_GV = 512, C_DK = 1024, C_DV = 1536, C_CX = 2048, C_CC = 2560, C_GA = 3072, C_GG = 3328, C_DQ = 3840, C_CB = 4352;
constexpr int C_OA = C_GG, C_OB = C_DQ, C_OC = C_CB;
constexpr int NZT = 19;
constexpr int NEXP = 16, DEXP = 512;
constexpr int NSLOT = 2 * NTOK + NEXP * 256;
constexpr float EPS = 1e-6f;
constexpr int GRID = 256;
constexpr int TPW = NTOK / GRID;

__device__ __forceinline__ unsigned f2bf(float f) { unsigned u = __builtin_bit_cast(unsigned, f); return (u + 0x7fffu + ((u >> 16) & 1u)) >> 16; }
__device__ __forceinline__ unsigned pk2(float lo, float hi) { f32x2 v = {lo, hi}; bf16x2_t b = __builtin_convertvector(v, bf16x2_t); return __builtin_bit_cast(unsigned, b); }
__device__ __forceinline__ float bflo(unsigned w) { return __builtin_bit_cast(float, w << 16); }
__device__ __forceinline__ float bfhi(unsigned w) { return __builtin_bit_cast(float, w & 0xffff0000u); }
__device__ __forceinline__ float bf2f(bf16_t b) { return __builtin_bit_cast(float, (unsigned)b << 16); }
__device__ __forceinline__ float sigmoidf_(float x) { return __builtin_amdgcn_rcpf(1.0f + __builtin_amdgcn_exp2f(-1.4426950408889634f * x)); }
__device__ __forceinline__ float siluf_(float x) { return x * sigmoidf_(x); }
__device__ __forceinline__ float wave_sum(float v) {
#pragma unroll
    for (int o = 1; o < 64; o <<= 1) v += __shfl_xor(v, o);
    return v;
}
__device__ __forceinline__ int crow(int r, int hi) { return (r & 3) + 8 * (r >> 2) + 4 * hi; }
#define LDS_WAIT() asm volatile("s_waitcnt lgkmcnt(0)" ::: "memory")
#define VM_WAIT() asm volatile("s_waitcnt vmcnt(0)" ::: "memory")

namespace pg8 {
#define PG8_LAS __attribute__((address_space(3)))
constexpr int BM = 256, BK = 64, HALF = 128, HTB = HALF * BK * 2  , STAGE_BYTES = 8 * HTB, NXCD = 8, WGM = 8;

__host__ __device__ __forceinline__ int lds_byte(int r, int c) { const int st = (r >> 4) * 2 + (c >> 5), rr = r & 15, cc = c & 31, ob = rr * 64 + cc * 2; return st * 1024 + (ob ^ (((ob >> 9) & 1) << 5)); }
__host__ __device__ __forceinline__ void stage_rc(int b, int& R, int& C) { const int st = b / 1024, sb = b % 1024, swz = sb ^ (((sb >> 9) & 1) << 5); R = (st >> 1) * 16 + swz / 64; C = (st & 1) * 32 + (swz % 64) / 2; }
__host__ __device__ __forceinline__ int perm32(int rho) { const int n = rho >> 4, i = rho & 15; return 8 * (i >> 2) + 4 * n + (i & 3); }

struct Unit { int pm, pn; int aoff; int tag; size_t boff; };
struct Gemm { const bf16_t* A; int lda; const bf16_t* Bt; int ldb; int K; };

struct StaticOrder {
    int nM, nN, nwg, G, c;
    __device__ void init(int M, int N, int G_, int c_) { nM = M / BM; nN = N / BM; nwg = nM * nN; G = G_; c = c_; }
    __device__ bool next(int i, Unit& u) const {
        const long L = (long)i * G + c; if (L >= nwg) return false;
        int wgid = (int)L; { const int q = nwg / NXCD, r = nwg % NXCD, xcd = wgid % NXCD, off = wgid / NXCD; wgid = (xcd < r ? xcd * (q + 1) : r * (q + 1) + (xcd - r) * q) + off; }
        const int nig = WGM * nN, gid = wgid / nig, fm = gid * WGM, gsz = (nM - fm) < WGM ? (nM - fm) : WGM;
        u.pm = fm + ((wgid % nig) % gsz); u.pn = (wgid % nig) / gsz; u.aoff = 0; u.tag = 0; u.boff = 0; return true;
    }
};

struct EpiBf16 {
    static constexpr bool PERM = true;
    bf16_t* O; int ldc; int tstride;
    __device__ __forceinline__ void operator()(const f32x4 (&acc)[2][2][4][2], const Unit& u, int wr, int wc, int fr, int fq) const {
        const int row0 = u.pm * BM + wr * 64 + fr; const int col0 = u.tag * tstride + u.pn * BM + wc * 32 + 8 * fq;
#pragma unroll
        for (int ai = 0; ai < 2; ++ai)
#pragma unroll
            for (int m = 0; m < 4; ++m) { bf16_t* rowp = O + (size_t)(row0 + ai * HALF + m * 16) * ldc + col0;
#pragma unroll
                for (int bj = 0; bj < 2; ++bj) { const f32x4 v0 = acc[ai][bj][m][0], v1 = acc[ai][bj][m][1];
                    u32x4 w; w.x = pk2(v0[0], v0[1]); w.y = pk2(v0[2], v0[3]); w.z = pk2(v1[0], v1[1]); w.w = pk2(v1[2], v1[3]);
                    *(u32x4*)(rowp + bj * HALF) = w; } }
    }
};
template <class Epi, class Sched, bool ALIGN_EPI = false, bool SP2 = false>
__device__ __forceinline__ void gemm_phase(PG8_LAS unsigned char* lds, const Gemm g, const Sched& S, const Epi& E) {
    int tid_l = threadIdx.x; asm volatile("" : "+v"(tid_l)); const int tid = tid_l;
    const int wid = __builtin_amdgcn_readfirstlane(tid >> 6), lane = tid & 63, wr = wid >> 2, wc = wid & 3, fr = lane & 15, fq = lane >> 4;
    const int K = g.K, nt = K / BK;
    unsigned voffA[2], voffB[2];
#pragma unroll
    for (int i = 0; i < 2; ++i) { int R, C; stage_rc(tid * 16 + i * 8192, R, C); const int Rb = Epi::PERM ? ((R & ~31) + perm32(R & 31)) : R;
        voffA[i] = (unsigned)(R * g.lda + C) * 2u; voffB[i] = (unsigned)(Rb * g.ldb + C) * 2u; }
    const size_t kstep = (size_t)(BK * 2);
    const size_t hstepA = (size_t)HALF * g.lda * 2, hstepB = (size_t)HALF * g.ldb * 2;
    const unsigned ldsw = (unsigned)wid * 1024u;
    const int aoff = lds_byte(wr * 64 + fr, fq * 8), boff = lds_byte(wc * 32 + fr, fq * 8);
#define PG8_UA(u) ((const char*)g.A + ((size_t)(u).pm * 2 * hstepA) + (size_t)(u).aoff * 2)
#define PG8_UB(u) ((const char*)g.Bt + ((size_t)(u).pn * 2 * hstepB) + (u).boff * 2)
#define PG8_SA(b, h) (((b) * 2 + (h)) * HTB)
#define PG8_SB(b, h) ((4 + (b) * 2 + (h)) * HTB)
#define PG8_STAGE(bufoff, gbase, voff) do { _Pragma("unroll") for (int _i = 0; _i < 2; ++_i) \
        __builtin_amdgcn_global_load_lds((const unsigned*)((const char*)(gbase) + (voff)[_i]), (PG8_LAS unsigned*)(lds + (bufoff) + ldsw + _i * 8192), 16, 0, 0); } while (0)
#define PG8_LDA(dst, b, h) do { _Pragma("unroll") for (int m = 0; m < 4; ++m) _Pragma("unroll") for (int k = 0; k < 2; ++k) dst[m][k] = *(const PG8_LAS bf16x8*)(lds + PG8_SA(b, h) + aoff + m * 2048 + k * 1024); } while (0)
#define PG8_LDB(dst, b, h) do { _Pragma("unroll") for (int n = 0; n < 2; ++n) _Pragma("unroll") for (int k = 0; k < 2; ++k) dst[n][k] = *(const PG8_LAS bf16x8*)(lds + PG8_SB(b, h) + boff + n * 2048 + k * 1024); } while (0)
#define PG8_MMA(ai, bj, At, Bt) do { __builtin_amdgcn_s_setprio(1); _Pragma("unroll") for (int m = 0; m < 4; ++m) _Pragma("unroll") for (int n = 0; n < 2; ++n) _Pragma("unroll") for (int k = 0; k < 2; ++k) \
        acc[ai][bj][m][n] = __builtin_amdgcn_mfma_f32_16x16x32_bf16(Bt[n][k], At[m][k], acc[ai][bj][m][n], 0, 0, 0); __builtin_amdgcn_s_setprio(0); } while (0)
#define PG8_WAIT_V(n) asm volatile("s_waitcnt vmcnt(" #n ")" ::: "memory")
#define PG8_WAIT_L(n) asm volatile("s_waitcnt lgkmcnt(" #n ")" ::: "memory")
#define PG8_BAR __builtin_amdgcn_s_barrier()
#define PG8_SCHED __builtin_amdgcn_sched_barrier(0)
    Unit cur, nxt; int ui = 0;
    if (!S.next(0, cur)) return;
    f32x4 acc[2][2][4][2];
#pragma unroll
    for (int a = 0; a < 2; ++a)
#pragma unroll
        for (int b = 0; b < 2; ++b)
#pragma unroll
            for (int m = 0; m < 4; ++m)
#pragma unroll
                for (int n = 0; n < 2; ++n) acc[a][b][m][n] = (f32x4){0.f, 0.f, 0.f, 0.f};
    bf16x8 At[4][2], B0[2][2], B1[2][2];
    const char* cA = PG8_UA(cur); const char* cB = PG8_UB(cur);
    if constexpr (SP2) {
        PG8_STAGE(PG8_SB(0, 0), cB, voffB); PG8_STAGE(PG8_SB(0, 1), cB + hstepB, voffB); PG8_STAGE(PG8_SA(0, 0), cA, voffA); PG8_STAGE(PG8_SA(0, 1), cA + hstepA, voffA);
        if (wr == 1) PG8_BAR;
        PG8_WAIT_V(2); PG8_BAR;
        PG8_STAGE(PG8_SB(1, 0), cB + kstep, voffB); PG8_STAGE(PG8_SA(1, 0), cA + kstep, voffA); PG8_STAGE(PG8_SB(1, 1), cB + hstepB + kstep, voffB);
        PG8_WAIT_V(6); PG8_BAR;
    } else {
        PG8_STAGE(PG8_SB(0, 0), cB, voffB); PG8_STAGE(PG8_SA(0, 0), cA, voffA); PG8_STAGE(PG8_SB(0, 1), cB + hstepB, voffB); PG8_STAGE(PG8_SA(0, 1), cA + hstepA, voffA);
        if (wr == 1) PG8_BAR;
        PG8_WAIT_V(4); PG8_BAR;
        PG8_STAGE(PG8_SB(1, 0), cB + kstep, voffB); PG8_STAGE(PG8_SA(1, 0), cA + kstep, voffA); PG8_STAGE(PG8_SB(1, 1), cB + hstepB + kstep, voffB);
        PG8_WAIT_V(6); PG8_BAR;
    }
    for (;;) {
        const bool has_next = S.next(ui + 1, nxt);
        const char* nA = has_next ? PG8_UA(nxt) : cA; const char* nB = has_next ? PG8_UB(nxt) : cB;
        for (int t = 0; t < nt; t += 2) {
            const bool last = (t == nt - 2);
            const char* a1 = cA + (size_t)(t + 1) * kstep;
            const char* a2 = last ? nA : cA + (size_t)(t + 2) * kstep; const char* b2 = last ? nB : cB + (size_t)(t + 2) * kstep;
            const char* a3 = a2 + kstep; const char* b3 = b2 + kstep;
            if constexpr (SP2) {
            PG8_LDB(B0, 0, 0); PG8_LDB(B1, 0, 1); PG8_SCHED; PG8_LDA(At, 0, 0); PG8_STAGE(PG8_SA(1, 1), a1 + hstepA, voffA);
            PG8_WAIT_V(8); PG8_WAIT_L(0); PG8_BAR; PG8_MMA(0, 0, At, B0); PG8_MMA(0, 1, At, B1); PG8_BAR; PG8_SCHED;
            PG8_LDA(At, 0, 1); PG8_STAGE(PG8_SB(0, 0), b2, voffB); PG8_STAGE(PG8_SB(0, 1), b2 + hstepB, voffB); PG8_STAGE(PG8_SA(0, 0), a2, voffA);
            PG8_WAIT_V(8); PG8_WAIT_L(0); PG8_BAR; PG8_MMA(1, 0, At, B0); PG8_MMA(1, 1, At, B1); PG8_BAR; PG8_SCHED;
            PG8_LDB(B0, 1, 0); PG8_LDB(B1, 1, 1); PG8_SCHED; PG8_LDA(At, 1, 0); PG8_STAGE(PG8_SA(0, 1), a2 + hstepA, voffA);
            PG8_WAIT_V(8); PG8_WAIT_L(0); PG8_BAR; PG8_MMA(0, 0, At, B0); PG8_MMA(0, 1, At, B1); PG8_BAR; PG8_SCHED;
            PG8_LDA(At, 1, 1); PG8_STAGE(PG8_SB(1, 0), b3, voffB); PG8_STAGE(PG8_SB(1, 1), b3 + hstepB, voffB); PG8_STAGE(PG8_SA(1, 0), a3, voffA);
            PG8_WAIT_V(8); PG8_WAIT_L(0); PG8_BAR; PG8_MMA(1, 0, At, B0); PG8_MMA(1, 1, At, B1); PG8_BAR; PG8_SCHED;
            } else {
            PG8_LDB(B0, 0, 0); PG8_SCHED; PG8_LDA(At, 0, 0); PG8_STAGE(PG8_SA(1, 1), a1 + hstepA, voffA);
            PG8_WAIT_L(8); PG8_BAR; PG8_WAIT_L(0); PG8_MMA(0, 0, At, B0); PG8_BAR; PG8_SCHED;
            PG8_LDB(B1, 0, 1); PG8_STAGE(PG8_SB(0, 0), b2, voffB);
            PG8_BAR; PG8_WAIT_L(0); PG8_MMA(0, 1, At, B1); PG8_BAR;
            PG8_LDA(At, 0, 1); PG8_STAGE(PG8_SA(0, 0), a2, voffA);
            PG8_BAR; PG8_WAIT_L(0); PG8_MMA(1, 0, At, B0); PG8_BAR; PG8_SCHED;
            PG8_STAGE(PG8_SB(0, 1), b2 + hstepB, voffB);
            PG8_WAIT_V(6); PG8_BAR; PG8_MMA(1, 1, At, B1); PG8_BAR;
            PG8_LDB(B0, 1, 0); PG8_SCHED; PG8_LDA(At, 1, 0); PG8_STAGE(PG8_SA(0, 1), a2 + hstepA, voffA);
            PG8_WAIT_L(8); PG8_BAR; PG8_WAIT_L(0); PG8_MMA(0, 0, At, B0); PG8_BAR; PG8_SCHED;
            PG8_LDB(B1, 1, 1); PG8_STAGE(PG8_SB(1, 0), b3, voffB);
            PG8_BAR; PG8_WAIT_L(0); PG8_MMA(0, 1, At, B1); PG8_BAR;
            PG8_LDA(At, 1, 1); PG8_STAGE(PG8_SA(1, 0), a3, voffA);
            PG8_BAR; PG8_WAIT_L(0); PG8_MMA(1, 0, At, B0); PG8_BAR; PG8_SCHED;
            PG8_STAGE(PG8_SB(1, 1), b3 + hstepB, voffB);
            PG8_WAIT_V(6); PG8_BAR; PG8_MMA(1, 1, At, B1); PG8_BAR;
            }
        }
        if constexpr (ALIGN_EPI) { if (wr == 0) PG8_BAR; }
        E(acc, cur, wr, wc, fr, fq);
        if (!has_next) break;
#pragma unroll
        for (int a = 0; a < 2; ++a)
#pragma unroll
            for (int b = 0; b < 2; ++b)
#pragma unroll
                for (int m = 0; m < 4; ++m)
#pragma unroll
                    for (int n = 0; n < 2; ++n) acc[a][b][m][n] = (f32x4){0.f, 0.f, 0.f, 0.f};
        cur = nxt; cA = nA; cB = nB; ++ui;
        if constexpr (ALIGN_EPI) { if (wr == 1) PG8_BAR; }
    }
    PG8_WAIT_V(0);
    if constexpr (!ALIGN_EPI) { if (wr == 0) PG8_BAR; }
    PG8_BAR;
#undef PG8_UA
#undef PG8_UB
#undef PG8_SA
#undef PG8_SB
#undef PG8_STAGE
#undef PG8_LDA
#undef PG8_LDB
#undef PG8_MMA
#undef PG8_WAIT_V
#undef PG8_WAIT_L
#undef PG8_BAR
#undef PG8_SCHED
}
}

#define XB_TMO      128
#define XB_XCNT(j)  (256  + 64 * (j))
#define XB_XSUB(j)  (1280 + 64 * (j))
#define XB_XGEN(j)  (2304 + 64 * (j))
#define XB_TOP      3328
#define XB_TOPGEN   3392
#define XCD_BAR_WORDS 3456
#define XB_SPIN_CAP (1u << 18)

__device__ __forceinline__ unsigned xb_ld(unsigned* p)              { return __hip_atomic_load(p, __ATOMIC_RELAXED, __HIP_MEMORY_SCOPE_AGENT); }
__device__ __forceinline__ unsigned xb_add(unsigned* p, unsigned v) { return __hip_atomic_fetch_add(p, v, __ATOMIC_RELAXED, __HIP_MEMORY_SCOPE_AGENT); }
__device__ __forceinline__ unsigned xb_xcc_id() { return (unsigned)__builtin_amdgcn_s_getreg((3 << 11) | 20) & 0xFu; }
#define XB_SPIN(cond, bar) do { unsigned _sp = 0; while (cond) { __builtin_amdgcn_s_sleep(1); \
    if ((++_sp & 255u) == 0u) { if (xb_ld(&(bar)[XB_TMO])) break; if (_sp > XB_SPIN_CAP) { atomicAdd(&(bar)[XB_TMO], 1u); break; } } } } while (0)

struct XcdBarrier {
    unsigned* bar; unsigned x;
    volatile LAS unsigned* st;
};

__device__ __forceinline__ XcdBarrier xcd_barrier_post(unsigned* bar, volatile LAS unsigned* st) {
    XcdBarrier b; b.bar = bar; b.x = xb_xcc_id(); b.st = st;
    if (threadIdx.x == 0) (void)xb_add(&bar[XB_XCNT(b.x)], 1u);
    return b;
}
__device__ __forceinline__ void xcd_barrier_complete(unsigned* bar, unsigned x, unsigned& nloc, unsigned& nx) {
    const unsigned G = gridDim.x * gridDim.y * gridDim.z;
    unsigned sum, cnt, mine, sp = 0u;
    for (;;) {
        sum = 0u; cnt = 0u; mine = 0u;
#pragma unroll
        for (unsigned j = 0; j < 16; ++j) { const unsigned c = xb_ld(&bar[XB_XCNT(j)]); sum += c; cnt += (c > 0u) ? 1u : 0u; mine = (j == x) ? c : mine; }
        if (sum == G) break;
        __builtin_amdgcn_s_sleep(1);
        if ((++sp & 255u) == 0u) { if (xb_ld(&bar[XB_TMO])) break; if (sp > XB_SPIN_CAP) { atomicAdd(&bar[XB_TMO], 1u); break; } }
    }
    nloc = mine > 0u ? mine : 1u; nx = cnt > 0u ? cnt : 1u;
}

__device__ __forceinline__ void xcd_barrier(const XcdBarrier& b) {
    asm volatile("s_waitcnt vmcnt(0)" ::: "memory");
    __syncthreads();
    if (threadIdx.x == 0) {
        unsigned* bar = b.bar;
        __builtin_amdgcn_s_waitcnt(0);
        unsigned nloc = b.st[0], nx = b.st[1];
        if (nloc == 0u) { xcd_barrier_complete(bar, b.x, nloc, nx); b.st[0] = nloc; b.st[1] = nx; }
        const unsigned old = xb_add(&bar[XB_XSUB(b.x)], 1u);
        const unsigned gen = old / nloc;
        if (old + 1u == (gen + 1u) * nloc) {
            __builtin_amdgcn_fence(__ATOMIC_RELEASE, "agent");
            asm volatile("s_waitcnt vmcnt(0)" ::: "memory");
            const unsigned og = xb_add(&bar[XB_TOP], 1u);
            const unsigned tg = og / nx;
            if (og + 1u == (tg + 1u) * nx) xb_add(&bar[XB_TOPGEN], 1u);
            else XB_SPIN(xb_ld(&bar[XB_TOPGEN]) == tg, bar);
            __builtin_amdgcn_fence(__ATOMIC_ACQUIRE, "agent");
            xb_add(&bar[XB_XGEN(b.x)], 1u);
            asm volatile("s_waitcnt vmcnt(0)" ::: "memory");
        } else {
            XB_SPIN(xb_ld(&bar[XB_XGEN(b.x)]) == gen, bar);
            __builtin_amdgcn_fence(__ATOMIC_ACQUIRE, "agent");
            asm volatile("s_waitcnt vmcnt(0)" ::: "memory");
        }
    }
    __syncthreads();
}

constexpr size_t MiB = 1u << 20;
constexpr size_t WS_CTL = 0, CTL_ZERO_BYTES = 1 * MiB;
constexpr size_t WS_WIN = 1 * MiB;
constexpr size_t WS_WO = WS_WIN + (size_t)31 * 256 * 1024 * 2;
constexpr size_t WS_WOUT = WS_WO + (size_t)3 * 1024 * 512 * 2;
constexpr size_t WS_WPG = WS_WOUT + (size_t)1024 * 1024 * 2;
constexpr size_t WS_WPLE = WS_WPG + (size_t)1024 * 1024 * 2;
constexpr size_t WS_WGU = WS_WPLE + (size_t)1024 * 256 * 2;
constexpr size_t WS_WDN = WS_WGU + (size_t)16 * 1024 * 1024 * 2;
constexpr size_t WS_WEND = WS_WDN + (size_t)16 * 1024 * 512 * 2;
static_assert(WS_WEND <= 73 * MiB, "weights");
constexpr size_t WS_HN = 73 * MiB;
constexpr size_t WS_PB = WS_HN + (size_t)NTOK * DM * 2;
constexpr size_t WS_Z = WS_PB + (size_t)NTOK * PLE * 2;
constexpr size_t WS_ZEND = WS_Z + (size_t)NTOK * ZP * 2;
constexpr size_t WS_SLOC = WS_ZEND;
constexpr size_t WS_DTAB = WS_SLOC + (size_t)2048 * 8192 * 2;
constexpr size_t WS_ROUTE = WS_DTAB + (size_t)2048 * 64 * 4;
constexpr size_t WS_HIST = WS_ROUTE + (size_t)NTOK * 16;
constexpr size_t WS_TBL = WS_HIST + (size_t)GRID * 16 * 4;
constexpr size_t WS_TOKSLOT = WS_TBL + 256;
constexpr size_t WS_SLOTW = WS_TOKSLOT + (size_t)NTOK * 8;
constexpr size_t WS_END = WS_SLOTW + (size_t)NSLOT * 4;
constexpr size_t WS_HG = WS_Z;
constexpr size_t WS_ACT = WS_HG + (size_t)NSLOT * DM * 2;
constexpr size_t WS_PL = WS_ACT + (size_t)NSLOT * DEXP * 2;
static_assert(WS_PL + (size_t)NTOK * DM * 2 <= WS_ZEND, "MoE overlay fits inside Z");
constexpr int CW_BAR = 4096;

constexpr int RING_BYTES = 131072;
constexpr int LDSCTL_OFF = RING_BYTES, MISC_OFF = LDSCTL_OFF + 320;
constexpr int LDS_BYTES = 147456;

__device__ __forceinline__ void tr_item(const float* W, int ldw, int col0, int K, bf16_t* WT, int nrows, int valid, LAS float* scr, int item, int lane) {
    const int nblk = nrows / 32, kb = item / nblk, nb = item % nblk, k0 = 64 * kb, n0 = 32 * nb;
    const bool ok = (n0 + (lane & 31)) < valid;
#pragma unroll 8
    for (int i = 0; i < 32; ++i) { const int kk = 2 * i + (lane >> 5); scr[kk * 33 + (lane & 31)] = ok ? W[(size_t)(k0 + kk) * ldw + col0 + n0 + (lane & 31)] : 0.f; }
    LDS_WAIT(); asm volatile("" ::: "memory");
    const int c = lane & 7;
#pragma unroll
    for (int j = 0; j < 4; ++j) { const int n = (lane >> 3) + 8 * j; const LAS float* s = scr + (8 * c) * 33 + n;
        u32x4 o; o.x = pk2(s[0 * 33], s[1 * 33]); o.y = pk2(s[2 * 33], s[3 * 33]); o.z = pk2(s[4 * 33], s[5 * 33]); o.w = pk2(s[6 * 33], s[7 * 33]);
        *(u32x4*)(WT + (size_t)(n0 + n) * K + k0 + 8 * c) = o; }
    LDS_WAIT(); asm volatile("" ::: "memory");
}
__device__ __forceinline__ int win_src_col(int t) {
    if (t < 4) return 256 * t;
    if (t < 8) return 2064 + 256 * (t - 4);
    if (t < 10) return 3088 + 256 * (t - 8);
    if (t < 12) return 4112 + 256 * (t - 10);
    if (t == 12) return 1536;
    if (t < 15) return 1024 + 256 * (t - 13);
    if (t < 17) return 1552 + 256 * (t - 15);
    if (t < 19) return 3600 + 256 * (t - 17);
    return 4624 + 256 * (t - 19);
}
__device__ __forceinline__ void rms_row_bf16(const float* xrow, const float* g, bf16_t* orow, int lane) {
    const f32x4* xr = (const f32x4*)xrow + lane; const f32x4* gr = (const f32x4*)g + lane;
    f32x4 v[4]; float s = 0.f;
#pragma unroll
    for (int j = 0; j < 4; ++j) { v[j] = xr[64 * j]; s += (v[j].x * v[j].x + v[j].y * v[j].y) + (v[j].z * v[j].z + v[j].w * v[j].w); }
    const float r = 1.0f / sqrtf(wave_sum(s) * (1.f / DM) + EPS);
    u32x2* o8 = (u32x2*)orow + lane;
#pragma unroll
    for (int j = 0; j < 4; ++j) { const f32x4 gg = gr[64 * j]; u32x2 w; w.x = pk2(v[j].x * r * gg.x, v[j].y * r * gg.y); w.y = pk2(v[j].z * r * gg.z, v[j].w * r * gg.w); o8[64 * j] = w; }
}

struct Ptrs { const float* in[24]; float* out; unsigned char* ws; };
struct Args { Ptrs p; int ph_lo, ph_hi; };
typedef const __attribute__((address_space(4))) Args* KA;

__device__ __forceinline__ void phaseA(KA P, int L, LAS unsigned char* lds, int vcu, int G, int wave, int lane, int tid) {
    LAS float* scr = (LAS float*)(lds + wave * 16384);
    const int gw = vcu * 8 + wave, NGW = G * 8;
    unsigned char* ws = P->p.ws;
    constexpr int I_WIN = 31 * 128, I_WO = 3 * 256, I_WOUT = 512, I_WPG = 512, I_WPLE = 128, I_WGU = 16 * 512, I_WDN = 16 * 256;
    constexpr int NITEMS = I_WIN + I_WO + I_WOUT + I_WPG + I_WPLE + I_WGU + I_WDN;
    for (int it = gw; it < NITEMS; it += NGW) {
        int r = it;
        if (r < I_WIN) { const int t = r / 128; tr_item(P->p.in[3] + (size_t)L * DM * INTOT, INTOT, win_src_col(t), DM, (bf16_t*)(ws + WS_WIN) + (size_t)t * 256 * DM, 256, t == 12 ? 16 : 256, scr, r % 128, lane); continue; } r -= I_WIN;
        if (r < I_WO) { const int j = r / 256; const float* src = (j == 0 ? P->p.in[7] : j == 1 ? P->p.in[10] : P->p.in[12]) + (size_t)L * 512 * DM;
            tr_item(src, DM, 0, 512, (bf16_t*)(ws + WS_WO) + (size_t)j * DM * 512, DM, DM, scr, r % 256, lane); continue; } r -= I_WO;
        if (r < I_WOUT) { tr_item(P->p.in[13] + (size_t)L * DM * DM, DM, 0, DM, (bf16_t*)(ws + WS_WOUT), DM, DM, scr, r, lane); continue; } r -= I_WOUT;
        if (r < I_WPG) { tr_item(P->p.in[22] + (size_t)L * DM * DM, DM, 0, DM, (bf16_t*)(ws + WS_WPG), DM, DM, scr, r, lane); continue; } r -= I_WPG;
        if (r < I_WPLE) { tr_item(P->p.in[21] + (size_t)L * PLE * DM, DM, 0, PLE, (bf16_t*)(ws + WS_WPLE), DM, DM, scr, r, lane); continue; } r -= I_WPLE;
        if (r < I_WGU) { const int e = r / 512, q = (r % 512) / 64, n = q >> 1, s = q & 1;
            tr_item(P->p.in[19] + (size_t)(L * NEXP + e) * DM * 1024, 1024, 512 * s + 128 * n, DM, (bf16_t*)(ws + WS_WGU) + (size_t)e * 1024 * DM + (size_t)(256 * n + 128 * s) * DM, 128, 128, scr, r % 64, lane); continue; } r -= I_WGU;
        { const int e = r / 256; tr_item(P->p.in[20] + (size_t)(L * NEXP + e) * DEXP * DM, DM, 0, DEXP, (bf16_t*)(ws + WS_WDN) + (size_t)e * DM * DEXP, DM, DM, scr, r % 256, lane); }
    }
    const float* xs = (L == 0) ? P->p.in[0] : P->p.out;
    for (int m = gw; m < NTOK; m += NGW) rms_row_bf16(xs + (size_t)m * DM, P->p.in[2] + (size_t)L * DM, (bf16_t*)(ws + WS_HN) + (size_t)m * DM, lane);
    const f32x4* ps = (const f32x4*)(P->p.in[1] + (size_t)L * NTOK * PLE); u32x2* pd = (u32x2*)(ws + WS_PB);
    for (int i = vcu * 512 + tid; i < NTOK * PLE / 4; i += G * 512) { const f32x4 v = ps[i]; u32x2 w; w.x = pk2(v.x, v.y); w.y = pk2(v.z, v.w); pd[i] = w; }
}

__device__ __forceinline__ float logsig16(float x) { return (fminf(x, 0.f) - log1pf(expf(-fabsf(x)))) * (1.0f / 16.0f); }
__device__ __forceinline__ void gla1_unit(int unit, bf16_t* Z, const float* wa2, const float* ba, bf16_t* SLOCT, float* DTAB, LAS unsigned char* lds, int wid, int lane, int tid) {
    const int bh = unit >> 8, c = unit & 255, b = bh >> 2, h = bh & 3; const size_t row0 = (size_t)b * T + (size_t)c * 64;
    LAS bf16_t* Qs = (LAS bf16_t*)lds; LAS bf16_t* Ks = (LAS bf16_t*)(lds + 8192); LAS bf16_t* KhT = (LAS bf16_t*)(lds + 16384); LAS bf16_t* VT = (LAS bf16_t*)(lds + 24576);
    LAS bf16_t* Am = (LAS bf16_t*)(lds + 40960); LAS float* WA = (LAS float*)(lds + 49152); LAS float* BA = (LAS float*)(lds + 53248);
    const int r32 = lane & 31, hi = lane >> 5;
    for (int i = tid; i < 1024; i += 512) WA[i] = wa2[(i >> 6) * 256 + h * 64 + (i & 63)];
    if (tid < 64) BA[tid] = ba[h * 64 + tid];
    __syncthreads();
    {
        const int t = lane, cb = wid * 8; const bf16_t* zr = Z + (row0 + t) * ZP;
        const u32x4 g0 = *(const u32x4*)(zr + C_GA), g1 = *(const u32x4*)(zr + C_GA + 8);
        float gaf[16]; gaf[0] = bflo(g0.x); gaf[1] = bfhi(g0.x); gaf[2] = bflo(g0.y); gaf[3] = bfhi(g0.y); gaf[4] = bflo(g0.z); gaf[5] = bfhi(g0.z); gaf[6] = bflo(g0.w); gaf[7] = bfhi(g0.w);
        gaf[8] = bflo(g1.x); gaf[9] = bfhi(g1.x); gaf[10] = bflo(g1.y); gaf[11] = bfhi(g1.y); gaf[12] = bflo(g1.z); gaf[13] = bfhi(g1.z); gaf[14] = bflo(g1.w); gaf[15] = bfhi(g1.w);
        float la[8];
#pragma unroll
        for (int i = 0; i < 8; ++i) { float x = BA[cb + i];
#pragma unroll
            for (int r = 0; r < 16; ++r) x = fmaf(gaf[r], WA[r * 64 + cb + i], x);
            la[i] = logsig16(x); }
#pragma unroll
        for (int off = 1; off < 64; off <<= 1) {
#pragma unroll
            for (int i = 0; i < 8; ++i) { const float y = __shfl_up(la[i], off); if (lane >= off) la[i] += y; } }
        const u32x4 qv = *(const u32x4*)(zr + C_GQ + h * 64 + cb), kv = *(const u32x4*)(zr + C_GK + h * 64 + cb);
        float qf[8], kf[8];
        qf[0] = bflo(qv.x); qf[1] = bfhi(qv.x); qf[2] = bflo(qv.y); qf[3] = bfhi(qv.y); qf[4] = bflo(qv.z); qf[5] = bfhi(qv.z); qf[6] = bflo(qv.w); qf[7] = bfhi(qv.w);
        kf[0] = bflo(kv.x); kf[1] = bfhi(kv.x); kf[2] = bflo(kv.y); kf[3] = bfhi(kv.y); kf[4] = bflo(kv.z); kf[5] = bfhi(kv.z); kf[6] = bflo(kv.w); kf[7] = bfhi(kv.w);
        float qs[8], ks[8];
#pragma unroll
        for (int i = 0; i < 8; ++i) { const float bl = __shfl(la[i], 63); const float eb = expf(la[i]);
            qs[i] = qf[i] * 0.125f * eb; ks[i] = kf[i] * expf(-la[i]);
            KhT[(cb + i) * 64 + t] = (bf16_t)f2bf(kf[i] * expf(bl - la[i]));
            if (lane == 63) DTAB[(size_t)unit * 64 + cb + i] = eb; }
        u32x4 qw, kw; qw.x = pk2(qs[0], qs[1]); qw.y = pk2(qs[2], qs[3]); qw.z = pk2(qs[4], qs[5]); qw.w = pk2(qs[6], qs[7]);
        kw.x = pk2(ks[0], ks[1]); kw.y = pk2(ks[2], ks[3]); kw.z = pk2(ks[4], ks[5]); kw.w = pk2(ks[6], ks[7]);
        *(LAS u32x4*)(Qs + t * 64 + cb) = qw; *(LAS u32x4*)(Ks + t * 64 + cb) = kw;
        *(u32x4*)(Z + (row0 + t) * ZP + C_GQ + h * 64 + cb) = qw;
        const u32x4 v0 = *(const u32x4*)(zr + C_GV + h * 128 + 16 * wid), v1 = *(const u32x4*)(zr + C_GV + h * 128 + 16 * wid + 8);
        LAS bf16_t* vt = VT + (16 * wid) * 64 + t;
        vt[0 * 64] = (bf16_t)(v0.x & 0xffff); vt[1 * 64] = (bf16_t)(v0.x >> 16); vt[2 * 64] = (bf16_t)(v0.y & 0xffff); vt[3 * 64] = (bf16_t)(v0.y >> 16);
        vt[4 * 64] = (bf16_t)(v0.z & 0xffff); vt[5 * 64] = (bf16_t)(v0.z >> 16); vt[6 * 64] = (bf16_t)(v0.w & 0xffff); vt[7 * 64] = (bf16_t)(v0.w >> 16);
        vt[8 * 64] = (bf16_t)(v1.x & 0xffff); vt[9 * 64] = (bf16_t)(v1.x >> 16); vt[10 * 64] = (bf16_t)(v1.y & 0xffff); vt[11 * 64] = (bf16_t)(v1.y >> 16);
        vt[12 * 64] = (bf16_t)(v1.z & 0xffff); vt[13 * 64] = (bf16_t)(v1.z >> 16); vt[14 * 64] = (bf16_t)(v1.w & 0xffff); vt[15 * 64] = (bf16_t)(v1.w >> 16);
    }
    __syncthreads();
    {
        const int vb = wid & 3, kb = wid >> 2; f32x16 acc = {};
#pragma unroll
        for (int ks = 0; ks < 4; ++ks) { const bf16x8 a = *(const LAS bf16x8*)(VT + (32 * vb + r32) * 64 + 16 * ks + 8 * hi); const bf16x8 bb = *(const LAS bf16x8*)(KhT + (32 * kb + r32) * 64 + 16 * ks + 8 * hi);
            acc = __builtin_amdgcn_mfma_f32_32x32x16_bf16(a, bb, acc, 0, 0, 0); }
        bf16_t* sp = SLOCT + (size_t)unit * 8192 + 32 * kb + r32;
#pragma unroll
        for (int r = 0; r < 16; ++r) sp[(32 * vb + crow(r, hi)) * 64] = (bf16_t)f2bf(acc[r]);
    }
    if (wid < 4) {
        const int sb = wid >> 1, tb = wid & 1; f32x16 acc = {};
        if (!(sb == 1 && tb == 0)) {
#pragma unroll
            for (int ks = 0; ks < 4; ++ks) { const bf16x8 a = *(const LAS bf16x8*)(Ks + (32 * sb + r32) * 64 + 16 * ks + 8 * hi); const bf16x8 bb = *(const LAS bf16x8*)(Qs + (32 * tb + r32) * 64 + 16 * ks + 8 * hi);
                acc = __builtin_amdgcn_mfma_f32_32x32x16_bf16(a, bb, acc, 0, 0, 0); }
        }
        const int t = 32 * tb + r32;
#pragma unroll
        for (int r = 0; r < 16; ++r) { const int s = 32 * sb + crow(r, hi); if (s > t) acc[r] = 0.f; }
#pragma unroll
        for (int g = 0; g < 4; ++g) { u32x2 w; w.x = pk2(acc[4 * g], acc[4 * g + 1]); w.y = pk2(acc[4 * g + 2], acc[4 * g + 3]); *(LAS u32x2*)(Am + t * 64 + 32 * sb + 8 * g + 4 * hi) = w; }
    }
    __syncthreads();
    {
        const int vb = wid & 3, tb = wid >> 2; f32x16 acc = {};
#pragma unroll
        for (int ks = 0; ks < 4; ++ks) { const bf16x8 a = *(const LAS bf16x8*)(Am + (32 * tb + r32) * 64 + 16 * ks + 8 * hi); const bf16x8 bb = *(const LAS bf16x8*)(VT + (32 * vb + r32) * 64 + 16 * ks + 8 * hi);
            acc = __builtin_amdgcn_mfma_f32_32x32x16_bf16(a, bb, acc, 0, 0, 0); }
        bf16_t* op = Z + (row0 + 32 * tb) * ZP + C_GV + h * 128 + 32 * vb + r32;
#pragma unroll
        for (int r = 0; r < 16; ++r) op[(size_t)crow(r, hi) * ZP] = (bf16_t)f2bf(acc[r]);
    }
    __syncthreads();
}

__device__ __forceinline__ void conv_ld_u(const bf16_t* Z, size_t row, int ch, float (&u)[8]) {
    const u32x4 a = *(const u32x4*)(Z + row * ZP + C_CX + ch), c = *(const u32x4*)(Z + row * ZP + C_CC + ch);
    u[0] = bflo(a.x) * bflo(c.x); u[1] = bfhi(a.x) * bfhi(c.x); u[2] = bflo(a.y) * bflo(c.y); u[3] = bfhi(a.y) * bfhi(c.y);
    u[4] = bflo(a.z) * bflo(c.z); u[5] = bfhi(a.z) * bfhi(c.z); u[6] = bflo(a.w) * bflo(c.w); u[7] = bfhi(a.w) * bfhi(c.w);
}
__device__ __forceinline__ void conv_unit(int cu, bf16_t* Z, const float* cw  , int wid, int lane) {
    const int ch = lane * 8; const size_t r0 = (size_t)cu * 128 + (size_t)wid * 16;
    float w0[8], w1[8], w2[8];
#pragma unroll
    for (int i = 0; i < 8; ++i) { w0[i] = cw[ch + i]; w1[i] = cw[512 + ch + i]; w2[i] = cw[1024 + ch + i]; }
    float u2[8], u1[8];
    if ((r0 % T) == 0) {
#pragma unroll
        for (int i = 0; i < 8; ++i) { u2[i] = 0.f; u1[i] = 0.f; }
    } else { conv_ld_u(Z, r0 - 2, ch, u2); conv_ld_u(Z, r0 - 1, ch, u1); }
    for (int i = 0; i < 16; ++i) { const size_t row = r0 + i; float u[8]; conv_ld_u(Z, row, ch, u);
        const u32x4 bq = *(const u32x4*)(Z + row * ZP + C_CB + ch);
        float bb[8]; bb[0] = bflo(bq.x); bb[1] = bfhi(bq.x); bb[2] = bflo(bq.y); bb[3] = bfhi(bq.y); bb[4] = bflo(bq.z); bb[5] = bfhi(bq.z); bb[6] = bflo(bq.w); bb[7] = bfhi(bq.w);
        float y[8];
#pragma unroll
        for (int k = 0; k < 8; ++k) { y[k] = bb[k] * (w0[k] * u2[k] + w1[k] * u1[k] + w2[k] * u[k]); u2[k] = u1[k]; u1[k] = u[k]; }
        u32x4 o; o.x = pk2(y[0], y[1]); o.y = pk2(y[2], y[3]); o.z = pk2(y[4], y[5]); o.w = pk2(y[6], y[7]);
        *(u32x4*)(Z + row * ZP + C_OC + ch) = o; }
}
namespace att {
constexpr int KVBLK = 64;
constexpr size_t SHM_V = 64 * 128 * 2, SHM_K = 64 * 128 * 2;
constexpr float C = 0.125f * 1.4426950408889634f;
constexpr float THR2 = 10.f;
#define KSWZ(row, colB) ((row) * 256 + ((colB) ^ (((row) & 7) << 4)))
#define SBAR() __builtin_amdgcn_sched_barrier(0)
__device__ __forceinline__ unsigned cvtpk(float lo, float hi) { unsigned r; asm volatile("v_cvt_pk_bf16_f32 %0, %1, %2" : "=v"(r) : "v"(lo), "v"(hi)); return r; }

__device__ __forceinline__ void partialSM(f32x16& p0, f32x16& p1, float& m_reg, float& mn, float& alpha, float kb0, float slope2, bool band, int dlim) {
#pragma unroll
    for (int r = 0; r < 16; ++r) { const float cr = (float)((r & 3) + 8 * (r >> 2)); p0[r] = fmaf(p0[r], C, fmaf(slope2, cr, kb0)); p1[r] = fmaf(p1[r], C, fmaf(slope2, cr + 32.f, kb0)); }
    if (band) {
#pragma unroll
        for (int r = 0; r < 16; ++r) { const int cr = (r & 3) + 8 * (r >> 2); if (cr > dlim) p0[r] = -1e30f; if (cr + 32 > dlim) p1[r] = -1e30f; }
    }
    float pmax = p0[0];
#pragma unroll
    for (int r = 1; r < 16; ++r) pmax = fmaxf(pmax, p0[r]);
#pragma unroll
    for (int r = 0; r < 16; ++r) pmax = fmaxf(pmax, p1[r]);
    { auto rr = __builtin_amdgcn_permlane32_swap(__float_as_uint(pmax), __float_as_uint(pmax), false, false);
      pmax = fmaxf(__uint_as_float(rr[0]), __uint_as_float(rr[1])); }
    if (__builtin_expect(__all(pmax - m_reg <= THR2), 1)) { mn = m_reg; alpha = 1.f; }
    else { mn = fmaxf(m_reg, pmax); alpha = __builtin_amdgcn_exp2f(m_reg - mn); m_reg = mn; }
#pragma unroll
    for (int r = 0; r < 16; ++r) { p0[r] -= mn; p1[r] -= mn; }
#pragma unroll
    for (int r = 0; r < 16; ++r) p0[r] = __builtin_amdgcn_exp2f(p0[r]);
}
__device__ __forceinline__ void finishSM(f32x16& p0, f32x16& p1, float alpha, float& l_reg, bf16x8& pa0, bf16x8& pa1, bf16x8& pa2, bf16x8& pa3) {
#pragma unroll
    for (int r = 0; r < 16; ++r) p1[r] = __builtin_amdgcn_exp2f(p1[r]);
    float ps = 0;
#pragma unroll
    for (int r = 0; r < 16; ++r) ps += p0[r];
#pragma unroll
    for (int r = 0; r < 16; ++r) ps += p1[r];
    { auto rr = __builtin_amdgcn_permlane32_swap(__float_as_uint(ps), __float_as_uint(ps), false, false);
      ps = __uint_as_float(rr[0]) + __uint_as_float(rr[1]); }
    l_reg = l_reg * alpha + ps;
#define PK4(P, BASE, OUT) do { unsigned a0 = cvtpk(P[BASE + 0], P[BASE + 1]), a1 = cvtpk(P[BASE + 2], P[BASE + 3]);   \
    unsigned b0 = cvtpk(P[BASE + 4], P[BASE + 5]), b1 = cvtpk(P[BASE + 6], P[BASE + 7]);                              \
    auto r0 = __builtin_amdgcn_permlane32_swap(a0, b0, false, false); auto r1 = __builtin_amdgcn_permlane32_swap(a1, b1, false, false); \
    u32x4 w = {r0[0], r1[0], r0[1], r1[1]}; OUT = *reinterpret_cast<bf16x8*>(&w); } while (0)
    PK4(p0, 0, pa0); PK4(p0, 8, pa1); PK4(p1, 0, pa2); PK4(p1, 8, pa3);
#undef PK4
}
__device__ __forceinline__ void qkt(f32x16& p0, f32x16& p1, const char* Ks, const bf16x8* qr, int r32, int hi, int m) {
    p0 = f32x16{}; p1 = f32x16{};
#pragma unroll
    for (int d0 = 0; d0 < 4; ++d0) { const int cb = ((4 * m + d0) * 16 + hi * 8) * 2;
        const bf16x8 b0 = *reinterpret_cast<const bf16x8*>(Ks + KSWZ(r32, cb));
        const bf16x8 b1 = *reinterpret_cast<const bf16x8*>(Ks + KSWZ(32 + r32, cb));
        p0 = __builtin_amdgcn_mfma_f32_32x32x16_bf16(b0, qr[d0], p0, 0, 0, 0);
        p1 = __builtin_amdgcn_mfma_f32_32x32x16_bf16(b1, qr[d0], p1, 0, 0, 0); }
}
__device__ __forceinline__ int v_st(int k, int c) { const int kk = (k & ~0xC) | ((k & 4) << 1) | ((k & 8) >> 1); return ((kk >> 3) * 4 + (c >> 5)) * 512 + ((kk & 7) * 32 + (c & 31)) * 2; }
__device__ __forceinline__ int v_rd_base(int lane) { return ((lane & 3) << 3) | (((lane >> 2) & 3) << 6) | (((lane >> 4) & 1) << 5) | (((lane >> 5) & 1) << 8); }
constexpr int v_rd_off(int d0, int ks, int half) { return d0 * 512 + ks * 4096 + half * 2048; }
template <int OFF> __device__ __forceinline__ s16x4 tr_read(int vb) {
    s16x4 r; asm volatile("ds_read_b64_tr_b16 %0, %1 offset:%2" : "=&v"(r) : "v"(vb), "i"(OFF) : "memory"); return r;
}
template <int D0> __device__ __forceinline__ void pv_one(f32x16& od, int vb, bf16x8 pa0, bf16x8 pa1, bf16x8 pa2, bf16x8 pa3) {
    const s16x4 l0 = tr_read<v_rd_off(D0, 0, 0)>(vb), h0 = tr_read<v_rd_off(D0, 0, 1)>(vb), l1 = tr_read<v_rd_off(D0, 1, 0)>(vb), h1 = tr_read<v_rd_off(D0, 1, 1)>(vb);
    const s16x4 l2 = tr_read<v_rd_off(D0, 2, 0)>(vb), h2 = tr_read<v_rd_off(D0, 2, 1)>(vb), l3 = tr_read<v_rd_off(D0, 3, 0)>(vb), h3 = tr_read<v_rd_off(D0, 3, 1)>(vb);
    asm volatile("s_waitcnt lgkmcnt(0)" ::: "memory"); SBAR();
#define PK(L, H) (bf16x8){L[0], L[1], L[2], L[3], H[0], H[1], H[2], H[3]}
    od = __builtin_amdgcn_mfma_f32_32x32x16_bf16(pa0, PK(l0, h0), od, 0, 0, 0);
    od = __builtin_amdgcn_mfma_f32_32x32x16_bf16(pa1, PK(l1, h1), od, 0, 0, 0);
    od = __builtin_amdgcn_mfma_f32_32x32x16_bf16(pa2, PK(l2, h2), od, 0, 0, 0);
    od = __builtin_amdgcn_mfma_f32_32x32x16_bf16(pa3, PK(l3, h3), od, 0, 0, 0);
#undef PK
}
__device__ __forceinline__ void pv_d0(f32x16* o, int vb, bf16x8 pa0, bf16x8 pa1, bf16x8 pa2, bf16x8 pa3) {
    pv_one<0>(o[0], vb, pa0, pa1, pa2, pa3); pv_one<1>(o[1], vb, pa0, pa1, pa2, pa3); pv_one<2>(o[2], vb, pa0, pa1, pa2, pa3); pv_one<3>(o[3], vb, pa0, pa1, pa2, pa3);
}

__device__ __forceinline__ void unit(int b, int h, int qb, float lam, float oneml, bf16_t* Z, const float* gdiff, char* lds) {
    int tid_l = threadIdx.x; asm volatile("" : "+v"(tid_l)); const int tid = tid_l;
    const int wid = tid >> 6, lane = tid & 63, r32 = lane & 31, hi = lane >> 5, m = wid >> 2, rb = wid & 3;
    const size_t rowbase = (size_t)b * T; const int q0 = qb * 128;
    const float slope2 = exp2f(-2.f * (float)(h + 1)) * 1.4426950408889634f;
    char* V_lds = lds; char* K_lds = lds + 2 * SHM_V;
    float* wsf = (float*)(lds + 2 * SHM_V + 2 * SHM_K) + wid * 64; float* li_l = wsf; float* al_l = wsf + 32;
    float m_reg = -1e30f, l_reg = 0; f32x16 o[4] = {}; bf16x8 qr[4];
    const bf16_t* Qw = Z + (rowbase + q0 + rb * 32 + r32) * ZP + C_DQ + h * 128 + m * 64 + hi * 8;
#pragma unroll
    for (int d0 = 0; d0 < 4; ++d0) qr[d0] = *reinterpret_cast<const bf16x8*>(Qw + d0 * 16);
    const bf16_t* Kh = Z + rowbase * ZP + C_DK + h * 128; const bf16_t* Vh = Z + rowbase * ZP + C_DV + h * 128;
    const int sr = tid >> 4, sc = (tid & 15) * 8, vst0 = v_st(sr, sc), vst1 = v_st(32 + sr, sc);
    const int vb0 = (int)(uintptr_t)V_lds + v_rd_base(lane);
    const int qrel = q0 + rb * 32 + r32;
    struct { bf16x8 vs0, vs1, ks0, ks1; } sr_[2];
#define SLOAD(i, k0) do { sr_[i].vs0 = *reinterpret_cast<const bf16x8*>(&Vh[(size_t)((k0) + sr) * ZP + sc]); sr_[i].vs1 = *reinterpret_cast<const bf16x8*>(&Vh[(size_t)((k0) + 32 + sr) * ZP + sc]); \
    sr_[i].ks0 = *reinterpret_cast<const bf16x8*>(&Kh[(size_t)((k0) + sr) * ZP + sc]); sr_[i].ks1 = *reinterpret_cast<const bf16x8*>(&Kh[(size_t)((k0) + 32 + sr) * ZP + sc]); } while (0)
#define SWRITE(bb, i) do { *(bf16x8*)(V_lds + (bb) * SHM_V + vst0) = sr_[i].vs0;          \
    *(bf16x8*)(V_lds + (bb) * SHM_V + vst1) = sr_[i].vs1; const int kc = sc * 2;               \
    *(bf16x8*)(K_lds + (bb) * SHM_K + KSWZ(sr, kc)) = sr_[i].ks0;                       \
    *(bf16x8*)(K_lds + (bb) * SHM_K + KSWZ(32 + sr, kc)) = sr_[i].ks1; } while (0)
#define SWAIT() asm volatile("s_waitcnt vmcnt(4)" ::: "memory")
#define RESC(a) do { if (__any((a) < 1.f)) { if (hi == 0) al_l[r32] = (a); asm volatile("s_waitcnt lgkmcnt(0)" ::: "memory"); \
    _Pragma("unroll") for (int d = 0; d < 4; ++d) _Pragma("unroll") for (int r = 0; r < 16; ++r) o[d][r] *= al_l[crow(r, hi)]; } } while (0)
#define PSM(P0, P1, MN, AL, j) partialSM(P0, P1, m_reg, MN, AL, slope2 * (float)(64 * (j) + 4 * hi - qrel), slope2, (j) >= NT - 2, qrel - 64 * (j) - 4 * hi)
    f32x16 pA0, pA1, pB0, pB1; float mnA, mnB, alA, alB; bf16x8 pa0, pa1, pa2, pa3; const int NT = 2 * (qb + 1);
    constexpr int SE = 0, SO = 1;
    SLOAD(SE, 0); asm volatile("s_waitcnt vmcnt(0)" ::: "memory"); SWRITE(0, SE); __syncthreads();
    qkt(pA0, pA1, K_lds, qr, r32, hi, m); PSM(pA0, pA1, mnA, alA, 0);
    SLOAD(SO, KVBLK); if (2 < NT) SLOAD(SE, 2 * KVBLK);
    SWAIT(); SWRITE(1, SO); __syncthreads();
    for (int j = 1; j + 1 < NT; j += 2) {
        SBAR(); qkt(pB0, pB1, K_lds + SHM_K, qr, r32, hi, m);
        finishSM(pA0, pA1, alA, l_reg, pa0, pa1, pa2, pa3); SBAR();
        SLOAD(SO, (j + 2) * KVBLK); SBAR();
        pv_d0(o, vb0, pa0, pa1, pa2, pa3); PSM(pB0, pB1, mnB, alB, j);
        __syncthreads(); SWAIT(); SWRITE(0, SE);
        RESC(alB); __syncthreads();
        SBAR(); qkt(pA0, pA1, K_lds, qr, r32, hi, m);
        finishSM(pB0, pB1, alB, l_reg, pa0, pa1, pa2, pa3); SBAR();
        if (j + 3 < NT) SLOAD(SE, (j + 3) * KVBLK); SBAR();
        pv_d0(o, vb0 + (int)SHM_V, pa0, pa1, pa2, pa3); PSM(pA0, pA1, mnA, alA, j + 1);
        __syncthreads(); SWAIT(); SWRITE(1, SO);
        RESC(alA); __syncthreads();
    }
    SBAR(); qkt(pB0, pB1, K_lds + SHM_K, qr, r32, hi, m);
    finishSM(pA0, pA1, alA, l_reg, pa0, pa1, pa2, pa3); SBAR();
    pv_d0(o, vb0, pa0, pa1, pa2, pa3); PSM(pB0, pB1, mnB, alB, NT - 1);
    __syncthreads(); RESC(alB);
    finishSM(pB0, pB1, alB, l_reg, pa0, pa1, pa2, pa3); SBAR();
    pv_d0(o, vb0 + (int)SHM_V, pa0, pa1, pa2, pa3);
    if (hi == 0) li_l[r32] = l_reg; asm volatile("s_waitcnt lgkmcnt(0)" ::: "memory");
    float rli[16];
#pragma unroll
    for (int r = 0; r < 16; ++r) rli[r] = __builtin_amdgcn_rcpf(li_l[crow(r, hi)]);
    __syncthreads();
    float* XO = (float*)lds + rb * 4096;
    if (m == 1) {
#pragma unroll
        for (int d0 = 0; d0 < 4; ++d0)
#pragma unroll
            for (int r = 0; r < 16; ++r) XO[(d0 * 16 + r) * 64 + lane] = o[d0][r] * rli[r];
    }
    __syncthreads();
    if (m == 0) {
        float ss[16];
#pragma unroll
        for (int r = 0; r < 16; ++r) ss[r] = 0.f;
#pragma unroll
        for (int d0 = 0; d0 < 4; ++d0)
#pragma unroll
            for (int r = 0; r < 16; ++r) { const float v = o[d0][r] * rli[r] - lam * XO[(d0 * 16 + r) * 64 + lane]; o[d0][r] = v; ss[r] += v * v; }
#pragma unroll
        for (int r = 0; r < 16; ++r) {
#pragma unroll
            for (int x = 1; x < 32; x <<= 1) ss[r] += __shfl_xor(ss[r], x);
            ss[r] = oneml / sqrtf(ss[r] * (1.f / 128.f) + EPS); }
        bf16_t* Ow = Z + (rowbase + q0 + rb * 32) * ZP + C_OB + h * 128 + r32;
#pragma unroll
        for (int d0 = 0; d0 < 4; ++d0) { const float gc = gdiff[32 * d0 + r32];
#pragma unroll
            for (int r = 0; r < 16; ++r) Ow[(size_t)crow(r, hi) * ZP + 32 * d0] = (bf16_t)f2bf(o[d0][r] * ss[r] * gc); }
    }
    __syncthreads();
#undef SLOAD
#undef SWRITE
#undef SWAIT
#undef RESC
#undef PSM
}
#undef KSWZ
#undef SBAR
}

__device__ __forceinline__ void gla_scan(bf16_t* SLOCT, const float* DTAB, int G, int tid) {
    if (tid >= 128) return;
    for (int pi = blockIdx.x * 128 + tid; pi < 32768; pi += G * 128) {
        const int bh = pi >> 12, e2 = (pi & 4095) * 2, dk = e2 & 63;
        float r0 = 0.f, r1 = 0.f;
        unsigned* sp = (unsigned*)(SLOCT + (size_t)bh * 256 * 8192 + e2); const float* dp = DTAB + (size_t)bh * 256 * 64 + dk;
        for (int c0 = 0; c0 < 256; c0 += 8) {
            unsigned u[8]; f32x2 d[8];
#pragma unroll
            for (int i = 0; i < 8; ++i) { u[i] = sp[(size_t)(c0 + i) * 4096]; d[i] = *(const f32x2*)(dp + (size_t)(c0 + i) * 64); }
#pragma unroll
            for (int i = 0; i < 8; ++i) { sp[(size_t)(c0 + i) * 4096] = pk2(r0, r1); r0 = fmaf(d[i].x, r0, bflo(u[i])); r1 = fmaf(d[i].y, r1, bfhi(u[i])); }
        }
    }
}

__device__ __forceinline__ void gla3_unit(int unit, bf16_t* Z, const bf16_t* SLOCT, const float* ggn, LAS unsigned char* lds, int wid, int lane) {
    const int bh = unit >> 8, c = unit & 255, b = bh >> 2, h = bh & 3; const size_t row0 = (size_t)b * T + (size_t)c * 64;
    const int r32 = lane & 31, hi = lane >> 5, vb = wid & 3, tb = wid >> 2;
    LAS float* SS = (LAS float*)lds;
    f32x16 acc = {};
#pragma unroll
    for (int ks = 0; ks < 4; ++ks) { const bf16x8 a = *(const bf16x8*)(Z + (row0 + 32 * tb + r32) * ZP + C_GQ + h * 64 + 16 * ks + 8 * hi);
        const bf16x8 bb = *(const bf16x8*)(SLOCT + (size_t)unit * 8192 + (32 * vb + r32) * 64 + 16 * ks + 8 * hi);
        acc = __builtin_amdgcn_mfma_f32_32x32x16_bf16(a, bb, acc, 0, 0, 0); }
    const bf16_t* oi = Z + (row0 + 32 * tb) * ZP + C_GV + h * 128 + 32 * vb + r32;
    float o[16], ss[16];
#pragma unroll
    for (int r = 0; r < 16; ++r) { o[r] = acc[r] + bf2f(oi[(size_t)crow(r, hi) * ZP]); ss[r] = o[r] * o[r]; }
#pragma unroll
    for (int r = 0; r < 16; ++r) {
#pragma unroll
        for (int x = 1; x < 32; x <<= 1) ss[r] += __shfl_xor(ss[r], x);
        if (r32 == 0) SS[wid * 32 + crow(r, hi)] = ss[r]; }
    __syncthreads();
    const float gcol = ggn[32 * vb + r32];
    bf16_t* gp = Z + (row0 + 32 * tb) * ZP + C_GG + h * 128 + 32 * vb + r32;
#pragma unroll
    for (int r = 0; r < 16; ++r) { const int tr = crow(r, hi);
        const float tot = (SS[(tb * 4 + 0) * 32 + tr] + SS[(tb * 4 + 1) * 32 + tr]) + (SS[(tb * 4 + 2) * 32 + tr] + SS[(tb * 4 + 3) * 32 + tr]);
        const float rstd = 1.0f / sqrtf(tot * (1.f / 128.f) + EPS);
        const float gg = bf2f(gp[(size_t)tr * ZP]);
        gp[(size_t)tr * ZP] = (bf16_t)f2bf(o[r] * rstd * gcol * siluf_(gg)); }
    __syncthreads();
}
namespace pg8 {
struct EpiMerge {
    static constexpr bool PERM = true;
    bf16_t* Z;
    __device__ __forceinline__ void operator()(const f32x4 (&acc)[2][2][4][2], const Unit& u, int wr, int wc, int fr, int fq) const {
        const int j = u.tag; const int row0 = u.pm * BM + wr * 64 + fr; const int col0 = u.pn * BM + wc * 32 + 8 * fq;
#pragma unroll
        for (int ai = 0; ai < 2; ++ai)
#pragma unroll
            for (int m = 0; m < 4; ++m) { bf16_t* rowp = Z + (size_t)(row0 + ai * HALF + m * 16) * ZP + col0;
#pragma unroll
                for (int bj = 0; bj < 2; ++bj) { const f32x4 v0 = acc[ai][bj][m][0], v1 = acc[ai][bj][m][1];
                    const u32x4 y = *(const u32x4*)(rowp + bj * HALF + 1024 * j);
                    u32x4 pv = {0u, 0u, 0u, 0u}; if (j > 0) pv = *(const u32x4*)(rowp + bj * HALF);
                    u32x4 w;
                    w.x = pk2(fmaf(sigmoidf_(v0[0]), bflo(y.x), bflo(pv.x)), fmaf(sigmoidf_(v0[1]), bfhi(y.x), bfhi(pv.x)));
                    w.y = pk2(fmaf(sigmoidf_(v0[2]), bflo(y.y), bflo(pv.y)), fmaf(sigmoidf_(v0[3]), bfhi(y.y), bfhi(pv.y)));
                    w.z = pk2(fmaf(sigmoidf_(v1[0]), bflo(y.z), bflo(pv.z)), fmaf(sigmoidf_(v1[1]), bfhi(y.z), bfhi(pv.z)));
                    w.w = pk2(fmaf(sigmoidf_(v1[2]), bflo(y.w), bflo(pv.w)), fmaf(sigmoidf_(v1[3]), bfhi(y.w), bfhi(pv.w)));
                    *(u32x4*)(rowp + bj * HALF) = w; }
                asm volatile("" ::: "memory"); }
    }
};
struct EpiRes {
    static constexpr bool PERM = false;
    const float* base; float* out;
    __device__ __forceinline__ void operator()(const f32x4 (&acc)[2][2][4][2], const Unit& u, int wr, int wc, int fr, int fq) const {
        const int row0 = u.pm * BM + wr * 64 + fr; const int col0 = u.pn * BM + wc * 32 + 4 * fq;
#pragma unroll
        for (int ai = 0; ai < 2; ++ai)
#pragma unroll
            for (int m = 0; m < 4; ++m) { const size_t off = (size_t)(row0 + ai * HALF + m * 16) * DM + col0;
#pragma unroll
                for (int bj = 0; bj < 2; ++bj)
#pragma unroll
                    for (int n = 0; n < 2; ++n) { const f32x4 bs = *(const f32x4*)(base + off + bj * HALF + n * 16); *(f32x4*)(out + off + bj * HALF + n * 16) = bs + acc[ai][bj][m][n]; } }
    }
};
struct EpiPle {
    static constexpr bool PERM = false;
    const float* base; float* out; const bf16_t* PL;
    __device__ __forceinline__ void operator()(const f32x4 (&acc)[2][2][4][2], const Unit& u, int wr, int wc, int fr, int fq) const {
        const int row0 = u.pm * BM + wr * 64 + fr; const int col0 = u.pn * BM + wc * 32 + 4 * fq;
#pragma unroll
        for (int ai = 0; ai < 2; ++ai)
#pragma unroll
            for (int m = 0; m < 4; ++m) { const size_t off = (size_t)(row0 + ai * HALF + m * 16) * DM + col0;
#pragma unroll
                for (int bj = 0; bj < 2; ++bj)
#pragma unroll
                    for (int n = 0; n < 2; ++n) { const f32x4 bs = *(const f32x4*)(base + off + bj * HALF + n * 16); const u32x2 pl = *(const u32x2*)(PL + off + bj * HALF + n * 16); const f32x4 a = acc[ai][bj][m][n];
                        f32x4 o; o.x = fmaf(sigmoidf_(a.x), bflo(pl.x), bs.x); o.y = fmaf(sigmoidf_(a.y), bfhi(pl.x), bs.y); o.z = fmaf(sigmoidf_(a.z), bflo(pl.y), bs.z); o.w = fmaf(sigmoidf_(a.w), bfhi(pl.y), bs.w);
                        *(f32x4*)(out + off + bj * HALF + n * 16) = o; } }
    }
};
struct EpiUp {
    static constexpr bool PERM = true;
    bf16_t* ACT;
    __device__ __forceinline__ void operator()(const f32x4 (&acc)[2][2][4][2], const Unit& u, int wr, int wc, int fr, int fq) const {
        const int row0 = u.pm * BM + wr * 64 + fr; const int col0 = u.pn * HALF + wc * 32 + 8 * fq;
#pragma unroll
        for (int ai = 0; ai < 2; ++ai)
#pragma unroll
            for (int m = 0; m < 4; ++m) { const f32x4 g0 = acc[ai][0][m][0], g1 = acc[ai][0][m][1], u0 = acc[ai][1][m][0], u1 = acc[ai][1][m][1];
                u32x4 w; w.x = pk2(siluf_(g0[0]) * u0[0], siluf_(g0[1]) * u0[1]); w.y = pk2(siluf_(g0[2]) * u0[2], siluf_(g0[3]) * u0[3]);
                w.z = pk2(siluf_(g1[0]) * u1[0], siluf_(g1[1]) * u1[1]); w.w = pk2(siluf_(g1[2]) * u1[2], siluf_(g1[3]) * u1[3]);
                *(u32x4*)(ACT + (size_t)(row0 + ai * HALF + m * 16) * DEXP + col0) = w; }
    }
};
struct EpiDown {
    static constexpr bool PERM = true;
    bf16_t* Y; const float* sw;
    __device__ __forceinline__ void operator()(const f32x4 (&acc)[2][2][4][2], const Unit& u, int wr, int wc, int fr, int fq) const {
        const int row0 = u.pm * BM + wr * 64 + fr; const int col0 = u.pn * BM + wc * 32 + 8 * fq;
#pragma unroll
        for (int ai = 0; ai < 2; ++ai)
#pragma unroll
            for (int m = 0; m < 4; ++m) { const int row = row0 + ai * HALF + m * 16; const float s = sw[row]; bf16_t* rowp = Y + (size_t)row * DM + col0;
#pragma unroll
                for (int bj = 0; bj < 2; ++bj) { const f32x4 v0 = acc[ai][bj][m][0] * s, v1 = acc[ai][bj][m][1] * s;
                    u32x4 w; w.x = pk2(v0[0], v0[1]); w.y = pk2(v0[2], v0[3]); w.z = pk2(v1[0], v1[1]); w.w = pk2(v1[2], v1[3]);
                    *(u32x4*)(rowp + bj * HALF) = w; } }
    }
};
struct MergeOrder {
    int c, G; int abase, astep; size_t bbase, bstep;
    __device__ bool next(int i, Unit& u) const { const int pair = (i / 3) * G + c, j = i % 3; if (pair >= 512) return false;
        u.pm = pair >> 2; u.pn = pair & 3; u.tag = j; u.aoff = abase + j * astep; u.boff = bbase + (size_t)j * bstep; return true; }
};
struct GroupOrder {
    const int* tbl;
    int c, G; size_t bstride;
    __device__ bool next(int i, Unit& u) const {
        int L = i * G + c; int found = 0, pm = 0, pn = 0, ee = 0;
#pragma unroll
        for (int e = 0; e < NEXP; ++e) { const int nt_e = (tbl[16 + e] + 255) >> 8, nu = nt_e * 4;
            if (!found && L < nu) { found = 1; pm = (tbl[e] >> 8) + (L >> 2); pn = L & 3; ee = e; }
            if (!found) L -= nu; }
        if (!found) return false;
        u.pm = pm; u.pn = pn; u.tag = ee; u.aoff = 0; u.boff = (size_t)ee * bstride; return true; }
};
}

__device__ __forceinline__ void phaseF(KA P, int L, LAS unsigned char* lds, int wave, int lane, int tid) {
    LAS float* WR = (LAS float*)lds; LAS int* E0 = (LAS int*)(lds + 81920); LAS int* E1 = (LAS int*)(lds + 82432); LAS float* W0 = (LAS float*)(lds + 82944); LAS float* W1 = (LAS float*)(lds + 83456);
    const float* wrg = P->p.in[15] + (size_t)L * DM * 4; const float* wre = P->p.in[17] + (size_t)L * DM * 16;
    for (int i = tid; i < DM * 4; i += 512) WR[(i & 3) * 1024 + (i >> 2)] = wrg[i];
    for (int i = tid; i < DM * 16; i += 512) WR[(4 + (i & 15)) * 1024 + (i >> 4)] = wre[i];
    __syncthreads();
    const float* brg = P->p.in[16] + L * 4; const float* bre = P->p.in[18] + L * 16; const float* g = P->p.in[14] + (size_t)L * DM;
    const int tok0 = blockIdx.x * TPW;
    int* RE0 = (int*)(P->p.ws + WS_ROUTE); int* RE1 = RE0 + NTOK; float* RW0 = (float*)(RE1 + NTOK); float* RW1 = RW0 + NTOK;
    for (int i = wave * 16; i < wave * 16 + 16; ++i) {
        const int tok = tok0 + i;
        const f32x4* xr = (const f32x4*)(P->p.out + (size_t)tok * DM) + lane; const f32x4* gr = (const f32x4*)g + lane;
        f32x4 v[4]; float s = 0.f;
#pragma unroll
        for (int j = 0; j < 4; ++j) { v[j] = xr[64 * j]; s += (v[j].x * v[j].x + v[j].y * v[j].y) + (v[j].z * v[j].z + v[j].w * v[j].w); }
        const float r = 1.0f / sqrtf(wave_sum(s) * (1.f / DM) + EPS);
        u32x2* o8 = (u32x2*)((bf16_t*)(P->p.ws + WS_HN) + (size_t)tok * DM) + lane;
#pragma unroll
        for (int j = 0; j < 4; ++j) { const f32x4 gg = gr[64 * j]; v[j].x *= r * gg.x; v[j].y *= r * gg.y; v[j].z *= r * gg.z; v[j].w *= r * gg.w;
            u32x2 w; w.x = pk2(v[j].x, v[j].y); w.y = pk2(v[j].z, v[j].w); o8[64 * j] = w; }
        float lg[20];
#pragma unroll
        for (int o = 0; o < 20; ++o) { float a = 0.f;
#pragma unroll
            for (int j = 0; j < 4; ++j) { const f32x4 w = *(const LAS f32x4*)(WR + o * 1024 + 256 * j + 4 * lane); a += (v[j].x * w.x + v[j].y * w.y) + (v[j].z * w.z + v[j].w * w.w); }
            lg[o] = wave_sum(a); }
        float gl[4];
#pragma unroll
        for (int q = 0; q < 4; ++q) gl[q] = lg[q] + brg[q];
        int gi = 0; float gm = gl[0];
#pragma unroll
        for (int q = 1; q < 4; ++q) if (gl[q] > gm) { gm = gl[q]; gi = q; }
        float den = 0.f;
#pragma unroll
        for (int q = 0; q < 4; ++q) den += expf(gl[q] - gm);
        const float gp = 1.0f / den;
        float wv[4];
#pragma unroll
        for (int q = 0; q < 4; ++q) { const float e0v = lg[4 + q] + bre[q], e1v = lg[8 + q] + bre[4 + q], e2v = lg[12 + q] + bre[8 + q], e3v = lg[16 + q] + bre[12 + q];
            wv[q] = gi == 0 ? e0v : gi == 1 ? e1v : gi == 2 ? e2v : e3v; }
        int i0 = 0; float m0 = wv[0];
#pragma unroll
        for (int q = 1; q < 4; ++q) if (wv[q] > m0) { m0 = wv[q]; i0 = q; }
        int i1 = -1; float m1 = 0.f;
#pragma unroll
        for (int q = 0; q < 4; ++q) if (q != i0 && (i1 < 0 || wv[q] > m1)) { m1 = wv[q]; i1 = q; }
        const float t = expf(m1 - m0); const float w0 = gp / (1.f + t), w1 = gp * t / (1.f + t);
        if (lane == 0) { const int e0 = gi * 4 + i0, e1 = gi * 4 + i1; E0[i] = e0; E1[i] = e1; W0[i] = w0; W1[i] = w1; RE0[tok] = e0; RE1[tok] = e1; RW0[tok] = w0; RW1[tok] = w1; }
    }
    __syncthreads();
    if (tid < 16) { int cnt = 0; for (int i = 0; i < TPW; ++i) cnt += (E0[i] == tid) + (E1[i] == tid); ((int*)(P->p.ws + WS_HIST))[blockIdx.x * 16 + tid] = cnt; }
    __syncthreads();
}

__device__ __forceinline__ void phaseG(KA P, LAS unsigned char* lds, int wave, int lane, int tid) {
    LAS int* E0 = (LAS int*)lds; LAS int* E1 = (LAS int*)(lds + 512); LAS int* S0 = (LAS int*)(lds + 1024); LAS int* S1 = (LAS int*)(lds + 1536);
    LAS int* TOT = (LAS int*)(lds + 2048); LAS int* PRE = (LAS int*)(lds + 2112); LAS int* EB = (LAS int*)(lds + 2176);
    const int* HIST = (const int*)(P->p.ws + WS_HIST); const int tok0 = blockIdx.x * TPW;
    const int* RE0 = (const int*)(P->p.ws + WS_ROUTE); const int* RE1 = RE0 + NTOK; const float* RW0 = (const float*)(RE1 + NTOK); const float* RW1 = RW0 + NTOK;
    LAS int* PT = (LAS int*)(lds + 4096); LAS int* PP = (LAS int*)(lds + 4096 + 2048);
    { const int e = tid & 15, part = tid >> 4; int tot = 0, pre = 0;
#pragma unroll
      for (int k = 0; k < 8; ++k) { const int w = part * 8 + k; const int hv = HIST[w * 16 + e]; tot += hv; if (w < (int)blockIdx.x) pre += hv; }
      PT[part * 16 + e] = tot; PP[part * 16 + e] = pre; }
    if (tid < TPW) { E0[tid] = RE0[tok0 + tid]; E1[tid] = RE1[tok0 + tid]; }
    __syncthreads();
    if (tid < 16) { int tot = 0, pre = 0; for (int q = 0; q < 32; ++q) { tot += PT[q * 16 + tid]; pre += PP[q * 16 + tid]; } TOT[tid] = tot; PRE[tid] = pre; }
    __syncthreads();
    if (tid == 0) { int eb = 0; for (int e = 0; e < NEXP; ++e) { EB[e] = eb; eb += (TOT[e] + 255) & ~255; }
        if (blockIdx.x == 0) { int* tbl = (int*)(P->p.ws + WS_TBL); for (int e = 0; e < NEXP; ++e) { tbl[e] = EB[e]; tbl[16 + e] = TOT[e]; } } }
    __syncthreads();
    if (tid < 16) { int run = EB[tid] + PRE[tid]; for (int i = 0; i < TPW; ++i) { if (E0[i] == tid) S0[i] = run++; if (E1[i] == tid) S1[i] = run++; } }
    __syncthreads();
    const bf16_t* H2 = (const bf16_t*)(P->p.ws + WS_HN); bf16_t* HG = (bf16_t*)(P->p.ws + WS_HG); float* SW = (float*)(P->p.ws + WS_SLOTW); int* TS = (int*)(P->p.ws + WS_TOKSLOT);
    for (int i = wave * 16; i < wave * 16 + 16; ++i) { const int tok = tok0 + i, s0 = S0[i], s1 = S1[i];
        const u32x4* src = (const u32x4*)(H2 + (size_t)tok * DM) + lane; const u32x4 a = src[0], b2 = src[64];
        u32x4* d0 = (u32x4*)(HG + (size_t)s0 * DM) + lane; u32x4* d1 = (u32x4*)(HG + (size_t)s1 * DM) + lane;
        d0[0] = a; d0[64] = b2; d1[0] = a; d1[64] = b2;
        if (lane == 0) { SW[s0] = RW0[tok]; SW[s1] = RW1[tok]; TS[2 * tok] = s0; TS[2 * tok + 1] = s1; } }
}

__device__ __forceinline__ void phaseJ_rows(KA P, int vcu, int G, int wave, int lane) {
    const bf16_t* Y = (const bf16_t*)(P->p.ws + WS_HG); const int* TS = (const int*)(P->p.ws + WS_TOKSLOT); bf16_t* XB = (bf16_t*)(P->p.ws + WS_HN);
    for (int tok = vcu * 8 + wave; tok < NTOK; tok += G * 8) { const int s0 = TS[2 * tok], s1 = TS[2 * tok + 1];
        f32x4* xr = (f32x4*)(P->p.out + (size_t)tok * DM) + lane; const u32x2* y0 = (const u32x2*)(Y + (size_t)s0 * DM) + lane; const u32x2* y1 = (const u32x2*)(Y + (size_t)s1 * DM) + lane;
        u32x2* o8 = (u32x2*)(XB + (size_t)tok * DM) + lane;
#pragma unroll
        for (int j = 0; j < 4; ++j) { f32x4 v = xr[64 * j]; const u32x2 a = y0[64 * j], b = y1[64 * j];
            v.x += bflo(a.x) + bflo(b.x); v.y += bfhi(a.x) + bfhi(b.x); v.z += bflo(a.y) + bflo(b.y); v.w += bfhi(a.y) + bfhi(b.y);
            xr[64 * j] = v; u32x2 w; w.x = pk2(v.x, v.y); w.y = pk2(v.z, v.w); o8[64 * j] = w; } }
}
__device__ __forceinline__ void final_rows(KA P, int vcu, int G, int wave, int lane) {
    const f32x4* gr = (const f32x4*)P->p.in[23] + lane;
    for (int tok = vcu * 8 + wave; tok < NTOK; tok += G * 8) { f32x4* xr = (f32x4*)(P->p.out + (size_t)tok * DM) + lane; f32x4 v[4]; float s = 0.f;
#pragma unroll
        for (int j = 0; j < 4; ++j) { v[j] = xr[64 * j]; s += (v[j].x * v[j].x + v[j].y * v[j].y) + (v[j].z * v[j].z + v[j].w * v[j].w); }
        const float r = 1.0f / sqrtf(wave_sum(s) * (1.f / DM) + EPS);
#pragma unroll
        for (int j = 0; j < 4; ++j) { const f32x4 gg = gr[64 * j]; f32x4 o; o.x = v[j].x * r * gg.x; o.y = v[j].y * r * gg.y; o.z = v[j].z * r * gg.z; o.w = v[j].w * r * gg.w; xr[64 * j] = o; } }
}
#ifndef MK_N_LAUNCHES
#define MK_N_LAUNCHES 27
#endif
constexpr int PH_PER_LAYER = 13, N_PHASES = DEPTH * PH_PER_LAYER + 1;
constexpr int N_LAUNCHES = MK_N_LAUNCHES;
static_assert(N_LAUNCHES == 1 || N_LAUNCHES == N_PHASES, "MK_N_LAUNCHES is 1 or 27");

#define PH_FN static __device__ __forceinline__ void
#define PH_COMMON int tid_l = threadIdx.x; asm volatile("" : "+v"(tid_l)); asm volatile("" : "+s"(ka)); asm volatile("" : "+s"(L)); const int tid = tid_l, lane = tid & 63, wave = __builtin_amdgcn_readfirstlane(tid >> 6); int G_l = gridDim.x, bx_l = blockIdx.x; asm volatile("" : "+s"(G_l)); asm volatile("" : "+s"(bx_l)); const int G = G_l, bx = bx_l; \
    const int vcu = (G % 8 == 0) ? (bx % 8) * (G / 8) + bx / 8 : bx; unsigned char* ws = ka->p.ws; (void)tid; (void)lane; (void)wave; (void)vcu; (void)ws; \
    bf16_t* Z = (bf16_t*)(ws + WS_Z); bf16_t* HN = (bf16_t*)(ws + WS_HN); (void)Z; (void)HN;

PH_FN ph_A(KA ka, int L, LAS unsigned char* L3) { PH_COMMON; KA P = ka; phaseA(P, L, L3, vcu, G, wave, lane, tid); }
PH_FN ph_B(KA ka, int L, LAS unsigned char* L3) { PH_COMMON;
    pg8::Gemm g{HN, DM, (const bf16_t*)(ws + WS_WIN), DM, DM}; pg8::StaticOrder S; S.init(NTOK, NZT * 256, G, bx);
    pg8::EpiBf16 E{Z, ZP, 0};
    pg8::gemm_phase<pg8::EpiBf16, pg8::StaticOrder, true, true>(L3, g, S, E); }
PH_FN ph_C1a(KA ka, int L, LAS unsigned char* L3) { PH_COMMON;
    const float* wa2 = ka->p.in[4] + (size_t)L * 16 * 256; const float* ba = ka->p.in[5] + (size_t)L * 256;
    for (int u = bx; u < 2048; u += G) gla1_unit(u, Z, wa2, ba, (bf16_t*)(ws + WS_SLOC), (float*)(ws + WS_DTAB), L3, wave, lane, tid);
    for (int cu = bx; cu < 256; cu += G) conv_unit(cu, Z, ka->p.in[11] + (size_t)L * 3 * 512, wave, lane); }
PH_FN ph_C1b(KA ka, int L, LAS unsigned char* L3) { PH_COMMON;
    const float* lp = ka->p.in[8] + (size_t)L * 256;
    const float sa = wave_sum(lp[lane] * lp[64 + lane]), sb = wave_sum(lp[128 + lane] * lp[192 + lane]);
    const float lam_init = 0.8f - 0.6f * expf(-0.3f * (float)L); const float lam = expf(sa) - expf(sb) + lam_init;
    const float* gd = ka->p.in[9] + (size_t)L * 128;
    for (int r = 0; r < 4; ++r) { const int uidx = r * 256 + ((r & 1) ? 255 - bx : bx); if (uidx >= 1024 || bx >= 256) break;
        const int qb = 127 - (uidx >> 3), bh = uidx & 7;
        att::unit(bh >> 2, bh & 3, qb, lam, 1.0f - lam_init, Z, gd, (char*)L3); } }
PH_FN ph_C2(KA ka, int L, LAS unsigned char* L3) { PH_COMMON; gla_scan((bf16_t*)(ws + WS_SLOC), (const float*)(ws + WS_DTAB), G, tid); }
PH_FN ph_C3(KA ka, int L, LAS unsigned char* L3) { PH_COMMON; for (int u = bx; u < 2048; u += G) gla3_unit(u, Z, (const bf16_t*)(ws + WS_SLOC), ka->p.in[6] + (size_t)L * 128, L3, wave, lane); }
PH_FN ph_D1(KA ka, int L, LAS unsigned char* L3) { PH_COMMON;
    pg8::Gemm g{Z, ZP, (const bf16_t*)(ws + WS_WO), 512, 512}; pg8::MergeOrder S{bx, G, C_OA, 512, 0, (size_t)DM * 512};
    pg8::EpiBf16 E{Z, ZP, 1024};
    pg8::gemm_phase<pg8::EpiBf16, pg8::MergeOrder, true, true>(L3, g, S, E); }
PH_FN ph_D2(KA ka, int L, LAS unsigned char* L3) { PH_COMMON;
    pg8::Gemm g{HN, DM, (const bf16_t*)(ws + WS_WIN), DM, DM}; pg8::MergeOrder S{bx, G, 0, 0, (size_t)NZT * 256 * DM, (size_t)4 * 256 * DM};
    pg8::EpiMerge E{Z};
    pg8::gemm_phase<pg8::EpiMerge, pg8::MergeOrder, true, true>(L3, g, S, E); }
PH_FN ph_E(KA ka, int L, LAS unsigned char* L3) { PH_COMMON;
    pg8::Gemm g{Z, ZP, (const bf16_t*)(ws + WS_WOUT), DM, DM}; pg8::StaticOrder S; S.init(NTOK, DM, G, bx);
    pg8::EpiRes E{L == 0 ? ka->p.in[0] : ka->p.out, ka->p.out};
    pg8::gemm_phase<pg8::EpiRes, pg8::StaticOrder, true, true>(L3, g, S, E); }
PH_FN ph_F(KA ka, int L, LAS unsigned char* L3) { PH_COMMON; KA P = ka; if (G == GRID) phaseF(P, L, L3, wave, lane, tid); }
PH_FN ph_G(KA ka, int L, LAS unsigned char* L3) { PH_COMMON; KA P = ka; if (G == GRID) phaseG(P, L3, wave, lane, tid); }
PH_FN ph_H(KA ka, int L, LAS unsigned char* L3) { PH_COMMON;
    pg8::Gemm g{(const bf16_t*)(ws + WS_HG), DM, (const bf16_t*)(ws + WS_WGU), DM, DM}; pg8::GroupOrder S{(const int*)(ws + WS_TBL), bx, G, (size_t)1024 * DM};
    pg8::EpiUp E{(bf16_t*)(ws + WS_ACT)};
    pg8::gemm_phase<pg8::EpiUp, pg8::GroupOrder, true, true>(L3, g, S, E); }
PH_FN ph_I(KA ka, int L, LAS unsigned char* L3) { PH_COMMON;
    pg8::Gemm g{(const bf16_t*)(ws + WS_ACT), DEXP, (const bf16_t*)(ws + WS_WDN), DEXP, DEXP}; pg8::GroupOrder S{(const int*)(ws + WS_TBL), bx, G, (size_t)DM * DEXP};
    pg8::EpiDown E{(bf16_t*)(ws + WS_HG), (const float*)(ws + WS_SLOTW)};
    pg8::gemm_phase<pg8::EpiDown, pg8::GroupOrder, true, true>(L3, g, S, E); }
PH_FN ph_J(KA ka, int L, LAS unsigned char* L3) { PH_COMMON; KA P = ka;
    phaseJ_rows(P, vcu, G, wave, lane);
    pg8::Gemm g{(const bf16_t*)(ws + WS_PB), PLE, (const bf16_t*)(ws + WS_WPLE), PLE, PLE}; pg8::StaticOrder S; S.init(NTOK, DM, G, bx);
    pg8::EpiBf16 E{(bf16_t*)(ws + WS_PL), DM, 0};
    pg8::gemm_phase<pg8::EpiBf16, pg8::StaticOrder, true, true>(L3, g, S, E); }
PH_FN ph_K(KA ka, int L, LAS unsigned char* L3) { PH_COMMON;
    pg8::Gemm g{HN, DM, (const bf16_t*)(ws + WS_WPG), DM, DM}; pg8::StaticOrder S; S.init(NTOK, DM, G, bx);
    pg8::EpiPle E{ka->p.out, ka->p.out, (const bf16_t*)(ws + WS_PL)};
    pg8::gemm_phase<pg8::EpiPle, pg8::StaticOrder, true, true>(L3, g, S, E); }
PH_FN ph_final(KA ka, int L, LAS unsigned char* L3) { PH_COMMON; KA P = ka; final_rows(P, vcu, G, wave, lane); }
static __device__ __forceinline__ void grid_bar(unsigned* barw, LAS unsigned* st) { XcdBarrier b; b.bar = barw; b.x = xb_xcc_id(); b.st = (volatile LAS unsigned*)st; xcd_barrier(b); }

__global__ void __launch_bounds__(512, 2) mega_fwd(Args args) {
    extern __shared__ __attribute__((aligned(16))) unsigned char lds[];
    LAS unsigned char* L3 = (LAS unsigned char*)lds;
    KA ka = (KA)__builtin_amdgcn_kernarg_segment_ptr();
    const int tid = threadIdx.x;
    for (int u = tid; u < (LDS_BYTES - LDSCTL_OFF) / 4; u += 512) ((LAS unsigned*)(L3 + LDSCTL_OFF))[u] = 0u;
    __syncthreads();
    unsigned* barw = (unsigned*)(args.p.ws + WS_CTL) + CW_BAR; LAS unsigned* st = (LAS unsigned*)(L3 + MISC_OFF) + 8;
    if (N_LAUNCHES == 1) (void)xcd_barrier_post(barw, (volatile LAS unsigned*)st);
    const int lo = args.ph_lo, hi = args.ph_hi;
#ifndef PHASE_MASK
#define PHASE_MASK 0xFFFFFFFu
#endif
#define IN(k) (((PHASE_MASK >> ((k) % PH_PER_LAYER + ((k) == N_PHASES - 1 ? PH_PER_LAYER : 0))) & 1u) && lo <= (k) && (k) < hi)
#define SEAM(k) do { if (IN(k) && IN((k) + 1)) grid_bar(barw, st); } while (0)
    for (int L = 0; L < DEPTH; ++L) {
        const int pb = L * PH_PER_LAYER;
        if (IN(pb + 0)) ph_A(ka, L, L3);
        SEAM(pb + 0);
        if (IN(pb + 1)) ph_B(ka, L, L3);
        SEAM(pb + 1);
        if (IN(pb + 2)) { ph_C1a(ka, L, L3); ph_C1b(ka, L, L3); }
        SEAM(pb + 2);
        if (IN(pb + 3)) ph_C2(ka, L, L3);
        SEAM(pb + 3);
        if (IN(pb + 4)) ph_C3(ka, L, L3);
        SEAM(pb + 4);
        if (IN(pb + 5)) { ph_D1(ka, L, L3); ph_D2(ka, L, L3); }
        SEAM(pb + 5);
        if (IN(pb + 6)) ph_E(ka, L, L3);
        SEAM(pb + 6);
        if (IN(pb + 7)) ph_F(ka, L, L3);
        SEAM(pb + 7);
        if (IN(pb + 8)) ph_G(ka, L, L3);
        SEAM(pb + 8);
        if (IN(pb + 9)) ph_H(ka, L, L3);
        SEAM(pb + 9);
        if (IN(pb + 10)) ph_I(ka, L, L3);
        SEAM(pb + 10);
        if (IN(pb + 11)) ph_J(ka, L, L3);
        SEAM(pb + 11);
        if (IN(pb + 12)) ph_K(ka, L, L3);
        SEAM(pb + 12);
    }
    if (IN(N_PHASES - 1)) ph_final(ka, 0, L3);
#undef IN
#undef SEAM
}

extern "C" void kernel_launch(void* const* d_in, const int* in_sizes, int n_in, void* d_out, int out_size, void* d_ws, size_t ws_size, hipStream_t stream) {
    static int grid = 0;
    if (grid == 0) {
        if (n_in != 24 || in_sizes[0] != NTOK * DM || out_size != NTOK * DM || ws_size < WS_END) {
            fprintf(stderr, "kernel_launch: built for 24 inputs, x/out of %d floats, >= %zu bytes of workspace; got n_in %d, in0 %d, out %d, ws %zu; nothing launched\n", NTOK * DM, (size_t)WS_END, n_in, n_in > 0 ? in_sizes[0] : -1, out_size, ws_size); grid = -1; return; }
        int dev = 0, cus = 0, per_cu = 0;
        if (hipGetDevice(&dev) != hipSuccess || hipDeviceGetAttribute(&cus, hipDeviceAttributeMultiprocessorCount, dev) != hipSuccess) { fprintf(stderr, "kernel_launch: device query failed\n"); grid = -1; return; }
        if (hipFuncSetAttribute((const void*)mega_fwd, hipFuncAttributeMaxDynamicSharedMemorySize, LDS_BYTES) != hipSuccess) { fprintf(stderr, "kernel_launch: hipFuncSetAttribute failed\n"); grid = -1; return; }
        if (hipOccupancyMaxActiveBlocksPerMultiprocessor(&per_cu, (const void*)mega_fwd, 512, LDS_BYTES) != hipSuccess || per_cu < 1)
            fprintf(stderr, "kernel_launch: note: occupancy query reports %d workgroups per CU\n", per_cu);
        (void)hipGetLastError();
        if (cus != GRID) { fprintf(stderr, "kernel_launch: built for a %d-CU device, found %d; nothing launched\n", GRID, cus); grid = -1; return; }
        grid = GRID;
    }
    if (grid < 0) return;
    if (hipMemsetAsync((char*)d_ws + WS_CTL, 0, CTL_ZERO_BYTES, stream) != hipSuccess) { fprintf(stderr, "kernel_launch: memset failed\n"); return; }
    Args a{};
    for (int i = 0; i < 24; ++i) a.p.in[i] = (const float*)d_in[i];
    a.p.out = (float*)d_out; a.p.ws = (unsigned char*)d_ws;
    for (int li = 0; li < N_LAUNCHES; ++li) {
        a.ph_lo = (N_LAUNCHES == 1) ? 0 : li; a.ph_hi = (N_LAUNCHES == 1) ? N_PHASES : li + 1;
        hipLaunchKernelGGL(mega_fwd, dim3(grid), dim3(512), LDS_BYTES, stream, a);
        const hipError_t le = hipPeekAtLastError();
        if (le != hipSuccess) { fprintf(stderr, "kernel_launch: launch %d failed: %s\n", li, hipGetErrorName(le)); break; }
    }
}
```

```cpp
#include <hip/hip_runtime.h>
#include <cstdio>
#include <cstdint>

#define LAS __attribute__((address_space(3)))
#define GAS __attribute__((address_space(1)))
typedef unsigned short bf16_t;
typedef short bf16x8 __attribute__((ext_vector_type(8)));
typedef short s16x4 __attribute__((ext_vector_type(4)));
typedef float f32x2 __attribute__((ext_vector_type(2)));
typedef float f32x4 __attribute__((ext_vector_type(4)));
typedef float f32x16 __attribute__((ext_vector_type(16)));
typedef unsigned u32x2 __attribute__((ext_vector_type(2)));
typedef unsigned u32x4 __attribute__((ext_vector_type(4)));
typedef __bf16 bf16x2_t __attribute__((ext_vector_type(2)));

constexpr int NB = 2, T = 16384, NTOK = NB * T, DM = 1024, DEPTH = 2, PLE = 256;
constexpr int INTOT = 7696;
constexpr int ZP = 4864;
constexpr int C_GQ = 0, C_GK = 256, C_GV = 512, C_DK = 1024, C_DV = 1536, C_CX = 2048, C_CC = 2560, C_GA = 3072, C_GG = 3328, C_DQ = 3840, C_CB = 4352;
constexpr int C_OA = C_GG, C_OB = C_DQ, C_OC = C_CB;
constexpr int NZT = 19;
constexpr int NEXP = 16, DEXP = 512;
constexpr int NSLOT = 2 * NTOK + NEXP * 256;
constexpr float EPS = 1e-6f;
constexpr int GRID = 256;
constexpr int TPW = NTOK / GRID;

__device__ __forceinline__ unsigned f2bf(float f) { unsigned u = __builtin_bit_cast(unsigned, f); return (u + 0x7fffu + ((u >> 16) & 1u)) >> 16; }
__device__ __forceinline__ unsigned pk2(float lo, float hi) { f32x2 v = {lo, hi}; bf16x2_t b = __builtin_convertvector(v, bf16x2_t); return __builtin_bit_cast(unsigned, b); }
__device__ __forceinline__ float bflo(unsigned w) { return __builtin_bit_cast(float, w << 16); }
__device__ __forceinline__ float bfhi(unsigned w) { return __builtin_bit_cast(float, w & 0xffff0000u); }
__device__ __forceinline__ float bf2f(bf16_t b) { return __builtin_bit_cast(float, (unsigned)b << 16); }
__device__ __forceinline__ float sigmoidf_(float x) { return __builtin_amdgcn_rcpf(1.0f + __builtin_amdgcn_exp2f(-1.4426950408889634f * x)); }
__device__ __forceinline__ float siluf_(float x) { return x * sigmoidf_(x); }
__device__ __forceinline__ float wave_sum(float v) {
#pragma unroll
    for (int o = 1; o < 64; o <<= 1) v += __shfl_xor(v, o);
    return v;
}
__device__ __forceinline__ int crow(int r, int hi) { return (r & 3) + 8 * (r >> 2) + 4 * hi; }
#define LDS_WAIT() asm volatile("s_waitcnt lgkmcnt(0)" ::: "memory")
#define VM_WAIT() asm volatile("s_waitcnt vmcnt(0)" ::: "memory")

namespace pg8 {
#define PG8_LAS __attribute__((address_space(3)))
constexpr int BM = 256, BK = 64, HALF = 128, HTB = HALF * BK * 2  , STAGE_BYTES = 8 * HTB, NXCD = 8, WGM = 8;

__host__ __device__ __forceinline__ int lds_byte(int r, int c) { const int st = (r >> 4) * 2 + (c >> 5), rr = r & 15, cc = c & 31, ob = rr * 64 + cc * 2; return st * 1024 + (ob ^ (((ob >> 9) & 1) << 5)); }
__host__ __device__ __forceinline__ void stage_rc(int b, int& R, int& C) { const int st = b / 1024, sb = b % 1024, swz = sb ^ (((sb >> 9) & 1) << 5); R = (st >> 1) * 16 + swz / 64; C = (st & 1) * 32 + (swz % 64) / 2; }
__host__ __device__ __forceinline__ int perm32(int rho) { const int n = rho >> 4, i = rho & 15; return 8 * (i >> 2) + 4 * n + (i & 3); }

struct Unit { int pm, pn; int aoff; int tag; size_t boff; };
struct Gemm { const bf16_t* A; int lda; const bf16_t* Bt; int ldb; int K; };

struct StaticOrder {
    int nM, nN, nwg, G, c;
    __device__ void init(int M, int N, int G_, int c_) { nM = M / BM; nN = N / BM; nwg = nM * nN; G = G_; c = c_; }
    __device__ bool next(int i, Unit& u) const {
        const long L = (long)i * G + c; if (L >= nwg) return false;
        int wgid = (int)L; { const int q = nwg / NXCD, r = nwg % NXCD, xcd = wgid % NXCD, off = wgid / NXCD; wgid = (xcd < r ? xcd * (q + 1) : r * (q + 1) + (xcd - r) * q) + off; }
        const int nig = WGM * nN, gid = wgid / nig, fm = gid * WGM, gsz = (nM - fm) < WGM ? (nM - fm) : WGM;
        u.pm = fm + ((wgid % nig) % gsz); u.pn = (wgid % nig) / gsz; u.aoff = 0; u.tag = 0; u.boff = 0; return true;
    }
};

struct EpiBf16 {
    static constexpr bool PERM = true;
    bf16_t* O; int ldc; int tstride;
    __device__ __forceinline__ void operator()(const f32x4 (&acc)[2][2][4][2], const Unit& u, int wr, int wc, int fr, int fq) const {
        const int row0 = u.pm * BM + wr * 64 + fr; const int col0 = u.tag * tstride + u.pn * BM + wc * 32 + 8 * fq;
#pragma unroll
        for (int ai = 0; ai < 2; ++ai)
#pragma unroll
            for (int m = 0; m < 4; ++m) { bf16_t* rowp = O + (size_t)(row0 + ai * HALF + m * 16) * ldc + col0;
#pragma unroll
                for (int bj = 0; bj < 2; ++bj) { const f32x4 v0 = acc[ai][bj][m][0], v1 = acc[ai][bj][m][1];
                    u32x4 w; w.x = pk2(v0[0], v0[1]); w.y = pk2(v0[2], v0[3]); w.z = pk2(v1[0], v1[1]); w.w = pk2(v1[2], v1[3]);
                    *(u32x4*)(rowp + bj * HALF) = w; } }
    }
};
template <class Epi, class Sched, bool ALIGN_EPI = false, bool SP2 = false>
__device__ __forceinline__ void gemm_phase(PG8_LAS unsigned char* lds, const Gemm g, const Sched& S, const Epi& E) {
    int tid_l = threadIdx.x; asm volatile("" : "+v"(tid_l)); const int tid = tid_l;
    const int wid = __builtin_amdgcn_readfirstlane(tid >> 6), lane = tid & 63, wr = wid >> 2, wc = wid & 3, fr = lane & 15, fq = lane >> 4;
    const int K = g.K, nt = K / BK;
    unsigned voffA[2], voffB[2];
#pragma unroll
    for (int i = 0; i < 2; ++i) { int R, C; stage_rc(tid * 16 + i * 8192, R, C); const int Rb = Epi::PERM ? ((R & ~31) + perm32(R & 31)) : R;
        voffA[i] = (unsigned)(R * g.lda + C) * 2u; voffB[i] = (unsigned)(Rb * g.ldb + C) * 2u; }
    const size_t kstep = (size_t)(BK * 2);
    const size_t hstepA = (size_t)HALF * g.lda * 2, hstepB = (size_t)HALF * g.ldb * 2;
    const unsigned ldsw = (unsigned)wid * 1024u;
    const int aoff = lds_byte(wr * 64 + fr, fq * 8), boff = lds_byte(wc * 32 + fr, fq * 8);
#define PG8_UA(u) ((const char*)g.A + ((size_t)(u).pm * 2 * hstepA) + (size_t)(u).aoff * 2)
#define PG8_UB(u) ((const char*)g.Bt + ((size_t)(u).pn * 2 * hstepB) + (u).boff * 2)
#define PG8_SA(b, h) (((b) * 2 + (h)) * HTB)
#define PG8_SB(b, h) ((4 + (b) * 2 + (h)) * HTB)
#define PG8_STAGE(bufoff, gbase, voff) do { _Pragma("unroll") for (int _i = 0; _i < 2; ++_i) \
        __builtin_amdgcn_global_load_lds((const unsigned*)((const char*)(gbase) + (voff)[_i]), (PG8_LAS unsigned*)(lds + (bufoff) + ldsw + _i * 8192), 16, 0, 0); } while (0)
#define PG8_LDA(dst, b, h) do { _Pragma("unroll") for (int m = 0; m < 4; ++m) _Pragma("unroll") for (int k = 0; k < 2; ++k) dst[m][k] = *(const PG8_LAS bf16x8*)(lds + PG8_SA(b, h) + aoff + m * 2048 + k * 1024); } while (0)
#define PG8_LDB(dst, b, h) do { _Pragma("unroll") for (int n = 0; n < 2; ++n) _Pragma("unroll") for (int k = 0; k < 2; ++k) dst[n][k] = *(const PG8_LAS bf16x8*)(lds + PG8_SB(b, h) + boff + n * 2048 + k * 1024); } while (0)
#define PG8_MMA(ai, bj, At, Bt) do { __builtin_amdgcn_s_setprio(1); _Pragma("unroll") for (int m = 0; m < 4; ++m) _Pragma("unroll") for (int n = 0; n < 2; ++n) _Pragma("unroll") for (int k = 0; k < 2; ++k) \
        acc[ai][bj][m][n] = __builtin_amdgcn_mfma_f32_16x16x32_bf16(Bt[n][k], At[m][k], acc[ai][bj][m][n], 0, 0, 0); __builtin_amdgcn_s_setprio(0); } while (0)
#define PG8_WAIT_V(n) asm volatile("s_waitcnt vmcnt(" #n ")" ::: "memory")
#define PG8_WAIT_L(n) asm volatile("s_waitcnt lgkmcnt(" #n ")" ::: "memory")
#define PG8_BAR __builtin_amdgcn_s_barrier()
#define PG8_SCHED __builtin_amdgcn_sched_barrier(0)
    Unit cur, nxt; int ui = 0;
    if (!S.next(0, cur)) return;
    f32x4 acc[2][2][4][2];
#pragma unroll
    for (int a = 0; a < 2; ++a)
#pragma unroll
        for (int b = 0; b < 2; ++b)
#pragma unroll
            for (int m = 0; m < 4; ++m)
#pragma unroll
                for (int n = 0; n < 2; ++n) acc[a][b][m][n] = (f32x4){0.f, 0.f, 0.f, 0.f};
    bf16x8 At[4][2], B0[2][2], B1[2][2];
    const char* cA = PG8_UA(cur); const char* cB = PG8_UB(cur);
    if constexpr (SP2) {
        PG8_STAGE(PG8_SB(0, 0), cB, voffB); PG8_STAGE(PG8_SB(0, 1), cB + hstepB, voffB); PG8_STAGE(PG8_SA(0, 0), cA, voffA); PG8_STAGE(PG8_SA(0, 1), cA + hstepA, voffA);
        if (wr == 1) PG8_BAR;
        PG8_WAIT_V(2); PG8_BAR;
        PG8_STAGE(PG8_SB(1, 0), cB + kstep, voffB); PG8_STAGE(PG8_SA(1, 0), cA + kstep, voffA); PG8_STAGE(PG8_SB(1, 1), cB + hstepB + kstep, voffB);
        PG8_WAIT_V(6); PG8_BAR;
    } else {
        PG8_STAGE(PG8_SB(0, 0), cB, voffB); PG8_STAGE(PG8_SA(0, 0), cA, voffA); PG8_STAGE(PG8_SB(0, 1), cB + hstepB, voffB); PG8_STAGE(PG8_SA(0, 1), cA + hstepA, voffA);
        if (wr == 1) PG8_BAR;
        PG8_WAIT_V(4); PG8_BAR;
        PG8_STAGE(PG8_SB(1, 0), cB + kstep, voffB); PG8_STAGE(PG8_SA(1, 0), cA + kstep, voffA); PG8_STAGE(PG8_SB(1, 1), cB + hstepB + kstep, voffB);
        PG8_WAIT_V(6); PG8_BAR;
    }
    for (;;) {
        const bool has_next = S.next(ui + 1, nxt);
        const char* nA = has_next ? PG8_UA(nxt) : cA; const char* nB = has_next ? PG8_UB(nxt) : cB;
        for (int t = 0; t < nt; t += 2) {
            const bool last = (t == nt - 2);
            const char* a1 = cA + (size_t)(t + 1) * kstep;
            const char* a2 = last ? nA : cA + (size_t)(t + 2) * kstep; const char* b2 = last ? nB : cB + (size_t)(t + 2) * kstep;
            const char* a3 = a2 + kstep; const char* b3 = b2 + kstep;
            if constexpr (SP2) {
            PG8_LDB(B0, 0, 0); PG8_LDB(B1, 0, 1); PG8_SCHED; PG8_LDA(At, 0, 0); PG8_STAGE(PG8_SA(1, 1), a1 + hstepA, voffA);
            PG8_WAIT_V(8); PG8_WAIT_L(0); PG8_BAR; PG8_MMA(0, 0, At, B0); PG8_MMA(0, 1, At, B1); PG8_BAR; PG8_SCHED;
            PG8_LDA(At, 0, 1); PG8_STAGE(PG8_SB(0, 0), b2, voffB); PG8_STAGE(PG8_SB(0, 1), b2 + hstepB, voffB); PG8_STAGE(PG8_SA(0, 0), a2, voffA);
            PG8_WAIT_V(8); PG8_WAIT_L(0); PG8_BAR; PG8_MMA(1, 0, At, B0); PG8_MMA(1, 1, At, B1); PG8_BAR; PG8_SCHED;
            PG8_LDB(B0, 1, 0); PG8_LDB(B1, 1, 1); PG8_SCHED; PG8_LDA(At, 1, 0); PG8_STAGE(PG8_SA(0, 1), a2 + hstepA, voffA);
            PG8_WAIT_V(8); PG8_WAIT_L(0); PG8_BAR; PG8_MMA(0, 0, At, B0); PG8_MMA(0, 1, At, B1); PG8_BAR; PG8_SCHED;
            PG8_LDA(At, 1, 1); PG8_STAGE(PG8_SB(1, 0), b3, voffB); PG8_STAGE(PG8_SB(1, 1), b3 + hstepB, voffB); PG8_STAGE(PG8_SA(1, 0), a3, voffA);
            PG8_WAIT_V(8); PG8_WAIT_L(0); PG8_BAR; PG8_MMA(1, 0, At, B0); PG8_MMA(1, 1, At, B1); PG8_BAR; PG8_SCHED;
            } else {
            PG8_LDB(B0, 0, 0); PG8_SCHED; PG8_LDA(At, 0, 0); PG8_STAGE(PG8_SA(1, 1), a1 + hstepA, voffA);
            PG8_WAIT_L(8); PG8_BAR; PG8_WAIT_L(0); PG8_MMA(0, 0, At, B0); PG8_BAR; PG8_SCHED;
            PG8_LDB(B1, 0, 1); PG8_STAGE(PG8_SB(0, 0), b2, voffB);
            PG8_BAR; PG8_WAIT_L(0); PG8_MMA(0, 1, At, B1); PG8_BAR;
            PG8_LDA(At, 0, 1); PG8_STAGE(PG8_SA(0, 0), a2, voffA);
            PG8_BAR; PG8_WAIT_L(0); PG8_MMA(1, 0, At, B0); PG8_BAR; PG8_SCHED;
            PG8_STAGE(PG8_SB(0, 1), b2 + hstepB, voffB);
            PG8_WAIT_V(6); PG8_BAR; PG8_MMA(1, 1, At, B1); PG8_BAR;
            PG8_LDB(B0, 1, 0); PG8_SCHED; PG8_LDA(At, 1, 0); PG8_STAGE(PG8_SA(0, 1), a2 + hstepA, voffA);
            PG8_WAIT_L(8); PG8_BAR; PG8_WAIT_L(0); PG8_MMA(0, 0, At, B0); PG8_BAR; PG8_SCHED;
            PG8_LDB(B1, 1, 1); PG8_STAGE(PG8_SB(1, 0), b3, voffB);
            PG8_BAR; PG8_WAIT_L(0); PG8_MMA(0, 1, At, B1); PG8_BAR;
            PG8_LDA(At, 1, 1); PG8_STAGE(PG8_SA(1, 0), a3, voffA);
            PG8_BAR; PG8_WAIT_L(0); PG8_MMA(1, 0, At, B0); PG8_BAR; PG8_SCHED;
            PG8_STAGE(PG8_SB(1, 1), b3 + hstepB, voffB);
            PG8_WAIT_V(6); PG8_BAR; PG8_MMA(1, 1, At, B1); PG8_BAR;
            }
        }
        if constexpr (ALIGN_EPI) { if (wr == 0) PG8_BAR; }
        E(acc, cur, wr, wc, fr, fq);
        if (!has_next) break;
#pragma unroll
        for (int a = 0; a < 2; ++a)
#pragma unroll
            for (int b = 0; b < 2; ++b)
#pragma unroll
                for (int m = 0; m < 4; ++m)
#pragma unroll
                    for (int n = 0; n < 2; ++n) acc[a][b][m][n] = (f32x4){0.f, 0.f, 0.f, 0.f};
        cur = nxt; cA = nA; cB = nB; ++ui;
        if constexpr (ALIGN_EPI) { if (wr == 1) PG8_BAR; }
    }
    PG8_WAIT_V(0);
    if constexpr (!ALIGN_EPI) { if (wr == 0) PG8_BAR; }
    PG8_BAR;
#undef PG8_UA
#undef PG8_UB
#undef PG8_SA
#undef PG8_SB
#undef PG8_STAGE
#undef PG8_LDA
#undef PG8_LDB
#undef PG8_MMA
#undef PG8_WAIT_V
#undef PG8_WAIT_L
#undef PG8_BAR
#undef PG8_SCHED
}
}

#define XB_TMO      128
#define XB_XCNT(j)  (256  + 64 * (j))
#define XB_XSUB(j)  (1280 + 64 * (j))
#define XB_XGEN(j)  (2304 + 64 * (j))
#define XB_TOP      3328
#define XB_TOPGEN   3392
#define XCD_BAR_WORDS 3456
#define XB_SPIN_CAP (1u << 18)

__device__ __forceinline__ unsigned xb_ld(unsigned* p)              { return __hip_atomic_load(p, __ATOMIC_RELAXED, __HIP_MEMORY_SCOPE_AGENT); }
__device__ __forceinline__ unsigned xb_add(unsigned* p, unsigned v) { return __hip_atomic_fetch_add(p, v, __ATOMIC_RELAXED, __HIP_MEMORY_SCOPE_AGENT); }
__device__ __forceinline__ unsigned xb_xcc_id() { return (unsigned)__builtin_amdgcn_s_getreg((3 << 11) | 20) & 0xFu; }
#define XB_SPIN(cond, bar) do { unsigned _sp = 0; while (cond) { __builtin_amdgcn_s_sleep(1); \
    if ((++_sp & 255u) == 0u) { if (xb_ld(&(bar)[XB_TMO])) break; if (_sp > XB_SPIN_CAP) { atomicAdd(&(bar)[XB_TMO], 1u); break; } } } } while (0)

struct XcdBarrier {
    unsigned* bar; unsigned x;
    volatile LAS unsigned* st;
};

__device__ __forceinline__ XcdBarrier xcd_barrier_post(unsigned* bar, volatile LAS unsigned* st) {
    XcdBarrier b; b.bar = bar; b.x = xb_xcc_id(); b.st = st;
    if (threadIdx.x == 0) (void)xb_add(&bar[XB_XCNT(b.x)], 1u);
    return b;
}
__device__ __forceinline__ void xcd_barrier_complete(unsigned* bar, unsigned x, unsigned& nloc, unsigned& nx) {
    const unsigned G = gridDim.x * gridDim.y * gridDim.z;
    unsigned sum, cnt, mine, sp = 0u;
    for (;;) {
        sum = 0u; cnt = 0u; mine = 0u;
#pragma unroll
        for (unsigned j = 0; j < 16; ++j) { const unsigned c = xb_ld(&bar[XB_XCNT(j)]); sum += c; cnt += (c > 0u) ? 1u : 0u; mine = (j == x) ? c : mine; }
        if (sum == G) break;
        __builtin_amdgcn_s_sleep(1);
        if ((++sp & 255u) == 0u) { if (xb_ld(&bar[XB_TMO])) break; if (sp > XB_SPIN_CAP) { atomicAdd(&bar[XB_TMO], 1u); break; } }
    }
    nloc = mine > 0u ? mine : 1u; nx = cnt > 0u ? cnt : 1u;
}

__device__ __forceinline__ void xcd_barrier(const XcdBarrier& b) {
    asm volatile("s_waitcnt vmcnt(0)" ::: "memory");
    __syncthreads();
    if (threadIdx.x == 0) {
        unsigned* bar = b.bar;
        __builtin_amdgcn_s_waitcnt(0);
        unsigned nloc = b.st[0], nx = b.st[1];
        if (nloc == 0u) { xcd_barrier_complete(bar, b.x, nloc, nx); b.st[0] = nloc; b.st[1] = nx; }
        const unsigned old = xb_add(&bar[XB_XSUB(b.x)], 1u);
        const unsigned gen = old / nloc;
        if (old + 1u == (gen + 1u) * nloc) {
            __builtin_amdgcn_fence(__ATOMIC_RELEASE, "agent");
            asm volatile("s_waitcnt vmcnt(0)" ::: "memory");
            const unsigned og = xb_add(&bar[XB_TOP], 1u);
            const unsigned tg = og / nx;
            if (og + 1u == (tg + 1u) * nx) xb_add(&bar[XB_TOPGEN], 1u);
            else XB_SPIN(xb_ld(&bar[XB_TOPGEN]) == tg, bar);
            __builtin_amdgcn_fence(__ATOMIC_ACQUIRE, "agent");
            xb_add(&bar[XB_XGEN(b.x)], 1u);
            asm volatile("s_waitcnt vmcnt(0)" ::: "memory");
        } else {
            XB_SPIN(xb_ld(&bar[XB_XGEN(b.x)]) == gen, bar);
            __builtin_amdgcn_fence(__ATOMIC_ACQUIRE, "agent");
            asm volatile("s_waitcnt vmcnt(0)" ::: "memory");
        }
    }
    __syncthreads();
}

constexpr size_t MiB = 1u << 20;
constexpr size_t WS_CTL = 0, CTL_ZERO_BYTES = 1 * MiB;
constexpr size_t WS_WIN = 1 * MiB;
constexpr size_t WS_WO = WS_WIN + (size_t)31 * 256 * 1024 * 2;
constexpr size_t WS_WOUT = WS_WO + (size_t)3 * 1024 * 512 * 2;
constexpr size_t WS_WPG = WS_WOUT + (size_t)1024 * 1024 * 2;
constexpr size_t WS_WPLE = WS_WPG + (size_t)1024 * 1024 * 2;
constexpr size_t WS_WGU = WS_WPLE + (size_t)1024 * 256 * 2;
constexpr size_t WS_WDN = WS_WGU + (size_t)16 * 1024 * 1024 * 2;
constexpr size_t WS_WEND = WS_WDN + (size_t)16 * 1024 * 512 * 2;
static_assert(WS_WEND <= 73 * MiB, "weights");
constexpr size_t WS_HN = 73 * MiB;
constexpr size_t WS_PB = WS_HN + (size_t)NTOK * DM * 2;
constexpr size_t WS_Z = WS_PB + (size_t)NTOK * PLE * 2;
constexpr size_t WS_ZEND = WS_Z + (size_t)NTOK * ZP * 2;
constexpr size_t WS_SLOC = WS_ZEND;
constexpr size_t WS_DTAB = WS_SLOC + (size_t)2048 * 8192 * 2;
constexpr size_t WS_ROUTE = WS_DTAB + (size_t)2048 * 64 * 4;
constexpr size_t WS_HIST = WS_ROUTE + (size_t)NTOK * 16;
constexpr size_t WS_TBL = WS_HIST + (size_t)GRID * 16 * 4;
constexpr size_t WS_TOKSLOT = WS_TBL + 256;
constexpr size_t WS_SLOTW = WS_TOKSLOT + (size_t)NTOK * 8;
constexpr size_t WS_END = WS_SLOTW + (size_t)NSLOT * 4;
constexpr size_t WS_HG = WS_Z;
constexpr size_t WS_ACT = WS_HG + (size_t)NSLOT * DM * 2;
constexpr size_t WS_PL = WS_ACT + (size_t)NSLOT * DEXP * 2;
static_assert(WS_PL + (size_t)NTOK * DM * 2 <= WS_ZEND, "MoE overlay fits inside Z");
constexpr int CW_BAR = 4096;

constexpr int RING_BYTES = 131072;
constexpr int LDSCTL_OFF = RING_BYTES, MISC_OFF = LDSCTL_OFF + 320;
constexpr int LDS_BYTES = 147456;

__device__ __forceinline__ void tr_item(const float* W, int ldw, int col0, int K, bf16_t* WT, int nrows, int valid, LAS float* scr, int item, int lane) {
    const int nblk = nrows / 32, kb = item / nblk, nb = item % nblk, k0 = 64 * kb, n0 = 32 * nb;
    const bool ok = (n0 + (lane & 31)) < valid;
#pragma unroll 8
    for (int i = 0; i < 32; ++i) { const int kk = 2 * i + (lane >> 5); scr[kk * 33 + (lane & 31)] = ok ? W[(size_t)(k0 + kk) * ldw + col0 + n0 + (lane & 31)] : 0.f; }
    LDS_WAIT(); asm volatile("" ::: "memory");
    const int c = lane & 7;
#pragma unroll
    for (int j = 0; j < 4; ++j) { const int n = (lane >> 3) + 8 * j; const LAS float* s = scr + (8 * c) * 33 + n;
        u32x4 o; o.x = pk2(s[0 * 33], s[1 * 33]); o.y = pk2(s[2 * 33], s[3 * 33]); o.z = pk2(s[4 * 33], s[5 * 33]); o.w = pk2(s[6 * 33], s[7 * 33]);
        *(u32x4*)(WT + (size_t)(n0 + n) * K + k0 + 8 * c) = o; }
    LDS_WAIT(); asm volatile("" ::: "memory");
}
__device__ __forceinline__ int win_src_col(int t) {
    if (t < 4) return 256 * t;
    if (t < 8) return 2064 + 256 * (t - 4);
    if (t < 10) return 3088 + 256 * (t - 8);
    if (t < 12) return 4112 + 256 * (t - 10);
    if (t == 12) return 1536;
    if (t < 15) return 1024 + 256 * (t - 13);
    if (t < 17) return 1552 + 256 * (t - 15);
    if (t < 19) return 3600 + 256 * (t - 17);
    return 4624 + 256 * (t - 19);
}
__device__ __forceinline__ void rms_row_bf16(const float* xrow, const float* g, bf16_t* orow, int lane) {
    const f32x4* xr = (const f32x4*)xrow + lane; const f32x4* gr = (const f32x4*)g + lane;
    f32x4 v[4]; float s = 0.f;
#pragma unroll
    for (int j = 0; j < 4; ++j) { v[j] = xr[64 * j]; s += (v[j].x * v[j].x + v[j].y * v[j].y) + (v[j].z * v[j].z + v[j].w * v[j].w); }
    const float r = 1.0f / sqrtf(wave_sum(s) * (1.f / DM) + EPS);
    u32x2* o8 = (u32x2*)orow + lane;
#pragma unroll
    for (int j = 0; j < 4; ++j) { const f32x4 gg = gr[64 * j]; u32x2 w; w.x = pk2(v[j].x * r * gg.x, v[j].y * r * gg.y); w.y = pk2(v[j].z * r * gg.z, v[j].w * r * gg.w); o8[64 * j] = w; }
}

struct Ptrs { const float* in[24]; float* out; unsigned char* ws; };
struct Args { Ptrs p; int ph_lo, ph_hi; };
typedef const __attribute__((address_space(4))) Args* KA;

__device__ __forceinline__ void phaseA(KA P, int L, LAS unsigned char* lds, int vcu, int G, int wave, int lane, int tid) {
    LAS float* scr = (LAS float*)(lds + wave * 16384);
    const int gw = vcu * 8 + wave, NGW = G * 8;
    unsigned char* ws = P->p.ws;
    constexpr int I_WIN = 31 * 128, I_WO = 3 * 256, I_WOUT = 512, I_WPG = 512, I_WPLE = 128, I_WGU = 16 * 512, I_WDN = 16 * 256;
    constexpr int NITEMS = I_WIN + I_WO + I_WOUT + I_WPG + I_WPLE + I_WGU + I_WDN;
    for (int it = gw; it < NITEMS; it += NGW) {
        int r = it;
        if (r < I_WIN) { const int t = r / 128; tr_item(P->p.in[3] + (size_t)L * DM * INTOT, INTOT, win_src_col(t), DM, (bf16_t*)(ws + WS_WIN) + (size_t)t * 256 * DM, 256, t == 12 ? 16 : 256, scr, r % 128, lane); continue; } r -= I_WIN;
        if (r < I_WO) { const int j = r / 256; const float* src = (j == 0 ? P->p.in[7] : j == 1 ? P->p.in[10] : P->p.in[12]) + (size_t)L * 512 * DM;
            tr_item(src, DM, 0, 512, (bf16_t*)(ws + WS_WO) + (size_t)j * DM * 512, DM, DM, scr, r % 256, lane); continue; } r -= I_WO;
        if (r < I_WOUT) { tr_item(P->p.in[13] + (size_t)L * DM * DM, DM, 0, DM, (bf16_t*)(ws + WS_WOUT), DM, DM, scr, r, lane); continue; } r -= I_WOUT;
        if (r < I_WPG) { tr_item(P->p.in[22] + (size_t)L * DM * DM, DM, 0, DM, (bf16_t*)(ws + WS_WPG), DM, DM, scr, r, lane); continue; } r -= I_WPG;
        if (r < I_WPLE) { tr_item(P->p.in[21] + (size_t)L * PLE * DM, DM, 0, PLE, (bf16_t*)(ws + WS_WPLE), DM, DM, scr, r, lane); continue; } r -= I_WPLE;
        if (r < I_WGU) { const int e = r / 512, q = (r % 512) / 64, n = q >> 1, s = q & 1;
            tr_item(P->p.in[19] + (size_t)(L * NEXP + e) * DM * 1024, 1024, 512 * s + 128 * n, DM, (bf16_t*)(ws + WS_WGU) + (size_t)e * 1024 * DM + (size_t)(256 * n + 128 * s) * DM, 128, 128, scr, r % 64, lane); continue; } r -= I_WGU;
        { const int e = r / 256; tr_item(P->p.in[20] + (size_t)(L * NEXP + e) * DEXP * DM, DM, 0, DEXP, (bf16_t*)(ws + WS_WDN) + (size_t)e * DM * DEXP, DM, DM, scr, r % 256, lane); }
    }
    const float* xs = (L == 0) ? P->p.in[0] : P->p.out;
    for (int m = gw; m < NTOK; m += NGW) rms_row_bf16(xs + (size_t)m * DM, P->p.in[2] + (size_t)L * DM, (bf16_t*)(ws + WS_HN) + (size_t)m * DM, lane);
    const f32x4* ps = (const f32x4*)(P->p.in[1] + (size_t)L * NTOK * PLE); u32x2* pd = (u32x2*)(ws + WS_PB);
    for (int i = vcu * 512 + tid; i < NTOK * PLE / 4; i += G * 512) { const f32x4 v = ps[i]; u32x2 w; w.x = pk2(v.x, v.y); w.y = pk2(v.z, v.w); pd[i] = w; }
}

__device__ __forceinline__ float logsig16(float x) { return (fminf(x, 0.f) - log1pf(expf(-fabsf(x)))) * (1.0f / 16.0f); }
__device__ __forceinline__ void gla1_unit(int unit, bf16_t* Z, const float* wa2, const float* ba, bf16_t* SLOCT, float* DTAB, LAS unsigned char* lds, int wid, int lane, int tid) {
    const int bh = unit >> 8, c = unit & 255, b = bh >> 2, h = bh & 3; const size_t row0 = (size_t)b * T + (size_t)c * 64;
    LAS bf16_t* Qs = (LAS bf16_t*)lds; LAS bf16_t* Ks = (LAS bf16_t*)(lds + 8192); LAS bf16_t* KhT = (LAS bf16_t*)(lds + 16384); LAS bf16_t* VT = (LAS bf16_t*)(lds + 24576);
    LAS bf16_t* Am = (LAS bf16_t*)(lds + 40960); LAS float* WA = (LAS float*)(lds + 49152); LAS float* BA = (LAS float*)(lds + 53248);
    const int r32 = lane & 31, hi = lane >> 5;
    for (int i = tid; i < 1024; i += 512) WA[i] = wa2[(i >> 6) * 256 + h * 64 + (i & 63)];
    if (tid < 64) BA[tid] = ba[h * 64 + tid];
    __syncthreads();
    {
        const int t = lane, cb = wid * 8; const bf16_t* zr = Z + (row0 + t) * ZP;
        const u32x4 g0 = *(const u32x4*)(zr + C_GA), g1 = *(const u32x4*)(zr + C_GA + 8);
        float gaf[16]; gaf[0] = bflo(g0.x); gaf[1] = bfhi(g0.x); gaf[2] = bflo(g0.y); gaf[3] = bfhi(g0.y); gaf[4] = bflo(g0.z); gaf[5] = bfhi(g0.z); gaf[6] = bflo(g0.w); gaf[7] = bfhi(g0.w);
        gaf[8] = bflo(g1.x); gaf[9] = bfhi(g1.x); gaf[10] = bflo(g1.y); gaf[11] = bfhi(g1.y); gaf[12] = bflo(g1.z); gaf[13] = bfhi(g1.z); gaf[14] = bflo(g1.w); gaf[15] = bfhi(g1.w);
        float la[8];
#pragma unroll
        for (int i = 0; i < 8; ++i) { float x = BA[cb + i];
#pragma unroll
            for (int r = 0; r < 16; ++r) x = fmaf(gaf[r], WA[r * 64 + cb + i], x);
            la[i] = logsig16(x); }
#pragma unroll
        for (int off = 1; off < 64; off <<= 1) {
#pragma unroll
            for (int i = 0; i < 8; ++i) { const float y = __shfl_up(la[i], off); if (lane >= off) la[i] += y; } }
        const u32x4 qv = *(const u32x4*)(zr + C_GQ + h * 64 + cb), kv = *(const u32x4*)(zr + C_GK + h * 64 + cb);
        float qf[8], kf[8];
        qf[0] = bflo(qv.x); qf[1] = bfhi(qv.x); qf[2] = bflo(qv.y); qf[3] = bfhi(qv.y); qf[4] = bflo(qv.z); qf[5] = bfhi(qv.z); qf[6] = bflo(qv.w); qf[7] = bfhi(qv.w);
        kf[0] = bflo(kv.x); kf[1] = bfhi(kv.x); kf[2] = bflo(kv.y); kf[3] = bfhi(kv.y); kf[4] = bflo(kv.z); kf[5] = bfhi(kv.z); kf[6] = bflo(kv.w); kf[7] = bfhi(kv.w);
        float qs[8], ks[8];
#pragma unroll
        for (int i = 0; i < 8; ++i) { const float bl = __shfl(la[i], 63); const float eb = expf(la[i]);
            qs[i] = qf[i] * 0.125f * eb; ks[i] = kf[i] * expf(-la[i]);
            KhT[(cb + i) * 64 + t] = (bf16_t)f2bf(kf[i] * expf(bl - la[i]));
            if (lane == 63) DTAB[(size_t)unit * 64 + cb + i] = eb; }
        u32x4 qw, kw; qw.x = pk2(qs[0], qs[1]); qw.y = pk2(qs[2], qs[3]); qw.z = pk2(qs[4], qs[5]); qw.w = pk2(qs[6], qs[7]);
        kw.x = pk2(ks[0], ks[1]); kw.y = pk2(ks[2], ks[3]); kw.z = pk2(ks[4], ks[5]); kw.w = pk2(ks[6], ks[7]);
        *(LAS u32x4*)(Qs + t * 64 + cb) = qw; *(LAS u32x4*)(Ks + t * 64 + cb) = kw;
        *(u32x4*)(Z + (row0 + t) * ZP + C_GQ + h * 64 + cb) = qw;
        const u32x4 v0 = *(const u32x4*)(zr + C_GV + h * 128 + 16 * wid), v1 = *(const u32x4*)(zr + C_GV + h * 128 + 16 * wid + 8);
        LAS bf16_t* vt = VT + (16 * wid) * 64 + t;
        vt[0 * 64] = (bf16_t)(v0.x & 0xffff); vt[1 * 64] = (bf16_t)(v0.x >> 16); vt[2 * 64] = (bf16_t)(v0.y & 0xffff); vt[3 * 64] = (bf16_t)(v0.y >> 16);
        vt[4 * 64] = (bf16_t)(v0.z & 0xffff); vt[5 * 64] = (bf16_t)(v0.z >> 16); vt[6 * 64] = (bf16_t)(v0.w & 0xffff); vt[7 * 64] = (bf16_t)(v0.w >> 16);
        vt[8 * 64] = (bf16_t)(v1.x & 0xffff); vt[9 * 64] = (bf16_t)(v1.x >> 16); vt[10 * 64] = (bf16_t)(v1.y & 0xffff); vt[11 * 64] = (bf16_t)(v1.y >> 16);
        vt[12 * 64] = (bf16_t)(v1.z & 0xffff); vt[13 * 64] = (bf16_t)(v1.z >> 16); vt[14 * 64] = (bf16_t)(v1.w & 0xffff); vt[15 * 64] = (bf16_t)(v1.w >> 16);
    }
    __syncthreads();
    {
        const int vb = wid & 3, kb = wid >> 2; f32x16 acc = {};
#pragma unroll
        for (int ks = 0; ks < 4; ++ks) { const bf16x8 a = *(const LAS bf16x8*)(VT + (32 * vb + r32) * 64 + 16 * ks + 8 * hi); const bf16x8 bb = *(const LAS bf16x8*)(KhT + (32 * kb + r32) * 64 + 16 * ks + 8 * hi);
            acc = __builtin_amdgcn_mfma_f32_32x32x16_bf16(a, bb, acc, 0, 0, 0); }
        bf16_t* sp = SLOCT + (size_t)unit * 8192 + 32 * kb + r32;
#pragma unroll
        for (int r = 0; r < 16; ++r) sp[(32 * vb + crow(r, hi)) * 64] = (bf16_t)f2bf(acc[r]);
    }
    if (wid < 4) {
        const int sb = wid >> 1, tb = wid & 1; f32x16 acc = {};
        if (!(sb == 1 && tb == 0)) {
#pragma unroll
            for (int ks = 0; ks < 4; ++ks) { const bf16x8 a = *(const LAS bf16x8*)(Ks + (32 * sb + r32) * 64 + 16 * ks + 8 * hi); const bf16x8 bb = *(const LAS bf16x8*)(Qs + (32 * tb + r32) * 64 + 16 * ks + 8 * hi);
                acc = __builtin_amdgcn_mfma_f32_32x32x16_bf16(a, bb, acc, 0, 0, 0); }
        }
        const int t = 32 * tb + r32;
#pragma unroll
        for (int r = 0; r < 16; ++r) { const int s = 32 * sb + crow(r, hi); if (s > t) acc[r] = 0.f; }
#pragma unroll
        for (int g = 0; g < 4; ++g) { u32x2 w; w.x = pk2(acc[4 * g], acc[4 * g + 1]); w.y = pk2(acc[4 * g + 2], acc[4 * g + 3]); *(LAS u32x2*)(Am + t * 64 + 32 * sb + 8 * g + 4 * hi) = w; }
    }
    __syncthreads();
    {
        const int vb = wid & 3, tb = wid >> 2; f32x16 acc = {};
#pragma unroll
        for (int ks = 0; ks < 4; ++ks) { const bf16x8 a = *(const LAS bf16x8*)(Am + (32 * tb + r32) * 64 + 16 * ks + 8 * hi); const bf16x8 bb = *(const LAS bf16x8*)(VT + (32 * vb + r32) * 64 + 16 * ks + 8 * hi);
            acc = __builtin_amdgcn_mfma_f32_32x32x16_bf16(a, bb, acc, 0, 0, 0); }
        bf16_t* op = Z + (row0 + 32 * tb) * ZP + C_GV + h * 128 + 32 * vb + r32;
#pragma unroll
        for (int r = 0; r < 16; ++r) op[(size_t)crow(r, hi) * ZP] = (bf16_t)f2bf(acc[r]);
    }
    __syncthreads();
}

__device__ __forceinline__ void conv_ld_u(const bf16_t* Z, size_t row, int ch, float (&u)[8]) {
    const u32x4 a = *(const u32x4*)(Z + row * ZP + C_CX + ch), c = *(const u32x4*)(Z + row * ZP + C_CC + ch);
    u[0] = bflo(a.x) * bflo(c.x); u[1] = bfhi(a.x) * bfhi(c.x); u[2] = bflo(a.y) * bflo(c.y); u[3] = bfhi(a.y) * bfhi(c.y);
    u[4] = bflo(a.z) * bflo(c.z); u[5] = bfhi(a.z) * bfhi(c.z); u[6] = bflo(a.w) * bflo(c.w); u[7] = bfhi(a.w) * bfhi(c.w);
}
__device__ __forceinline__ void conv_unit(int cu, bf16_t* Z, const float* cw  , int wid, int lane) {
    const int ch = lane * 8; const size_t r0 = (size_t)cu * 128 + (size_t)wid * 16;
    float w0[8], w1[8], w2[8];
#pragma unroll
    for (int i = 0; i < 8; ++i) { w0[i] = cw[ch + i]; w1[i] = cw[512 + ch + i]; w2[i] = cw[1024 + ch + i]; }
    float u2[8], u1[8];
    if ((r0 % T) == 0) {
#pragma unroll
        for (int i = 0; i < 8; ++i) { u2[i] = 0.f; u1[i] = 0.f; }
    } else { conv_ld_u(Z, r0 - 2, ch, u2); conv_ld_u(Z, r0 - 1, ch, u1); }
    for (int i = 0; i < 16; ++i) { const size_t row = r0 + i; float u[8]; conv_ld_u(Z, row, ch, u);
        const u32x4 bq = *(const u32x4*)(Z + row * ZP + C_CB + ch);
        float bb[8]; bb[0] = bflo(bq.x); bb[1] = bfhi(bq.x); bb[2] = bflo(bq.y); bb[3] = bfhi(bq.y); bb[4] = bflo(bq.z); bb[5] = bfhi(bq.z); bb[6] = bflo(bq.w); bb[7] = bfhi(bq.w);
        float y[8];
#pragma unroll
        for (int k = 0; k < 8; ++k) { y[k] = bb[k] * (w0[k] * u2[k] + w1[k] * u1[k] + w2[k] * u[k]); u2[k] = u1[k]; u1[k] = u[k]; }
        u32x4 o; o.x = pk2(y[0], y[1]); o.y = pk2(y[2], y[3]); o.z = pk2(y[4], y[5]); o.w = pk2(y[6], y[7]);
        *(u32x4*)(Z + row * ZP + C_OC + ch) = o; }
}
namespace att {
constexpr int KVBLK = 64;
constexpr size_t SHM_V = 64 * 128 * 2, SHM_K = 64 * 128 * 2;
constexpr float C = 0.125f * 1.4426950408889634f;
constexpr float THR2 = 10.f;
#define KSWZ(row, colB) ((row) * 256 + ((colB) ^ (((row) & 7) << 4)))
#define SBAR() __builtin_amdgcn_sched_barrier(0)
__device__ __forceinline__ unsigned cvtpk(float lo, float hi) { unsigned r; asm volatile("v_cvt_pk_bf16_f32 %0, %1, %2" : "=v"(r) : "v"(lo), "v"(hi)); return r; }

__device__ __forceinline__ void partialSM(f32x16& p0, f32x16& p1, float& m_reg, float& mn, float& alpha, float kb0, float slope2, bool band, int dlim) {
#pragma unroll
    for (int r = 0; r < 16; ++r) { const float cr = (float)((r & 3) + 8 * (r >> 2)); p0[r] = fmaf(p0[r], C, fmaf(slope2, cr, kb0)); p1[r] = fmaf(p1[r], C, fmaf(slope2, cr + 32.f, kb0)); }
    if (band) {
#pragma unroll
        for (int r = 0; r < 16; ++r) { const int cr = (r & 3) + 8 * (r >> 2); if (cr > dlim) p0[r] = -1e30f; if (cr + 32 > dlim) p1[r] = -1e30f; }
    }
    float pmax = p0[0];
#pragma unroll
    for (int r = 1; r < 16; ++r) pmax = fmaxf(pmax, p0[r]);
#pragma unroll
    for (int r = 0; r < 16; ++r) pmax = fmaxf(pmax, p1[r]);
    { auto rr = __builtin_amdgcn_permlane32_swap(__float_as_uint(pmax), __float_as_uint(pmax), false, false);
      pmax = fmaxf(__uint_as_float(rr[0]), __uint_as_float(rr[1])); }
    if (__builtin_expect(__all(pmax - m_reg <= THR2), 1)) { mn = m_reg; alpha = 1.f; }
    else { mn = fmaxf(m_reg, pmax); alpha = __builtin_amdgcn_exp2f(m_reg - mn); m_reg = mn; }
#pragma unroll
    for (int r = 0; r < 16; ++r) { p0[r] -= mn; p1[r] -= mn; }
#pragma unroll
    for (int r = 0; r < 16; ++r) p0[r] = __builtin_amdgcn_exp2f(p0[r]);
}
__device__ __forceinline__ void finishSM(f32x16& p0, f32x16& p1, float alpha, float& l_reg, bf16x8& pa0, bf16x8& pa1, bf16x8& pa2, bf16x8& pa3) {
#pragma unroll
    for (int r = 0; r < 16; ++r) p1[r] = __builtin_amdgcn_exp2f(p1[r]);
    float ps = 0;
#pragma unroll
    for (int r = 0; r < 16; ++r) ps += p0[r];
#pragma unroll
    for (int r = 0; r < 16; ++r) ps += p1[r];
    { auto rr = __builtin_amdgcn_permlane32_swap(__float_as_uint(ps), __float_as_uint(ps), false, false);
      ps = __uint_as_float(rr[0]) + __uint_as_float(rr[1]); }
    l_reg = l_reg * alpha + ps;
#define PK4(P, BASE, OUT) do { unsigned a0 = cvtpk(P[BASE + 0], P[BASE + 1]), a1 = cvtpk(P[BASE + 2], P[BASE + 3]);   \
    unsigned b0 = cvtpk(P[BASE + 4], P[BASE + 5]), b1 = cvtpk(P[BASE + 6], P[BASE + 7]);                              \
    auto r0 = __builtin_amdgcn_permlane32_swap(a0, b0, false, false); auto r1 = __builtin_amdgcn_permlane32_swap(a1, b1, false, false); \
    u32x4 w = {r0[0], r1[0], r0[1], r1[1]}; OUT = *reinterpret_cast<bf16x8*>(&w); } while (0)
    PK4(p0, 0, pa0); PK4(p0, 8, pa1); PK4(p1, 0, pa2); PK4(p1, 8, pa3);
#undef PK4
}
__device__ __forceinline__ void qkt(f32x16& p0, f32x16& p1, const char* Ks, const bf16x8* qr, int r32, int hi, int m) {
    p0 = f32x16{}; p1 = f32x16{};
#pragma unroll
    for (int d0 = 0; d0 < 4; ++d0) { const int cb = ((4 * m + d0) * 16 + hi * 8) * 2;
        const bf16x8 b0 = *reinterpret_cast<const bf16x8*>(Ks + KSWZ(r32, cb));
        const bf16x8 b1 = *reinterpret_cast<const bf16x8*>(Ks + KSWZ(32 + r32, cb));
        p0 = __builtin_amdgcn_mfma_f32_32x32x16_bf16(b0, qr[d0], p0, 0, 0, 0);
        p1 = __builtin_amdgcn_mfma_f32_32x32x16_bf16(b1, qr[d0], p1, 0, 0, 0); }
}
__device__ __forceinline__ int v_st(int k, int c) { const int kk = (k & ~0xC) | ((k & 4) << 1) | ((k & 8) >> 1); return ((kk >> 3) * 4 + (c >> 5)) * 512 + ((kk & 7) * 32 + (c & 31)) * 2; }
__device__ __forceinline__ int v_rd_base(int lane) { return ((lane & 3) << 3) | (((lane >> 2) & 3) << 6) | (((lane >> 4) & 1) << 5) | (((lane >> 5) & 1) << 8); }
constexpr int v_rd_off(int d0, int ks, int half) { return d0 * 512 + ks * 4096 + half * 2048; }
template <int OFF> __device__ __forceinline__ s16x4 tr_read(int vb) {
    s16x4 r; asm volatile("ds_read_b64_tr_b16 %0, %1 offset:%2" : "=&v"(r) : "v"(vb), "i"(OFF) : "memory"); return r;
}
template <int D0> __device__ __forceinline__ void pv_one(f32x16& od, int vb, bf16x8 pa0, bf16x8 pa1, bf16x8 pa2, bf16x8 pa3) {
    const s16x4 l0 = tr_read<v_rd_off(D0, 0, 0)>(vb), h0 = tr_read<v_rd_off(D0, 0, 1)>(vb), l1 = tr_read<v_rd_off(D0, 1, 0)>(vb), h1 = tr_read<v_rd_off(D0, 1, 1)>(vb);
    const s16x4 l2 = tr_read<v_rd_off(D0, 2, 0)>(vb), h2 = tr_read<v_rd_off(D0, 2, 1)>(vb), l3 = tr_read<v_rd_off(D0, 3, 0)>(vb), h3 = tr_read<v_rd_off(D0, 3, 1)>(vb);
    asm volatile("s_waitcnt lgkmcnt(0)" ::: "memory"); SBAR();
#define PK(L, H) (bf16x8){L[0], L[1], L[2], L[3], H[0], H[1], H[2], H[3]}
    od = __builtin_amdgcn_mfma_f32_32x32x16_bf16(pa0, PK(l0, h0), od, 0, 0, 0);
    od = __builtin_amdgcn_mfma_f32_32x32x16_bf16(pa1, PK(l1, h1), od, 0, 0, 0);
    od = __builtin_amdgcn_mfma_f32_32x32x16_bf16(pa2, PK(l2, h2), od, 0, 0, 0);
    od = __builtin_amdgcn_mfma_f32_32x32x16_bf16(pa3, PK(l3, h3), od, 0, 0, 0);
#undef PK
}
__device__ __forceinline__ void pv_d0(f32x16* o, int vb, bf16x8 pa0, bf16x8 pa1, bf16x8 pa2, bf16x8 pa3) {
    pv_one<0>(o[0], vb, pa0, pa1, pa2, pa3); pv_one<1>(o[1], vb, pa0, pa1, pa2, pa3); pv_one<2>(o[2], vb, pa0, pa1, pa2, pa3); pv_one<3>(o[3], vb, pa0, pa1, pa2, pa3);
}

__device__ __forceinline__ void unit(int b, int h, int qb, float lam, float oneml, bf16_t* Z, const float* gdiff, char* lds) {
    int tid_l = threadIdx.x; asm volatile("" : "+v"(tid_l)); const int tid = tid_l;
    const int wid = tid >> 6, lane = tid & 63, r32 = lane & 31, hi = lane >> 5, m = wid >> 2, rb = wid & 3;
    const size_t rowbase = (size_t)b * T; const int q0 = qb * 128;
    const float slope2 = exp2f(-2.f * (float)(h + 1)) * 1.4426950408889634f;
    char* V_lds = lds; char* K_lds = lds + 2 * SHM_V;
    float* wsf = (float*)(lds + 2 * SHM_V + 2 * SHM_K) + wid * 64; float* li_l = wsf; float* al_l = wsf + 32;
    float m_reg = -1e30f, l_reg = 0; f32x16 o[4] = {}; bf16x8 qr[4];
    const bf16_t* Qw = Z + (rowbase + q0 + rb * 32 + r32) * ZP + C_DQ + h * 128 + m * 64 + hi * 8;
#pragma unroll
    for (int d0 = 0; d0 < 4; ++d0) qr[d0] = *reinterpret_cast<const bf16x8*>(Qw + d0 * 16);
    const bf16_t* Kh = Z + rowbase * ZP + C_DK + h * 128; const bf16_t* Vh = Z + rowbase * ZP + C_DV + h * 128;
    const int sr = tid >> 4, sc = (tid & 15) * 8, vst0 = v_st(sr, sc), vst1 = v_st(32 + sr, sc);
    const int vb0 = (int)(uintptr_t)V_lds + v_rd_base(lane);
    const int qrel = q0 + rb * 32 + r32;
    struct { bf16x8 vs0, vs1, ks0, ks1; } sr_[2];
#define SLOAD(i, k0) do { sr_[i].vs0 = *reinterpret_cast<const bf16x8*>(&Vh[(size_t)((k0) + sr) * ZP + sc]); sr_[i].vs1 = *reinterpret_cast<const bf16x8*>(&Vh[(size_t)((k0) + 32 + sr) * ZP + sc]); \
    sr_[i].ks0 = *reinterpret_cast<const bf16x8*>(&Kh[(size_t)((k0) + sr) * ZP + sc]); sr_[i].ks1 = *reinterpret_cast<const bf16x8*>(&Kh[(size_t)((k0) + 32 + sr) * ZP + sc]); } while (0)
#define SWRITE(bb, i) do { *(bf16x8*)(V_lds + (bb) * SHM_V + vst0) = sr_[i].vs0;          \
    *(bf16x8*)(V_lds + (bb) * SHM_V + vst1) = sr_[i].vs1; const int kc = sc * 2;               \
    *(bf16x8*)(K_lds + (bb) * SHM_K + KSWZ(sr, kc)) = sr_[i].ks0;                       \
    *(bf16x8*)(K_lds + (bb) * SHM_K + KSWZ(32 + sr, kc)) = sr_[i].ks1; } while (0)
#define SWAIT() asm volatile("s_waitcnt vmcnt(4)" ::: "memory")
#define RESC(a) do { if (__any((a) < 1.f)) { if (hi == 0) al_l[r32] = (a); asm volatile("s_waitcnt lgkmcnt(0)" ::: "memory"); \
    _Pragma("unroll") for (int d = 0; d < 4; ++d) _Pragma("unroll") for (int r = 0; r < 16; ++r) o[d][r] *= al_l[crow(r, hi)]; } } while (0)
#define PSM(P0, P1, MN, AL, j) partialSM(P0, P1, m_reg, MN, AL, slope2 * (float)(64 * (j) + 4 * hi - qrel), slope2, (j) >= NT - 2, qrel - 64 * (j) - 4 * hi)
    f32x16 pA0, pA1, pB0, pB1; float mnA, mnB, alA, alB; bf16x8 pa0, pa1, pa2, pa3; const int NT = 2 * (qb + 1);
    constexpr int SE = 0, SO = 1;
    SLOAD(SE, 0); asm volatile("s_waitcnt vmcnt(0)" ::: "memory"); SWRITE(0, SE); __syncthreads();
    qkt(pA0, pA1, K_lds, qr, r32, hi, m); PSM(pA0, pA1, mnA, alA, 0);
    SLOAD(SO, KVBLK); if (2 < NT) SLOAD(SE, 2 * KVBLK);
    SWAIT(); SWRITE(1, SO); __syncthreads();
    for (int j = 1; j + 1 < NT; j += 2) {
        SBAR(); qkt(pB0, pB1, K_lds + SHM_K, qr, r32, hi, m);
        finishSM(pA0, pA1, alA, l_reg, pa0, pa1, pa2, pa3); SBAR();
        SLOAD(SO, (j + 2) * KVBLK); SBAR();
        pv_d0(o, vb0, pa0, pa1, pa2, pa3); PSM(pB0, pB1, mnB, alB, j);
        __syncthreads(); SWAIT(); SWRITE(0, SE);
        RESC(alB); __syncthreads();
        SBAR(); qkt(pA0, pA1, K_lds, qr, r32, hi, m);
        finishSM(pB0, pB1, alB, l_reg, pa0, pa1, pa2, pa3); SBAR();
        if (j + 3 < NT) SLOAD(SE, (j + 3) * KVBLK); SBAR();
        pv_d0(o, vb0 + (int)SHM_V, pa0, pa1, pa2, pa3); PSM(pA0, pA1, mnA, alA, j + 1);
        __syncthreads(); SWAIT(); SWRITE(1, SO);
        RESC(alA); __syncthreads();
    }
    SBAR(); qkt(pB0, pB1, K_lds + SHM_K, qr, r32, hi, m);
    finishSM(pA0, pA1, alA, l_reg, pa0, pa1, pa2, pa3); SBAR();
    pv_d0(o, vb0, pa0, pa1, pa2, pa3); PSM(pB0, pB1, mnB, alB, NT - 1);
    __syncthreads(); RESC(alB);
    finishSM(pB0, pB1, alB, l_reg, pa0, pa1, pa2, pa3); SBAR();
    pv_d0(o, vb0 + (int)SHM_V, pa0, pa1, pa2, pa3);
    if (hi == 0) li_l[r32] = l_reg; asm volatile("s_waitcnt lgkmcnt(0)" ::: "memory");
    float rli[16];
#pragma unroll
    for (int r = 0; r < 16; ++r) rli[r] = __builtin_amdgcn_rcpf(li_l[crow(r, hi)]);
    __syncthreads();
    float* XO = (float*)lds + rb * 4096;
    if (m == 1) {
#pragma unroll
        for (int d0 = 0; d0 < 4; ++d0)
#pragma unroll
            for (int r = 0; r < 16; ++r) XO[(d0 * 16 + r) * 64 + lane] = o[d0][r] * rli[r];
    }
    __syncthreads();
    if (m == 0) {
        float ss[16];
#pragma unroll
        for (int r = 0; r < 16; ++r) ss[r] = 0.f;
#pragma unroll
        for (int d0 = 0; d0 < 4; ++d0)
#pragma unroll
            for (int r = 0; r < 16; ++r) { const float v = o[d0][r] * rli[r] - lam * XO[(d0 * 16 + r) * 64 + lane]; o[d0][r] = v; ss[r] += v * v; }
#pragma unroll
        for (int r = 0; r < 16; ++r) {
#pragma unroll
            for (int x = 1; x < 32; x <<= 1) ss[r] += __shfl_xor(ss[r], x);
            ss[r] = oneml / sqrtf(ss[r] * (1.f / 128.f) + EPS); }
        bf16_t* Ow = Z + (rowbase + q0 + rb * 32) * ZP + C_OB + h * 128 + r32;
#pragma unroll
        for (int d0 = 0; d0 < 4; ++d0) { const float gc = gdiff[32 * d0 + r32];
#pragma unroll
            for (int r = 0; r < 16; ++r) Ow[(size_t)crow(r, hi) * ZP + 32 * d0] = (bf16_t)f2bf(o[d0][r] * ss[r] * gc); }
    }
    __syncthreads();
#undef SLOAD
#undef SWRITE
#undef SWAIT
#undef RESC
#undef PSM
}
#undef KSWZ
#undef SBAR
}

__device__ __forceinline__ void gla_scan(bf16_t* SLOCT, const float* DTAB, int G, int tid) {
    if (tid >= 128) return;
    for (int pi = blockIdx.x * 128 + tid; pi < 32768; pi += G * 128) {
        const int bh = pi >> 12, e2 = (pi & 4095) * 2, dk = e2 & 63;
        float r0 = 0.f, r1 = 0.f;
        unsigned* sp = (unsigned*)(SLOCT + (size_t)bh * 256 * 8192 + e2); const float* dp = DTAB + (size_t)bh * 256 * 64 + dk;
        for (int c0 = 0; c0 < 256; c0 += 8) {
            unsigned u[8]; f32x2 d[8];
#pragma unroll
            for (int i = 0; i < 8; ++i) { u[i] = sp[(size_t)(c0 + i) * 4096]; d[i] = *(const f32x2*)(dp + (size_t)(c0 + i) * 64); }
#pragma unroll
            for (int i = 0; i < 8; ++i) { sp[(size_t)(c0 + i) * 4096] = pk2(r0, r1); r0 = fmaf(d[i].x, r0, bflo(u[i])); r1 = fmaf(d[i].y, r1, bfhi(u[i])); }
        }
    }
}

__device__ __forceinline__ void gla3_unit(int unit, bf16_t* Z, const bf16_t* SLOCT, const float* ggn, LAS unsigned char* lds, int wid, int lane) {
    const int bh = unit >> 8, c = unit & 255, b = bh >> 2, h = bh & 3; const size_t row0 = (size_t)b * T + (size_t)c * 64;
    const int r32 = lane & 31, hi = lane >> 5, vb = wid & 3, tb = wid >> 2;
    LAS float* SS = (LAS float*)lds;
    f32x16 acc = {};
#pragma unroll
    for (int ks = 0; ks < 4; ++ks) { const bf16x8 a = *(const bf16x8*)(Z + (row0 + 32 * tb + r32) * ZP + C_GQ + h * 64 + 16 * ks + 8 * hi);
        const bf16x8 bb = *(const bf16x8*)(SLOCT + (size_t)unit * 8192 + (32 * vb + r32) * 64 + 16 * ks + 8 * hi);
        acc = __builtin_amdgcn_mfma_f32_32x32x16_bf16(a, bb, acc, 0, 0, 0); }
    const bf16_t* oi = Z + (row0 + 32 * tb) * ZP + C_GV + h * 128 + 32 * vb + r32;
    float o[16], ss[16];
#pragma unroll
    for (int r = 0; r < 16; ++r) { o[r] = acc[r] + bf2f(oi[(size_t)crow(r, hi) * ZP]); ss[r] = o[r] * o[r]; }
#pragma unroll
    for (int r = 0; r < 16; ++r) {
#pragma unroll
        for (int x = 1; x < 32; x <<= 1) ss[r] += __shfl_xor(ss[r], x);
        if (r32 == 0) SS[wid * 32 + crow(r, hi)] = ss[r]; }
    __syncthreads();
    const float gcol = ggn[32 * vb + r32];
    bf16_t* gp = Z + (row0 + 32 * tb) * ZP + C_GG + h * 128 + 32 * vb + r32;
#pragma unroll
    for (int r = 0; r < 16; ++r) { const int tr = crow(r, hi);
        const float tot = (SS[(tb * 4 + 0) * 32 + tr] + SS[(tb * 4 + 1) * 32 + tr]) + (SS[(tb * 4 + 2) * 32 + tr] + SS[(tb * 4 + 3) * 32 + tr]);
        const float rstd = 1.0f / sqrtf(tot * (1.f / 128.f) + EPS);
        const float gg = bf2f(gp[(size_t)tr * ZP]);
        gp[(size_t)tr * ZP] = (bf16_t)f2bf(o[r] * rstd * gcol * siluf_(gg)); }
    __syncthreads();
}
namespace pg8 {
struct EpiMerge {
    static constexpr bool PERM = true;
    bf16_t* Z;
    __device__ __forceinline__ void operator()(const f32x4 (&acc)[2][2][4][2], const Unit& u, int wr, int wc, int fr, int fq) const {
        const int j = u.tag; const int row0 = u.pm * BM + wr * 64 + fr; const int col0 = u.pn * BM + wc * 32 + 8 * fq;
#pragma unroll
        for (int ai = 0; ai < 2; ++ai)
#pragma unroll
            for (int m = 0; m < 4; ++m) { bf16_t* rowp = Z + (size_t)(row0 + ai * HALF + m * 16) * ZP + col0;
#pragma unroll
                for (int bj = 0; bj < 2; ++bj) { const f32x4 v0 = acc[ai][bj][m][0], v1 = acc[ai][bj][m][1];
                    const u32x4 y = *(const u32x4*)(rowp + bj * HALF + 1024 * j);
                    u32x4 pv = {0u, 0u, 0u, 0u}; if (j > 0) pv = *(const u32x4*)(rowp + bj * HALF);
                    u32x4 w;
                    w.x = pk2(fmaf(sigmoidf_(v0[0]), bflo(y.x), bflo(pv.x)), fmaf(sigmoidf_(v0[1]), bfhi(y.x), bfhi(pv.x)));
                    w.y = pk2(fmaf(sigmoidf_(v0[2]), bflo(y.y), bflo(pv.y)), fmaf(sigmoidf_(v0[3]), bfhi(y.y), bfhi(pv.y)));
                    w.z = pk2(fmaf(sigmoidf_(v1[0]), bflo(y.z), bflo(pv.z)), fmaf(sigmoidf_(v1[1]), bfhi(y.z), bfhi(pv.z)));
                    w.w = pk2(fmaf(sigmoidf_(v1[2]), bflo(y.w), bflo(pv.w)), fmaf(sigmoidf_(v1[3]), bfhi(y.w), bfhi(pv.w)));
                    *(u32x4*)(rowp + bj * HALF) = w; }
                asm volatile("" ::: "memory"); }
    }
};
struct EpiRes {
    static constexpr bool PERM = false;
    const float* base; float* out;
    __device__ __forceinline__ void operator()(const f32x4 (&acc)[2][2][4][2], const Unit& u, int wr, int wc, int fr, int fq) const {
        const int row0 = u.pm * BM + wr * 64 + fr; const int col0 = u.pn * BM + wc * 32 + 4 * fq;
#pragma unroll
        for (int ai = 0; ai < 2; ++ai)
#pragma unroll
            for (int m = 0; m < 4; ++m) { const size_t off = (size_t)(row0 + ai * HALF + m * 16) * DM + col0;
#pragma unroll
                for (int bj = 0; bj < 2; ++bj)
#pragma unroll
                    for (int n = 0; n < 2; ++n) { const f32x4 bs = *(const f32x4*)(base + off + bj * HALF + n * 16); *(f32x4*)(out + off + bj * HALF + n * 16) = bs + acc[ai][bj][m][n]; } }
    }
};
struct EpiPle {
    static constexpr bool PERM = false;
    const float* base; float* out; const bf16_t* PL;
    __device__ __forceinline__ void operator()(const f32x4 (&acc)[2][2][4][2], const Unit& u, int wr, int wc, int fr, int fq) const {
        const int row0 = u.pm * BM + wr * 64 + fr; const int col0 = u.pn * BM + wc * 32 + 4 * fq;
#pragma unroll
        for (int ai = 0; ai < 2; ++ai)
#pragma unroll
            for (int m = 0; m < 4; ++m) { const size_t off = (size_t)(row0 + ai * HALF + m * 16) * DM + col0;
#pragma unroll
                for (int bj = 0; bj < 2; ++bj)
#pragma unroll
                    for (int n = 0; n < 2; ++n) { const f32x4 bs = *(const f32x4*)(base + off + bj * HALF + n * 16); const u32x2 pl = *(const u32x2*)(PL + off + bj * HALF + n * 16); const f32x4 a = acc[ai][bj][m][n];
                        f32x4 o; o.x = fmaf(sigmoidf_(a.x), bflo(pl.x), bs.x); o.y = fmaf(sigmoidf_(a.y), bfhi(pl.x), bs.y); o.z = fmaf(sigmoidf_(a.z), bflo(pl.y), bs.z); o.w = fmaf(sigmoidf_(a.w), bfhi(pl.y), bs.w);
                        *(f32x4*)(out + off + bj * HALF + n * 16) = o; } }
    }
};
struct EpiUp {
    static constexpr bool PERM = true;
    bf16_t* ACT;
    __device__ __forceinline__ void operator()(const f32x4 (&acc)[2][2][4][2], const Unit& u, int wr, int wc, int fr, int fq) const {
        const int row0 = u.pm * BM + wr * 64 + fr; const int col0 = u.pn * HALF + wc * 32 + 8 * fq;
#pragma unroll
        for (int ai = 0; ai < 2; ++ai)
#pragma unroll
            for (int m = 0; m < 4; ++m) { const f32x4 g0 = acc[ai][0][m][0], g1 = acc[ai][0][m][1], u0 = acc[ai][1][m][0], u1 = acc[ai][1][m][1];
                u32x4 w; w.x = pk2(siluf_(g0[0]) * u0[0], siluf_(g0[1]) * u0[1]); w.y = pk2(siluf_(g0[2]) * u0[2], siluf_(g0[3]) * u0[3]);
                w.z = pk2(siluf_(g1[0]) * u1[0], siluf_(g1[1]) * u1[1]); w.w = pk2(siluf_(g1[2]) * u1[2], siluf_(g1[3]) * u1[3]);
                *(u32x4*)(ACT + (size_t)(row0 + ai * HALF + m * 16) * DEXP + col0) = w; }
    }
};
struct EpiDown {
    static constexpr bool PERM = true;
    bf16_t* Y; const float* sw;
    __device__ __forceinline__ void operator()(const f32x4 (&acc)[2][2][4][2], const Unit& u, int wr, int wc, int fr, int fq) const {
        const int row0 = u.pm * BM + wr * 64 + fr; const int col0 = u.pn * BM + wc * 32 + 8 * fq;
#pragma unroll
        for (int ai = 0; ai < 2; ++ai)
#pragma unroll
            for (int m = 0; m < 4; ++m) { const int row = row0 + ai * HALF + m * 16; const float s = sw[row]; bf16_t* rowp = Y + (size_t)row * DM + col0;
#pragma unroll
                for (int bj = 0; bj < 2; ++bj) { const f32x4 v0 = acc[ai][bj][m][0] * s, v1 = acc[ai][bj][m][1] * s;
                    u32x4 w; w.x = pk2(v0[0], v0[1]); w.y = pk2(v0[2], v0[3]); w.z = pk2(v1[0], v1[1]); w.w = pk2(v1[2], v1[3]);
                    *(u32x4*)(rowp + bj * HALF) = w; } }
    }
};
struct MergeOrder {
    int c, G; int abase, astep; size_t bbase, bstep;
    __device__ bool next(int i, Unit& u) const { const int pair = (i / 3) * G + c, j = i % 3; if (pair >= 512) return false;
        u.pm = pair >> 2; u.pn = pair & 3; u.tag = j; u.aoff = abase + j * astep; u.boff = bbase + (size_t)j * bstep; return true; }
};
struct GroupOrder {
    const int* tbl;
    int c, G; size_t bstride;
    __device__ bool next(int i, Unit& u) const {
        int L = i * G + c; int found = 0, pm = 0, pn = 0, ee = 0;
#pragma unroll
        for (int e = 0; e < NEXP; ++e) { const int nt_e = (tbl[16 + e] + 255) >> 8, nu = nt_e * 4;
            if (!found && L < nu) { found = 1; pm = (tbl[e] >> 8) + (L >> 2); pn = L & 3; ee = e; }
            if (!found) L -= nu; }
        if (!found) return false;
        u.pm = pm; u.pn = pn; u.tag = ee; u.aoff = 0; u.boff = (size_t)ee * bstride; return true; }
};
}

__device__ __forceinline__ void phaseF(KA P, int L, LAS unsigned char* lds, int wave, int lane, int tid) {
    LAS float* WR = (LAS float*)lds; LAS int* E0 = (LAS int*)(lds + 81920); LAS int* E1 = (LAS int*)(lds + 82432); LAS float* W0 = (LAS float*)(lds + 82944); LAS float* W1 = (LAS float*)(lds + 83456);
    const float* wrg = P->p.in[15] + (size_t)L * DM * 4; const float* wre = P->p.in[17] + (size_t)L * DM * 16;
    for (int i = tid; i < DM * 4; i += 512) WR[(i & 3) * 1024 + (i >> 2)] = wrg[i];
    for (int i = tid; i < DM * 16; i += 512) WR[(4 + (i & 15)) * 1024 + (i >> 4)] = wre[i];
    __syncthreads();
    const float* brg = P->p.in[16] + L * 4; const float* bre = P->p.in[18] + L * 16; const float* g = P->p.in[14] + (size_t)L * DM;
    const int tok0 = blockIdx.x * TPW;
    int* RE0 = (int*)(P->p.ws + WS_ROUTE); int* RE1 = RE0 + NTOK; float* RW0 = (float*)(RE1 + NTOK); float* RW1 = RW0 + NTOK;
    for (int i = wave * 16; i < wave * 16 + 16; ++i) {
        const int tok = tok0 + i;
        const f32x4* xr = (const f32x4*)(P->p.out + (size_t)tok * DM) + lane; const f32x4* gr = (const f32x4*)g + lane;
        f32x4 v[4]; float s = 0.f;
#pragma unroll
        for (int j = 0; j < 4; ++j) { v[j] = xr[64 * j]; s += (v[j].x * v[j].x + v[j].y * v[j].y) + (v[j].z * v[j].z + v[j].w * v[j].w); }
        const float r = 1.0f / sqrtf(wave_sum(s) * (1.f / DM) + EPS);
        u32x2* o8 = (u32x2*)((bf16_t*)(P->p.ws + WS_HN) + (size_t)tok * DM) + lane;
#pragma unroll
        for (int j = 0; j < 4; ++j) { const f32x4 gg = gr[64 * j]; v[j].x *= r * gg.x; v[j].y *= r * gg.y; v[j].z *= r * gg.z; v[j].w *= r * gg.w;
            u32x2 w; w.x = pk2(v[j].x, v[j].y); w.y = pk2(v[j].z, v[j].w); o8[64 * j] = w; }
        float lg[20];
#pragma unroll
        for (int o = 0; o < 20; ++o) { float a = 0.f;
#pragma unroll
            for (int j = 0; j < 4; ++j) { const f32x4 w = *(const LAS f32x4*)(WR + o * 1024 + 256 * j + 4 * lane); a += (v[j].x * w.x + v[j].y * w.y) + (v[j].z * w.z + v[j].w * w.w); }
            lg[o] = wave_sum(a); }
        float gl[4];
#pragma unroll
        for (int q = 0; q < 4; ++q) gl[q] = lg[q] + brg[q];
        int gi = 0; float gm = gl[0];
#pragma unroll
        for (int q = 1; q < 4; ++q) if (gl[q] > gm) { gm = gl[q]; gi = q; }
        float den = 0.f;
#pragma unroll
        for (int q = 0; q < 4; ++q) den += expf(gl[q] - gm);
        const float gp = 1.0f / den;
        float wv[4];
#pragma unroll
        for (int q = 0; q < 4; ++q) { const float e0v = lg[4 + q] + bre[q], e1v = lg[8 + q] + bre[4 + q], e2v = lg[12 + q] + bre[8 + q], e3v = lg[16 + q] + bre[12 + q];
            wv[q] = gi == 0 ? e0v : gi == 1 ? e1v : gi == 2 ? e2v : e3v; }
        int i0 = 0; float m0 = wv[0];
#pragma unroll
        for (int q = 1; q < 4; ++q) if (wv[q] > m0) { m0 = wv[q]; i0 = q; }
        int i1 = -1; float m1 = 0.f;
#pragma unroll
        for (int q = 0; q < 4; ++q) if (q != i0 && (i1 < 0 || wv[q] > m1)) { m1 = wv[q]; i1 = q; }
        const float t = expf(m1 - m0); const float w0 = gp / (1.f + t), w1 = gp * t / (1.f + t);
        if (lane == 0) { const int e0 = gi * 4 + i0, e1 = gi * 4 + i1; E0[i] = e0; E1[i] = e1; W0[i] = w0; W1[i] = w1; RE0[tok] = e0; RE1[tok] = e1; RW0[tok] = w0; RW1[tok] = w1; }
    }
    __syncthreads();
    if (tid < 16) { int cnt = 0; for (int i = 0; i < TPW; ++i) cnt += (E0[i] == tid) + (E1[i] == tid); ((int*)(P->p.ws + WS_HIST))[blockIdx.x * 16 + tid] = cnt; }
    __syncthreads();
}

__device__ __forceinline__ void phaseG(KA P, LAS unsigned char* lds, int wave, int lane, int tid) {
    LAS int* E0 = (LAS int*)lds; LAS int* E1 = (LAS int*)(lds + 512); LAS int* S0 = (LAS int*)(lds + 1024); LAS int* S1 = (LAS int*)(lds + 1536);
    LAS int* TOT = (LAS int*)(lds + 2048); LAS int* PRE = (LAS int*)(lds + 2112); LAS int* EB = (LAS int*)(lds + 2176);
    const int* HIST = (const int*)(P->p.ws + WS_HIST); const int tok0 = blockIdx.x * TPW;
    const int* RE0 = (const int*)(P->p.ws + WS_ROUTE); const int* RE1 = RE0 + NTOK; const float* RW0 = (const float*)(RE1 + NTOK); const float* RW1 = RW0 + NTOK;
    LAS int* PT = (LAS int*)(lds + 4096); LAS int* PP = (LAS int*)(lds + 4096 + 2048);
    { const int e = tid & 15, part = tid >> 4; int tot = 0, pre = 0;
#pragma unroll
      for (int k = 0; k < 8; ++k) { const int w = part * 8 + k; const int hv = HIST[w * 16 + e]; tot += hv; if (w < (int)blockIdx.x) pre += hv; }
      PT[part * 16 + e] = tot; PP[part * 16 + e] = pre; }
    if (tid < TPW) { E0[tid] = RE0[tok0 + tid]; E1[tid] = RE1[tok0 + tid]; }
    __syncthreads();
    if (tid < 16) { int tot = 0, pre = 0; for (int q = 0; q < 32; ++q) { tot += PT[q * 16 + tid]; pre += PP[q * 16 + tid]; } TOT[tid] = tot; PRE[tid] = pre; }
    __syncthreads();
    if (tid == 0) { int eb = 0; for (int e = 0; e < NEXP; ++e) { EB[e] = eb; eb += (TOT[e] + 255) & ~255; }
        if (blockIdx.x == 0) { int* tbl = (int*)(P->p.ws + WS_TBL); for (int e = 0; e < NEXP; ++e) { tbl[e] = EB[e]; tbl[16 + e] = TOT[e]; } } }
    __syncthreads();
    if (tid < 16) { int run = EB[tid] + PRE[tid]; for (int i = 0; i < TPW; ++i) { if (E0[i] == tid) S0[i] = run++; if (E1[i] == tid) S1[i] = run++; } }
    __syncthreads();
    const bf16_t* H2 = (const bf16_t*)(P->p.ws + WS_HN); bf16_t* HG = (bf16_t*)(P->p.ws + WS_HG); float* SW = (float*)(P->p.ws + WS_SLOTW); int* TS = (int*)(P->p.ws + WS_TOKSLOT);
    for (int i = wave * 16; i < wave * 16 + 16; ++i) { const int tok = tok0 + i, s0 = S0[i], s1 = S1[i];
        const u32x4* src = (const u32x4*)(H2 + (size_t)tok * DM) + lane; const u32x4 a = src[0], b2 = src[64];
        u32x4* d0 = (u32x4*)(HG + (size_t)s0 * DM) + lane; u32x4* d1 = (u32x4*)(HG + (size_t)s1 * DM) + lane;
        d0[0] = a; d0[64] = b2; d1[0] = a; d1[64] = b2;
        if (lane == 0) { SW[s0] = RW0[tok]; SW[s1] = RW1[tok]; TS[2 * tok] = s0; TS[2 * tok + 1] = s1; } }
}

__device__ __forceinline__ void phaseJ_rows(KA P, int vcu, int G, int wave, int lane) {
    const bf16_t* Y = (const bf16_t*)(P->p.ws + WS_HG); const int* TS = (const int*)(P->p.ws + WS_TOKSLOT); bf16_t* XB = (bf16_t*)(P->p.ws + WS_HN);
    for (int tok = vcu * 8 + wave; tok < NTOK; tok += G * 8) { const int s0 = TS[2 * tok], s1 = TS[2 * tok + 1];
        f32x4* xr = (f32x4*)(P->p.out + (size_t)tok * DM) + lane; const u32x2* y0 = (const u32x2*)(Y + (size_t)s0 * DM) + lane; const u32x2* y1 = (const u32x2*)(Y + (size_t)s1 * DM) + lane;
        u32x2* o8 = (u32x2*)(XB + (size_t)tok * DM) + lane;
#pragma unroll
        for (int j = 0; j < 4; ++j) { f32x4 v = xr[64 * j]; const u32x2 a = y0[64 * j], b = y1[64 * j];
            v.x += bflo(a.x) + bflo(b.x); v.y += bfhi(a.x) + bfhi(b.x); v.z += bflo(a.y) + bflo(b.y); v.w += bfhi(a.y) + bfhi(b.y);
            xr[64 * j] = v; u32x2 w; w.x = pk2(v.x, v.y); w.y = pk2(v.z, v.w); o8[64 * j] = w; } }
}
__device__ __forceinline__ void final_rows(KA P, int vcu, int G, int wave, int lane) {
    const f32x4* gr = (const f32x4*)P->p.in[23] + lane;
    for (int tok = vcu * 8 + wave; tok < NTOK; tok += G * 8) { f32x4* xr = (f32x4*)(P->p.out + (size_t)tok * DM) + lane; f32x4 v[4]; float s = 0.f;
#pragma unroll
        for (int j = 0; j < 4; ++j) { v[j] = xr[64 * j]; s += (v[j].x * v[j].x + v[j].y * v[j].y) + (v[j].z * v[j].z + v[j].w * v[j].w); }
        const float r = 1.0f / sqrtf(wave_sum(s) * (1.f / DM) + EPS);
#pragma unroll
        for (int j = 0; j < 4; ++j) { const f32x4 gg = gr[64 * j]; f32x4 o; o.x = v[j].x * r * gg.x; o.y = v[j].y * r * gg.y; o.z = v[j].z * r * gg.z; o.w = v[j].w * r * gg.w; xr[64 * j] = o; } }
}
#ifndef MK_N_LAUNCHES
#define MK_N_LAUNCHES 1
#endif
constexpr int PH_PER_LAYER = 13, N_PHASES = DEPTH * PH_PER_LAYER + 1;
constexpr int N_LAUNCHES = MK_N_LAUNCHES;
static_assert(N_LAUNCHES == 1 || N_LAUNCHES == N_PHASES, "MK_N_LAUNCHES is 1 or 27");

#define PH_FN static __device__ __forceinline__ void
#define PH_COMMON int tid_l = threadIdx.x; asm volatile("" : "+v"(tid_l)); asm volatile("" : "+s"(ka)); asm volatile("" : "+s"(L)); const int tid = tid_l, lane = tid & 63, wave = __builtin_amdgcn_readfirstlane(tid >> 6); int G_l = gridDim.x, bx_l = blockIdx.x; asm volatile("" : "+s"(G_l)); asm volatile("" : "+s"(bx_l)); const int G = G_l, bx = bx_l; \
    const int vcu = (G % 8 == 0) ? (bx % 8) * (G / 8) + bx / 8 : bx; unsigned char* ws = ka->p.ws; (void)tid; (void)lane; (void)wave; (void)vcu; (void)ws; \
    bf16_t* Z = (bf16_t*)(ws + WS_Z); bf16_t* HN = (bf16_t*)(ws + WS_HN); (void)Z; (void)HN;

PH_FN ph_A(KA ka, int L, LAS unsigned char* L3) { PH_COMMON; KA P = ka; phaseA(P, L, L3, vcu, G, wave, lane, tid); }
PH_FN ph_B(KA ka, int L, LAS unsigned char* L3) { PH_COMMON;
    pg8::Gemm g{HN, DM, (const bf16_t*)(ws + WS_WIN), DM, DM}; pg8::StaticOrder S; S.init(NTOK, NZT * 256, G, bx);
    pg8::EpiBf16 E{Z, ZP, 0};
    pg8::gemm_phase<pg8::EpiBf16, pg8::StaticOrder, true, true>(L3, g, S, E); }
PH_FN ph_C1a(KA ka, int L, LAS unsigned char* L3) { PH_COMMON;
    const float* wa2 = ka->p.in[4] + (size_t)L * 16 * 256; const float* ba = ka->p.in[5] + (size_t)L * 256;
    for (int u = bx; u < 2048; u += G) gla1_unit(u, Z, wa2, ba, (bf16_t*)(ws + WS_SLOC), (float*)(ws + WS_DTAB), L3, wave, lane, tid);
    for (int cu = bx; cu < 256; cu += G) conv_unit(cu, Z, ka->p.in[11] + (size_t)L * 3 * 512, wave, lane); }
PH_FN ph_C1b(KA ka, int L, LAS unsigned char* L3) { PH_COMMON;
    const float* lp = ka->p.in[8] + (size_t)L * 256;
    const float sa = wave_sum(lp[lane] * lp[64 + lane]), sb = wave_sum(lp[128 + lane] * lp[192 + lane]);
    const float lam_init = 0.8f - 0.6f * expf(-0.3f * (float)L); const float lam = expf(sa) - expf(sb) + lam_init;
    const float* gd = ka->p.in[9] + (size_t)L * 128;
    for (int r = 0; r < 4; ++r) { const int uidx = r * 256 + ((r & 1) ? 255 - bx : bx); if (uidx >= 1024 || bx >= 256) break;
        const int qb = 127 - (uidx >> 3), bh = uidx & 7;
        att::unit(bh >> 2, bh & 3, qb, lam, 1.0f - lam_init, Z, gd, (char*)L3); } }
PH_FN ph_C2(KA ka, int L, LAS unsigned char* L3) { PH_COMMON; gla_scan((bf16_t*)(ws + WS_SLOC), (const float*)(ws + WS_DTAB), G, tid); }
PH_FN ph_C3(KA ka, int L, LAS unsigned char* L3) { PH_COMMON; for (int u = bx; u < 2048; u += G) gla3_unit(u, Z, (const bf16_t*)(ws + WS_SLOC), ka->p.in[6] + (size_t)L * 128, L3, wave, lane); }
PH_FN ph_D1(KA ka, int L, LAS unsigned char* L3) { PH_COMMON;
    pg8::Gemm g{Z, ZP, (const bf16_t*)(ws + WS_WO), 512, 512}; pg8::MergeOrder S{bx, G, C_OA, 512, 0, (size_t)DM * 512};
    pg8::EpiBf16 E{Z, ZP, 1024};
    pg8::gemm_phase<pg8::EpiBf16, pg8::MergeOrder, true, true>(L3, g, S, E); }
PH_FN ph_D2(KA ka, int L, LAS unsigned char* L3) { PH_COMMON;
    pg8::Gemm g{HN, DM, (const bf16_t*)(ws + WS_WIN), DM, DM}; pg8::MergeOrder S{bx, G, 0, 0, (size_t)NZT * 256 * DM, (size_t)4 * 256 * DM};
    pg8::EpiMerge E{Z};
    pg8::gemm_phase<pg8::EpiMerge, pg8::MergeOrder, true, true>(L3, g, S, E); }
PH_FN ph_E(KA ka, int L, LAS unsigned char* L3) { PH_COMMON;
    pg8::Gemm g{Z, ZP, (const bf16_t*)(ws + WS_WOUT), DM, DM}; pg8::StaticOrder S; S.init(NTOK, DM, G, bx);
    pg8::EpiRes E{L == 0 ? ka->p.in[0] : ka->p.out, ka->p.out};
    pg8::gemm_phase<pg8::EpiRes, pg8::StaticOrder, true, true>(L3, g, S, E); }
PH_FN ph_F(KA ka, int L, LAS unsigned char* L3) { PH_COMMON; KA P = ka; if (G == GRID) phaseF(P, L, L3, wave, lane, tid); }
PH_FN ph_G(KA ka, int L, LAS unsigned char* L3) { PH_COMMON; KA P = ka; if (G == GRID) phaseG(P, L3, wave, lane, tid); }
PH_FN ph_H(KA ka, int L, LAS unsigned char* L3) { PH_COMMON;
    pg8::Gemm g{(const bf16_t*)(ws + WS_HG), DM, (const bf16_t*)(ws + WS_WGU), DM, DM}; pg8::GroupOrder S{(const int*)(ws + WS_TBL), bx, G, (size_t)1024 * DM};
    pg8::EpiUp E{(bf16_t*)(ws + WS_ACT)};
    pg8::gemm_phase<pg8::EpiUp, pg8::GroupOrder, true, true>(L3, g, S, E); }
PH_FN ph_I(KA ka, int L, LAS unsigned char* L3) { PH_COMMON;
    pg8::Gemm g{(const bf16_t*)(ws + WS_ACT), DEXP, (const bf16_t*)(ws + WS_WDN), DEXP, DEXP}; pg8::GroupOrder S{(const int*)(ws + WS_TBL), bx, G, (size_t)DM * DEXP};
    pg8::EpiDown E{(bf16_t*)(ws + WS_HG), (const float*)(ws + WS_SLOTW)};
    pg8::gemm_phase<pg8::EpiDown, pg8::GroupOrder, true, true>(L3, g, S, E); }
PH_FN ph_J(KA ka, int L, LAS unsigned char* L3) { PH_COMMON; KA P = ka;
    phaseJ_rows(P, vcu, G, wave, lane);
    pg8::Gemm g{(const bf16_t*)(ws + WS_PB), PLE, (const bf16_t*)(ws + WS_WPLE), PLE, PLE}; pg8::StaticOrder S; S.init(NTOK, DM, G, bx);
    pg8::EpiBf16 E{(bf16_t*)(ws + WS_PL), DM, 0};
    pg8::gemm_phase<pg8::EpiBf16, pg8::StaticOrder, true, true>(L3, g, S, E); }
PH_FN ph_K(KA ka, int L, LAS unsigned char* L3) { PH_COMMON;
    pg8::Gemm g{HN, DM, (const bf16_t*)(ws + WS_WPG), DM, DM}; pg8::StaticOrder S; S.init(NTOK, DM, G, bx);
    pg8::EpiPle E{ka->p.out, ka->p.out, (const bf16_t*)(ws + WS_PL)};
    pg8::gemm_phase<pg8::EpiPle, pg8::StaticOrder, true, true>(L3, g, S, E); }
PH_FN ph_final(KA ka, int L, LAS unsigned char* L3) { PH_COMMON; KA P = ka; final_rows(P, vcu, G, wave, lane); }
static __device__ __forceinline__ void grid_bar(unsigned* barw, LAS unsigned* st) { XcdBarrier b; b.bar = barw; b.x = xb_xcc_id(); b.st = (volatile LAS unsigned*)st; xcd_barrier(b); }

__global__ void __launch_bounds__(512, 2) mega_fwd(Args args) {
    extern __shared__ __attribute__((aligned(16))) unsigned char lds[];
    LAS unsigned char* L3 = (LAS unsigned char*)lds;
    KA ka = (KA)__builtin_amdgcn_kernarg_segment_ptr();
    const int tid = threadIdx.x;
    for (int u = tid; u < (LDS_BYTES - LDSCTL_OFF) / 4; u += 512) ((LAS unsigned*)(L3 + LDSCTL_OFF))[u] = 0u;
    __syncthreads();
    unsigned* barw = (unsigned*)(args.p.ws + WS_CTL) + CW_BAR; LAS unsigned* st = (LAS unsigned*)(L3 + MISC_OFF) + 8;
    if (N_LAUNCHES == 1) (void)xcd_barrier_post(barw, (volatile LAS unsigned*)st);
    const int lo = args.ph_lo, hi = args.ph_hi;
#ifndef PHASE_MASK
#define PHASE_MASK 0xFFFFFFFu
#endif
#define IN(k) (((PHASE_MASK >> ((k) % PH_PER_LAYER + ((k) == N_PHASES - 1 ? PH_PER_LAYER : 0))) & 1u) && lo <= (k) && (k) < hi)
#define SEAM(k) do { if (IN(k) && IN((k) + 1)) grid_bar(barw, st); } while (0)
    for (int L = 0; L < DEPTH; ++L) {
        const int pb = L * PH_PER_LAYER;
        if (IN(pb + 0)) ph_A(ka, L, L3);
        SEAM(pb + 0);
        if (IN(pb + 1)) ph_B(ka, L, L3);
        SEAM(pb + 1);
        if (IN(pb + 2)) { ph_C1a(ka, L, L3); ph_C1b(ka, L, L3); }
        SEAM(pb + 2);
        if (IN(pb + 3)) ph_C2(ka, L, L3);
        SEAM(pb + 3);
        if (IN(pb + 4)) ph_C3(ka, L, L3);
        SEAM(pb + 4);
        if (IN(pb + 5)) { ph_D1(ka, L, L3); ph_D2(ka, L, L3); }
        SEAM(pb + 5);
        if (IN(pb + 6)) ph_E(ka, L, L3);
        SEAM(pb + 6);
        if (IN(pb + 7)) ph_F(ka, L, L3);
        SEAM(pb + 7);
        if (IN(pb + 8)) ph_G(ka, L, L3);
        SEAM(pb + 8);
        if (IN(pb + 9)) ph_H(ka, L, L3);
        SEAM(pb + 9);
        if (IN(pb + 10)) ph_I(ka, L, L3);
        SEAM(pb + 10);
        if (IN(pb + 11)) ph_J(ka, L, L3);
        SEAM(pb + 11);
        if (IN(pb + 12)) ph_K(ka, L, L3);
        SEAM(pb + 12);
    }
    if (IN(N_PHASES - 1)) ph_final(ka, 0, L3);
#undef IN
#undef SEAM
}

extern "C" void kernel_launch(void* const* d_in, const int* in_sizes, int n_in, void* d_out, int out_size, void* d_ws, size_t ws_size, hipStream_t stream) {
    static int grid = 0;
    if (grid == 0) {
        if (n_in != 24 || in_sizes[0] != NTOK * DM || out_size != NTOK * DM || ws_size < WS_END) {
            fprintf(stderr, "kernel_launch: built for 24 inputs, x/out of %d floats, >= %zu bytes of workspace; got n_in %d, in0 %d, out %d, ws %zu; nothing launched\n", NTOK * DM, (size_t)WS_END, n_in, n_in > 0 ? in_sizes[0] : -1, out_size, ws_size); grid = -1; return; }
        int dev = 0, cus = 0, per_cu = 0;
        if (hipGetDevice(&dev) != hipSuccess || hipDeviceGetAttribute(&cus, hipDeviceAttributeMultiprocessorCount, dev) != hipSuccess) { fprintf(stderr, "kernel_launch: device query failed\n"); grid = -1; return; }
        if (hipFuncSetAttribute((const void*)mega_fwd, hipFuncAttributeMaxDynamicSharedMemorySize, LDS_BYTES) != hipSuccess) { fprintf(stderr, "kernel_launch: hipFuncSetAttribute failed\n"); grid = -1; return; }
        if (hipOccupancyMaxActiveBlocksPerMultiprocessor(&per_cu, (const void*)mega_fwd, 512, LDS_BYTES) != hipSuccess || per_cu < 1)
            fprintf(stderr, "kernel_launch: note: occupancy query reports %d workgroups per CU\n", per_cu);
        (void)hipGetLastError();
        if (cus != GRID) { fprintf(stderr, "kernel_launch: built for a %d-CU device, found %d; nothing launched\n", GRID, cus); grid = -1; return; }
        grid = GRID;
    }
    if (grid < 0) return;
    if (hipMemsetAsync((char*)d_ws + WS_CTL, 0, CTL_ZERO_BYTES, stream) != hipSuccess) { fprintf(stderr, "kernel_launch: memset failed\n"); return; }
    Args a{};
    for (int i = 0; i < 24; ++i) a.p.in[i] = (const float*)d_in[i];
    a.p.out = (float*)d_out; a.p.ws = (unsigned char*)d_ws;
    for (int li = 0; li < N_LAUNCHES; ++li) {
        a.ph_lo = (N_LAUNCHES == 1) ? 0 : li; a.ph_hi = (N_LAUNCHES == 1) ? N_PHASES : li + 1;
        hipLaunchKernelGGL(mega_fwd, dim3(grid), dim3(512), LDS_BYTES, stream, a);
        const hipError_t le = hipPeekAtLastError();
        if (le != hipSuccess) { fprintf(stderr, "kernel_launch: launch %d failed: %s\n", li, hipGetErrorName(le)); break; }
    }
}
```

```cpp
#include <hip/hip_runtime.h>
#include <cstdio>
#include <cstdint>

#define LAS __attribute__((address_space(3)))
#define GAS __attribute__((address_space(1)))
typedef unsigned short bf16_t;
typedef short bf16x8 __attribute__((ext_vector_type(8)));
typedef short s16x4 __attribute__((ext_vector_type(4)));
typedef float f32x2 __attribute__((ext_vector_type(2)));
typedef float f32x4 __attribute__((ext_vector_type(4)));
typedef float f32x16 __attribute__((ext_vector_type(16)));
typedef unsigned u32x2 __attribute__((ext_vector_type(2)));
typedef unsigned u32x4 __attribute__((ext_vector_type(4)));
typedef __bf16 bf16x2_t __attribute__((ext_vector_type(2)));

constexpr int NB = 2, T = 16384, NTOK = NB * T, DM = 1024, DEPTH = 2, PLE = 256;
constexpr int INTOT = 7696;
constexpr int ZP = 4864;
constexpr int C_GQ = 0, C_GK = 256, C_GV = 512, C_DK = 1024, C_DV = 1536, C_CX = 2048, C_CC = 2560, C_GA = 3072, C_GG = 3328, C_DQ = 3840, C_CB = 4352;
constexpr int C_OA = C_GG, C_OB = C_DQ, C_OC = C_CB;
constexpr int NZT = 19;
constexpr int NEXP = 16, DEXP = 512;
constexpr int NSLOT = 2 * NTOK + NEXP * 256;
constexpr float EPS = 1e-6f;
constexpr int GRID = 256;
constexpr int TPW = NTOK / GRID;

__device__ __forceinline__ unsigned f2bf(float f) { unsigned u = __builtin_bit_cast(unsigned, f); return (u + 0x7fffu + ((u >> 16) & 1u)) >> 16; }
__device__ __forceinline__ unsigned pk2(float lo, float hi) { f32x2 v = {lo, hi}; bf16x2_t b = __builtin_convertvector(v, bf16x2_t); return __builtin_bit_cast(unsigned, b); }
__device__ __forceinline__ float bflo(unsigned w) { return __builtin_bit_cast(float, w << 16); }
__device__ __forceinline__ float bfhi(unsigned w) { return __builtin_bit_cast(float, w & 0xffff0000u); }
__device__ __forceinline__ float bf2f(bf16_t b) { return __builtin_bit_cast(float, (unsigned)b << 16); }
__device__ __forceinline__ float sigmoidf_(float x) { return __builtin_amdgcn_rcpf(1.0f + __builtin_amdgcn_exp2f(-1.4426950408889634f * x)); }
__device__ __forceinline__ float siluf_(float x) { return x * sigmoidf_(x); }
__device__ __forceinline__ float wave_sum(float v) {
#pragma unroll
    for (int o = 1; o < 64; o <<= 1) v += __shfl_xor(v, o);
    return v;
}
__device__ __forceinline__ int crow(int r, int hi) { return (r & 3) + 8 * (r >> 2) + 4 * hi; }
#define LDS_WAIT() asm volatile("s_waitcnt lgkmcnt(0)" ::: "memory")
#define VM_WAIT() asm volatile("s_waitcnt vmcnt(0)" ::: "memory")

namespace pg8 {
#define PG8_LAS __attribute__((address_space(3)))
constexpr int BM = 256, BK = 64, HALF = 128, HTB = HALF * BK * 2  , STAGE_BYTES = 8 * HTB, NXCD = 8, WGM = 8;

__host__ __device__ __forceinline__ int lds_byte(int r, int c) { const int st = (r >> 4) * 2 + (c >> 5), rr = r & 15, cc = c & 31, ob = rr * 64 + cc * 2; return st * 1024 + (ob ^ (((ob >> 9) & 1) << 5)); }
__host__ __device__ __forceinline__ void stage_rc(int b, int& R, int& C) { const int st = b / 1024, sb = b % 1024, swz = sb ^ (((sb >> 9) & 1) << 5); R = (st >> 1) * 16 + swz / 64; C = (st & 1) * 32 + (swz % 64) / 2; }
__host__ __device__ __forceinline__ int perm32(int rho) { const int n = rho >> 4, i = rho & 15; return 8 * (i >> 2) + 4 * n + (i & 3); }

struct Unit { int pm, pn; int aoff; int tag; size_t boff; };
struct Gemm { const bf16_t* A; int lda; const bf16_t* Bt; int ldb; int K; };

struct StaticOrder {
    int nM, nN, nwg, G, c;
    __device__ void init(int M, int N, int G_, int c_) { nM = M / BM; nN = N / BM; nwg = nM * nN; G = G_; c = c_; }
    __device__ bool next(int i, Unit& u) const {
        const long L = (long)i * G + c; if (L >= nwg) return false;
        int wgid = (int)L; { const int q = nwg / NXCD, r = nwg % NXCD, xcd = wgid % NXCD, off = wgid / NXCD; wgid = (xcd < r ? xcd * (q + 1) : r * (q + 1) + (xcd - r) * q) + off; }
        const int nig = WGM * nN, gid = wgid / nig, fm = gid * WGM, gsz = (nM - fm) < WGM ? (nM - fm) : WGM;
        u.pm = fm + ((wgid % nig) % gsz); u.pn = (wgid % nig) / gsz; u.aoff = 0; u.tag = 0; u.boff = 0; return true;
    }
};

struct EpiBf16 {
    static constexpr bool PERM = true;
    bf16_t* O; int ldc; int tstride;
    __device__ __forceinline__ void operator()(const f32x4 (&acc)[2][2][4][2], const Unit& u, int wr, int wc, int fr, int fq) const {
        const int row0 = u.pm * BM + wr * 64 + fr; const int col0 = u.tag * tstride + u.pn * BM + wc * 32 + 8 * fq;
#pragma unroll
        for (int ai = 0; ai < 2; ++ai)
#pragma unroll
            for (int m = 0; m < 4; ++m) { bf16_t* rowp = O + (size_t)(row0 + ai * HALF + m * 16) * ldc + col0;
#pragma unroll
                for (int bj = 0; bj < 2; ++bj) { const f32x4 v0 = acc[ai][bj][m][0], v1 = acc[ai][bj][m][1];
                    u32x4 w; w.x = pk2(v0[0], v0[1]); w.y = pk2(v0[2], v0[3]); w.z = pk2(v1[0], v1[1]); w.w = pk2(v1[2], v1[3]);
                    *(u32x4*)(rowp + bj * HALF) = w; } }
    }
};
template <class Epi, class Sched, bool ALIGN_EPI = false, bool SP2 = false>
__device__ __forceinline__ void gemm_phase(PG8_LAS unsigned char* lds, const Gemm g, const Sched& S, const Epi& E) {
    int tid_l = threadIdx.x; asm volatile("" : "+v"(tid_l)); const int tid = tid_l;
    const int wid = __builtin_amdgcn_readfirstlane(tid >> 6), lane = tid & 63, wr = wid >> 2, wc = wid & 3, fr = lane & 15, fq = lane >> 4;
    const int K = g.K, nt = K / BK;
    unsigned voffA[2], voffB[2];
#pragma unroll
    for (int i = 0; i < 2; ++i) { int R, C; stage_rc(tid * 16 + i * 8192, R, C); const int Rb = Epi::PERM ? ((R & ~31) + perm32(R & 31)) : R;
        voffA[i] = (unsigned)(R * g.lda + C) * 2u; voffB[i] = (unsigned)(Rb * g.ldb + C) * 2u; }
    const size_t kstep = (size_t)(BK * 2);
    const size_t hstepA = (size_t)HALF * g.lda * 2, hstepB = (size_t)HALF * g.ldb * 2;
    const unsigned ldsw = (unsigned)wid * 1024u;
    const int aoff = lds_byte(wr * 64 + fr, fq * 8), boff = lds_byte(wc * 32 + fr, fq * 8);
#define PG8_UA(u) ((const char*)g.A + ((size_t)(u).pm * 2 * hstepA) + (size_t)(u).aoff * 2)
#define PG8_UB(u) ((const char*)g.Bt + ((size_t)(u).pn * 2 * hstepB) + (u).boff * 2)
#define PG8_SA(b, h) (((b) * 2 + (h)) * HTB)
#define PG8_SB(b, h) ((4 + (b) * 2 + (h)) * HTB)
#define PG8_STAGE(bufoff, gbase, voff) do { _Pragma("unroll") for (int _i = 0; _i < 2; ++_i) \
        __builtin_amdgcn_global_load_lds((const unsigned*)((const char*)(gbase) + (voff)[_i]), (PG8_LAS unsigned*)(lds + (bufoff) + ldsw + _i * 8192), 16, 0, 0); } while (0)
#define PG8_LDA(dst, b, h) do { _Pragma("unroll") for (int m = 0; m < 4; ++m) _Pragma("unroll") for (int k = 0; k < 2; ++k) dst[m][k] = *(const PG8_LAS bf16x8*)(lds + PG8_SA(b, h) + aoff + m * 2048 + k * 1024); } while (0)
#define PG8_LDB(dst, b, h) do { _Pragma("unroll") for (int n = 0; n < 2; ++n) _Pragma("unroll") for (int k = 0; k < 2; ++k) dst[n][k] = *(const PG8_LAS bf16x8*)(lds + PG8_SB(b, h) + boff + n * 2048 + k * 1024); } while (0)
#define PG8_MMA(ai, bj, At, Bt) do { __builtin_amdgcn_s_setprio(1); _Pragma("unroll") for (int m = 0; m < 4; ++m) _Pragma("unroll") for (int n = 0; n < 2; ++n) _Pragma("unroll") for (int k = 0; k < 2; ++k) \
        acc[ai][bj][m][n] = __builtin_amdgcn_mfma_f32_16x16x32_bf16(Bt[n][k], At[m][k], acc[ai][bj][m][n], 0, 0, 0); __builtin_amdgcn_s_setprio(0); } while (0)
#define PG8_WAIT_V(n) asm volatile("s_waitcnt vmcnt(" #n ")" ::: "memory")
#define PG8_WAIT_L(n) asm volatile("s_waitcnt lgkmcnt(" #n ")" ::: "memory")
#define PG8_BAR __builtin_amdgcn_s_barrier()
#define PG8_SCHED __builtin_amdgcn_sched_barrier(0)
    Unit cur, nxt; int ui = 0;
    if (!S.next(0, cur)) return;
    f32x4 acc[2][2][4][2];
#pragma unroll
    for (int a = 0; a < 2; ++a)
#pragma unroll
        for (int b = 0; b < 2; ++b)
#pragma unroll
            for (int m = 0; m < 4; ++m)
#pragma unroll
                for (int n = 0; n < 2; ++n) acc[a][b][m][n] = (f32x4){0.f, 0.f, 0.f, 0.f};
    bf16x8 At[4][2], B0[2][2], B1[2][2];
    const char* cA = PG8_UA(cur); const char* cB = PG8_UB(cur);
    if constexpr (SP2) {
        PG8_STAGE(PG8_SB(0, 0), cB, voffB); PG8_STAGE(PG8_SB(0, 1), cB + hstepB, voffB); PG8_STAGE(PG8_SA(0, 0), cA, voffA); PG8_STAGE(PG8_SA(0, 1), cA + hstepA, voffA);
        if (wr == 1) PG8_BAR;
        PG8_WAIT_V(2); PG8_BAR;
        PG8_STAGE(PG8_SB(1, 0), cB + kstep, voffB); PG8_STAGE(PG8_SA(1, 0), cA + kstep, voffA); PG8_STAGE(PG8_SB(1, 1), cB + hstepB + kstep, voffB);
        PG8_WAIT_V(6); PG8_BAR;
    } else {
        PG8_STAGE(PG8_SB(0, 0), cB, voffB); PG8_STAGE(PG8_SA(0, 0), cA, voffA); PG8_STAGE(PG8_SB(0, 1), cB + hstepB, voffB); PG8_STAGE(PG8_SA(0, 1), cA + hstepA, voffA);
        if (wr == 1) PG8_BAR;
        PG8_WAIT_V(4); PG8_BAR;
        PG8_STAGE(PG8_SB(1, 0), cB + kstep, voffB); PG8_STAGE(PG8_SA(1, 0), cA + kstep, voffA); PG8_STAGE(PG8_SB(1, 1), cB + hstepB + kstep, voffB);
        PG8_WAIT_V(6); PG8_BAR;
    }
    for (;;) {
        const bool has_next = S.next(ui + 1, nxt);
        const char* nA = has_next ? PG8_UA(nxt) : cA; const char* nB = has_next ? PG8_UB(nxt) : cB;
        for (int t = 0; t < nt; t += 2) {
            const bool last = (t == nt - 2);
            const char* a1 = cA + (size_t)(t + 1) * kstep;
            const char* a2 = last ? nA : cA + (size_t)(t + 2) * kstep; const char* b2 = last ? nB : cB + (size_t)(t + 2) * kstep;
            const char* a3 = a2 + kstep; const char* b3 = b2 + kstep;
            if constexpr (SP2) {
            PG8_LDB(B0, 0, 0); PG8_LDB(B1, 0, 1); PG8_SCHED; PG8_LDA(At, 0, 0); PG8_STAGE(PG8_SA(1, 1), a1 + hstepA, voffA);
            PG8_WAIT_V(8); PG8_WAIT_L(0); PG8_BAR; PG8_MMA(0, 0, At, B0); PG8_MMA(0, 1, At, B1); PG8_BAR; PG8_SCHED;
            PG8_LDA(At, 0, 1); PG8_STAGE(PG8_SB(0, 0), b2, voffB); PG8_STAGE(PG8_SB(0, 1), b2 + hstepB, voffB); PG8_STAGE(PG8_SA(0, 0), a2, voffA);
            PG8_WAIT_V(8); PG8_WAIT_L(0); PG8_BAR; PG8_MMA(1, 0, At, B0); PG8_MMA(1, 1, At, B1); PG8_BAR; PG8_SCHED;
            PG8_LDB(B0, 1, 0); PG8_LDB(B1, 1, 1); PG8_SCHED; PG8_LDA(At, 1, 0); PG8_STAGE(PG8_SA(0, 1), a2 + hstepA, voffA);
            PG8_WAIT_V(8); PG8_WAIT_L(0); PG8_BAR; PG8_MMA(0, 0, At, B0); PG8_MMA(0, 1, At, B1); PG8_BAR; PG8_SCHED;
            PG8_LDA(At, 1, 1); PG8_STAGE(PG8_SB(1, 0), b3, voffB); PG8_STAGE(PG8_SB(1, 1), b3 + hstepB, voffB); PG8_STAGE(PG8_SA(1, 0), a3, voffA);
            PG8_WAIT_V(8); PG8_WAIT_L(0); PG8_BAR; PG8_MMA(1, 0, At, B0); PG8_MMA(1, 1, At, B1); PG8_BAR; PG8_SCHED;
            } else {
            PG8_LDB(B0, 0, 0); PG8_SCHED; PG8_LDA(At, 0, 0); PG8_STAGE(PG8_SA(1, 1), a1 + hstepA, voffA);
            PG8_WAIT_L(8); PG8_BAR; PG8_WAIT_L(0); PG8_MMA(0, 0, At, B0); PG8_BAR; PG8_SCHED;
            PG8_LDB(B1, 0, 1); PG8_STAGE(PG8_SB(0, 0), b2, voffB);
            PG8_BAR; PG8_WAIT_L(0); PG8_MMA(0, 1, At, B1); PG8_BAR;
            PG8_LDA(At, 0, 1); PG8_STAGE(PG8_SA(0, 0), a2, voffA);
            PG8_BAR; PG8_WAIT_L(0); PG8_MMA(1, 0, At, B0); PG8_BAR; PG8_SCHED;
            PG8_STAGE(PG8_SB(0, 1), b2 + hstepB, voffB);
            PG8_WAIT_V(6); PG8_BAR; PG8_MMA(1, 1, At, B1); PG8_BAR;
            PG8_LDB(B0, 1, 0); PG8_SCHED; PG8_LDA(At, 1, 0); PG8_STAGE(PG8_SA(0, 1), a2 + hstepA, voffA);
            PG8_WAIT_L(8); PG8_BAR; PG8_WAIT_L(0); PG8_MMA(0, 0, At, B0); PG8_BAR; PG8_SCHED;
            PG8_LDB(B1, 1, 1); PG8_STAGE(PG8_SB(1, 0), b3, voffB);
            PG8_BAR; PG8_WAIT_L(0); PG8_MMA(0, 1, At, B1); PG8_BAR;
            PG8_LDA(At, 1, 1); PG8_STAGE(PG8_SA(1, 0), a3, voffA);
            PG8_BAR; PG8_WAIT_L(0); PG8_MMA(1, 0, At, B0); PG8_BAR; PG8_SCHED;
            PG8_STAGE(PG8_SB(1, 1), b3 + hstepB, voffB);
            PG8_WAIT_V(6); PG8_BAR; PG8_MMA(1, 1, At, B1); PG8_BAR;
            }
        }
        if constexpr (ALIGN_EPI) { if (wr == 0) PG8_BAR; }
        E(acc, cur, wr, wc, fr, fq);
        if (!has_next) break;
#pragma unroll
        for (int a = 0; a < 2; ++a)
#pragma unroll
            for (int b = 0; b < 2; ++b)
#pragma unroll
                for (int m = 0; m < 4; ++m)
#pragma unroll
                    for (int n = 0; n < 2; ++n) acc[a][b][m][n] = (f32x4){0.f, 0.f, 0.f, 0.f};
        cur = nxt; cA = nA; cB = nB; ++ui;
        if constexpr (ALIGN_EPI) { if (wr == 1) PG8_BAR; }
    }
    PG8_WAIT_V(0);
    if constexpr (!ALIGN_EPI) { if (wr == 0) PG8_BAR; }
    PG8_BAR;
#undef PG8_UA
#undef PG8_UB
#undef PG8_SA
#undef PG8_SB
#undef PG8_STAGE
#undef PG8_LDA
#undef PG8_LDB
#undef PG8_MMA
#undef PG8_WAIT_V
#undef PG8_WAIT_L
#undef PG8_BAR
#undef PG8_SCHED
}
}

#define XB_TMO      128
#define XB_XCNT(j)  (256  + 64 * (j))
#define XB_XSUB(j)  (1280 + 64 * (j))
#define XB_XGEN(j)  (2304 + 64 * (j))
#define XB_TOP      3328
#define XB_TOPGEN   3392
#define XCD_BAR_WORDS 3456
#define XB_SPIN_CAP (1u << 18)

__device__ __forceinline__ unsigned xb_ld(unsigned* p)              { return __hip_atomic_load(p, __ATOMIC_RELAXED, __HIP_MEMORY_SCOPE_AGENT); }
__device__ __forceinline__ unsigned xb_add(unsigned* p, unsigned v) { return __hip_atomic_fetch_add(p, v, __ATOMIC_RELAXED, __HIP_MEMORY_SCOPE_AGENT); }
__device__ __forceinline__ unsigned xb_xcc_id() { return (unsigned)__builtin_amdgcn_s_getreg((3 << 11) | 20) & 0xFu; }
#define XB_SPIN(cond, bar) do { unsigned _sp = 0; while (cond) { __builtin_amdgcn_s_sleep(1); \
    if ((++_sp & 255u) == 0u) { if (xb_ld(&(bar)[XB_TMO])) break; if (_sp > XB_SPIN_CAP) { atomicAdd(&(bar)[XB_TMO], 1u); break; } } } } while (0)

struct XcdBarrier {
    unsigned* bar; unsigned x;
    volatile LAS unsigned* st;
};

__device__ __forceinline__ XcdBarrier xcd_barrier_post(unsigned* bar, volatile LAS unsigned* st) {
    XcdBarrier b; b.bar = bar; b.x = xb_xcc_id(); b.st = st;
    if (threadIdx.x == 0) (void)xb_add(&bar[XB_XCNT(b.x)], 1u);
    return b;
}
__device__ __forceinline__ void xcd_barrier_complete(unsigned* bar, unsigned x, unsigned& nloc, unsigned& nx) {
    const unsigned G = gridDim.x * gridDim.y * gridDim.z;
    unsigned sum, cnt, mine, sp = 0u;
    for (;;) {
        sum = 0u; cnt = 0u; mine = 0u;
#pragma unroll
        for (unsigned j = 0; j < 16; ++j) { const unsigned c = xb_ld(&bar[XB_XCNT(j)]); sum += c; cnt += (c > 0u) ? 1u : 0u; mine = (j == x) ? c : mine; }
        if (sum == G) break;
        __builtin_amdgcn_s_sleep(1);
        if ((++sp & 255u) == 0u) { if (xb_ld(&bar[XB_TMO])) break; if (sp > XB_SPIN_CAP) { atomicAdd(&bar[XB_TMO], 1u); break; } }
    }
    nloc = mine > 0u ? mine : 1u; nx = cnt > 0u ? cnt : 1u;
}

__device__ __forceinline__ void xcd_barrier(const XcdBarrier& b) {
    asm volatile("s_waitcnt vmcnt(0)" ::: "memory");
    __syncthreads();
    if (threadIdx.x == 0) {
        unsigned* bar = b.bar;
        __builtin_amdgcn_s_waitcnt(0);
        unsigned nloc = b.st[0], nx = b.st[1];
        if (nloc == 0u) { xcd_barrier_complete(bar, b.x, nloc, nx); b.st[0] = nloc; b.st[1] = nx; }
        const unsigned old = xb_add(&bar[XB_XSUB(b.x)], 1u);
        const unsigned gen = old / nloc;
        if (old + 1u == (gen + 1u) * nloc) {
            __builtin_amdgcn_fence(__ATOMIC_RELEASE, "agent");
            asm volatile("s_waitcnt vmcnt(0)" ::: "memory");
            const unsigned og = xb_add(&bar[XB_TOP], 1u);
            const unsigned tg = og / nx;
            if (og + 1u == (tg + 1u) * nx) xb_add(&bar[XB_TOPGEN], 1u);
            else XB_SPIN(xb_ld(&bar[XB_TOPGEN]) == tg, bar);
            __builtin_amdgcn_fence(__ATOMIC_ACQUIRE, "agent");
            xb_add(&bar[XB_XGEN(b.x)], 1u);
            asm volatile("s_waitcnt vmcnt(0)" ::: "memory");
        } else {
            XB_SPIN(xb_ld(&bar[XB_XGEN(b.x)]) == gen, bar);
            __builtin_amdgcn_fence(__ATOMIC_ACQUIRE, "agent");
            asm volatile("s_waitcnt vmcnt(0)" ::: "memory");
        }
    }
    __syncthreads();
}

constexpr size_t MiB = 1u << 20;
constexpr size_t WS_CTL = 0, CTL_ZERO_BYTES = 1 * MiB;
constexpr size_t WS_WIN = 1 * MiB;
constexpr size_t WS_WO = WS_WIN + (size_t)31 * 256 * 1024 * 2;
constexpr size_t WS_WOUT = WS_WO + (size_t)3 * 1024 * 512 * 2;
constexpr size_t WS_WPG = WS_WOUT + (size_t)1024 * 1024 * 2;
constexpr size_t WS_WPLE = WS_WPG + (size_t)1024 * 1024 * 2;
constexpr size_t WS_WGU = WS_WPLE + (size_t)1024 * 256 * 2;
constexpr size_t WS_WDN = WS_WGU + (size_t)16 * 1024 * 1024 * 2;
constexpr size_t WS_WEND = WS_WDN + (size_t)16 * 1024 * 512 * 2;
static_assert(WS_WEND <= 73 * MiB, "weights");
constexpr size_t WS_HN = 73 * MiB;
constexpr size_t WS_PB = WS_HN + (size_t)NTOK * DM * 2;
constexpr size_t WS_Z = WS_PB + (size_t)NTOK * PLE * 2;
constexpr size_t WS_ZEND = WS_Z + (size_t)NTOK * ZP * 2;
constexpr size_t WS_SLOC = WS_ZEND;
constexpr size_t WS_DTAB = WS_SLOC + (size_t)2048 * 8192 * 2;
constexpr size_t WS_ROUTE = WS_DTAB + (size_t)2048 * 64 * 4;
constexpr size_t WS_HIST = WS_ROUTE + (size_t)NTOK * 16;
constexpr size_t WS_TBL = WS_HIST + (size_t)GRID * 16 * 4;
constexpr size_t WS_TOKSLOT = WS_TBL + 256;
constexpr size_t WS_SLOTW = WS_TOKSLOT + (size_t)NTOK * 8;
constexpr size_t WS_END = WS_SLOTW + (size_t)NSLOT * 4;
constexpr size_t WS_HG = WS_Z;
constexpr size_t WS_ACT = WS_HG + (size_t)NSLOT * DM * 2;
constexpr size_t WS_PL = WS_ACT + (size_t)NSLOT * DEXP * 2;
static_assert(WS_PL + (size_t)NTOK * DM * 2 <= WS_ZEND, "MoE overlay fits inside Z");
constexpr int CW_BAR = 4096;
constexpr int CW_QHEAD = 8192, CW_KN = 8192 + 256;

constexpr int RING_BYTES = 131072;
constexpr int LDSCTL_OFF = RING_BYTES, MISC_OFF = LDSCTL_OFF + 320;
constexpr int LDS_BYTES = 147456;

__device__ __forceinline__ void tr_item(const float* W, int ldw, int col0, int K, bf16_t* WT, int nrows, int valid, LAS float* scr, int item, int lane) {
    const int nblk = nrows / 32, kb = item / nblk, nb = item % nblk, k0 = 64 * kb, n0 = 32 * nb;
    const bool ok = (n0 + (lane & 31)) < valid;
#pragma unroll 8
    for (int i = 0; i < 32; ++i) { const int kk = 2 * i + (lane >> 5); scr[kk * 33 + (lane & 31)] = ok ? W[(size_t)(k0 + kk) * ldw + col0 + n0 + (lane & 31)] : 0.f; }
    LDS_WAIT(); asm volatile("" ::: "memory");
    const int c = lane & 7;
#pragma unroll
    for (int j = 0; j < 4; ++j) { const int n = (lane >> 3) + 8 * j; const LAS float* s = scr + (8 * c) * 33 + n;
        u32x4 o; o.x = pk2(s[0 * 33], s[1 * 33]); o.y = pk2(s[2 * 33], s[3 * 33]); o.z = pk2(s[4 * 33], s[5 * 33]); o.w = pk2(s[6 * 33], s[7 * 33]);
        *(u32x4*)(WT + (size_t)(n0 + n) * K + k0 + 8 * c) = o; }
    LDS_WAIT(); asm volatile("" ::: "memory");
}
__device__ __forceinline__ int win_src_col(int t) {
    if (t < 4) return 256 * t;
    if (t < 8) return 2064 + 256 * (t - 4);
    if (t < 10) return 3088 + 256 * (t - 8);
    if (t < 12) return 4112 + 256 * (t - 10);
    if (t == 12) return 1536;
    if (t < 15) return 1024 + 256 * (t - 13);
    if (t < 17) return 1552 + 256 * (t - 15);
    if (t < 19) return 3600 + 256 * (t - 17);
    return 4624 + 256 * (t - 19);
}
__device__ __forceinline__ void rms_row_bf16(const float* xrow, const float* g, bf16_t* orow, int lane) {
    const f32x4* xr = (const f32x4*)xrow + lane; const f32x4* gr = (const f32x4*)g + lane;
    f32x4 v[4]; float s = 0.f;
#pragma unroll
    for (int j = 0; j < 4; ++j) { v[j] = xr[64 * j]; s += (v[j].x * v[j].x + v[j].y * v[j].y) + (v[j].z * v[j].z + v[j].w * v[j].w); }
    const float r = 1.0f / sqrtf(wave_sum(s) * (1.f / DM) + EPS);
    u32x2* o8 = (u32x2*)orow + lane;
#pragma unroll
    for (int j = 0; j < 4; ++j) { const f32x4 gg = gr[64 * j]; u32x2 w; w.x = pk2(v[j].x * r * gg.x, v[j].y * r * gg.y); w.y = pk2(v[j].z * r * gg.z, v[j].w * r * gg.w); o8[64 * j] = w; }
}

struct Ptrs { const float* in[24]; float* out; unsigned char* ws; };
struct Args { Ptrs p; int ph_lo, ph_hi; };
typedef const __attribute__((address_space(4))) Args* KA;

__device__ __forceinline__ void phaseA(KA P, int L, LAS unsigned char* lds, int vcu, int G, int wave, int lane, int tid) {
    LAS float* scr = (LAS float*)(lds + wave * 16384);
    const int gw = vcu * 8 + wave, NGW = G * 8;
    unsigned char* ws = P->p.ws;
    constexpr int I_WIN = 31 * 128, I_WO = 3 * 256, I_WOUT = 512, I_WPG = 512, I_WPLE = 128, I_WGU = 16 * 512, I_WDN = 16 * 256;
    constexpr int NITEMS = I_WIN + I_WO + I_WOUT + I_WPG + I_WPLE + I_WGU + I_WDN;
    for (int it = gw; it < NITEMS; it += NGW) {
        int r = it;
        if (r < I_WIN) { const int t = r / 128; tr_item(P->p.in[3] + (size_t)L * DM * INTOT, INTOT, win_src_col(t), DM, (bf16_t*)(ws + WS_WIN) + (size_t)t * 256 * DM, 256, t == 12 ? 16 : 256, scr, r % 128, lane); continue; } r -= I_WIN;
        if (r < I_WO) { const int j = r / 256; const float* src = (j == 0 ? P->p.in[7] : j == 1 ? P->p.in[10] : P->p.in[12]) + (size_t)L * 512 * DM;
            tr_item(src, DM, 0, 512, (bf16_t*)(ws + WS_WO) + (size_t)j * DM * 512, DM, DM, scr, r % 256, lane); continue; } r -= I_WO;
        if (r < I_WOUT) { tr_item(P->p.in[13] + (size_t)L * DM * DM, DM, 0, DM, (bf16_t*)(ws + WS_WOUT), DM, DM, scr, r, lane); continue; } r -= I_WOUT;
        if (r < I_WPG) { tr_item(P->p.in[22] + (size_t)L * DM * DM, DM, 0, DM, (bf16_t*)(ws + WS_WPG), DM, DM, scr, r, lane); continue; } r -= I_WPG;
        if (r < I_WPLE) { tr_item(P->p.in[21] + (size_t)L * PLE * DM, DM, 0, PLE, (bf16_t*)(ws + WS_WPLE), DM, DM, scr, r, lane); continue; } r -= I_WPLE;
        if (r < I_WGU) { const int e = r / 512, q = (r % 512) / 64, n = q >> 1, s = q & 1;
            tr_item(P->p.in[19] + (size_t)(L * NEXP + e) * DM * 1024, 1024, 512 * s + 128 * n, DM, (bf16_t*)(ws + WS_WGU) + (size_t)e * 1024 * DM + (size_t)(256 * n + 128 * s) * DM, 128, 128, scr, r % 64, lane); continue; } r -= I_WGU;
        { const int e = r / 256; tr_item(P->p.in[20] + (size_t)(L * NEXP + e) * DEXP * DM, DM, 0, DEXP, (bf16_t*)(ws + WS_WDN) + (size_t)e * DM * DEXP, DM, DM, scr, r % 256, lane); }
    }
    const float* xs = (L == 0) ? P->p.in[0] : P->p.out;
    for (int m = gw; m < NTOK; m += NGW) rms_row_bf16(xs + (size_t)m * DM, P->p.in[2] + (size_t)L * DM, (bf16_t*)(ws + WS_HN) + (size_t)m * DM, lane);
    const f32x4* ps = (const f32x4*)(P->p.in[1] + (size_t)L * NTOK * PLE); u32x2* pd = (u32x2*)(ws + WS_PB);
    for (int i = vcu * 512 + tid; i < NTOK * PLE / 4; i += G * 512) { const f32x4 v = ps[i]; u32x2 w; w.x = pk2(v.x, v.y); w.y = pk2(v.z, v.w); pd[i] = w; }
}

__device__ __forceinline__ float logsig16(float x) { return (fminf(x, 0.f) - log1pf(expf(-fabsf(x)))) * (1.0f / 16.0f); }
__device__ __forceinline__ void gla1_unit(int unit, bf16_t* Z, const float* wa2, const float* ba, bf16_t* SLOCT, float* DTAB, LAS unsigned char* lds, int wid, int lane, int tid) {
    const int bh = unit >> 8, c = unit & 255, b = bh >> 2, h = bh & 3; const size_t row0 = (size_t)b * T + (size_t)c * 64;
    LAS bf16_t* Qs = (LAS bf16_t*)lds; LAS bf16_t* Ks = (LAS bf16_t*)(lds + 8192); LAS bf16_t* KhT = (LAS bf16_t*)(lds + 16384); LAS bf16_t* VT = (LAS bf16_t*)(lds + 24576);
    LAS bf16_t* Am = (LAS bf16_t*)(lds + 40960); LAS float* WA = (LAS float*)(lds + 49152); LAS float* BA = (LAS float*)(lds + 53248);
    const int r32 = lane & 31, hi = lane >> 5;
    for (int i = tid; i < 1024; i += 512) WA[i] = wa2[(i >> 6) * 256 + h * 64 + (i & 63)];
    if (tid < 64) BA[tid] = ba[h * 64 + tid];
    __syncthreads();
    {
        const int t = lane, cb = wid * 8; const bf16_t* zr = Z + (row0 + t) * ZP;
        const u32x4 g0 = *(const u32x4*)(zr + C_GA), g1 = *(const u32x4*)(zr + C_GA + 8);
        float gaf[16]; gaf[0] = bflo(g0.x); gaf[1] = bfhi(g0.x); gaf[2] = bflo(g0.y); gaf[3] = bfhi(g0.y); gaf[4] = bflo(g0.z); gaf[5] = bfhi(g0.z); gaf[6] = bflo(g0.w); gaf[7] = bfhi(g0.w);
        gaf[8] = bflo(g1.x); gaf[9] = bfhi(g1.x); gaf[10] = bflo(g1.y); gaf[11] = bfhi(g1.y); gaf[12] = bflo(g1.z); gaf[13] = bfhi(g1.z); gaf[14] = bflo(g1.w); gaf[15] = bfhi(g1.w);
        float la[8];
#pragma unroll
        for (int i = 0; i < 8; ++i) { float x = BA[cb + i];
#pragma unroll
            for (int r = 0; r < 16; ++r) x = fmaf(gaf[r], WA[r * 64 + cb + i], x);
            la[i] = logsig16(x); }
#pragma unroll
        for (int off = 1; off < 64; off <<= 1) {
#pragma unroll
            for (int i = 0; i < 8; ++i) { const float y = __shfl_up(la[i], off); if (lane >= off) la[i] += y; } }
        const u32x4 qv = *(const u32x4*)(zr + C_GQ + h * 64 + cb), kv = *(const u32x4*)(zr + C_GK + h * 64 + cb);
        float qf[8], kf[8];
        qf[0] = bflo(qv.x); qf[1] = bfhi(qv.x); qf[2] = bflo(qv.y); qf[3] = bfhi(qv.y); qf[4] = bflo(qv.z); qf[5] = bfhi(qv.z); qf[6] = bflo(qv.w); qf[7] = bfhi(qv.w);
        kf[0] = bflo(kv.x); kf[1] = bfhi(kv.x); kf[2] = bflo(kv.y); kf[3] = bfhi(kv.y); kf[4] = bflo(kv.z); kf[5] = bfhi(kv.z); kf[6] = bflo(kv.w); kf[7] = bfhi(kv.w);
        float qs[8], ks[8];
#pragma unroll
        for (int i = 0; i < 8; ++i) { const float bl = __shfl(la[i], 63); const float eb = expf(la[i]);
            qs[i] = qf[i] * 0.125f * eb; ks[i] = kf[i] * expf(-la[i]);
            KhT[(cb + i) * 64 + t] = (bf16_t)f2bf(kf[i] * expf(bl - la[i]));
            if (lane == 63) DTAB[(size_t)unit * 64 + cb + i] = eb; }
        u32x4 qw, kw; qw.x = pk2(qs[0], qs[1]); qw.y = pk2(qs[2], qs[3]); qw.z = pk2(qs[4], qs[5]); qw.w = pk2(qs[6], qs[7]);
        kw.x = pk2(ks[0], ks[1]); kw.y = pk2(ks[2], ks[3]); kw.z = pk2(ks[4], ks[5]); kw.w = pk2(ks[6], ks[7]);
        *(LAS u32x4*)(Qs + t * 64 + cb) = qw; *(LAS u32x4*)(Ks + t * 64 + cb) = kw;
        *(u32x4*)(Z + (row0 + t) * ZP + C_GQ + h * 64 + cb) = qw;
        const u32x4 v0 = *(const u32x4*)(zr + C_GV + h * 128 + 16 * wid), v1 = *(const u32x4*)(zr + C_GV + h * 128 + 16 * wid + 8);
        LAS bf16_t* vt = VT + (16 * wid) * 64 + t;
        vt[0 * 64] = (bf16_t)(v0.x & 0xffff); vt[1 * 64] = (bf16_t)(v0.x >> 16); vt[2 * 64] = (bf16_t)(v0.y & 0xffff); vt[3 * 64] = (bf16_t)(v0.y >> 16);
        vt[4 * 64] = (bf16_t)(v0.z & 0xffff); vt[5 * 64] = (bf16_t)(v0.z >> 16); vt[6 * 64] = (bf16_t)(v0.w & 0xffff); vt[7 * 64] = (bf16_t)(v0.w >> 16);
        vt[8 * 64] = (bf16_t)(v1.x & 0xffff); vt[9 * 64] = (bf16_t)(v1.x >> 16); vt[10 * 64] = (bf16_t)(v1.y & 0xffff); vt[11 * 64] = (bf16_t)(v1.y >> 16);
        vt[12 * 64] = (bf16_t)(v1.z & 0xffff); vt[13 * 64] = (bf16_t)(v1.z >> 16); vt[14 * 64] = (bf16_t)(v1.w & 0xffff); vt[15 * 64] = (bf16_t)(v1.w >> 16);
    }
    __syncthreads();
    {
        const int vb = wid & 3, kb = wid >> 2; f32x16 acc = {};
#pragma unroll
        for (int ks = 0; ks < 4; ++ks) { const bf16x8 a = *(const LAS bf16x8*)(VT + (32 * vb + r32) * 64 + 16 * ks + 8 * hi); const bf16x8 bb = *(const LAS bf16x8*)(KhT + (32 * kb + r32) * 64 + 16 * ks + 8 * hi);
            acc = __builtin_amdgcn_mfma_f32_32x32x16_bf16(a, bb, acc, 0, 0, 0); }
        bf16_t* sp = SLOCT + (size_t)unit * 8192 + 32 * kb + r32;
#pragma unroll
        for (int r = 0; r < 16; ++r) sp[(32 * vb + crow(r, hi)) * 64] = (bf16_t)f2bf(acc[r]);
    }
    if (wid < 4) {
        const int sb = wid >> 1, tb = wid & 1; f32x16 acc = {};
        if (!(sb == 1 && tb == 0)) {
#pragma unroll
            for (int ks = 0; ks < 4; ++ks) { const bf16x8 a = *(const LAS bf16x8*)(Ks + (32 * sb + r32) * 64 + 16 * ks + 8 * hi); const bf16x8 bb = *(const LAS bf16x8*)(Qs + (32 * tb + r32) * 64 + 16 * ks + 8 * hi);
                acc = __builtin_amdgcn_mfma_f32_32x32x16_bf16(a, bb, acc, 0, 0, 0); }
        }
        const int t = 32 * tb + r32;
#pragma unroll
        for (int r = 0; r < 16; ++r) { const int s = 32 * sb + crow(r, hi); if (s > t) acc[r] = 0.f; }
#pragma unroll
        for (int g = 0; g < 4; ++g) { u32x2 w; w.x = pk2(acc[4 * g], acc[4 * g + 1]); w.y = pk2(acc[4 * g + 2], acc[4 * g + 3]); *(LAS u32x2*)(Am + t * 64 + 32 * sb + 8 * g + 4 * hi) = w; }
    }
    __syncthreads();
    {
        const int vb = wid & 3, tb = wid >> 2; f32x16 acc = {};
#pragma unroll
        for (int ks = 0; ks < 4; ++ks) { const bf16x8 a = *(const LAS bf16x8*)(Am + (32 * tb + r32) * 64 + 16 * ks + 8 * hi); const bf16x8 bb = *(const LAS bf16x8*)(VT + (32 * vb + r32) * 64 + 16 * ks + 8 * hi);
            acc = __builtin_amdgcn_mfma_f32_32x32x16_bf16(a, bb, acc, 0, 0, 0); }
        bf16_t* op = Z + (row0 + 32 * tb) * ZP + C_GV + h * 128 + 32 * vb + r32;
#pragma unroll
        for (int r = 0; r < 16; ++r) op[(size_t)crow(r, hi) * ZP] = (bf16_t)f2bf(acc[r]);
    }
    __syncthreads();
}

__device__ __forceinline__ void conv_ld_u(const bf16_t* Z, size_t row, int ch, float (&u)[8]) {
    const u32x4 a = *(const u32x4*)(Z + row * ZP + C_CX + ch), c = *(const u32x4*)(Z + row * ZP + C_CC + ch);
    u[0] = bflo(a.x) * bflo(c.x); u[1] = bfhi(a.x) * bfhi(c.x); u[2] = bflo(a.y) * bflo(c.y); u[3] = bfhi(a.y) * bfhi(c.y);
    u[4] = bflo(a.z) * bflo(c.z); u[5] = bfhi(a.z) * bfhi(c.z); u[6] = bflo(a.w) * bflo(c.w); u[7] = bfhi(a.w) * bfhi(c.w);
}
__device__ __forceinline__ void conv_unit(int cu, bf16_t* Z, const float* cw  , int wid, int lane) {
    const int ch = lane * 8; const size_t r0 = (size_t)cu * 128 + (size_t)wid * 16;
    float w0[8], w1[8], w2[8];
#pragma unroll
    for (int i = 0; i < 8; ++i) { w0[i] = cw[ch + i]; w1[i] = cw[512 + ch + i]; w2[i] = cw[1024 + ch + i]; }
    float u2[8], u1[8];
    if ((r0 % T) == 0) {
#pragma unroll
        for (int i = 0; i < 8; ++i) { u2[i] = 0.f; u1[i] = 0.f; }
    } else { conv_ld_u(Z, r0 - 2, ch, u2); conv_ld_u(Z, r0 - 1, ch, u1); }
    for (int i = 0; i < 16; ++i) { const size_t row = r0 + i; float u[8]; conv_ld_u(Z, row, ch, u);
        const u32x4 bq = *(const u32x4*)(Z + row * ZP + C_CB + ch);
        float bb[8]; bb[0] = bflo(bq.x); bb[1] = bfhi(bq.x); bb[2] = bflo(bq.y); bb[3] = bfhi(bq.y); bb[4] = bflo(bq.z); bb[5] = bfhi(bq.z); bb[6] = bflo(bq.w); bb[7] = bfhi(bq.w);
        float y[8];
#pragma unroll
        for (int k = 0; k < 8; ++k) { y[k] = bb[k] * (w0[k] * u2[k] + w1[k] * u1[k] + w2[k] * u[k]); u2[k] = u1[k]; u1[k] = u[k]; }
        u32x4 o; o.x = pk2(y[0], y[1]); o.y = pk2(y[2], y[3]); o.z = pk2(y[4], y[5]); o.w = pk2(y[6], y[7]);
        *(u32x4*)(Z + row * ZP + C_OC + ch) = o; }
}

__device__ __forceinline__ void knorm_unit(int cu, const bf16_t* Z, unsigned* KN  , LAS unsigned char* lds, int wid, int lane, int tid) {
    const size_t r0 = (size_t)cu * 128 + (size_t)wid * 16; float mx = 0.f;
    for (int i = 0; i < 16; ++i) { const u32x4 a = *(const u32x4*)(Z + (r0 + i) * ZP + C_DK + lane * 8);
        const float f0 = bflo(a.x), f1 = bfhi(a.x), f2 = bflo(a.y), f3 = bfhi(a.y), f4 = bflo(a.z), f5 = bfhi(a.z), f6 = bflo(a.w), f7 = bfhi(a.w);
        float s = (f0 * f0 + f1 * f1) + (f2 * f2 + f3 * f3) + (f4 * f4 + f5 * f5) + (f6 * f6 + f7 * f7);
        s += __shfl_xor(s, 1); s += __shfl_xor(s, 2); s += __shfl_xor(s, 4);
        mx = fmaxf(mx, s); }
    mx = fmaxf(mx, __shfl_xor(mx, 8));
    LAS float* SC = (LAS float*)lds;
    if ((lane & 15) == 0) SC[wid * 4 + (lane >> 4)] = mx;
    __syncthreads();
    if (tid < 4) { float v = SC[tid];
#pragma unroll
        for (int w = 1; w < 8; ++w) v = fmaxf(v, SC[w * 4 + tid]);
        const int b = (int)(((size_t)cu * 128) / T);
        __hip_atomic_fetch_max(KN + b * 4 + tid, __float_as_uint(v), __ATOMIC_RELAXED, __HIP_MEMORY_SCOPE_AGENT); }
    __syncthreads();
}
namespace att {
constexpr int KVBLK = 64;
constexpr size_t SHM_V = 64 * 128 * 2, SHM_K = 64 * 128 * 2;
constexpr float C = 0.125f * 1.4426950408889634f;
constexpr float THR2 = 10.f;
constexpr float WTHR = 40.f;
#define KSWZ(row, colB) ((row) * 256 + ((colB) ^ (((row) & 7) << 4)))
#define SBAR() __builtin_amdgcn_sched_barrier(0)
__device__ __forceinline__ unsigned cvtpk(float lo, float hi) { unsigned r; asm volatile("v_cvt_pk_bf16_f32 %0, %1, %2" : "=v"(r) : "v"(lo), "v"(hi)); return r; }

__device__ __forceinline__ void partialSM(f32x16& p0, f32x16& p1, float& m_reg, float& alpha, float tc, float c32, bool band, int dlim) {
    if (band) {
#pragma unroll
        for (int r = 0; r < 16; ++r) { const int cr = (r & 3) + 8 * (r >> 2); if (cr > dlim) p0[r] = -1e30f; if (cr + 32 > dlim) p1[r] = -1e30f; }
    }
    float pm0 = p0[0], pm1 = p1[0];
#pragma unroll
    for (int r = 1; r < 16; ++r) { pm0 = fmaxf(pm0, p0[r]); pm1 = fmaxf(pm1, p1[r]); }
    float pmax = fmaxf(pm0, pm1 + c32) + tc;
    { auto rr = __builtin_amdgcn_permlane32_swap(__float_as_uint(pmax), __float_as_uint(pmax), false, false);
      pmax = fmaxf(__uint_as_float(rr[0]), __uint_as_float(rr[1])); }
    if (__builtin_expect(__all(pmax - m_reg <= THR2), 1)) { alpha = 1.f; }
    else { const float mn = fmaxf(m_reg, pmax); alpha = __builtin_amdgcn_exp2f(m_reg - mn); m_reg = mn; }
    const float s0 = m_reg - tc, s1 = s0 - c32;
#pragma unroll
    for (int r = 0; r < 16; ++r) { p0[r] -= s0; p1[r] -= s1; }
#pragma unroll
    for (int r = 0; r < 16; ++r) p0[r] = __builtin_amdgcn_exp2f(p0[r]);
}
__device__ __forceinline__ void finishSM(f32x16& p0, f32x16& p1, float alpha, float& l_reg, bf16x8& pa0, bf16x8& pa1, bf16x8& pa2, bf16x8& pa3) {
#pragma unroll
    for (int r = 0; r < 16; ++r) p1[r] = __builtin_amdgcn_exp2f(p1[r]);
    float ps = 0;
#pragma unroll
    for (int r = 0; r < 16; ++r) ps += p0[r];
#pragma unroll
    for (int r = 0; r < 16; ++r) ps += p1[r];
    { auto rr = __builtin_amdgcn_permlane32_swap(__float_as_uint(ps), __float_as_uint(ps), false, false);
      ps = __uint_as_float(rr[0]) + __uint_as_float(rr[1]); }
    l_reg = l_reg * alpha + ps;
#define PK4(P, BASE, OUT) do { unsigned a0 = cvtpk(P[BASE + 0], P[BASE + 1]), a1 = cvtpk(P[BASE + 2], P[BASE + 3]);   \
    unsigned b0 = cvtpk(P[BASE + 4], P[BASE + 5]), b1 = cvtpk(P[BASE + 6], P[BASE + 7]);                              \
    auto r0 = __builtin_amdgcn_permlane32_swap(a0, b0, false, false); auto r1 = __builtin_amdgcn_permlane32_swap(a1, b1, false, false); \
    u32x4 w = {r0[0], r1[0], r0[1], r1[1]}; OUT = *reinterpret_cast<bf16x8*>(&w); } while (0)
    PK4(p0, 0, pa0); PK4(p0, 8, pa1); PK4(p1, 0, pa2); PK4(p1, 8, pa3);
#undef PK4
}
__device__ __forceinline__ void qkt(f32x16& p0, f32x16& p1, const char* Ks, const bf16x8* qr, const f32x16& biasv, int r32, int hi, int m) {
#pragma unroll
    for (int d0 = 0; d0 < 4; ++d0) { const int cb = ((4 * m + d0) * 16 + hi * 8) * 2;
        const bf16x8 b0 = *reinterpret_cast<const bf16x8*>(Ks + KSWZ(r32, cb));
        const bf16x8 b1 = *reinterpret_cast<const bf16x8*>(Ks + KSWZ(32 + r32, cb));
        if (d0 == 0) { p0 = __builtin_amdgcn_mfma_f32_32x32x16_bf16(b0, qr[0], biasv, 0, 0, 0); p1 = __builtin_amdgcn_mfma_f32_32x32x16_bf16(b1, qr[0], biasv, 0, 0, 0); }
        else { p0 = __builtin_amdgcn_mfma_f32_32x32x16_bf16(b0, qr[d0], p0, 0, 0, 0); p1 = __builtin_amdgcn_mfma_f32_32x32x16_bf16(b1, qr[d0], p1, 0, 0, 0); } }
}
__device__ __forceinline__ int v_st(int k, int c) { const int kk = (k & ~0xC) | ((k & 4) << 1) | ((k & 8) >> 1); return ((kk >> 3) * 4 + (c >> 5)) * 512 + ((kk & 7) * 32 + (c & 31)) * 2; }
__device__ __forceinline__ int v_rd_base(int lane) { return ((lane & 3) << 3) | (((lane >> 2) & 3) << 6) | (((lane >> 4) & 1) << 5) | (((lane >> 5) & 1) << 8); }
constexpr int v_rd_off(int d0, int ks, int half) { return d0 * 512 + ks * 4096 + half * 2048; }
template <int OFF> __device__ __forceinline__ s16x4 tr_read(int vb) {
    s16x4 r; asm volatile("ds_read_b64_tr_b16 %0, %1 offset:%2" : "=&v"(r) : "v"(vb), "i"(OFF) : "memory"); return r;
}
template <int D0> __device__ __forceinline__ void pv_one(f32x16& od, int vb, bf16x8 pa0, bf16x8 pa1, bf16x8 pa2, bf16x8 pa3) {
    const s16x4 l0 = tr_read<v_rd_off(D0, 0, 0)>(vb), h0 = tr_read<v_rd_off(D0, 0, 1)>(vb), l1 = tr_read<v_rd_off(D0, 1, 0)>(vb), h1 = tr_read<v_rd_off(D0, 1, 1)>(vb);
    const s16x4 l2 = tr_read<v_rd_off(D0, 2, 0)>(vb), h2 = tr_read<v_rd_off(D0, 2, 1)>(vb), l3 = tr_read<v_rd_off(D0, 3, 0)>(vb), h3 = tr_read<v_rd_off(D0, 3, 1)>(vb);
    asm volatile("s_waitcnt lgkmcnt(0)" ::: "memory"); SBAR();
#define PK(L, H) (bf16x8){L[0], L[1], L[2], L[3], H[0], H[1], H[2], H[3]}
    od = __builtin_amdgcn_mfma_f32_32x32x16_bf16(pa0, PK(l0, h0), od, 0, 0, 0);
    od = __builtin_amdgcn_mfma_f32_32x32x16_bf16(pa1, PK(l1, h1), od, 0, 0, 0);
    od = __builtin_amdgcn_mfma_f32_32x32x16_bf16(pa2, PK(l2, h2), od, 0, 0, 0);
    od = __builtin_amdgcn_mfma_f32_32x32x16_bf16(pa3, PK(l3, h3), od, 0, 0, 0);
#undef PK
}
__device__ __forceinline__ void pv_d0(f32x16* o, int vb, bf16x8 pa0, bf16x8 pa1, bf16x8 pa2, bf16x8 pa3) {
    pv_one<0>(o[0], vb, pa0, pa1, pa2, pa3); pv_one<1>(o[1], vb, pa0, pa1, pa2, pa3); pv_one<2>(o[2], vb, pa0, pa1, pa2, pa3); pv_one<3>(o[3], vb, pa0, pa1, pa2, pa3);
}

__device__ __forceinline__ void unit(int b, int h, int qb, float lam, float oneml, float kn2, bf16_t* Z, const float* gdiff, char* lds) {
    int tid_l = threadIdx.x; asm volatile("" : "+v"(tid_l)); const int tid = tid_l;
    const int wid = tid >> 6, lane = tid & 63, r32 = lane & 31, hi = lane >> 5, m = wid >> 2, rb = wid & 3;
    const size_t rowbase = (size_t)b * T; const int q0 = qb * 128;
    const float slope2 = exp2f(-2.f * (float)(h + 1)) * 1.4426950408889634f;
    char* V_lds = lds; char* K_lds = lds + 2 * SHM_V;
    float* wsf = (float*)(lds + 2 * SHM_V + 2 * SHM_K) + wid * 64; float* li_l = wsf; float* al_l = wsf + 32;
    float m_reg = -1e30f, l_reg = 0; f32x16 o[4] = {}; bf16x8 qr[4];
    const bf16_t* Qw = Z + (rowbase + q0 + rb * 32 + r32) * ZP + C_DQ + h * 128 + m * 64 + hi * 8;
    float qss = 0.f;
#pragma unroll
    for (int d0 = 0; d0 < 4; ++d0) { const u32x4 w = *reinterpret_cast<const u32x4*>(Qw + d0 * 16);
        const float f0 = bflo(w.x), f1 = bfhi(w.x), f2 = bflo(w.y), f3 = bfhi(w.y), f4 = bflo(w.z), f5 = bfhi(w.z), f6 = bflo(w.w), f7 = bfhi(w.w);
        qss += (f0 * f0 + f1 * f1) + (f2 * f2 + f3 * f3) + (f4 * f4 + f5 * f5) + (f6 * f6 + f7 * f7);
        u32x4 s; s.x = pk2(f0 * C, f1 * C); s.y = pk2(f2 * C, f3 * C); s.z = pk2(f4 * C, f5 * C); s.w = pk2(f6 * C, f7 * C); qr[d0] = __builtin_bit_cast(bf16x8, s); }
    { auto rr = __builtin_amdgcn_permlane32_swap(__float_as_uint(qss), __float_as_uint(qss), false, false); qss = __uint_as_float(rr[0]) + __uint_as_float(rr[1]); }
#pragma unroll
    for (int x = 1; x < 32; x <<= 1) qss = fmaxf(qss, __shfl_xor(qss, x));
    const bf16_t* Kh = Z + rowbase * ZP + C_DK + h * 128; const bf16_t* Vh = Z + rowbase * ZP + C_DV + h * 128;
    const int sr = tid >> 4, sc = (tid & 15) * 8, vst0 = v_st(sr, sc), vst1 = v_st(32 + sr, sc);
    const int vb0 = (int)(uintptr_t)V_lds + v_rd_base(lane);
    const int qrel = q0 + rb * 32 + r32;
    const float c32 = 32.f * slope2;
    f32x16 biasv;
#pragma unroll
    for (int r = 0; r < 16; ++r) biasv[r] = slope2 * (float)((r & 3) + 8 * (r >> 2));
    asm volatile("" : "+v"(biasv));
    if (lane == 0) wsf[0] = qss; asm volatile("s_waitcnt lgkmcnt(0)" ::: "memory"); __syncthreads();
    float qn2 = 0.f;
#pragma unroll
    for (int w = 0; w < 8; ++w) qn2 = fmaxf(qn2, ((float*)(lds + 2 * SHM_V + 2 * SHM_K))[w * 64]);
    const float wd = (WTHR + 2.f * sqrtf(qn2) * sqrtf(kn2) * C) / slope2;
    int jlo = (int)floorf(((float)(q0 - 63) - wd) * (1.f / 64.f)); jlo = jlo < 0 ? 0 : (jlo & ~1);
    jlo = __builtin_amdgcn_readfirstlane(jlo);
    __syncthreads();
    struct { bf16x8 vs0, vs1, ks0, ks1; } sr_[2];
#define SLOAD(i, k0) do { sr_[i].vs0 = *reinterpret_cast<const bf16x8*>(&Vh[(size_t)((k0) + sr) * ZP + sc]); sr_[i].vs1 = *reinterpret_cast<const bf16x8*>(&Vh[(size_t)((k0) + 32 + sr) * ZP + sc]); \
    sr_[i].ks0 = *reinterpret_cast<const bf16x8*>(&Kh[(size_t)((k0) + sr) * ZP + sc]); sr_[i].ks1 = *reinterpret_cast<const bf16x8*>(&Kh[(size_t)((k0) + 32 + sr) * ZP + sc]); } while (0)
#define SWRITE(bb, i) do { *(bf16x8*)(V_lds + (bb) * SHM_V + vst0) = sr_[i].vs0;          \
    *(bf16x8*)(V_lds + (bb) * SHM_V + vst1) = sr_[i].vs1; const int kc = sc * 2;               \
    *(bf16x8*)(K_lds + (bb) * SHM_K + KSWZ(sr, kc)) = sr_[i].ks0;                       \
    *(bf16x8*)(K_lds + (bb) * SHM_K + KSWZ(32 + sr, kc)) = sr_[i].ks1; } while (0)
#define SWAIT() asm volatile("s_waitcnt vmcnt(4)" ::: "memory")
#define RESC(a) do { if (__any((a) < 1.f)) { if (hi == 0) al_l[r32] = (a); asm volatile("s_waitcnt lgkmcnt(0)" ::: "memory"); \
    _Pragma("unroll") for (int d = 0; d < 4; ++d) _Pragma("unroll") for (int r = 0; r < 16; ++r) o[d][r] *= al_l[crow(r, hi)]; } } while (0)
#define PSM(P0, P1, AL, j) partialSM(P0, P1, m_reg, AL, slope2 * (float)(64 * (j) + 4 * hi - qrel), c32, (j) >= NT - 2, qrel - 64 * (j) - 4 * hi)
    f32x16 pA0, pA1, pB0, pB1; float alA, alB; bf16x8 pa0, pa1, pa2, pa3; const int NT = 2 * (qb + 1);
    constexpr int SE = 0, SO = 1;
    SLOAD(SE, jlo * KVBLK); asm volatile("s_waitcnt vmcnt(0)" ::: "memory"); SWRITE(0, SE); __syncthreads();
    qkt(pA0, pA1, K_lds, qr, biasv, r32, hi, m); PSM(pA0, pA1, alA, jlo);
    SLOAD(SO, (jlo + 1) * KVBLK); if (jlo + 2 < NT) SLOAD(SE, (jlo + 2) * KVBLK);
    SWAIT(); SWRITE(1, SO); __syncthreads();
    for (int j = jlo + 1; j + 1 < NT; j += 2) {
        SBAR(); qkt(pB0, pB1, K_lds + SHM_K, qr, biasv, r32, hi, m);
        finishSM(pA0, pA1, alA, l_reg, pa0, pa1, pa2, pa3); SBAR();
        SLOAD(SO, (j + 2) * KVBLK); SBAR();
        pv_d0(o, vb0, pa0, pa1, pa2, pa3); PSM(pB0, pB1, alB, j);
        __syncthreads(); SWAIT(); SWRITE(0, SE);
        RESC(alB); __syncthreads();
        SBAR(); qkt(pA0, pA1, K_lds, qr, biasv, r32, hi, m);
        finishSM(pB0, pB1, alB, l_reg, pa0, pa1, pa2, pa3); SBAR();
        if (j + 3 < NT) SLOAD(SE, (j + 3) * KVBLK); SBAR();
        pv_d0(o, vb0 + (int)SHM_V, pa0, pa1, pa2, pa3); PSM(pA0, pA1, alA, j + 1);
        __syncthreads(); SWAIT(); SWRITE(1, SO);
        RESC(alA); __syncthreads();
    }
    SBAR(); qkt(pB0, pB1, K_lds + SHM_K, qr, biasv, r32, hi, m);
    finishSM(pA0, pA1, alA, l_reg, pa0, pa1, pa2, pa3); SBAR();
    pv_d0(o, vb0, pa0, pa1, pa2, pa3); PSM(pB0, pB1, alB, NT - 1);
    __syncthreads(); RESC(alB);
    finishSM(pB0, pB1, alB, l_reg, pa0, pa1, pa2, pa3); SBAR();
    pv_d0(o, vb0 + (int)SHM_V, pa0, pa1, pa2, pa3);
    if (hi == 0) li_l[r32] = l_reg; asm volatile("s_waitcnt lgkmcnt(0)" ::: "memory");
    float rli[16];
#pragma unroll
    for (int r = 0; r < 16; ++r) rli[r] = __builtin_amdgcn_rcpf(li_l[crow(r, hi)]);
    __syncthreads();
    float* XO = (float*)lds + rb * 4096;
    if (m == 1) {
#pragma unroll
        for (int d0 = 0; d0 < 4; ++d0)
#pragma unroll
            for (int r = 0; r < 16; ++r) XO[(d0 * 16 + r) * 64 + lane] = o[d0][r] * rli[r];
    }
    __syncthreads();
    if (m == 0) {
        float ss[16];
#pragma unroll
        for (int r = 0; r < 16; ++r) ss[r] = 0.f;
#pragma unroll
        for (int d0 = 0; d0 < 4; ++d0)
#pragma unroll
            for (int r = 0; r < 16; ++r) { const float v = o[d0][r] * rli[r] - lam * XO[(d0 * 16 + r) * 64 + lane]; o[d0][r] = v; ss[r] += v * v; }
#pragma unroll
        for (int r = 0; r < 16; ++r) {
#pragma unroll
            for (int x = 1; x < 32; x <<= 1) ss[r] += __shfl_xor(ss[r], x);
            ss[r] = oneml / sqrtf(ss[r] * (1.f / 128.f) + EPS); }
        bf16_t* Ow = Z + (rowbase + q0 + rb * 32) * ZP + C_OB + h * 128 + r32;
#pragma unroll
        for (int d0 = 0; d0 < 4; ++d0) { const float gc = gdiff[32 * d0 + r32];
#pragma unroll
            for (int r = 0; r < 16; ++r) Ow[(size_t)crow(r, hi) * ZP + 32 * d0] = (bf16_t)f2bf(o[d0][r] * ss[r] * gc); }
    }
    __syncthreads();
#undef SLOAD
#undef SWRITE
#undef SWAIT
#undef RESC
#undef PSM
}
#undef KSWZ
#undef SBAR
}

__device__ __forceinline__ void gla_scan(bf16_t* SLOCT, const float* DTAB, LAS unsigned char* lds, int G, int bx, int tid) {
    const int seg = tid >> 5, pl = tid & 31; LAS f32x4* PR = (LAS f32x4*)lds;
    for (int grp = bx; grp < 1024; grp += G) {
        const int pi = grp * 32 + pl, bh = pi >> 12, e2 = (pi & 4095) * 2, dk = e2 & 63;
        unsigned* sp = (unsigned*)(SLOCT + (size_t)bh * 256 * 8192 + e2) + (size_t)(seg * 16) * 4096; const float* dp = DTAB + (size_t)bh * 256 * 64 + dk + (size_t)(seg * 16) * 64;
        unsigned u[16]; f32x2 d[16];
#pragma unroll
        for (int i = 0; i < 16; ++i) { u[i] = sp[(size_t)i * 4096]; d[i] = *(const f32x2*)(dp + (size_t)i * 64); }
        float r0 = 0.f, r1 = 0.f, P0 = 1.f, P1 = 1.f;
#pragma unroll
        for (int i = 0; i < 16; ++i) { r0 = fmaf(d[i].x, r0, bflo(u[i])); r1 = fmaf(d[i].y, r1, bfhi(u[i])); P0 *= d[i].x; P1 *= d[i].y; }
        PR[seg * 32 + pl] = (f32x4){P0, P1, r0, r1};
        __syncthreads();
        float i0 = 0.f, i1 = 0.f;
        for (int s = 0; s < seg; ++s) { const f32x4 q = PR[s * 32 + pl]; i0 = fmaf(q.x, i0, q.z); i1 = fmaf(q.y, i1, q.w); }
#pragma unroll
        for (int i = 0; i < 16; ++i) { sp[(size_t)i * 4096] = pk2(i0, i1); i0 = fmaf(d[i].x, i0, bflo(u[i])); i1 = fmaf(d[i].y, i1, bfhi(u[i])); }
        __syncthreads();
    }
}

__device__ __forceinline__ void gla3_unit(int unit, bf16_t* Z, const bf16_t* SLOCT, const float* ggn, LAS unsigned char* lds, int wid, int lane) {
    const int bh = unit >> 8, c = unit & 255, b = bh >> 2, h = bh & 3; const size_t row0 = (size_t)b * T + (size_t)c * 64;
    const int r32 = lane & 31, hi = lane >> 5, vb = wid & 3, tb = wid >> 2;
    LAS float* SS = (LAS float*)lds;
    f32x16 acc = {};
#pragma unroll
    for (int ks = 0; ks < 4; ++ks) { const bf16x8 a = *(const bf16x8*)(Z + (row0 + 32 * tb + r32) * ZP + C_GQ + h * 64 + 16 * ks + 8 * hi);
        const bf16x8 bb = *(const bf16x8*)(SLOCT + (size_t)unit * 8192 + (32 * vb + r32) * 64 + 16 * ks + 8 * hi);
        acc = __builtin_amdgcn_mfma_f32_32x32x16_bf16(a, bb, acc, 0, 0, 0); }
    const bf16_t* oi = Z + (row0 + 32 * tb) * ZP + C_GV + h * 128 + 32 * vb + r32;
    float o[16], ss[16];
#pragma unroll
    for (int r = 0; r < 16; ++r) { o[r] = acc[r] + bf2f(oi[(size_t)crow(r, hi) * ZP]); ss[r] = o[r] * o[r]; }
#pragma unroll
    for (int r = 0; r < 16; ++r) {
#pragma unroll
        for (int x = 1; x < 32; x <<= 1) ss[r] += __shfl_xor(ss[r], x);
        if (r32 == 0) SS[wid * 32 + crow(r, hi)] = ss[r]; }
    __syncthreads();
    const float gcol = ggn[32 * vb + r32];
    bf16_t* gp = Z + (row0 + 32 * tb) * ZP + C_GG + h * 128 + 32 * vb + r32;
#pragma unroll
    for (int r = 0; r < 16; ++r) { const int tr = crow(r, hi);
        const float tot = (SS[(tb * 4 + 0) * 32 + tr] + SS[(tb * 4 + 1) * 32 + tr]) + (SS[(tb * 4 + 2) * 32 + tr] + SS[(tb * 4 + 3) * 32 + tr]);
        const float rstd = 1.0f / sqrtf(tot * (1.f / 128.f) + EPS);
        const float gg = bf2f(gp[(size_t)tr * ZP]);
        gp[(size_t)tr * ZP] = (bf16_t)f2bf(o[r] * rstd * gcol * siluf_(gg)); }
    __syncthreads();
}
namespace pg8 {
struct EpiMerge {
    static constexpr bool PERM = true;
    bf16_t* Z;
    __device__ __forceinline__ void operator()(const f32x4 (&acc)[2][2][4][2], const Unit& u, int wr, int wc, int fr, int fq) const {
        const int j = u.tag; const int row0 = u.pm * BM + wr * 64 + fr; const int col0 = u.pn * BM + wc * 32 + 8 * fq;
#pragma unroll
        for (int ai = 0; ai < 2; ++ai)
#pragma unroll
            for (int m = 0; m < 4; ++m) { bf16_t* rowp = Z + (size_t)(row0 + ai * HALF + m * 16) * ZP + col0;
#pragma unroll
                for (int bj = 0; bj < 2; ++bj) { const f32x4 v0 = acc[ai][bj][m][0], v1 = acc[ai][bj][m][1];
                    const u32x4 y = *(const u32x4*)(rowp + bj * HALF + 1024 * j);
                    u32x4 pv = {0u, 0u, 0u, 0u}; if (j > 0) pv = *(const u32x4*)(rowp + bj * HALF);
                    u32x4 w;
                    w.x = pk2(fmaf(sigmoidf_(v0[0]), bflo(y.x), bflo(pv.x)), fmaf(sigmoidf_(v0[1]), bfhi(y.x), bfhi(pv.x)));
                    w.y = pk2(fmaf(sigmoidf_(v0[2]), bflo(y.y), bflo(pv.y)), fmaf(sigmoidf_(v0[3]), bfhi(y.y), bfhi(pv.y)));
                    w.z = pk2(fmaf(sigmoidf_(v1[0]), bflo(y.z), bflo(pv.z)), fmaf(sigmoidf_(v1[1]), bfhi(y.z), bfhi(pv.z)));
                    w.w = pk2(fmaf(sigmoidf_(v1[2]), bflo(y.w), bflo(pv.w)), fmaf(sigmoidf_(v1[3]), bfhi(y.w), bfhi(pv.w)));
                    *(u32x4*)(rowp + bj * HALF) = w; }
                asm volatile("" ::: "memory"); }
    }
};
struct EpiRes {
    static constexpr bool PERM = false;
    const float* base; float* out;
    __device__ __forceinline__ void operator()(const f32x4 (&acc)[2][2][4][2], const Unit& u, int wr, int wc, int fr, int fq) const {
        const int row0 = u.pm * BM + wr * 64 + fr; const int col0 = u.pn * BM + wc * 32 + 4 * fq;
#pragma unroll
        for (int ai = 0; ai < 2; ++ai)
#pragma unroll
            for (int m = 0; m < 4; ++m) { const size_t off = (size_t)(row0 + ai * HALF + m * 16) * DM + col0;
#pragma unroll
                for (int bj = 0; bj < 2; ++bj)
#pragma unroll
                    for (int n = 0; n < 2; ++n) { const f32x4 bs = *(const f32x4*)(base + off + bj * HALF + n * 16); *(f32x4*)(out + off + bj * HALF + n * 16) = bs + acc[ai][bj][m][n]; } }
    }
};
struct EpiPle {
    static constexpr bool PERM = false;
    const float* base; float* out; const bf16_t* PL;
    __device__ __forceinline__ void operator()(const f32x4 (&acc)[2][2][4][2], const Unit& u, int wr, int wc, int fr, int fq) const {
        const int row0 = u.pm * BM + wr * 64 + fr; const int col0 = u.pn * BM + wc * 32 + 4 * fq;
#pragma unroll
        for (int ai = 0; ai < 2; ++ai)
#pragma unroll
            for (int m = 0; m < 4; ++m) { const size_t off = (size_t)(row0 + ai * HALF + m * 16) * DM + col0;
#pragma unroll
                for (int bj = 0; bj < 2; ++bj)
#pragma unroll
                    for (int n = 0; n < 2; ++n) { const f32x4 bs = *(const f32x4*)(base + off + bj * HALF + n * 16); const u32x2 pl = *(const u32x2*)(PL + off + bj * HALF + n * 16); const f32x4 a = acc[ai][bj][m][n];
                        f32x4 o; o.x = fmaf(sigmoidf_(a.x), bflo(pl.x), bs.x); o.y = fmaf(sigmoidf_(a.y), bfhi(pl.x), bs.y); o.z = fmaf(sigmoidf_(a.z), bflo(pl.y), bs.z); o.w = fmaf(sigmoidf_(a.w), bfhi(pl.y), bs.w);
                        *(f32x4*)(out + off + bj * HALF + n * 16) = o; } }
    }
};
struct EpiUp {
    static constexpr bool PERM = true;
    bf16_t* ACT;
    __device__ __forceinline__ void operator()(const f32x4 (&acc)[2][2][4][2], const Unit& u, int wr, int wc, int fr, int fq) const {
        const int row0 = u.pm * BM + wr * 64 + fr; const int col0 = u.pn * HALF + wc * 32 + 8 * fq;
#pragma unroll
        for (int ai = 0; ai < 2; ++ai)
#pragma unroll
            for (int m = 0; m < 4; ++m) { const f32x4 g0 = acc[ai][0][m][0], g1 = acc[ai][0][m][1], u0 = acc[ai][1][m][0], u1 = acc[ai][1][m][1];
                u32x4 w; w.x = pk2(siluf_(g0[0]) * u0[0], siluf_(g0[1]) * u0[1]); w.y = pk2(siluf_(g0[2]) * u0[2], siluf_(g0[3]) * u0[3]);
                w.z = pk2(siluf_(g1[0]) * u1[0], siluf_(g1[1]) * u1[1]); w.w = pk2(siluf_(g1[2]) * u1[2], siluf_(g1[3]) * u1[3]);
                *(u32x4*)(ACT + (size_t)(row0 + ai * HALF + m * 16) * DEXP + col0) = w; }
    }
};
struct EpiDown {
    static constexpr bool PERM = true;
    bf16_t* Y; const float* sw;
    __device__ __forceinline__ void operator()(const f32x4 (&acc)[2][2][4][2], const Unit& u, int wr, int wc, int fr, int fq) const {
        const int row0 = u.pm * BM + wr * 64 + fr; const int col0 = u.pn * BM + wc * 32 + 8 * fq;
#pragma unroll
        for (int ai = 0; ai < 2; ++ai)
#pragma unroll
            for (int m = 0; m < 4; ++m) { const int row = row0 + ai * HALF + m * 16; const float s = sw[row]; bf16_t* rowp = Y + (size_t)row * DM + col0;
#pragma unroll
                for (int bj = 0; bj < 2; ++bj) { const f32x4 v0 = acc[ai][bj][m][0] * s, v1 = acc[ai][bj][m][1] * s;
                    u32x4 w; w.x = pk2(v0[0], v0[1]); w.y = pk2(v0[2], v0[3]); w.z = pk2(v1[0], v1[1]); w.w = pk2(v1[2], v1[3]);
                    *(u32x4*)(rowp + bj * HALF) = w; } }
    }
};
struct MergeOrder {
    int c, G; int abase, astep; size_t bbase, bstep;
    __device__ bool next(int i, Unit& u) const { const int pair = (i / 3) * G + c, j = i % 3; if (pair >= 512) return false;
        u.pm = pair >> 2; u.pn = pair & 3; u.tag = j; u.aoff = abase + j * astep; u.boff = bbase + (size_t)j * bstep; return true; }
};
struct GroupOrder {
    const int* tbl;
    int c, G; size_t bstride;
    __device__ bool next(int i, Unit& u) const {
        int L = i * G + c; int found = 0, pm = 0, pn = 0, ee = 0;
#pragma unroll
        for (int e = 0; e < NEXP; ++e) { const int nt_e = (tbl[16 + e] + 255) >> 8, nu = nt_e * 4;
            if (!found && L < nu) { found = 1; pm = (tbl[e] >> 8) + (L >> 2); pn = L & 3; ee = e; }
            if (!found) L -= nu; }
        if (!found) return false;
        u.pm = pm; u.pn = pn; u.tag = ee; u.aoff = 0; u.boff = (size_t)ee * bstride; return true; }
};
}

__device__ __forceinline__ void phaseF(KA P, int L, LAS unsigned char* lds, int wave, int lane, int tid) {
    LAS float* WR = (LAS float*)lds; LAS int* E0 = (LAS int*)(lds + 81920); LAS int* E1 = (LAS int*)(lds + 82432); LAS float* W0 = (LAS float*)(lds + 82944); LAS float* W1 = (LAS float*)(lds + 83456);
    const float* wrg = P->p.in[15] + (size_t)L * DM * 4; const float* wre = P->p.in[17] + (size_t)L * DM * 16;
    for (int i = tid; i < DM * 4; i += 512) WR[(i & 3) * 1024 + (i >> 2)] = wrg[i];
    for (int i = tid; i < DM * 16; i += 512) WR[(4 + (i & 15)) * 1024 + (i >> 4)] = wre[i];
    __syncthreads();
    const float* brg = P->p.in[16] + L * 4; const float* bre = P->p.in[18] + L * 16; const float* g = P->p.in[14] + (size_t)L * DM;
    const int tok0 = blockIdx.x * TPW;
    int* RE0 = (int*)(P->p.ws + WS_ROUTE); int* RE1 = RE0 + NTOK; float* RW0 = (float*)(RE1 + NTOK); float* RW1 = RW0 + NTOK;
    for (int i = wave * 16; i < wave * 16 + 16; ++i) {
        const int tok = tok0 + i;
        const f32x4* xr = (const f32x4*)(P->p.out + (size_t)tok * DM) + lane; const f32x4* gr = (const f32x4*)g + lane;
        f32x4 v[4]; float s = 0.f;
#pragma unroll
        for (int j = 0; j < 4; ++j) { v[j] = xr[64 * j]; s += (v[j].x * v[j].x + v[j].y * v[j].y) + (v[j].z * v[j].z + v[j].w * v[j].w); }
        const float r = 1.0f / sqrtf(wave_sum(s) * (1.f / DM) + EPS);
        u32x2* o8 = (u32x2*)((bf16_t*)(P->p.ws + WS_HN) + (size_t)tok * DM) + lane;
#pragma unroll
        for (int j = 0; j < 4; ++j) { const f32x4 gg = gr[64 * j]; v[j].x *= r * gg.x; v[j].y *= r * gg.y; v[j].z *= r * gg.z; v[j].w *= r * gg.w;
            u32x2 w; w.x = pk2(v[j].x, v[j].y); w.y = pk2(v[j].z, v[j].w); o8[64 * j] = w; }
        float lg[20];
#pragma unroll
        for (int o = 0; o < 20; ++o) { float a = 0.f;
#pragma unroll
            for (int j = 0; j < 4; ++j) { const f32x4 w = *(const LAS f32x4*)(WR + o * 1024 + 256 * j + 4 * lane); a += (v[j].x * w.x + v[j].y * w.y) + (v[j].z * w.z + v[j].w * w.w); }
            lg[o] = wave_sum(a); }
        float gl[4];
#pragma unroll
        for (int q = 0; q < 4; ++q) gl[q] = lg[q] + brg[q];
        int gi = 0; float gm = gl[0];
#pragma unroll
        for (int q = 1; q < 4; ++q) if (gl[q] > gm) { gm = gl[q]; gi = q; }
        float den = 0.f;
#pragma unroll
        for (int q = 0; q < 4; ++q) den += expf(gl[q] - gm);
        const float gp = 1.0f / den;
        float wv[4];
#pragma unroll
        for (int q = 0; q < 4; ++q) { const float e0v = lg[4 + q] + bre[q], e1v = lg[8 + q] + bre[4 + q], e2v = lg[12 + q] + bre[8 + q], e3v = lg[16 + q] + bre[12 + q];
            wv[q] = gi == 0 ? e0v : gi == 1 ? e1v : gi == 2 ? e2v : e3v; }
        int i0 = 0; float m0 = wv[0];
#pragma unroll
        for (int q = 1; q < 4; ++q) if (wv[q] > m0) { m0 = wv[q]; i0 = q; }
        int i1 = -1; float m1 = 0.f;
#pragma unroll
        for (int q = 0; q < 4; ++q) if (q != i0 && (i1 < 0 || wv[q] > m1)) { m1 = wv[q]; i1 = q; }
        const float t = expf(m1 - m0); const float w0 = gp / (1.f + t), w1 = gp * t / (1.f + t);
        if (lane == 0) { const int e0 = gi * 4 + i0, e1 = gi * 4 + i1; E0[i] = e0; E1[i] = e1; W0[i] = w0; W1[i] = w1; RE0[tok] = e0; RE1[tok] = e1; RW0[tok] = w0; RW1[tok] = w1; }
    }
    __syncthreads();
    if (tid < 16) { int cnt = 0; for (int i = 0; i < TPW; ++i) cnt += (E0[i] == tid) + (E1[i] == tid); ((int*)(P->p.ws + WS_HIST))[blockIdx.x * 16 + tid] = cnt; }
    __syncthreads();
}

__device__ __forceinline__ void phaseG(KA P, LAS unsigned char* lds, int wave, int lane, int tid) {
    LAS int* E0 = (LAS int*)lds; LAS int* E1 = (LAS int*)(lds + 512); LAS int* S0 = (LAS int*)(lds + 1024); LAS int* S1 = (LAS int*)(lds + 1536);
    LAS int* TOT = (LAS int*)(lds + 2048); LAS int* PRE = (LAS int*)(lds + 2112); LAS int* EB = (LAS int*)(lds + 2176);
    const int* HIST = (const int*)(P->p.ws + WS_HIST); const int tok0 = blockIdx.x * TPW;
    const int* RE0 = (const int*)(P->p.ws + WS_ROUTE); const int* RE1 = RE0 + NTOK; const float* RW0 = (const float*)(RE1 + NTOK); const float* RW1 = RW0 + NTOK;
    LAS int* PT = (LAS int*)(lds + 4096); LAS int* PP = (LAS int*)(lds + 4096 + 2048);
    { const int e = tid & 15, part = tid >> 4; int tot = 0, pre = 0;
#pragma unroll
      for (int k = 0; k < 8; ++k) { const int w = part * 8 + k; const int hv = HIST[w * 16 + e]; tot += hv; if (w < (int)blockIdx.x) pre += hv; }
      PT[part * 16 + e] = tot; PP[part * 16 + e] = pre; }
    if (tid < TPW) { E0[tid] = RE0[tok0 + tid]; E1[tid] = RE1[tok0 + tid]; }
    __syncthreads();
    if (tid < 16) { int tot = 0, pre = 0; for (int q = 0; q < 32; ++q) { tot += PT[q * 16 + tid]; pre += PP[q * 16 + tid]; } TOT[tid] = tot; PRE[tid] = pre; }
    __syncthreads();
    if (tid == 0) { int eb = 0; for (int e = 0; e < NEXP; ++e) { EB[e] = eb; eb += (TOT[e] + 255) & ~255; }
        if (blockIdx.x == 0) { int* tbl = (int*)(P->p.ws + WS_TBL); for (int e = 0; e < NEXP; ++e) { tbl[e] = EB[e]; tbl[16 + e] = TOT[e]; } } }
    __syncthreads();
    if (tid < 16) { int run = EB[tid] + PRE[tid]; for (int i = 0; i < TPW; ++i) { if (E0[i] == tid) S0[i] = run++; if (E1[i] == tid) S1[i] = run++; } }
    __syncthreads();
    const bf16_t* H2 = (const bf16_t*)(P->p.ws + WS_HN); bf16_t* HG = (bf16_t*)(P->p.ws + WS_HG); float* SW = (float*)(P->p.ws + WS_SLOTW); int* TS = (int*)(P->p.ws + WS_TOKSLOT);
    for (int i = wave * 16; i < wave * 16 + 16; ++i) { const int tok = tok0 + i, s0 = S0[i], s1 = S1[i];
        const u32x4* src = (const u32x4*)(H2 + (size_t)tok * DM) + lane; const u32x4 a = src[0], b2 = src[64];
        u32x4* d0 = (u32x4*)(HG + (size_t)s0 * DM) + lane; u32x4* d1 = (u32x4*)(HG + (size_t)s1 * DM) + lane;
        d0[0] = a; d0[64] = b2; d1[0] = a; d1[64] = b2;
        if (lane == 0) { SW[s0] = RW0[tok]; SW[s1] = RW1[tok]; TS[2 * tok] = s0; TS[2 * tok + 1] = s1; } }
}

__device__ __forceinline__ void phaseJ_rows(KA P, int vcu, int G, int wave, int lane) {
    const bf16_t* Y = (const bf16_t*)(P->p.ws + WS_HG); const int* TS = (const int*)(P->p.ws + WS_TOKSLOT); bf16_t* XB = (bf16_t*)(P->p.ws + WS_HN);
    for (int tok = vcu * 8 + wave; tok < NTOK; tok += G * 8) { const int s0 = TS[2 * tok], s1 = TS[2 * tok + 1];
        f32x4* xr = (f32x4*)(P->p.out + (size_t)tok * DM) + lane; const u32x2* y0 = (const u32x2*)(Y + (size_t)s0 * DM) + lane; const u32x2* y1 = (const u32x2*)(Y + (size_t)s1 * DM) + lane;
        u32x2* o8 = (u32x2*)(XB + (size_t)tok * DM) + lane;
#pragma unroll
        for (int j = 0; j < 4; ++j) { f32x4 v = xr[64 * j]; const u32x2 a = y0[64 * j], b = y1[64 * j];
            v.x += bflo(a.x) + bflo(b.x); v.y += bfhi(a.x) + bfhi(b.x); v.z += bflo(a.y) + bflo(b.y); v.w += bfhi(a.y) + bfhi(b.y);
            xr[64 * j] = v; u32x2 w; w.x = pk2(v.x, v.y); w.y = pk2(v.z, v.w); o8[64 * j] = w; } }
}
__device__ __forceinline__ void final_rows(KA P, int vcu, int G, int wave, int lane) {
    const f32x4* gr = (const f32x4*)P->p.in[23] + lane;
    for (int tok = vcu * 8 + wave; tok < NTOK; tok += G * 8) { f32x4* xr = (f32x4*)(P->p.out + (size_t)tok * DM) + lane; f32x4 v[4]; float s = 0.f;
#pragma unroll
        for (int j = 0; j < 4; ++j) { v[j] = xr[64 * j]; s += (v[j].x * v[j].x + v[j].y * v[j].y) + (v[j].z * v[j].z + v[j].w * v[j].w); }
        const float r = 1.0f / sqrtf(wave_sum(s) * (1.f / DM) + EPS);
#pragma unroll
        for (int j = 0; j < 4; ++j) { const f32x4 gg = gr[64 * j]; f32x4 o; o.x = v[j].x * r * gg.x; o.y = v[j].y * r * gg.y; o.z = v[j].z * r * gg.z; o.w = v[j].w * r * gg.w; xr[64 * j] = o; } }
}
#ifndef MK_N_LAUNCHES
#define MK_N_LAUNCHES 1
#endif
constexpr int PH_PER_LAYER = 13, N_PHASES = DEPTH * PH_PER_LAYER + 1;
constexpr int N_LAUNCHES = MK_N_LAUNCHES;
static_assert(N_LAUNCHES == 1 || N_LAUNCHES == N_PHASES, "MK_N_LAUNCHES is 1 or 27");

#define PH_FN static __device__ __forceinline__ void
#define PH_COMMON int tid_l = threadIdx.x; asm volatile("" : "+v"(tid_l)); asm volatile("" : "+s"(ka)); asm volatile("" : "+s"(L)); const int tid = tid_l, lane = tid & 63, wave = __builtin_amdgcn_readfirstlane(tid >> 6); int G_l = gridDim.x, bx_l = blockIdx.x; asm volatile("" : "+s"(G_l)); asm volatile("" : "+s"(bx_l)); const int G = G_l, bx = bx_l; \
    const int vcu = (G % 8 == 0) ? (bx % 8) * (G / 8) + bx / 8 : bx; unsigned char* ws = ka->p.ws; (void)tid; (void)lane; (void)wave; (void)vcu; (void)ws; \
    bf16_t* Z = (bf16_t*)(ws + WS_Z); bf16_t* HN = (bf16_t*)(ws + WS_HN); (void)Z; (void)HN;

PH_FN ph_A(KA ka, int L, LAS unsigned char* L3) { PH_COMMON; KA P = ka; phaseA(P, L, L3, vcu, G, wave, lane, tid); }
PH_FN ph_B(KA ka, int L, LAS unsigned char* L3) { PH_COMMON;
    pg8::Gemm g{HN, DM, (const bf16_t*)(ws + WS_WIN), DM, DM}; pg8::StaticOrder S; S.init(NTOK, NZT * 256, G, bx);
    pg8::EpiBf16 E{Z, ZP, 0};
    pg8::gemm_phase<pg8::EpiBf16, pg8::StaticOrder, true, true>(L3, g, S, E); }
PH_FN ph_C1a(KA ka, int L, LAS unsigned char* L3) { PH_COMMON;
    const float* wa2 = ka->p.in[4] + (size_t)L * 16 * 256; const float* ba = ka->p.in[5] + (size_t)L * 256;
    for (int u = bx; u < 2048; u += G) gla1_unit(u, Z, wa2, ba, (bf16_t*)(ws + WS_SLOC), (float*)(ws + WS_DTAB), L3, wave, lane, tid);
    for (int cu = bx; cu < 256; cu += G) conv_unit(cu, Z, ka->p.in[11] + (size_t)L * 3 * 512, wave, lane);
    for (int cu = bx; cu < 256; cu += G) knorm_unit(cu, Z, (unsigned*)(ws + WS_CTL) + CW_KN + 64 * L, L3, wave, lane, tid); }
PH_FN ph_C1b(KA ka, int L, LAS unsigned char* L3) { PH_COMMON;
    gla_scan((bf16_t*)(ws + WS_SLOC), (const float*)(ws + WS_DTAB), L3, G, bx, tid);
    const float* lp = ka->p.in[8] + (size_t)L * 256;
    const float sa = wave_sum(lp[lane] * lp[64 + lane]), sb = wave_sum(lp[128 + lane] * lp[192 + lane]);
    const float lam_init = 0.8f - 0.6f * expf(-0.3f * (float)L); const float lam = expf(sa) - expf(sb) + lam_init;
    const float* gd = ka->p.in[9] + (size_t)L * 128;
    unsigned* head = (unsigned*)(ws + WS_CTL) + CW_QHEAD + 64 * L; const unsigned* KN = (const unsigned*)(ws + WS_CTL) + CW_KN + 64 * L;
    LAS int* qslot = (LAS int*)(L3 + 69632);
    for (;;) {
        if (tid == 0) *qslot = (int)__hip_atomic_fetch_add(head, 1u, __ATOMIC_RELAXED, __HIP_MEMORY_SCOPE_AGENT);
        __syncthreads(); const int u = __builtin_amdgcn_readfirstlane(*qslot); __syncthreads();
        if (u >= 1024) break;
        const int h = 3 - (u >> 8), r = u & 255, qb = 127 - (r >> 1), b = r & 1;
        att::unit(b, h, qb, lam, 1.0f - lam_init, __uint_as_float(KN[b * 4 + h]), Z, gd, (char*)L3); } }
PH_FN ph_C3(KA ka, int L, LAS unsigned char* L3) { PH_COMMON; for (int u = bx; u < 2048; u += G) gla3_unit(u, Z, (const bf16_t*)(ws + WS_SLOC), ka->p.in[6] + (size_t)L * 128, L3, wave, lane); }
PH_FN ph_D1(KA ka, int L, LAS unsigned char* L3) { PH_COMMON;
    pg8::Gemm g{Z, ZP, (const bf16_t*)(ws + WS_WO), 512, 512}; pg8::MergeOrder S{bx, G, C_OA, 512, 0, (size_t)DM * 512};
    pg8::EpiBf16 E{Z, ZP, 1024};
    pg8::gemm_phase<pg8::EpiBf16, pg8::MergeOrder, true, true>(L3, g, S, E); }
PH_FN ph_D2(KA ka, int L, LAS unsigned char* L3) { PH_COMMON;
    pg8::Gemm g{HN, DM, (const bf16_t*)(ws + WS_WIN), DM, DM}; pg8::MergeOrder S{bx, G, 0, 0, (size_t)NZT * 256 * DM, (size_t)4 * 256 * DM};
    pg8::EpiMerge E{Z};
    pg8::gemm_phase<pg8::EpiMerge, pg8::MergeOrder, true, true>(L3, g, S, E); }
PH_FN ph_E(KA ka, int L, LAS unsigned char* L3) { PH_COMMON;
    pg8::Gemm g{Z, ZP, (const bf16_t*)(ws + WS_WOUT), DM, DM}; pg8::StaticOrder S; S.init(NTOK, DM, G, bx);
    pg8::EpiRes E{L == 0 ? ka->p.in[0] : ka->p.out, ka->p.out};
    pg8::gemm_phase<pg8::EpiRes, pg8::StaticOrder, true, true>(L3, g, S, E); }
PH_FN ph_F(KA ka, int L, LAS unsigned char* L3) { PH_COMMON; KA P = ka; if (G == GRID) phaseF(P, L, L3, wave, lane, tid); }
PH_FN ph_G(KA ka, int L, LAS unsigned char* L3) { PH_COMMON; KA P = ka; if (G == GRID) phaseG(P, L3, wave, lane, tid); }
PH_FN ph_H(KA ka, int L, LAS unsigned char* L3) { PH_COMMON;
    pg8::Gemm g{(const bf16_t*)(ws + WS_HG), DM, (const bf16_t*)(ws + WS_WGU), DM, DM}; pg8::GroupOrder S{(const int*)(ws + WS_TBL), bx, G, (size_t)1024 * DM};
    pg8::EpiUp E{(bf16_t*)(ws + WS_ACT)};
    pg8::gemm_phase<pg8::EpiUp, pg8::GroupOrder, true, true>(L3, g, S, E); }
PH_FN ph_I(KA ka, int L, LAS unsigned char* L3) { PH_COMMON;
    pg8::Gemm g{(const bf16_t*)(ws + WS_ACT), DEXP, (const bf16_t*)(ws + WS_WDN), DEXP, DEXP}; pg8::GroupOrder S{(const int*)(ws + WS_TBL), bx, G, (size_t)DM * DEXP};
    pg8::EpiDown E{(bf16_t*)(ws + WS_HG), (const float*)(ws + WS_SLOTW)};
    pg8::gemm_phase<pg8::EpiDown, pg8::GroupOrder, true, true>(L3, g, S, E); }
PH_FN ph_J(KA ka, int L, LAS unsigned char* L3) { PH_COMMON; KA P = ka;
    phaseJ_rows(P, vcu, G, wave, lane);
    pg8::Gemm g{(const bf16_t*)(ws + WS_PB), PLE, (const bf16_t*)(ws + WS_WPLE), PLE, PLE}; pg8::StaticOrder S; S.init(NTOK, DM, G, bx);
    pg8::EpiBf16 E{(bf16_t*)(ws + WS_PL), DM, 0};
    pg8::gemm_phase<pg8::EpiBf16, pg8::StaticOrder, true, true>(L3, g, S, E); }
PH_FN ph_K(KA ka, int L, LAS unsigned char* L3) { PH_COMMON;
    pg8::Gemm g{HN, DM, (const bf16_t*)(ws + WS_WPG), DM, DM}; pg8::StaticOrder S; S.init(NTOK, DM, G, bx);
    pg8::EpiPle E{ka->p.out, ka->p.out, (const bf16_t*)(ws + WS_PL)};
    pg8::gemm_phase<pg8::EpiPle, pg8::StaticOrder, true, true>(L3, g, S, E); }
PH_FN ph_final(KA ka, int L, LAS unsigned char* L3) { PH_COMMON; KA P = ka; final_rows(P, vcu, G, wave, lane); }
static __device__ __forceinline__ void grid_bar(unsigned* barw, LAS unsigned* st) { XcdBarrier b; b.bar = barw; b.x = xb_xcc_id(); b.st = (volatile LAS unsigned*)st; xcd_barrier(b); }

__global__ void __launch_bounds__(512, 2) mega_fwd(Args args) {
    extern __shared__ __attribute__((aligned(16))) unsigned char lds[];
    LAS unsigned char* L3 = (LAS unsigned char*)lds;
    KA ka = (KA)__builtin_amdgcn_kernarg_segment_ptr();
    const int tid = threadIdx.x;
    for (int u = tid; u < (LDS_BYTES - LDSCTL_OFF) / 4; u += 512) ((LAS unsigned*)(L3 + LDSCTL_OFF))[u] = 0u;
    __syncthreads();
    unsigned* barw = (unsigned*)(args.p.ws + WS_CTL) + CW_BAR; LAS unsigned* st = (LAS unsigned*)(L3 + MISC_OFF) + 8;
    if (N_LAUNCHES == 1) (void)xcd_barrier_post(barw, (volatile LAS unsigned*)st);
    const int lo = args.ph_lo, hi = args.ph_hi;
#ifndef PHASE_MASK
#define PHASE_MASK 0xFFFFFFFu
#endif
#define IN(k) (((PHASE_MASK >> ((k) % PH_PER_LAYER + ((k) == N_PHASES - 1 ? PH_PER_LAYER : 0))) & 1u) && lo <= (k) && (k) < hi)
#define SEAM(k) do { if (IN(k) && IN((k) + 1)) grid_bar(barw, st); } while (0)
    for (int L = 0; L < DEPTH; ++L) {
        const int pb = L * PH_PER_LAYER;
        if (IN(pb + 0)) { ph_A(ka, L, L3);
#ifdef DUP_A
            __syncthreads(); ph_A(ka, L, L3);
#endif
        }
        SEAM(pb + 0);
        if (IN(pb + 1)) { ph_B(ka, L, L3);
#ifdef DUP_B
            ph_B(ka, L, L3);
#endif
        }
        SEAM(pb + 1);
        if (IN(pb + 2)) ph_C1a(ka, L, L3);
        SEAM(pb + 2);
        if (IN(pb + 3)) ph_C1b(ka, L, L3);
        SEAM(pb + 3);
        if (IN(pb + 4)) ph_C3(ka, L, L3);
        SEAM(pb + 4);
        if (IN(pb + 5)) { ph_D1(ka, L, L3); ph_D2(ka, L, L3); }
        SEAM(pb + 5);
        if (IN(pb + 6)) ph_E(ka, L, L3);
        SEAM(pb + 6);
        if (IN(pb + 7)) { ph_F(ka, L, L3);
#ifdef DUP_F
            __syncthreads(); ph_F(ka, L, L3);
#endif
        }
        SEAM(pb + 7);
        if (IN(pb + 8)) { ph_G(ka, L, L3);
#ifdef DUP_G
            __syncthreads(); ph_G(ka, L, L3);
#endif
        }
        SEAM(pb + 8);
        if (IN(pb + 9)) { ph_H(ka, L, L3);
#ifdef DUP_H
            __syncthreads(); ph_H(ka, L, L3);
#endif
        }
        SEAM(pb + 9);
        if (IN(pb + 10)) { ph_I(ka, L, L3);
#ifdef DUP_I
            __syncthreads(); ph_I(ka, L, L3);
#endif
        }
        SEAM(pb + 10);
        if (IN(pb + 11)) ph_J(ka, L, L3);
        SEAM(pb + 11);
        if (IN(pb + 12)) ph_K(ka, L, L3);
        SEAM(pb + 12);
    }
    if (IN(N_PHASES - 1)) ph_final(ka, 0, L3);
#undef IN
#undef SEAM
}

extern "C" void kernel_launch(void* const* d_in, const int* in_sizes, int n_in, void* d_out, int out_size, void* d_ws, size_t ws_size, hipStream_t stream) {
    static int grid = 0;
    if (grid == 0) {
        if (n_in != 24 || in_sizes[0] != NTOK * DM || out_size != NTOK * DM || ws_size < WS_END) {
            fprintf(stderr, "kernel_launch: built for 24 inputs, x/out of %d floats, >= %zu bytes of workspace; got n_in %d, in0 %d, out %d, ws %zu; nothing launched\n", NTOK * DM, (size_t)WS_END, n_in, n_in > 0 ? in_sizes[0] : -1, out_size, ws_size); grid = -1; return; }
        int dev = 0, cus = 0, per_cu = 0;
        if (hipGetDevice(&dev) != hipSuccess || hipDeviceGetAttribute(&cus, hipDeviceAttributeMultiprocessorCount, dev) != hipSuccess) { fprintf(stderr, "kernel_launch: device query failed\n"); grid = -1; return; }
        if (hipFuncSetAttribute((const void*)mega_fwd, hipFuncAttributeMaxDynamicSharedMemorySize, LDS_BYTES) != hipSuccess) { fprintf(stderr, "kernel_launch: hipFuncSetAttribute failed\n"); grid = -1; return; }
        if (hipOccupancyMaxActiveBlocksPerMultiprocessor(&per_cu, (const void*)mega_fwd, 512, LDS_BYTES) != hipSuccess || per_cu < 1)
            fprintf(stderr, "kernel_launch: note: occupancy query reports %d workgroups per CU\n", per_cu);
        (void)hipGetLastError();
        if (cus != GRID) { fprintf(stderr, "kernel_launch: built for a %d-CU device, found %d; nothing launched\n", GRID, cus); grid = -1; return; }
        grid = GRID;
    }
    if (grid < 0) return;
    if (hipMemsetAsync((char*)d_ws + WS_CTL, 0, CTL_ZERO_BYTES, stream) != hipSuccess) { fprintf(stderr, "kernel_launch: memset failed\n"); return; }
    Args a{};
    for (int i = 0; i < 24; ++i) a.p.in[i] = (const float*)d_in[i];
    a.p.out = (float*)d_out; a.p.ws = (unsigned char*)d_ws;
    for (int li = 0; li < N_LAUNCHES; ++li) {
        a.ph_lo = (N_LAUNCHES == 1) ? 0 : li; a.ph_hi = (N_LAUNCHES == 1) ? N_PHASES : li + 1;
        hipLaunchKernelGGL(mega_fwd, dim3(grid), dim3(512), LDS_BYTES, stream, a);
        const hipError_t le = hipPeekAtLastError();
        if (le != hipSuccess) { fprintf(stderr, "kernel_launch: launch %d failed: %s\n", li, hipGetErrorName(le)); break; }
    }
}
```

```cpp
#include <hip/hip_runtime.h>
#include <cstdio>
#include <cstdint>

#define LAS __attribute__((address_space(3)))
#define GAS __attribute__((address_space(1)))
typedef unsigned short bf16_t;
typedef short bf16x8 __attribute__((ext_vector_type(8)));
typedef short s16x4 __attribute__((ext_vector_type(4)));
typedef float f32x2 __attribute__((ext_vector_type(2)));
typedef float f32x4 __attribute__((ext_vector_type(4)));
typedef float f32x16 __attribute__((ext_vector_type(16)));
typedef unsigned u32x2 __attribute__((ext_vector_type(2)));
typedef unsigned u32x4 __attribute__((ext_vector_type(4)));
typedef __bf16 bf16x2_t __attribute__((ext_vector_type(2)));

constexpr int NB = 2, T = 16384, NTOK = NB * T, DM = 1024, DEPTH = 2, PLE = 256;
constexpr int INTOT = 7696;
constexpr int ZP = 4864;
constexpr int C_GQ = 0, C_GK = 256, C_GV = 512, C_DK = 1024, C_DV = 1536, C_CX = 2048, C_CC = 2560, C_GA = 3072, C_GG = 3328, C_DQ = 3840, C_CB = 4352;
constexpr int C_OA = C_GG, C_OB = C_DQ, C_OC = C_CB;
constexpr int NZT = 19;
constexpr int NEXP = 16, DEXP = 512;
constexpr int NSLOT = 2 * NTOK + NEXP * 256;
constexpr float EPS = 1e-6f;
constexpr int GRID = 256;
constexpr int TPW = NTOK / GRID;

__device__ __forceinline__ unsigned f2bf(float f) { unsigned u = __builtin_bit_cast(unsigned, f); return (u + 0x7fffu + ((u >> 16) & 1u)) >> 16; }
__device__ __forceinline__ unsigned pk2(float lo, float hi) { f32x2 v = {lo, hi}; bf16x2_t b = __builtin_convertvector(v, bf16x2_t); return __builtin_bit_cast(unsigned, b); }
__device__ __forceinline__ float bflo(unsigned w) { return __builtin_bit_cast(float, w << 16); }
__device__ __forceinline__ float bfhi(unsigned w) { return __builtin_bit_cast(float, w & 0xffff0000u); }
__device__ __forceinline__ float bf2f(bf16_t b) { return __builtin_bit_cast(float, (unsigned)b << 16); }
__device__ __forceinline__ float sigmoidf_(float x) { return __builtin_amdgcn_rcpf(1.0f + __builtin_amdgcn_exp2f(-1.4426950408889634f * x)); }
__device__ __forceinline__ float siluf_(float x) { return x * sigmoidf_(x); }
__device__ __forceinline__ float wave_sum(float v) {
#pragma unroll
    for (int o = 1; o < 64; o <<= 1) v += __shfl_xor(v, o);
    return v;
}
__device__ __forceinline__ float dpp_f(float x, int ctrl_sel) {
    const int xi = __builtin_bit_cast(int, x); int r;
    if (ctrl_sel == 0) r = __builtin_amdgcn_update_dpp(0, xi, 0xB1, 0xF, 0xF, true);
    else if (ctrl_sel == 1) r = __builtin_amdgcn_update_dpp(0, xi, 0x4E, 0xF, 0xF, true);
    else if (ctrl_sel == 2) r = __builtin_amdgcn_update_dpp(0, xi, 0x141, 0xF, 0xF, true);
    else r = __builtin_amdgcn_update_dpp(0, xi, 0x140, 0xF, 0xF, true);
    return __builtin_bit_cast(float, r); }
__device__ __forceinline__ float row16_sum(float x) { x += dpp_f(x, 0); x += dpp_f(x, 1); x += dpp_f(x, 2); x += dpp_f(x, 3); return x; }
__device__ __forceinline__ float rdl(float x, int l) { return __builtin_bit_cast(float, __builtin_amdgcn_readlane(__builtin_bit_cast(int, x), l)); }
__device__ __forceinline__ float wave_sum_hi(float x) { x = row16_sum(x);
    x += __builtin_bit_cast(float, __builtin_amdgcn_update_dpp(0, __builtin_bit_cast(int, x), 0x142, 0xA, 0xF, false));
    x += __builtin_bit_cast(float, __builtin_amdgcn_update_dpp(0, __builtin_bit_cast(int, x), 0x143, 0xC, 0xF, false)); return x; }
__device__ __forceinline__ float wave_sum_dpp(float x) { return rdl(wave_sum_hi(x), 63); }
__device__ __forceinline__ int crow(int r, int hi) { return (r & 3) + 8 * (r >> 2) + 4 * hi; }
#define LDS_WAIT() asm volatile("s_waitcnt lgkmcnt(0)" ::: "memory")
#define VM_WAIT() asm volatile("s_waitcnt vmcnt(0)" ::: "memory")

namespace pg8 {
#define PG8_LAS __attribute__((address_space(3)))
constexpr int BM = 256, BK = 64, HALF = 128, HTB = HALF * BK * 2  , STAGE_BYTES = 8 * HTB, NXCD = 8, WGM = 8;

__host__ __device__ __forceinline__ int lds_byte(int r, int c) { const int st = (r >> 4) * 2 + (c >> 5), rr = r & 15, cc = c & 31, ob = rr * 64 + cc * 2; return st * 1024 + (ob ^ (((ob >> 9) & 1) << 5)); }
__host__ __device__ __forceinline__ void stage_rc(int b, int& R, int& C) { const int st = b / 1024, sb = b % 1024, swz = sb ^ (((sb >> 9) & 1) << 5); R = (st >> 1) * 16 + swz / 64; C = (st & 1) * 32 + (swz % 64) / 2; }
__host__ __device__ __forceinline__ int perm32(int rho) { const int n = rho >> 4, i = rho & 15; return 8 * (i >> 2) + 4 * n + (i & 3); }

struct Unit { int pm, pn; int aoff; int tag; size_t boff; };
struct Gemm { const bf16_t* A; int lda; const bf16_t* Bt; int ldb; int K; };

struct StaticOrder {
    int nM, nN, nwg, G, c;
    __device__ void init(int M, int N, int G_, int c_) { nM = M / BM; nN = N / BM; nwg = nM * nN; G = G_; c = c_; }
    __device__ bool next(int i, Unit& u) const {
        const long L = (long)i * G + c; if (L >= nwg) return false;
        int wgid = (int)L; { const int q = nwg / NXCD, r = nwg % NXCD, xcd = wgid % NXCD, off = wgid / NXCD; wgid = (xcd < r ? xcd * (q + 1) : r * (q + 1) + (xcd - r) * q) + off; }
        const int nig = WGM * nN, gid = wgid / nig, fm = gid * WGM, gsz = (nM - fm) < WGM ? (nM - fm) : WGM;
        u.pm = fm + ((wgid % nig) % gsz); u.pn = (wgid % nig) / gsz; u.aoff = 0; u.tag = 0; u.boff = 0; return true;
    }
};

struct EpiBf16 {
    static constexpr bool PERM = true;
    bf16_t* O; int ldc; int tstride;
    __device__ __forceinline__ void operator()(const f32x4 (&acc)[2][2][4][2], const Unit& u, int wr, int wc, int fr, int fq) const {
        const int row0 = u.pm * BM + wr * 64 + fr; const int col0 = u.tag * tstride + u.pn * BM + wc * 32 + 8 * fq;
#pragma unroll
        for (int ai = 0; ai < 2; ++ai)
#pragma unroll
            for (int m = 0; m < 4; ++m) { bf16_t* rowp = O + (size_t)(row0 + ai * HALF + m * 16) * ldc + col0;
#pragma unroll
                for (int bj = 0; bj < 2; ++bj) { const f32x4 v0 = acc[ai][bj][m][0], v1 = acc[ai][bj][m][1];
                    u32x4 w; w.x = pk2(v0[0], v0[1]); w.y = pk2(v0[2], v0[3]); w.z = pk2(v1[0], v1[1]); w.w = pk2(v1[2], v1[3]);
                    *(u32x4*)(rowp + bj * HALF) = w; } }
    }
};
template <class Epi, class Sched, bool ALIGN_EPI = false, bool SP2 = false>
__device__ __forceinline__ void gemm_phase(PG8_LAS unsigned char* lds, const Gemm g, const Sched& S, const Epi& E) {
    int tid_l = threadIdx.x; asm volatile("" : "+v"(tid_l)); const int tid = tid_l;
    const int wid = __builtin_amdgcn_readfirstlane(tid >> 6), lane = tid & 63, wr = wid >> 2, wc = wid & 3, fr = lane & 15, fq = lane >> 4;
    const int K = g.K, nt = K / BK;
    unsigned voffA[2], voffB[2];
#pragma unroll
    for (int i = 0; i < 2; ++i) { int R, C; stage_rc(tid * 16 + i * 8192, R, C); const int Rb = Epi::PERM ? ((R & ~31) + perm32(R & 31)) : R;
        voffA[i] = (unsigned)(R * g.lda + C) * 2u; voffB[i] = (unsigned)(Rb * g.ldb + C) * 2u; }
    const size_t kstep = (size_t)(BK * 2);
    const size_t hstepA = (size_t)HALF * g.lda * 2, hstepB = (size_t)HALF * g.ldb * 2;
    const unsigned ldsw = (unsigned)wid * 1024u;
    const int aoff = lds_byte(wr * 64 + fr, fq * 8), boff = lds_byte(wc * 32 + fr, fq * 8);
#define PG8_UA(u) ((const char*)g.A + ((size_t)(u).pm * 2 * hstepA) + (size_t)(u).aoff * 2)
#define PG8_UB(u) ((const char*)g.Bt + ((size_t)(u).pn * 2 * hstepB) + (u).boff * 2)
#define PG8_SA(b, h) (((b) * 2 + (h)) * HTB)
#define PG8_SB(b, h) ((4 + (b) * 2 + (h)) * HTB)
#define PG8_STAGE(bufoff, gbase, voff) do { _Pragma("unroll") for (int _i = 0; _i < 2; ++_i) \
        __builtin_amdgcn_global_load_lds((const unsigned*)((const char*)(gbase) + (voff)[_i]), (PG8_LAS unsigned*)(lds + (bufoff) + ldsw + _i * 8192), 16, 0, 0); } while (0)
#define PG8_LDA(dst, b, h) do { _Pragma("unroll") for (int m = 0; m < 4; ++m) _Pragma("unroll") for (int k = 0; k < 2; ++k) dst[m][k] = *(const PG8_LAS bf16x8*)(lds + PG8_SA(b, h) + aoff + m * 2048 + k * 1024); } while (0)
#define PG8_LDB(dst, b, h) do { _Pragma("unroll") for (int n = 0; n < 2; ++n) _Pragma("unroll") for (int k = 0; k < 2; ++k) dst[n][k] = *(const PG8_LAS bf16x8*)(lds + PG8_SB(b, h) + boff + n * 2048 + k * 1024); } while (0)
#define PG8_MMA(ai, bj, At, Bt) do { __builtin_amdgcn_s_setprio(1); _Pragma("unroll") for (int m = 0; m < 4; ++m) _Pragma("unroll") for (int n = 0; n < 2; ++n) _Pragma("unroll") for (int k = 0; k < 2; ++k) \
        acc[ai][bj][m][n] = __builtin_amdgcn_mfma_f32_16x16x32_bf16(Bt[n][k], At[m][k], acc[ai][bj][m][n], 0, 0, 0); __builtin_amdgcn_s_setprio(0); } while (0)
#define PG8_WAIT_V(n) asm volatile("s_waitcnt vmcnt(" #n ")" ::: "memory")
#define PG8_WAIT_L(n) asm volatile("s_waitcnt lgkmcnt(" #n ")" ::: "memory")
#define PG8_BAR __builtin_amdgcn_s_barrier()
#define PG8_SCHED __builtin_amdgcn_sched_barrier(0)
    Unit cur, nxt; int ui = 0;
    if (!S.next(0, cur)) return;
    f32x4 acc[2][2][4][2];
#pragma unroll
    for (int a = 0; a < 2; ++a)
#pragma unroll
        for (int b = 0; b < 2; ++b)
#pragma unroll
            for (int m = 0; m < 4; ++m)
#pragma unroll
                for (int n = 0; n < 2; ++n) acc[a][b][m][n] = (f32x4){0.f, 0.f, 0.f, 0.f};
    bf16x8 At[4][2], B0[2][2], B1[2][2];
    const char* cA = PG8_UA(cur); const char* cB = PG8_UB(cur);
    if constexpr (SP2) {
        PG8_STAGE(PG8_SB(0, 0), cB, voffB); PG8_STAGE(PG8_SB(0, 1), cB + hstepB, voffB); PG8_STAGE(PG8_SA(0, 0), cA, voffA); PG8_STAGE(PG8_SA(0, 1), cA + hstepA, voffA);
        if (wr == 1) PG8_BAR;
        PG8_WAIT_V(2); PG8_BAR;
        PG8_STAGE(PG8_SB(1, 0), cB + kstep, voffB); PG8_STAGE(PG8_SA(1, 0), cA + kstep, voffA); PG8_STAGE(PG8_SB(1, 1), cB + hstepB + kstep, voffB);
        PG8_WAIT_V(6); PG8_BAR;
    } else {
        PG8_STAGE(PG8_SB(0, 0), cB, voffB); PG8_STAGE(PG8_SA(0, 0), cA, voffA); PG8_STAGE(PG8_SB(0, 1), cB + hstepB, voffB); PG8_STAGE(PG8_SA(0, 1), cA + hstepA, voffA);
        if (wr == 1) PG8_BAR;
        PG8_WAIT_V(4); PG8_BAR;
        PG8_STAGE(PG8_SB(1, 0), cB + kstep, voffB); PG8_STAGE(PG8_SA(1, 0), cA + kstep, voffA); PG8_STAGE(PG8_SB(1, 1), cB + hstepB + kstep, voffB);
        PG8_WAIT_V(6); PG8_BAR;
    }
    for (;;) {
        const bool has_next = S.next(ui + 1, nxt);
        const char* nA = has_next ? PG8_UA(nxt) : cA; const char* nB = has_next ? PG8_UB(nxt) : cB;
        for (int t = 0; t < nt; t += 2) {
            const bool last = (t == nt - 2);
            const char* a1 = cA + (size_t)(t + 1) * kstep;
            const char* a2 = last ? nA : cA + (size_t)(t + 2) * kstep; const char* b2 = last ? nB : cB + (size_t)(t + 2) * kstep;
            const char* a3 = a2 + kstep; const char* b3 = b2 + kstep;
            if constexpr (SP2) {
            PG8_LDB(B0, 0, 0); PG8_LDB(B1, 0, 1); PG8_SCHED; PG8_LDA(At, 0, 0); PG8_STAGE(PG8_SA(1, 1), a1 + hstepA, voffA);
            PG8_WAIT_V(8); PG8_WAIT_L(0); PG8_BAR; PG8_MMA(0, 0, At, B0); PG8_MMA(0, 1, At, B1); PG8_BAR; PG8_SCHED;
            PG8_LDA(At, 0, 1); PG8_STAGE(PG8_SB(0, 0), b2, voffB); PG8_STAGE(PG8_SB(0, 1), b2 + hstepB, voffB); PG8_STAGE(PG8_SA(0, 0), a2, voffA);
            PG8_WAIT_V(8); PG8_WAIT_L(0); PG8_BAR; PG8_MMA(1, 0, At, B0); PG8_MMA(1, 1, At, B1); PG8_BAR; PG8_SCHED;
            PG8_LDB(B0, 1, 0); PG8_LDB(B1, 1, 1); PG8_SCHED; PG8_LDA(At, 1, 0); PG8_STAGE(PG8_SA(0, 1), a2 + hstepA, voffA);
            PG8_WAIT_V(8); PG8_WAIT_L(0); PG8_BAR; PG8_MMA(0, 0, At, B0); PG8_MMA(0, 1, At, B1); PG8_BAR; PG8_SCHED;
            PG8_LDA(At, 1, 1); PG8_STAGE(PG8_SB(1, 0), b3, voffB); PG8_STAGE(PG8_SB(1, 1), b3 + hstepB, voffB); PG8_STAGE(PG8_SA(1, 0), a3, voffA);
            PG8_WAIT_V(8); PG8_WAIT_L(0); PG8_BAR; PG8_MMA(1, 0, At, B0); PG8_MMA(1, 1, At, B1); PG8_BAR; PG8_SCHED;
            } else {
            PG8_LDB(B0, 0, 0); PG8_SCHED; PG8_LDA(At, 0, 0); PG8_STAGE(PG8_SA(1, 1), a1 + hstepA, voffA);
            PG8_WAIT_L(8); PG8_BAR; PG8_WAIT_L(0); PG8_MMA(0, 0, At, B0); PG8_BAR; PG8_SCHED;
            PG8_LDB(B1, 0, 1); PG8_STAGE(PG8_SB(0, 0), b2, voffB);
            PG8_BAR; PG8_WAIT_L(0); PG8_MMA(0, 1, At, B1); PG8_BAR;
            PG8_LDA(At, 0, 1); PG8_STAGE(PG8_SA(0, 0), a2, voffA);
            PG8_BAR; PG8_WAIT_L(0); PG8_MMA(1, 0, At, B0); PG8_BAR; PG8_SCHED;
            PG8_STAGE(PG8_SB(0, 1), b2 + hstepB, voffB);
            PG8_WAIT_V(6); PG8_BAR; PG8_MMA(1, 1, At, B1); PG8_BAR;
            PG8_LDB(B0, 1, 0); PG8_SCHED; PG8_LDA(At, 1, 0); PG8_STAGE(PG8_SA(0, 1), a2 + hstepA, voffA);
            PG8_WAIT_L(8); PG8_BAR; PG8_WAIT_L(0); PG8_MMA(0, 0, At, B0); PG8_BAR; PG8_SCHED;
            PG8_LDB(B1, 1, 1); PG8_STAGE(PG8_SB(1, 0), b3, voffB);
            PG8_BAR; PG8_WAIT_L(0); PG8_MMA(0, 1, At, B1); PG8_BAR;
            PG8_LDA(At, 1, 1); PG8_STAGE(PG8_SA(1, 0), a3, voffA);
            PG8_BAR; PG8_WAIT_L(0); PG8_MMA(1, 0, At, B0); PG8_BAR; PG8_SCHED;
            PG8_STAGE(PG8_SB(1, 1), b3 + hstepB, voffB);
            PG8_WAIT_V(6); PG8_BAR; PG8_MMA(1, 1, At, B1); PG8_BAR;
            }
        }
        if constexpr (ALIGN_EPI) { if (wr == 0) PG8_BAR; }
        E(acc, cur, wr, wc, fr, fq);
        if (!has_next) break;
#pragma unroll
        for (int a = 0; a < 2; ++a)
#pragma unroll
            for (int b = 0; b < 2; ++b)
#pragma unroll
                for (int m = 0; m < 4; ++m)
#pragma unroll
                    for (int n = 0; n < 2; ++n) acc[a][b][m][n] = (f32x4){0.f, 0.f, 0.f, 0.f};
        cur = nxt; cA = nA; cB = nB; ++ui;
        if constexpr (ALIGN_EPI) { if (wr == 1) PG8_BAR; }
    }
    PG8_WAIT_V(0);
    if constexpr (!ALIGN_EPI) { if (wr == 0) PG8_BAR; }
    PG8_BAR;
#undef PG8_UA
#undef PG8_UB
#undef PG8_SA
#undef PG8_SB
#undef PG8_STAGE
#undef PG8_LDA
#undef PG8_LDB
#undef PG8_MMA
#undef PG8_WAIT_V
#undef PG8_WAIT_L
#undef PG8_BAR
#undef PG8_SCHED
}
}

#define XB_TMO      128
#define XB_XCNT(j)  (256  + 64 * (j))
#define XB_XSUB(j)  (1280 + 64 * (j))
#define XB_XGEN(j)  (2304 + 64 * (j))
#define XB_TOP      3328
#define XB_TOPGEN   3392
#define XCD_BAR_WORDS 3456
#define XB_SPIN_CAP (1u << 18)

__device__ __forceinline__ unsigned xb_ld(unsigned* p)              { return __hip_atomic_load(p, __ATOMIC_RELAXED, __HIP_MEMORY_SCOPE_AGENT); }
__device__ __forceinline__ unsigned xb_add(unsigned* p, unsigned v) { return __hip_atomic_fetch_add(p, v, __ATOMIC_RELAXED, __HIP_MEMORY_SCOPE_AGENT); }
__device__ __forceinline__ unsigned xb_xcc_id() { return (unsigned)__builtin_amdgcn_s_getreg((3 << 11) | 20) & 0xFu; }
#define XB_SPIN(cond, bar) do { unsigned _sp = 0; while (cond) { __builtin_amdgcn_s_sleep(1); \
    if ((++_sp & 255u) == 0u) { if (xb_ld(&(bar)[XB_TMO])) break; if (_sp > XB_SPIN_CAP) { atomicAdd(&(bar)[XB_TMO], 1u); break; } } } } while (0)

struct XcdBarrier {
    unsigned* bar; unsigned x;
    volatile LAS unsigned* st;
};

__device__ __forceinline__ XcdBarrier xcd_barrier_post(unsigned* bar, volatile LAS unsigned* st) {
    XcdBarrier b; b.bar = bar; b.x = xb_xcc_id(); b.st = st;
    if (threadIdx.x == 0) (void)xb_add(&bar[XB_XCNT(b.x)], 1u);
    return b;
}
__device__ __forceinline__ void xcd_barrier_complete(unsigned* bar, unsigned x, unsigned& nloc, unsigned& nx) {
    const unsigned G = gridDim.x * gridDim.y * gridDim.z;
    unsigned sum, cnt, mine, sp = 0u;
    for (;;) {
        sum = 0u; cnt = 0u; mine = 0u;
#pragma unroll
        for (unsigned j = 0; j < 16; ++j) { const unsigned c = xb_ld(&bar[XB_XCNT(j)]); sum += c; cnt += (c > 0u) ? 1u : 0u; mine = (j == x) ? c : mine; }
        if (sum == G) break;
        __builtin_amdgcn_s_sleep(1);
        if ((++sp & 255u) == 0u) { if (xb_ld(&bar[XB_TMO])) break; if (sp > XB_SPIN_CAP) { atomicAdd(&bar[XB_TMO], 1u); break; } }
    }
    nloc = mine > 0u ? mine : 1u; nx = cnt > 0u ? cnt : 1u;
}

__device__ __forceinline__ void xcd_barrier(const XcdBarrier& b) {
    asm volatile("s_waitcnt vmcnt(0)" ::: "memory");
    __syncthreads();
    if (threadIdx.x == 0) {
        unsigned* bar = b.bar;
        __builtin_amdgcn_s_waitcnt(0);
        unsigned nloc = b.st[0], nx = b.st[1];
        if (nloc == 0u) { xcd_barrier_complete(bar, b.x, nloc, nx); b.st[0] = nloc; b.st[1] = nx; }
        const unsigned old = xb_add(&bar[XB_XSUB(b.x)], 1u);
        const unsigned gen = old / nloc;
        if (old + 1u == (gen + 1u) * nloc) {
            __builtin_amdgcn_fence(__ATOMIC_RELEASE, "agent");
            asm volatile("s_waitcnt vmcnt(0)" ::: "memory");
            const unsigned og = xb_add(&bar[XB_TOP], 1u);
            const unsigned tg = og / nx;
            if (og + 1u == (tg + 1u) * nx) xb_add(&bar[XB_TOPGEN], 1u);
            else XB_SPIN(xb_ld(&bar[XB_TOPGEN]) == tg, bar);
            __builtin_amdgcn_fence(__ATOMIC_ACQUIRE, "agent");
            xb_add(&bar[XB_XGEN(b.x)], 1u);
            asm volatile("s_waitcnt vmcnt(0)" ::: "memory");
        } else {
            XB_SPIN(xb_ld(&bar[XB_XGEN(b.x)]) == gen, bar);
            __builtin_amdgcn_fence(__ATOMIC_ACQUIRE, "agent");
            asm volatile("s_waitcnt vmcnt(0)" ::: "memory");
        }
    }
    __syncthreads();
}

constexpr size_t MiB = 1u << 20;
constexpr size_t WS_CTL = 0, CTL_ZERO_BYTES = 1 * MiB;
constexpr size_t WS_WIN = 1 * MiB;
constexpr size_t WS_WO = WS_WIN + (size_t)31 * 256 * 1024 * 2;
constexpr size_t WS_WOUT = WS_WO + (size_t)3 * 1024 * 512 * 2;
constexpr size_t WS_WPG = WS_WOUT + (size_t)1024 * 1024 * 2;
constexpr size_t WS_WPLE = WS_WPG + (size_t)1024 * 1024 * 2;
constexpr size_t WS_WGU = WS_WPLE + (size_t)1024 * 256 * 2;
constexpr size_t WS_WDN = WS_WGU + (size_t)16 * 1024 * 1024 * 2;
constexpr size_t WS_WEND = WS_WDN + (size_t)16 * 1024 * 512 * 2;
static_assert(WS_WEND <= 73 * MiB, "weights");
constexpr size_t WS_HN = 73 * MiB;
constexpr size_t WS_PB = WS_HN + (size_t)NTOK * DM * 2;
constexpr size_t WS_Z = WS_PB + (size_t)NTOK * PLE * 2;
constexpr size_t WS_ZEND = WS_Z + (size_t)NTOK * ZP * 2;
constexpr size_t WS_SLOC = WS_ZEND;
constexpr size_t WS_DTAB = WS_SLOC + (size_t)2048 * 8192 * 2;
constexpr size_t WS_ROUTE = WS_DTAB + (size_t)2048 * 64 * 4;
constexpr size_t WS_HIST = WS_ROUTE + (size_t)NTOK * 16;
constexpr size_t WS_TBL = WS_HIST + (size_t)GRID * 16 * 4;
constexpr size_t WS_TOKSLOT = WS_TBL + 256;
constexpr size_t WS_SLOTW = WS_TOKSLOT + (size_t)NTOK * 8;
constexpr size_t WS_END = WS_SLOTW + (size_t)NSLOT * 4;
constexpr size_t WS_HG = WS_Z;
constexpr size_t WS_ACT = WS_HG + (size_t)NSLOT * DM * 2;
constexpr size_t WS_PL = WS_ACT + (size_t)NSLOT * DEXP * 2;
static_assert(WS_PL + (size_t)NTOK * DM * 2 <= WS_ZEND, "MoE overlay fits inside Z");
constexpr int CW_BAR = 4096;
constexpr int CW_QHEAD = 8192, CW_KN = 8192 + 256;

constexpr int RING_BYTES = 131072;
constexpr int LDSCTL_OFF = RING_BYTES, MISC_OFF = LDSCTL_OFF + 320;
constexpr int LDS_BYTES = 147456;

__device__ __forceinline__ void tr_item(const float* W, int ldw, int col0, int K, bf16_t* WT, int nrows, int valid, LAS float* scr, int item, int lane) {
    const int nblk = nrows / 32, kb = item / nblk, nb = item % nblk, k0 = 64 * kb, n0 = 32 * nb;
    const bool ok = (n0 + (lane & 31)) < valid;
#pragma unroll 8
    for (int i = 0; i < 32; ++i) { const int kk = 2 * i + (lane >> 5); scr[kk * 33 + (lane & 31)] = ok ? W[(size_t)(k0 + kk) * ldw + col0 + n0 + (lane & 31)] : 0.f; }
    LDS_WAIT(); asm volatile("" ::: "memory");
    const int c = lane & 7;
#pragma unroll
    for (int j = 0; j < 4; ++j) { const int n = (lane >> 3) + 8 * j; const LAS float* s = scr + (8 * c) * 33 + n;
        u32x4 o; o.x = pk2(s[0 * 33], s[1 * 33]); o.y = pk2(s[2 * 33], s[3 * 33]); o.z = pk2(s[4 * 33], s[5 * 33]); o.w = pk2(s[6 * 33], s[7 * 33]);
        *(u32x4*)(WT + (size_t)(n0 + n) * K + k0 + 8 * c) = o; }
    LDS_WAIT(); asm volatile("" ::: "memory");
}
__device__ __forceinline__ int win_src_col(int t) {
    if (t < 4) return 256 * t;
    if (t < 8) return 2064 + 256 * (t - 4);
    if (t < 10) return 3088 + 256 * (t - 8);
    if (t < 12) return 4112 + 256 * (t - 10);
    if (t == 12) return 1536;
    if (t < 15) return 1024 + 256 * (t - 13);
    if (t < 17) return 1552 + 256 * (t - 15);
    if (t < 19) return 3600 + 256 * (t - 17);
    return 4624 + 256 * (t - 19);
}
template <int NR> __device__ __forceinline__ void rms_rows_bf16(const float* x, const float* g, bf16_t* o, int m0, int mstep, int lane) {
    f32x4 v[NR][4]; float s[NR];
#pragma unroll
    for (int q = 0; q < NR; ++q) { const f32x4* xr = (const f32x4*)(x + (size_t)(m0 + q * mstep) * DM) + lane;
#pragma unroll
        for (int j = 0; j < 4; ++j) v[q][j] = xr[64 * j]; }
    const f32x4* gr = (const f32x4*)g + lane; f32x4 gg[4];
#pragma unroll
    for (int j = 0; j < 4; ++j) gg[j] = gr[64 * j];
#pragma unroll
    for (int q = 0; q < NR; ++q) { s[q] = 0.f;
#pragma unroll
        for (int j = 0; j < 4; ++j) s[q] += (v[q][j].x * v[q][j].x + v[q][j].y * v[q][j].y) + (v[q][j].z * v[q][j].z + v[q][j].w * v[q][j].w); }
#pragma unroll
    for (int q = 0; q < NR; ++q) s[q] = wave_sum_dpp(s[q]);
#pragma unroll
    for (int q = 0; q < NR; ++q) { const float r = 1.0f / sqrtf(s[q] * (1.f / DM) + EPS); u32x2* o8 = (u32x2*)(o + (size_t)(m0 + q * mstep) * DM) + lane;
#pragma unroll
        for (int j = 0; j < 4; ++j) { u32x2 w; w.x = pk2(v[q][j].x * r * gg[j].x, v[q][j].y * r * gg[j].y); w.y = pk2(v[q][j].z * r * gg[j].z, v[q][j].w * r * gg[j].w); o8[64 * j] = w; } }
}

struct Ptrs { const float* in[24]; float* out; unsigned char* ws; };
struct Args { Ptrs p; int ph_lo, ph_hi; };
typedef const __attribute__((address_space(4))) Args* KA;

__device__ __forceinline__ void phaseA(KA P, int L, LAS unsigned char* lds, int vcu, int G, int wave, int lane, int tid) {
    LAS float* scr = (LAS float*)(lds + wave * 16384);
    const int gw = vcu * 8 + wave, NGW = G * 8;
    unsigned char* ws = P->p.ws;
    constexpr int I_WIN = 31 * 128, I_WO = 3 * 256, I_WOUT = 512, I_WPG = 512, I_WPLE = 128, I_WGU = 16 * 512, I_WDN = 16 * 256;
    constexpr int NITEMS = I_WIN + I_WO + I_WOUT + I_WPG + I_WPLE + I_WGU + I_WDN;
    for (int it = gw; it < NITEMS; it += NGW) {
        int r = it;
        if (r < I_WIN) { const int t = r / 128; tr_item(P->p.in[3] + (size_t)L * DM * INTOT, INTOT, win_src_col(t), DM, (bf16_t*)(ws + WS_WIN) + (size_t)t * 256 * DM, 256, t == 12 ? 16 : 256, scr, r % 128, lane); continue; } r -= I_WIN;
        if (r < I_WO) { const int j = r / 256; const float* src = (j == 0 ? P->p.in[7] : j == 1 ? P->p.in[10] : P->p.in[12]) + (size_t)L * 512 * DM;
            tr_item(src, DM, 0, 512, (bf16_t*)(ws + WS_WO) + (size_t)j * DM * 512, DM, DM, scr, r % 256, lane); continue; } r -= I_WO;
        if (r < I_WOUT) { tr_item(P->p.in[13] + (size_t)L * DM * DM, DM, 0, DM, (bf16_t*)(ws + WS_WOUT), DM, DM, scr, r, lane); continue; } r -= I_WOUT;
        if (r < I_WPG) { tr_item(P->p.in[22] + (size_t)L * DM * DM, DM, 0, DM, (bf16_t*)(ws + WS_WPG), DM, DM, scr, r, lane); continue; } r -= I_WPG;
        if (r < I_WPLE) { tr_item(P->p.in[21] + (size_t)L * PLE * DM, DM, 0, PLE, (bf16_t*)(ws + WS_WPLE), DM, DM, scr, r, lane); continue; } r -= I_WPLE;
        if (r < I_WGU) { const int e = r / 512, q = (r % 512) / 64, n = q >> 1, s = q & 1;
            tr_item(P->p.in[19] + (size_t)(L * NEXP + e) * DM * 1024, 1024, 512 * s + 128 * n, DM, (bf16_t*)(ws + WS_WGU) + (size_t)e * 1024 * DM + (size_t)(256 * n + 128 * s) * DM, 128, 128, scr, r % 64, lane); continue; } r -= I_WGU;
        { const int e = r / 256; tr_item(P->p.in[20] + (size_t)(L * NEXP + e) * DEXP * DM, DM, 0, DEXP, (bf16_t*)(ws + WS_WDN) + (size_t)e * DM * DEXP, DM, DM, scr, r % 256, lane); }
    }
    const float* xs = (L == 0) ? P->p.in[0] : P->p.out;
    for (int m = gw; m < NTOK; m += 4 * NGW) rms_rows_bf16<4>(xs, P->p.in[2] + (size_t)L * DM, (bf16_t*)(ws + WS_HN), m, NGW, lane);
    const f32x4* ps = (const f32x4*)(P->p.in[1] + (size_t)L * NTOK * PLE); u32x2* pd = (u32x2*)(ws + WS_PB);
    for (int i = vcu * 512 + tid; i < NTOK * PLE / 4; i += G * 512) { const f32x4 v = ps[i]; u32x2 w; w.x = pk2(v.x, v.y); w.y = pk2(v.z, v.w); pd[i] = w; }
}

__device__ __forceinline__ float logsig16(float x) { return (fminf(x, 0.f) - log1pf(expf(-fabsf(x)))) * (1.0f / 16.0f); }
__device__ __forceinline__ void gla1_unit(int unit, bf16_t* Z, const float* wa2, const float* ba, bf16_t* SLOCT, float* DTAB, LAS unsigned char* lds, int wid, int lane, int tid, int dry = 0) {
    const int bh = unit >> 8, c = unit & 255, b = bh >> 2, h = bh & 3; const size_t row0 = (size_t)b * T + (size_t)c * 64;
    LAS bf16_t* Qs = (LAS bf16_t*)lds; LAS bf16_t* Ks = (LAS bf16_t*)(lds + 8192); LAS bf16_t* KhT = (LAS bf16_t*)(lds + 16384); LAS bf16_t* VT = (LAS bf16_t*)(lds + 24576);
    LAS bf16_t* Am = (LAS bf16_t*)(lds + 40960); LAS float* WA = (LAS float*)(lds + 49152); LAS float* BA = (LAS float*)(lds + 53248);
    const int r32 = lane & 31, hi = lane >> 5;
    for (int i = tid; i < 1024; i += 512) WA[i] = wa2[(i >> 6) * 256 + h * 64 + (i & 63)];
    if (tid < 64) BA[tid] = ba[h * 64 + tid];
    __syncthreads();
    {
        const int t = lane, cb = wid * 8; const bf16_t* zr = Z + (row0 + t) * ZP;
        const u32x4 g0 = *(const u32x4*)(zr + C_GA), g1 = *(const u32x4*)(zr + C_GA + 8);
        float gaf[16]; gaf[0] = bflo(g0.x); gaf[1] = bfhi(g0.x); gaf[2] = bflo(g0.y); gaf[3] = bfhi(g0.y); gaf[4] = bflo(g0.z); gaf[5] = bfhi(g0.z); gaf[6] = bflo(g0.w); gaf[7] = bfhi(g0.w);
        gaf[8] = bflo(g1.x); gaf[9] = bfhi(g1.x); gaf[10] = bflo(g1.y); gaf[11] = bfhi(g1.y); gaf[12] = bflo(g1.z); gaf[13] = bfhi(g1.z); gaf[14] = bflo(g1.w); gaf[15] = bfhi(g1.w);
        float la[8];
#pragma unroll
        for (int i = 0; i < 8; ++i) { float x = BA[cb + i];
#pragma unroll
            for (int r = 0; r < 16; ++r) x = fmaf(gaf[r], WA[r * 64 + cb + i], x);
            la[i] = logsig16(x); }
#pragma unroll
        for (int off = 1; off < 64; off <<= 1) {
#pragma unroll
            for (int i = 0; i < 8; ++i) { const float y = __shfl_up(la[i], off); if (lane >= off) la[i] += y; } }
        const u32x4 qv = *(const u32x4*)(zr + C_GQ + h * 64 + cb), kv = *(const u32x4*)(zr + C_GK + h * 64 + cb);
        float qf[8], kf[8];
        qf[0] = bflo(qv.x); qf[1] = bfhi(qv.x); qf[2] = bflo(qv.y); qf[3] = bfhi(qv.y); qf[4] = bflo(qv.z); qf[5] = bfhi(qv.z); qf[6] = bflo(qv.w); qf[7] = bfhi(qv.w);
        kf[0] = bflo(kv.x); kf[1] = bfhi(kv.x); kf[2] = bflo(kv.y); kf[3] = bfhi(kv.y); kf[4] = bflo(kv.z); kf[5] = bfhi(kv.z); kf[6] = bflo(kv.w); kf[7] = bfhi(kv.w);
        float qs[8], ks[8];
#pragma unroll
        for (int i = 0; i < 8; ++i) { const float bl = __shfl(la[i], 63); const float eb = expf(la[i]);
            qs[i] = qf[i] * 0.125f * eb; ks[i] = kf[i] * expf(-la[i]);
            KhT[(cb + i) * 64 + t] = (bf16_t)f2bf(kf[i] * expf(bl - la[i]));
            if (lane == 63) DTAB[(size_t)unit * 64 + cb + i] = eb; }
        u32x4 qw, kw; qw.x = pk2(qs[0], qs[1]); qw.y = pk2(qs[2], qs[3]); qw.z = pk2(qs[4], qs[5]); qw.w = pk2(qs[6], qs[7]);
        kw.x = pk2(ks[0], ks[1]); kw.y = pk2(ks[2], ks[3]); kw.z = pk2(ks[4], ks[5]); kw.w = pk2(ks[6], ks[7]);
        *(LAS u32x4*)(Qs + t * 64 + cb) = qw; *(LAS u32x4*)(Ks + t * 64 + cb) = kw;
        if (!dry) *(u32x4*)(Z + (row0 + t) * ZP + C_GQ + h * 64 + cb) = qw;
        const u32x4 v0 = *(const u32x4*)(zr + C_GV + h * 128 + 16 * wid), v1 = *(const u32x4*)(zr + C_GV + h * 128 + 16 * wid + 8);
        LAS bf16_t* vt = VT + (16 * wid) * 64 + t;
        vt[0 * 64] = (bf16_t)(v0.x & 0xffff); vt[1 * 64] = (bf16_t)(v0.x >> 16); vt[2 * 64] = (bf16_t)(v0.y & 0xffff); vt[3 * 64] = (bf16_t)(v0.y >> 16);
        vt[4 * 64] = (bf16_t)(v0.z & 0xffff); vt[5 * 64] = (bf16_t)(v0.z >> 16); vt[6 * 64] = (bf16_t)(v0.w & 0xffff); vt[7 * 64] = (bf16_t)(v0.w >> 16);
        vt[8 * 64] = (bf16_t)(v1.x & 0xffff); vt[9 * 64] = (bf16_t)(v1.x >> 16); vt[10 * 64] = (bf16_t)(v1.y & 0xffff); vt[11 * 64] = (bf16_t)(v1.y >> 16);
        vt[12 * 64] = (bf16_t)(v1.z & 0xffff); vt[13 * 64] = (bf16_t)(v1.z >> 16); vt[14 * 64] = (bf16_t)(v1.w & 0xffff); vt[15 * 64] = (bf16_t)(v1.w >> 16);
    }
    __syncthreads();
    {
        const int vb = wid & 3, kb = wid >> 2; f32x16 acc = {};
#pragma unroll
        for (int ks = 0; ks < 4; ++ks) { const bf16x8 a = *(const LAS bf16x8*)(VT + (32 * vb + r32) * 64 + 16 * ks + 8 * hi); const bf16x8 bb = *(const LAS bf16x8*)(KhT + (32 * kb + r32) * 64 + 16 * ks + 8 * hi);
            acc = __builtin_amdgcn_mfma_f32_32x32x16_bf16(a, bb, acc, 0, 0, 0); }
        bf16_t* sp = SLOCT + (size_t)unit * 8192 + 32 * kb + r32;
#pragma unroll
        for (int r = 0; r < 16; ++r) sp[(32 * vb + crow(r, hi)) * 64] = (bf16_t)f2bf(acc[r]);
    }
    if (wid < 4) {
        const int sb = wid >> 1, tb = wid & 1; f32x16 acc = {};
        if (!(sb == 1 && tb == 0)) {
#pragma unroll
            for (int ks = 0; ks < 4; ++ks) { const bf16x8 a = *(const LAS bf16x8*)(Ks + (32 * sb + r32) * 64 + 16 * ks + 8 * hi); const bf16x8 bb = *(const LAS bf16x8*)(Qs + (32 * tb + r32) * 64 + 16 * ks + 8 * hi);
                acc = __builtin_amdgcn_mfma_f32_32x32x16_bf16(a, bb, acc, 0, 0, 0); }
        }
        const int t = 32 * tb + r32;
#pragma unroll
        for (int r = 0; r < 16; ++r) { const int s = 32 * sb + crow(r, hi); if (s > t) acc[r] = 0.f; }
#pragma unroll
        for (int g = 0; g < 4; ++g) { u32x2 w; w.x = pk2(acc[4 * g], acc[4 * g + 1]); w.y = pk2(acc[4 * g + 2], acc[4 * g + 3]); *(LAS u32x2*)(Am + t * 64 + 32 * sb + 8 * g + 4 * hi) = w; }
    }
    __syncthreads();
    {
        const int vb = wid & 3, tb = wid >> 2; f32x16 acc = {};
#pragma unroll
        for (int ks = 0; ks < 4; ++ks) { const bf16x8 a = *(const LAS bf16x8*)(Am + (32 * tb + r32) * 64 + 16 * ks + 8 * hi); const bf16x8 bb = *(const LAS bf16x8*)(VT + (32 * vb + r32) * 64 + 16 * ks + 8 * hi);
            acc = __builtin_amdgcn_mfma_f32_32x32x16_bf16(a, bb, acc, 0, 0, 0); }
        bf16_t* op = Z + (row0 + 32 * tb) * ZP + C_GV + h * 128 + 32 * vb + r32;
#pragma unroll
        for (int r = 0; r < 16; ++r) if (!dry) op[(size_t)crow(r, hi) * ZP] = (bf16_t)f2bf(acc[r]);
    }
    __syncthreads();
}

__device__ __forceinline__ void conv_ld_u(const bf16_t* Z, size_t row, int ch, float (&u)[8]) {
    const u32x4 a = *(const u32x4*)(Z + row * ZP + C_CX + ch), c = *(const u32x4*)(Z + row * ZP + C_CC + ch);
    u[0] = bflo(a.x) * bflo(c.x); u[1] = bfhi(a.x) * bfhi(c.x); u[2] = bflo(a.y) * bflo(c.y); u[3] = bfhi(a.y) * bfhi(c.y);
    u[4] = bflo(a.z) * bflo(c.z); u[5] = bfhi(a.z) * bfhi(c.z); u[6] = bflo(a.w) * bflo(c.w); u[7] = bfhi(a.w) * bfhi(c.w);
}
__device__ __forceinline__ void conv_unit(int cu, bf16_t* Z, const float* cw  , int wid, int lane, int dry = 0) {
    const int ch = lane * 8; const size_t r0 = (size_t)cu * 128 + (size_t)wid * 16;
    float w0[8], w1[8], w2[8];
#pragma unroll
    for (int i = 0; i < 8; ++i) { w0[i] = cw[ch + i]; w1[i] = cw[512 + ch + i]; w2[i] = cw[1024 + ch + i]; }
    float u2[8], u1[8];
    if ((r0 % T) == 0) {
#pragma unroll
        for (int i = 0; i < 8; ++i) { u2[i] = 0.f; u1[i] = 0.f; }
    } else { conv_ld_u(Z, r0 - 2, ch, u2); conv_ld_u(Z, r0 - 1, ch, u1); }
    for (int i = 0; i < 16; ++i) { const size_t row = r0 + i; float u[8]; conv_ld_u(Z, row, ch, u);
        const u32x4 bq = *(const u32x4*)(Z + row * ZP + C_CB + ch);
        float bb[8]; bb[0] = bflo(bq.x); bb[1] = bfhi(bq.x); bb[2] = bflo(bq.y); bb[3] = bfhi(bq.y); bb[4] = bflo(bq.z); bb[5] = bfhi(bq.z); bb[6] = bflo(bq.w); bb[7] = bfhi(bq.w);
        float y[8];
#pragma unroll
        for (int k = 0; k < 8; ++k) { y[k] = bb[k] * (w0[k] * u2[k] + w1[k] * u1[k] + w2[k] * u[k]); u2[k] = u1[k]; u1[k] = u[k]; }
        u32x4 o; o.x = pk2(y[0], y[1]); o.y = pk2(y[2], y[3]); o.z = pk2(y[4], y[5]); o.w = pk2(y[6], y[7]);
        if (!dry) *(u32x4*)(Z + row * ZP + C_OC + ch) = o; }
}

__device__ __forceinline__ void knorm_unit(int cu, const bf16_t* Z, unsigned* KN  , LAS unsigned char* lds, int wid, int lane, int tid) {
    const size_t r0 = (size_t)cu * 128 + (size_t)wid * 16; float mx = 0.f;
    for (int i = 0; i < 16; ++i) { const u32x4 a = *(const u32x4*)(Z + (r0 + i) * ZP + C_DK + lane * 8);
        const float f0 = bflo(a.x), f1 = bfhi(a.x), f2 = bflo(a.y), f3 = bfhi(a.y), f4 = bflo(a.z), f5 = bfhi(a.z), f6 = bflo(a.w), f7 = bfhi(a.w);
        float s = (f0 * f0 + f1 * f1) + (f2 * f2 + f3 * f3) + (f4 * f4 + f5 * f5) + (f6 * f6 + f7 * f7);
        s += __shfl_xor(s, 1); s += __shfl_xor(s, 2); s += __shfl_xor(s, 4);
        mx = fmaxf(mx, s); }
    mx = fmaxf(mx, __shfl_xor(mx, 8));
    LAS float* SC = (LAS float*)lds;
    if ((lane & 15) == 0) SC[wid * 4 + (lane >> 4)] = mx;
    __syncthreads();
    if (tid < 4) { float v = SC[tid];
#pragma unroll
        for (int w = 1; w < 8; ++w) v = fmaxf(v, SC[w * 4 + tid]);
        const int b = (int)(((size_t)cu * 128) / T);
        __hip_atomic_fetch_max(KN + b * 4 + tid, __float_as_uint(v), __ATOMIC_RELAXED, __HIP_MEMORY_SCOPE_AGENT); }
    __syncthreads();
}
namespace att {
constexpr int KVBLK = 64;
constexpr size_t SHM_V = 64 * 128 * 2, SHM_K = 64 * 128 * 2;
constexpr float C = 0.125f * 1.4426950408889634f;
constexpr float THR2 = 10.f;
constexpr float WTHR = 40.f;
#define KSWZ(row, colB) ((row) * 256 + ((colB) ^ (((row) & 7) << 4)))
#define SBAR() __builtin_amdgcn_sched_barrier(0)
__device__ __forceinline__ unsigned cvtpk(float lo, float hi) { unsigned r; asm volatile("v_cvt_pk_bf16_f32 %0, %1, %2" : "=v"(r) : "v"(lo), "v"(hi)); return r; }

__device__ __forceinline__ void partialSM(f32x16& p0, f32x16& p1, float& m_reg, float& alpha, float tc, float c32, bool band, int dlim) {
    if (band) {
#pragma unroll
        for (int r = 0; r < 16; ++r) { const int cr = (r & 3) + 8 * (r >> 2); if (cr > dlim) p0[r] = -1e30f; if (cr + 32 > dlim) p1[r] = -1e30f; }
    }
    float pm0 = p0[0], pm1 = p1[0];
#pragma unroll
    for (int r = 1; r < 16; ++r) { pm0 = fmaxf(pm0, p0[r]); pm1 = fmaxf(pm1, p1[r]); }
    float pmax = fmaxf(pm0, pm1 + c32) + tc;
    { auto rr = __builtin_amdgcn_permlane32_swap(__float_as_uint(pmax), __float_as_uint(pmax), false, false);
      pmax = fmaxf(__uint_as_float(rr[0]), __uint_as_float(rr[1])); }
    if (__builtin_expect(__all(pmax - m_reg <= THR2), 1)) { alpha = 1.f; }
    else { const float mn = fmaxf(m_reg, pmax); alpha = __builtin_amdgcn_exp2f(m_reg - mn); m_reg = mn; }
    const float s0 = m_reg - tc, s1 = s0 - c32;
#pragma unroll
    for (int r = 0; r < 16; ++r) { p0[r] -= s0; p1[r] -= s1; }
#pragma unroll
    for (int r = 0; r < 16; ++r) p0[r] = __builtin_amdgcn_exp2f(p0[r]);
}
__device__ __forceinline__ void finishSM(f32x16& p0, f32x16& p1, float alpha, float& l_reg, bf16x8& pa0, bf16x8& pa1, bf16x8& pa2, bf16x8& pa3) {
#pragma unroll
    for (int r = 0; r < 16; ++r) p1[r] = __builtin_amdgcn_exp2f(p1[r]);
    float ps = 0;
#pragma unroll
    for (int r = 0; r < 16; ++r) ps += p0[r];
#pragma unroll
    for (int r = 0; r < 16; ++r) ps += p1[r];
    { auto rr = __builtin_amdgcn_permlane32_swap(__float_as_uint(ps), __float_as_uint(ps), false, false);
      ps = __uint_as_float(rr[0]) + __uint_as_float(rr[1]); }
    l_reg = l_reg * alpha + ps;
#define PK4(P, BASE, OUT) do { unsigned a0 = cvtpk(P[BASE + 0], P[BASE + 1]), a1 = cvtpk(P[BASE + 2], P[BASE + 3]);   \
    unsigned b0 = cvtpk(P[BASE + 4], P[BASE + 5]), b1 = cvtpk(P[BASE + 6], P[BASE + 7]);                              \
    auto r0 = __builtin_amdgcn_permlane32_swap(a0, b0, false, false); auto r1 = __builtin_amdgcn_permlane32_swap(a1, b1, false, false); \
    u32x4 w = {r0[0], r1[0], r0[1], r1[1]}; OUT = *reinterpret_cast<bf16x8*>(&w); } while (0)
    PK4(p0, 0, pa0); PK4(p0, 8, pa1); PK4(p1, 0, pa2); PK4(p1, 8, pa3);
#undef PK4
}
__device__ __forceinline__ void qkt(f32x16& p0, f32x16& p1, const char* Ks, const bf16x8* qr, const f32x16& biasv, int r32, int hi, int m) {
#pragma unroll
    for (int d0 = 0; d0 < 4; ++d0) { const int cb = ((4 * m + d0) * 16 + hi * 8) * 2;
        const bf16x8 b0 = *reinterpret_cast<const bf16x8*>(Ks + KSWZ(r32, cb));
        const bf16x8 b1 = *reinterpret_cast<const bf16x8*>(Ks + KSWZ(32 + r32, cb));
        if (d0 == 0) { p0 = __builtin_amdgcn_mfma_f32_32x32x16_bf16(b0, qr[0], biasv, 0, 0, 0); p1 = __builtin_amdgcn_mfma_f32_32x32x16_bf16(b1, qr[0], biasv, 0, 0, 0); }
        else { p0 = __builtin_amdgcn_mfma_f32_32x32x16_bf16(b0, qr[d0], p0, 0, 0, 0); p1 = __builtin_amdgcn_mfma_f32_32x32x16_bf16(b1, qr[d0], p1, 0, 0, 0); } }
}
__device__ __forceinline__ int v_st(int k, int c) { const int kk = (k & ~0xC) | ((k & 4) << 1) | ((k & 8) >> 1); return ((kk >> 3) * 4 + (c >> 5)) * 512 + ((kk & 7) * 32 + (c & 31)) * 2; }
__device__ __forceinline__ int v_rd_base(int lane) { return ((lane & 3) << 3) | (((lane >> 2) & 3) << 6) | (((lane >> 4) & 1) << 5) | (((lane >> 5) & 1) << 8); }
constexpr int v_rd_off(int d0, int ks, int half) { return d0 * 512 + ks * 4096 + half * 2048; }
template <int OFF> __device__ __forceinline__ s16x4 tr_read(int vb) {
    s16x4 r; asm volatile("ds_read_b64_tr_b16 %0, %1 offset:%2" : "=&v"(r) : "v"(vb), "i"(OFF) : "memory"); return r;
}
template <int D0> __device__ __forceinline__ void pv_one(f32x16& od, int vb, bf16x8 pa0, bf16x8 pa1, bf16x8 pa2, bf16x8 pa3) {
    const s16x4 l0 = tr_read<v_rd_off(D0, 0, 0)>(vb), h0 = tr_read<v_rd_off(D0, 0, 1)>(vb), l1 = tr_read<v_rd_off(D0, 1, 0)>(vb), h1 = tr_read<v_rd_off(D0, 1, 1)>(vb);
    const s16x4 l2 = tr_read<v_rd_off(D0, 2, 0)>(vb), h2 = tr_read<v_rd_off(D0, 2, 1)>(vb), l3 = tr_read<v_rd_off(D0, 3, 0)>(vb), h3 = tr_read<v_rd_off(D0, 3, 1)>(vb);
    asm volatile("s_waitcnt lgkmcnt(0)" ::: "memory"); SBAR();
#define PK(L, H) (bf16x8){L[0], L[1], L[2], L[3], H[0], H[1], H[2], H[3]}
    od = __builtin_amdgcn_mfma_f32_32x32x16_bf16(pa0, PK(l0, h0), od, 0, 0, 0);
    od = __builtin_amdgcn_mfma_f32_32x32x16_bf16(pa1, PK(l1, h1), od, 0, 0, 0);
    od = __builtin_amdgcn_mfma_f32_32x32x16_bf16(pa2, PK(l2, h2), od, 0, 0, 0);
    od = __builtin_amdgcn_mfma_f32_32x32x16_bf16(pa3, PK(l3, h3), od, 0, 0, 0);
#undef PK
}
__device__ __forceinline__ void pv_d0(f32x16* o, int vb, bf16x8 pa0, bf16x8 pa1, bf16x8 pa2, bf16x8 pa3) {
    pv_one<0>(o[0], vb, pa0, pa1, pa2, pa3); pv_one<1>(o[1], vb, pa0, pa1, pa2, pa3); pv_one<2>(o[2], vb, pa0, pa1, pa2, pa3); pv_one<3>(o[3], vb, pa0, pa1, pa2, pa3);
}

__device__ __forceinline__ void unit(int b, int h, int qb, float lam, float oneml, float kn2, bf16_t* Z, const float* gdiff, char* lds, int dry = 0) {
    int tid_l = threadIdx.x; asm volatile("" : "+v"(tid_l)); const int tid = tid_l;
    const int wid = tid >> 6, lane = tid & 63, r32 = lane & 31, hi = lane >> 5, m = wid >> 2, rb = wid & 3;
    const size_t rowbase = (size_t)b * T; const int q0 = qb * 128;
    const float slope2 = exp2f(-2.f * (float)(h + 1)) * 1.4426950408889634f;
    char* V_lds = lds; char* K_lds = lds + 2 * SHM_V;
    float* wsf = (float*)(lds + 2 * SHM_V + 2 * SHM_K) + wid * 64; float* li_l = wsf; float* al_l = wsf + 32;
    float m_reg = -1e30f, l_reg = 0; f32x16 o[4] = {}; bf16x8 qr[4];
    const bf16_t* Qw = Z + (rowbase + q0 + rb * 32 + r32) * ZP + C_DQ + h * 128 + m * 64 + hi * 8;
    float qss = 0.f;
#pragma unroll
    for (int d0 = 0; d0 < 4; ++d0) { const u32x4 w = *reinterpret_cast<const u32x4*>(Qw + d0 * 16);
        const float f0 = bflo(w.x), f1 = bfhi(w.x), f2 = bflo(w.y), f3 = bfhi(w.y), f4 = bflo(w.z), f5 = bfhi(w.z), f6 = bflo(w.w), f7 = bfhi(w.w);
        qss += (f0 * f0 + f1 * f1) + (f2 * f2 + f3 * f3) + (f4 * f4 + f5 * f5) + (f6 * f6 + f7 * f7);
        u32x4 s; s.x = pk2(f0 * C, f1 * C); s.y = pk2(f2 * C, f3 * C); s.z = pk2(f4 * C, f5 * C); s.w = pk2(f6 * C, f7 * C); qr[d0] = __builtin_bit_cast(bf16x8, s); }
    { auto rr = __builtin_amdgcn_permlane32_swap(__float_as_uint(qss), __float_as_uint(qss), false, false); qss = __uint_as_float(rr[0]) + __uint_as_float(rr[1]); }
#pragma unroll
    for (int x = 1; x < 32; x <<= 1) qss = fmaxf(qss, __shfl_xor(qss, x));
    const bf16_t* Kh = Z + rowbase * ZP + C_DK + h * 128; const bf16_t* Vh = Z + rowbase * ZP + C_DV + h * 128;
    const int sr = tid >> 4, sc = (tid & 15) * 8, vst0 = v_st(sr, sc), vst1 = v_st(32 + sr, sc);
    const int vb0 = (int)(uintptr_t)V_lds + v_rd_base(lane);
    const int qrel = q0 + rb * 32 + r32;
    const float c32 = 32.f * slope2;
    f32x16 biasv;
#pragma unroll
    for (int r = 0; r < 16; ++r) biasv[r] = slope2 * (float)((r & 3) + 8 * (r >> 2));
    asm volatile("" : "+v"(biasv));
    struct { bf16x8 vs0, vs1, ks0, ks1; } sr_[1];
#define SLOAD(i, k0) do { sr_[i].vs0 = *reinterpret_cast<const bf16x8*>(&Vh[(size_t)((k0) + sr) * ZP + sc]); sr_[i].vs1 = *reinterpret_cast<const bf16x8*>(&Vh[(size_t)((k0) + 32 + sr) * ZP + sc]); \
    sr_[i].ks0 = *reinterpret_cast<const bf16x8*>(&Kh[(size_t)((k0) + sr) * ZP + sc]); sr_[i].ks1 = *reinterpret_cast<const bf16x8*>(&Kh[(size_t)((k0) + 32 + sr) * ZP + sc]); } while (0)
#define SWRITE(bb, i) do { *(bf16x8*)(V_lds + (bb) * SHM_V + vst0) = sr_[i].vs0;          \
    *(bf16x8*)(V_lds + (bb) * SHM_V + vst1) = sr_[i].vs1; const int kc = sc * 2;               \
    *(bf16x8*)(K_lds + (bb) * SHM_K + KSWZ(sr, kc)) = sr_[i].ks0;                       \
    *(bf16x8*)(K_lds + (bb) * SHM_K + KSWZ(32 + sr, kc)) = sr_[i].ks1; } while (0)
    const int NT = 2 * (qb + 1);
    float mband;
    { SLOAD(0, (NT - 2) * KVBLK); asm volatile("s_waitcnt vmcnt(0)" ::: "memory"); SWRITE(0, 0); SLOAD(0, (NT - 1) * KVBLK); asm volatile("s_waitcnt vmcnt(0)" ::: "memory"); SWRITE(1, 0);
      if (lane == 0) wsf[0] = qss; asm volatile("s_waitcnt lgkmcnt(0)" ::: "memory"); __syncthreads();
      f32x16 t0, t1; float mx = -1e30f;
#pragma unroll
      for (int bt = 0; bt < 2; ++bt) { const int j = NT - 2 + bt; qkt(t0, t1, K_lds + bt * SHM_K, qr, biasv, r32, hi, m); const int dlim = qrel - 64 * j - 4 * hi;
#pragma unroll
          for (int r = 0; r < 16; ++r) { const int cr = (r & 3) + 8 * (r >> 2); if (cr > dlim) t0[r] = -1e30f; if (cr + 32 > dlim) t1[r] = -1e30f; }
          float a0 = t0[0], a1 = t1[0];
#pragma unroll
          for (int r = 1; r < 16; ++r) { a0 = fmaxf(a0, t0[r]); a1 = fmaxf(a1, t1[r]); }
          mx = fmaxf(mx, fmaxf(a0, a1 + c32) + slope2 * (float)(64 * j + 4 * hi - qrel)); }
      { auto rr = __builtin_amdgcn_permlane32_swap(__float_as_uint(mx), __float_as_uint(mx), false, false); mx = fmaxf(__uint_as_float(rr[0]), __uint_as_float(rr[1])); }
#pragma unroll
      for (int x = 1; x < 32; x <<= 1) mx = fminf(mx, __shfl_xor(mx, x));
      mband = mx; }
    float qn2 = 0.f;
#pragma unroll
    for (int w = 0; w < 8; ++w) qn2 = fmaxf(qn2, ((float*)(lds + 2 * SHM_V + 2 * SHM_K))[w * 64]);
    __syncthreads();
    if (lane == 0) wsf[0] = mband; asm volatile("s_waitcnt lgkmcnt(0)" ::: "memory"); __syncthreads();
    float mbmin = 1e30f;
#pragma unroll
    for (int w = 0; w < 8; ++w) mbmin = fminf(mbmin, ((float*)(lds + 2 * SHM_V + 2 * SHM_K))[w * 64]);
    const float wd = (WTHR + 1.02f * sqrtf(qn2) * sqrtf(kn2) * C - mbmin) / slope2;
    int jlo = (int)floorf(((float)(q0 - 63) - wd) * (1.f / 64.f)); jlo = jlo < 0 ? 0 : (jlo & ~1);
    jlo = __builtin_amdgcn_readfirstlane(jlo);
    __syncthreads();
#define SWAIT() asm volatile("s_waitcnt vmcnt(0)" ::: "memory")
#define RESC(a) do { if (__any((a) < 1.f)) { if (hi == 0) al_l[r32] = (a); asm volatile("s_waitcnt lgkmcnt(0)" ::: "memory"); \
    _Pragma("unroll") for (int d = 0; d < 4; ++d) _Pragma("unroll") for (int r = 0; r < 16; ++r) o[d][r] *= al_l[crow(r, hi)]; } } while (0)
#define PSM(P0, P1, AL, j) partialSM(P0, P1, m_reg, AL, slope2 * (float)(64 * (j) + 4 * hi - qrel), c32, (j) >= NT - 2, qrel - 64 * (j) - 4 * hi)
    f32x16 pA0, pA1, pB0, pB1; float alA, alB; bf16x8 pa0, pa1, pa2, pa3;
    constexpr int SE = 0, SO = 0;
    SLOAD(SE, jlo * KVBLK); asm volatile("s_waitcnt vmcnt(0)" ::: "memory"); SWRITE(0, SE); __syncthreads();
    qkt(pA0, pA1, K_lds, qr, biasv, r32, hi, m); PSM(pA0, pA1, alA, jlo);
    SLOAD(SO, (jlo + 1) * KVBLK);
    SWAIT(); SWRITE(1, SO); __syncthreads();
    for (int j = jlo + 1; j + 1 < NT; j += 2) {
        SBAR(); qkt(pB0, pB1, K_lds + SHM_K, qr, biasv, r32, hi, m);
        finishSM(pA0, pA1, alA, l_reg, pa0, pa1, pa2, pa3); SBAR();
        SLOAD(SO, (j + 1) * KVBLK); SBAR();
        pv_d0(o, vb0, pa0, pa1, pa2, pa3); PSM(pB0, pB1, alB, j);
        __syncthreads(); SWAIT(); SWRITE(0, SE);
        RESC(alB); __syncthreads();
        SBAR(); qkt(pA0, pA1, K_lds, qr, biasv, r32, hi, m);
        finishSM(pB0, pB1, alB, l_reg, pa0, pa1, pa2, pa3); SBAR();
        SLOAD(SE, (j + 2) * KVBLK); SBAR();
        pv_d0(o, vb0 + (int)SHM_V, pa0, pa1, pa2, pa3); PSM(pA0, pA1, alA, j + 1);
        __syncthreads(); SWAIT(); SWRITE(1, SO);
        RESC(alA); __syncthreads();
    }
    SBAR(); qkt(pB0, pB1, K_lds + SHM_K, qr, biasv, r32, hi, m);
    finishSM(pA0, pA1, alA, l_reg, pa0, pa1, pa2, pa3); SBAR();
    pv_d0(o, vb0, pa0, pa1, pa2, pa3); PSM(pB0, pB1, alB, NT - 1);
    __syncthreads(); RESC(alB);
    finishSM(pB0, pB1, alB, l_reg, pa0, pa1, pa2, pa3); SBAR();
    pv_d0(o, vb0 + (int)SHM_V, pa0, pa1, pa2, pa3);
    if (hi == 0) li_l[r32] = l_reg; asm volatile("s_waitcnt lgkmcnt(0)" ::: "memory");
    float rli[16];
#pragma unroll
    for (int r = 0; r < 16; ++r) rli[r] = __builtin_amdgcn_rcpf(li_l[crow(r, hi)]);
    __syncthreads();
    float* XO = (float*)lds + rb * 4096;
    if (m == 1) {
#pragma unroll
        for (int d0 = 0; d0 < 4; ++d0)
#pragma unroll
            for (int r = 0; r < 16; ++r) XO[(d0 * 16 + r) * 64 + lane] = o[d0][r] * rli[r];
    }
    __syncthreads();
    if (m == 0) {
        float ss[16];
#pragma unroll
        for (int r = 0; r < 16; ++r) ss[r] = 0.f;
#pragma unroll
        for (int d0 = 0; d0 < 4; ++d0)
#pragma unroll
            for (int r = 0; r < 16; ++r) { const float v = o[d0][r] * rli[r] - lam * XO[(d0 * 16 + r) * 64 + lane]; o[d0][r] = v; ss[r] += v * v; }
#pragma unroll
        for (int r = 0; r < 16; ++r) {
#pragma unroll
            for (int x = 1; x < 32; x <<= 1) ss[r] += __shfl_xor(ss[r], x);
            ss[r] = oneml / sqrtf(ss[r] * (1.f / 128.f) + EPS); }
        bf16_t* Ow = Z + (rowbase + q0 + rb * 32) * ZP + C_OB + h * 128 + r32;
#pragma unroll
        for (int d0 = 0; d0 < 4; ++d0) { const float gc = gdiff[32 * d0 + r32];
#pragma unroll
            for (int r = 0; r < 16; ++r) if (!dry) Ow[(size_t)crow(r, hi) * ZP + 32 * d0] = (bf16_t)f2bf(o[d0][r] * ss[r] * gc); }
    }
    __syncthreads();
#undef SLOAD
#undef SWRITE
#undef SWAIT
#undef RESC
#undef PSM
}
#undef KSWZ
#undef SBAR
}

__device__ __forceinline__ void gla_scan(bf16_t* SLOCT, const float* DTAB, LAS unsigned char* lds, int G, int bx, int tid) {
    const int seg = tid >> 5, pl = tid & 31; LAS f32x4* PR = (LAS f32x4*)lds;
    for (int grp = bx; grp < 1024; grp += G) {
        const int pi = grp * 32 + pl, bh = pi >> 12, e2 = (pi & 4095) * 2, dk = e2 & 63;
        unsigned* sp = (unsigned*)(SLOCT + (size_t)bh * 256 * 8192 + e2) + (size_t)(seg * 16) * 4096; const float* dp = DTAB + (size_t)bh * 256 * 64 + dk + (size_t)(seg * 16) * 64;
        unsigned u[16]; f32x2 d[16];
#pragma unroll
        for (int i = 0; i < 16; ++i) { u[i] = sp[(size_t)i * 4096]; d[i] = *(const f32x2*)(dp + (size_t)i * 64); }
        float r0 = 0.f, r1 = 0.f, P0 = 1.f, P1 = 1.f;
#pragma unroll
        for (int i = 0; i < 16; ++i) { r0 = fmaf(d[i].x, r0, bflo(u[i])); r1 = fmaf(d[i].y, r1, bfhi(u[i])); P0 *= d[i].x; P1 *= d[i].y; }
        PR[seg * 32 + pl] = (f32x4){P0, P1, r0, r1};
        __syncthreads();
        float i0 = 0.f, i1 = 0.f;
        for (int s = 0; s < seg; ++s) { const f32x4 q = PR[s * 32 + pl]; i0 = fmaf(q.x, i0, q.z); i1 = fmaf(q.y, i1, q.w); }
#pragma unroll
        for (int i = 0; i < 16; ++i) { sp[(size_t)i * 4096] = pk2(i0, i1); i0 = fmaf(d[i].x, i0, bflo(u[i])); i1 = fmaf(d[i].y, i1, bfhi(u[i])); }
        __syncthreads();
    }
}

__device__ __forceinline__ void gla3_unit(int unit, bf16_t* Z, const bf16_t* SLOCT, const float* ggn, LAS unsigned char* lds, int wid, int lane, int dry = 0) {
    const int bh = unit >> 8, c = unit & 255, b = bh >> 2, h = bh & 3; const size_t row0 = (size_t)b * T + (size_t)c * 64;
    const int r32 = lane & 31, hi = lane >> 5, vb = wid & 3, tb = wid >> 2;
    LAS float* SS = (LAS float*)lds;
    f32x16 acc = {};
#pragma unroll
    for (int ks = 0; ks < 4; ++ks) { const bf16x8 a = *(const bf16x8*)(Z + (row0 + 32 * tb + r32) * ZP + C_GQ + h * 64 + 16 * ks + 8 * hi);
        const bf16x8 bb = *(const bf16x8*)(SLOCT + (size_t)unit * 8192 + (32 * vb + r32) * 64 + 16 * ks + 8 * hi);
        acc = __builtin_amdgcn_mfma_f32_32x32x16_bf16(a, bb, acc, 0, 0, 0); }
    const bf16_t* oi = Z + (row0 + 32 * tb) * ZP + C_GV + h * 128 + 32 * vb + r32;
    float o[16], ss[16];
#pragma unroll
    for (int r = 0; r < 16; ++r) { o[r] = acc[r] + bf2f(oi[(size_t)crow(r, hi) * ZP]); ss[r] = o[r] * o[r]; }
#pragma unroll
    for (int r = 0; r < 16; ++r) {
#pragma unroll
        for (int x = 1; x < 32; x <<= 1) ss[r] += __shfl_xor(ss[r], x);
        if (r32 == 0) SS[wid * 32 + crow(r, hi)] = ss[r]; }
    __syncthreads();
    const float gcol = ggn[32 * vb + r32];
    bf16_t* gp = Z + (row0 + 32 * tb) * ZP + C_GG + h * 128 + 32 * vb + r32;
#pragma unroll
    for (int r = 0; r < 16; ++r) { const int tr = crow(r, hi);
        const float tot = (SS[(tb * 4 + 0) * 32 + tr] + SS[(tb * 4 + 1) * 32 + tr]) + (SS[(tb * 4 + 2) * 32 + tr] + SS[(tb * 4 + 3) * 32 + tr]);
        const float rstd = 1.0f / sqrtf(tot * (1.f / 128.f) + EPS);
        const float gg = bf2f(gp[(size_t)tr * ZP]);
        if (!dry) gp[(size_t)tr * ZP] = (bf16_t)f2bf(o[r] * rstd * gcol * siluf_(gg)); }
    __syncthreads();
}
namespace pg8 {
struct EpiMerge {
    static constexpr bool PERM = true;
    bf16_t* Z; int dry;
    __device__ __forceinline__ void operator()(const f32x4 (&acc)[2][2][4][2], const Unit& u, int wr, int wc, int fr, int fq) const {
        const int j = u.tag; const int row0 = u.pm * BM + wr * 64 + fr; const int col0 = u.pn * BM + wc * 32 + 8 * fq;
#pragma unroll
        for (int ai = 0; ai < 2; ++ai)
#pragma unroll
            for (int m = 0; m < 4; ++m) { bf16_t* rowp = Z + (size_t)(row0 + ai * HALF + m * 16) * ZP + col0;
#pragma unroll
                for (int bj = 0; bj < 2; ++bj) { const f32x4 v0 = acc[ai][bj][m][0], v1 = acc[ai][bj][m][1];
                    const u32x4 y = *(const u32x4*)(rowp + bj * HALF + 1024 * j);
                    u32x4 pv = {0u, 0u, 0u, 0u}; if (j > 0) pv = *(const u32x4*)(rowp + bj * HALF);
                    u32x4 w;
                    w.x = pk2(fmaf(sigmoidf_(v0[0]), bflo(y.x), bflo(pv.x)), fmaf(sigmoidf_(v0[1]), bfhi(y.x), bfhi(pv.x)));
                    w.y = pk2(fmaf(sigmoidf_(v0[2]), bflo(y.y), bflo(pv.y)), fmaf(sigmoidf_(v0[3]), bfhi(y.y), bfhi(pv.y)));
                    w.z = pk2(fmaf(sigmoidf_(v1[0]), bflo(y.z), bflo(pv.z)), fmaf(sigmoidf_(v1[1]), bfhi(y.z), bfhi(pv.z)));
                    w.w = pk2(fmaf(sigmoidf_(v1[2]), bflo(y.w), bflo(pv.w)), fmaf(sigmoidf_(v1[3]), bfhi(y.w), bfhi(pv.w)));
                    if (!dry) *(u32x4*)(rowp + bj * HALF) = w; }
                asm volatile("" ::: "memory"); }
    }
};
struct EpiRes {
    static constexpr bool PERM = false;
    const float* base; float* out; int dry;
    __device__ __forceinline__ void operator()(const f32x4 (&acc)[2][2][4][2], const Unit& u, int wr, int wc, int fr, int fq) const {
        const int row0 = u.pm * BM + wr * 64 + fr; const int col0 = u.pn * BM + wc * 32 + 4 * fq;
#pragma unroll
        for (int ai = 0; ai < 2; ++ai)
#pragma unroll
            for (int m = 0; m < 4; ++m) { const size_t off = (size_t)(row0 + ai * HALF + m * 16) * DM + col0;
#pragma unroll
                for (int bj = 0; bj < 2; ++bj)
#pragma unroll
                    for (int n = 0; n < 2; ++n) { const f32x4 bs = *(const f32x4*)(base + off + bj * HALF + n * 16); if (!dry) *(f32x4*)(out + off + bj * HALF + n * 16) = bs + acc[ai][bj][m][n]; } }
    }
};
struct EpiPle {
    static constexpr bool PERM = false;
    const float* base; float* out; const bf16_t* PL; int dry;
    __device__ __forceinline__ void operator()(const f32x4 (&acc)[2][2][4][2], const Unit& u, int wr, int wc, int fr, int fq) const {
        const int row0 = u.pm * BM + wr * 64 + fr; const int col0 = u.pn * BM + wc * 32 + 4 * fq;
#pragma unroll
        for (int ai = 0; ai < 2; ++ai)
#pragma unroll
            for (int m = 0; m < 4; ++m) { const size_t off = (size_t)(row0 + ai * HALF + m * 16) * DM + col0;
#pragma unroll
                for (int bj = 0; bj < 2; ++bj)
#pragma unroll
                    for (int n = 0; n < 2; ++n) { const f32x4 bs = *(const f32x4*)(base + off + bj * HALF + n * 16); const u32x2 pl = *(const u32x2*)(PL + off + bj * HALF + n * 16); const f32x4 a = acc[ai][bj][m][n];
                        f32x4 o; o.x = fmaf(sigmoidf_(a.x), bflo(pl.x), bs.x); o.y = fmaf(sigmoidf_(a.y), bfhi(pl.x), bs.y); o.z = fmaf(sigmoidf_(a.z), bflo(pl.y), bs.z); o.w = fmaf(sigmoidf_(a.w), bfhi(pl.y), bs.w);
                        if (!dry) *(f32x4*)(out + off + bj * HALF + n * 16) = o; } }
    }
};
struct EpiUp {
    static constexpr bool PERM = true;
    bf16_t* ACT;
    __device__ __forceinline__ void operator()(const f32x4 (&acc)[2][2][4][2], const Unit& u, int wr, int wc, int fr, int fq) const {
        const int row0 = u.pm * BM + wr * 64 + fr; const int col0 = u.pn * HALF + wc * 32 + 8 * fq;
#pragma unroll
        for (int ai = 0; ai < 2; ++ai)
#pragma unroll
            for (int m = 0; m < 4; ++m) { const f32x4 g0 = acc[ai][0][m][0], g1 = acc[ai][0][m][1], u0 = acc[ai][1][m][0], u1 = acc[ai][1][m][1];
                u32x4 w; w.x = pk2(siluf_(g0[0]) * u0[0], siluf_(g0[1]) * u0[1]); w.y = pk2(siluf_(g0[2]) * u0[2], siluf_(g0[3]) * u0[3]);
                w.z = pk2(siluf_(g1[0]) * u1[0], siluf_(g1[1]) * u1[1]); w.w = pk2(siluf_(g1[2]) * u1[2], siluf_(g1[3]) * u1[3]);
                *(u32x4*)(ACT + (size_t)(row0 + ai * HALF + m * 16) * DEXP + col0) = w; }
    }
};
struct EpiDown {
    static constexpr bool PERM = true;
    bf16_t* Y; const float* sw;
    __device__ __forceinline__ void operator()(const f32x4 (&acc)[2][2][4][2], const Unit& u, int wr, int wc, int fr, int fq) const {
        const int row0 = u.pm * BM + wr * 64 + fr; const int col0 = u.pn * BM + wc * 32 + 8 * fq;
#pragma unroll
        for (int ai = 0; ai < 2; ++ai)
#pragma unroll
            for (int m = 0; m < 4; ++m) { const int row = row0 + ai * HALF + m * 16; const float s = sw[row]; bf16_t* rowp = Y + (size_t)row * DM + col0;
#pragma unroll
                for (int bj = 0; bj < 2; ++bj) { const f32x4 v0 = acc[ai][bj][m][0] * s, v1 = acc[ai][bj][m][1] * s;
                    u32x4 w; w.x = pk2(v0[0], v0[1]); w.y = pk2(v0[2], v0[3]); w.z = pk2(v1[0], v1[1]); w.w = pk2(v1[2], v1[3]);
                    *(u32x4*)(rowp + bj * HALF) = w; } }
    }
};
struct MergeOrder {
    int c, G; int abase, astep; size_t bbase, bstep;
    __device__ bool next(int i, Unit& u) const { const int pair = (i / 3) * G + c, j = i % 3; if (pair >= 512) return false;
        u.pm = pair >> 2; u.pn = pair & 3; u.tag = j; u.aoff = abase + j * astep; u.boff = bbase + (size_t)j * bstep; return true; }
};
struct GroupOrder {
    const int* tbl;
    int c, G; size_t bstride;
    __device__ bool next(int i, Unit& u) const {
        int L = i * G + c; int found = 0, pm = 0, pn = 0, ee = 0;
#pragma unroll
        for (int e = 0; e < NEXP; ++e) { const int nt_e = (tbl[16 + e] + 255) >> 8, nu = nt_e * 4;
            if (!found && L < nu) { found = 1; pm = (tbl[e] >> 8) + (L >> 2); pn = L & 3; ee = e; }
            if (!found) L -= nu; }
        if (!found) return false;
        u.pm = pm; u.pn = pn; u.tag = ee; u.aoff = 0; u.boff = (size_t)ee * bstride; return true; }
};
}

__device__ __forceinline__ void phaseF(KA P, int L, LAS unsigned char* lds, int wave, int lane, int tid) {
    LAS float* WR = (LAS float*)lds; LAS int* E0 = (LAS int*)(lds + 81920); LAS int* E1 = (LAS int*)(lds + 82432); LAS float* W0 = (LAS float*)(lds + 82944); LAS float* W1 = (LAS float*)(lds + 83456);
    const float* wrg = P->p.in[15] + (size_t)L * DM * 4; const float* wre = P->p.in[17] + (size_t)L * DM * 16;
    for (int i = tid; i < DM * 4; i += 512) WR[(i & 3) * 1024 + (i >> 2)] = wrg[i];
    for (int i = tid; i < DM * 16; i += 512) WR[(4 + (i & 15)) * 1024 + (i >> 4)] = wre[i];
    __syncthreads();
    const float* brg = P->p.in[16] + L * 4; const float* bre = P->p.in[18] + L * 16; const float* g = P->p.in[14] + (size_t)L * DM;
    const int tok0 = blockIdx.x * TPW;
    int* RE0 = (int*)(P->p.ws + WS_ROUTE); int* RE1 = RE0 + NTOK; float* RW0 = (float*)(RE1 + NTOK); float* RW1 = RW0 + NTOK;
    const f32x4* gr = (const f32x4*)g + lane; f32x4 gg[4];
#pragma unroll
    for (int j = 0; j < 4; ++j) gg[j] = gr[64 * j];
    float brg_[4], bre_[16];
#pragma unroll
    for (int q = 0; q < 4; ++q) brg_[q] = brg[q];
#pragma unroll
    for (int q = 0; q < 16; ++q) bre_[q] = bre[q];
    constexpr int NRB = 2;
    for (int i0 = wave * 16; i0 < wave * 16 + 16; i0 += NRB) {
        f32x4 v[NRB][4]; float s[NRB];
#pragma unroll
        for (int q = 0; q < NRB; ++q) { const f32x4* xr = (const f32x4*)(P->p.out + (size_t)(tok0 + i0 + q) * DM) + lane;
#pragma unroll
            for (int j = 0; j < 4; ++j) v[q][j] = xr[64 * j]; }
#pragma unroll
        for (int q = 0; q < NRB; ++q) { s[q] = 0.f;
#pragma unroll
            for (int j = 0; j < 4; ++j) s[q] += (v[q][j].x * v[q][j].x + v[q][j].y * v[q][j].y) + (v[q][j].z * v[q][j].z + v[q][j].w * v[q][j].w); }
#pragma unroll
        for (int q = 0; q < NRB; ++q) { const float r = 1.0f / sqrtf(wave_sum_dpp(s[q]) * (1.f / DM) + EPS);
            u32x2* o8 = (u32x2*)((bf16_t*)(P->p.ws + WS_HN) + (size_t)(tok0 + i0 + q) * DM) + lane;
#pragma unroll
            for (int j = 0; j < 4; ++j) { v[q][j].x *= r * gg[j].x; v[q][j].y *= r * gg[j].y; v[q][j].z *= r * gg[j].z; v[q][j].w *= r * gg[j].w;
                u32x2 w; w.x = pk2(v[q][j].x, v[q][j].y); w.y = pk2(v[q][j].z, v[q][j].w); o8[64 * j] = w; } }
        float lg[NRB][20];
#pragma unroll
        for (int o = 0; o < 20; ++o) { f32x4 w[4];
#pragma unroll
            for (int j = 0; j < 4; ++j) w[j] = *(const LAS f32x4*)(WR + o * 1024 + 256 * j + 4 * lane);
#pragma unroll
            for (int q = 0; q < NRB; ++q) { float a = 0.f;
#pragma unroll
                for (int j = 0; j < 4; ++j) a += (v[q][j].x * w[j].x + v[q][j].y * w[j].y) + (v[q][j].z * w[j].z + v[q][j].w * w[j].w);
                lg[q][o] = wave_sum_hi(a); }
            __builtin_amdgcn_sched_barrier(0); }
#pragma unroll
        for (int qq = 0; qq < NRB; ++qq) {
            const int i = i0 + qq, tok = tok0 + i;
            float gl[4];
#pragma unroll
            for (int q = 0; q < 4; ++q) gl[q] = lg[qq][q] + brg_[q];
            int gi = 0; float gm = gl[0];
#pragma unroll
            for (int q = 1; q < 4; ++q) if (gl[q] > gm) { gm = gl[q]; gi = q; }
            float den = 0.f;
#pragma unroll
            for (int q = 0; q < 4; ++q) den += expf(gl[q] - gm);
            const float gp = 1.0f / den;
            float wv[4];
#pragma unroll
            for (int q = 0; q < 4; ++q) { const float e0v = lg[qq][4 + q] + bre_[q], e1v = lg[qq][8 + q] + bre_[4 + q], e2v = lg[qq][12 + q] + bre_[8 + q], e3v = lg[qq][16 + q] + bre_[12 + q];
                wv[q] = gi == 0 ? e0v : gi == 1 ? e1v : gi == 2 ? e2v : e3v; }
            int i1s = 0; float m0 = wv[0];
#pragma unroll
            for (int q = 1; q < 4; ++q) if (wv[q] > m0) { m0 = wv[q]; i1s = q; }
            int i2s = -1; float m1 = 0.f;
#pragma unroll
            for (int q = 0; q < 4; ++q) if (q != i1s && (i2s < 0 || wv[q] > m1)) { m1 = wv[q]; i2s = q; }
            const float t = expf(m1 - m0); const float w0 = gp / (1.f + t), w1 = gp * t / (1.f + t);
            if (lane == 63) { const int e0 = gi * 4 + i1s, e1 = gi * 4 + i2s; E0[i] = e0; E1[i] = e1; W0[i] = w0; W1[i] = w1; RE0[tok] = e0; RE1[tok] = e1; RW0[tok] = w0; RW1[tok] = w1; } }
    }
    __syncthreads();
    if (tid < 16) { int cnt = 0; for (int i = 0; i < TPW; ++i) cnt += (E0[i] == tid) + (E1[i] == tid); ((int*)(P->p.ws + WS_HIST))[blockIdx.x * 16 + tid] = cnt; }
    __syncthreads();
}

__device__ __forceinline__ void phaseG(KA P, LAS unsigned char* lds, int wave, int lane, int tid) {
    LAS int* E0 = (LAS int*)lds; LAS int* E1 = (LAS int*)(lds + 512); LAS int* S0 = (LAS int*)(lds + 1024); LAS int* S1 = (LAS int*)(lds + 1536);
    LAS int* TOT = (LAS int*)(lds + 2048); LAS int* PRE = (LAS int*)(lds + 2112); LAS int* EB = (LAS int*)(lds + 2176);
    const int* HIST = (const int*)(P->p.ws + WS_HIST); const int tok0 = blockIdx.x * TPW;
    const int* RE0 = (const int*)(P->p.ws + WS_ROUTE); const int* RE1 = RE0 + NTOK; const float* RW0 = (const float*)(RE1 + NTOK); const float* RW1 = RW0 + NTOK;
    LAS int* PT = (LAS int*)(lds + 4096); LAS int* PP = (LAS int*)(lds + 4096 + 2048);
    { const int e = tid & 15, part = tid >> 4; int tot = 0, pre = 0;
#pragma unroll
      for (int k = 0; k < 8; ++k) { const int w = part * 8 + k; const int hv = HIST[w * 16 + e]; tot += hv; if (w < (int)blockIdx.x) pre += hv; }
      PT[part * 16 + e] = tot; PP[part * 16 + e] = pre; }
    if (tid < TPW) { E0[tid] = RE0[tok0 + tid]; E1[tid] = RE1[tok0 + tid]; }
    __syncthreads();
    if (tid < 16) { int tot = 0, pre = 0; for (int q = 0; q < 32; ++q) { tot += PT[q * 16 + tid]; pre += PP[q * 16 + tid]; } TOT[tid] = tot; PRE[tid] = pre; }
    __syncthreads();
    if (tid == 0) { int eb = 0; for (int e = 0; e < NEXP; ++e) { EB[e] = eb; eb += (TOT[e] + 255) & ~255; }
        if (blockIdx.x == 0) { int* tbl = (int*)(P->p.ws + WS_TBL); for (int e = 0; e < NEXP; ++e) { tbl[e] = EB[e]; tbl[16 + e] = TOT[e]; } } }
    __syncthreads();
    if (tid < 16) { int run = EB[tid] + PRE[tid]; for (int i = 0; i < TPW; ++i) { if (E0[i] == tid) S0[i] = run++; if (E1[i] == tid) S1[i] = run++; } }
    __syncthreads();
    const bf16_t* H2 = (const bf16_t*)(P->p.ws + WS_HN); bf16_t* HG = (bf16_t*)(P->p.ws + WS_HG); float* SW = (float*)(P->p.ws + WS_SLOTW); int* TS = (int*)(P->p.ws + WS_TOKSLOT);
    for (int i0 = wave * 16; i0 < wave * 16 + 16; i0 += 4) { u32x4 a[4], b2[4];
#pragma unroll
        for (int q = 0; q < 4; ++q) { const u32x4* src = (const u32x4*)(H2 + (size_t)(tok0 + i0 + q) * DM) + lane; a[q] = src[0]; b2[q] = src[64]; }
#pragma unroll
        for (int q = 0; q < 4; ++q) { const int i = i0 + q, tok = tok0 + i, s0 = S0[i], s1 = S1[i];
            u32x4* d0 = (u32x4*)(HG + (size_t)s0 * DM) + lane; u32x4* d1 = (u32x4*)(HG + (size_t)s1 * DM) + lane;
            d0[0] = a[q]; d0[64] = b2[q]; d1[0] = a[q]; d1[64] = b2[q];
            if (lane == 0) { SW[s0] = RW0[tok]; SW[s1] = RW1[tok]; TS[2 * tok] = s0; TS[2 * tok + 1] = s1; } } }
}

__device__ __forceinline__ void phaseJ_rows(KA P, int vcu, int G, int wave, int lane, int dry = 0) {
    const bf16_t* Y = (const bf16_t*)(P->p.ws + WS_HG); const int* TS = (const int*)(P->p.ws + WS_TOKSLOT); bf16_t* XB = (bf16_t*)(P->p.ws + WS_HN);
    for (int tok0 = vcu * 8 + wave; tok0 < NTOK; tok0 += 2 * G * 8) { f32x4 v[2][4]; u32x2 ya[2][4], yb[2][4];
#pragma unroll
        for (int q = 0; q < 2; ++q) { const int tok = tok0 + q * G * 8; const int s0 = TS[2 * tok], s1 = TS[2 * tok + 1];
            const f32x4* xr = (const f32x4*)(P->p.out + (size_t)tok * DM) + lane; const u32x2* y0 = (const u32x2*)(Y + (size_t)s0 * DM) + lane; const u32x2* y1 = (const u32x2*)(Y + (size_t)s1 * DM) + lane;
#pragma unroll
            for (int j = 0; j < 4; ++j) { v[q][j] = xr[64 * j]; ya[q][j] = y0[64 * j]; yb[q][j] = y1[64 * j]; } }
#pragma unroll
        for (int q = 0; q < 2; ++q) { const int tok = tok0 + q * G * 8; f32x4* xr = (f32x4*)(P->p.out + (size_t)tok * DM) + lane; u32x2* o8 = (u32x2*)(XB + (size_t)tok * DM) + lane;
#pragma unroll
            for (int j = 0; j < 4; ++j) { f32x4 t = v[q][j]; const u32x2 a = ya[q][j], b = yb[q][j];
                t.x += bflo(a.x) + bflo(b.x); t.y += bfhi(a.x) + bfhi(b.x); t.z += bflo(a.y) + bflo(b.y); t.w += bfhi(a.y) + bfhi(b.y);
                if (!dry) { xr[64 * j] = t; u32x2 w; w.x = pk2(t.x, t.y); w.y = pk2(t.z, t.w); o8[64 * j] = w; } } } }
}
__device__ __forceinline__ void final_rows(KA P, int vcu, int G, int wave, int lane) {
    const f32x4* gr = (const f32x4*)P->p.in[23] + lane; f32x4 gg[4];
#pragma unroll
    for (int j = 0; j < 4; ++j) gg[j] = gr[64 * j];
    const int NGW = G * 8;
    for (int t0 = vcu * 8 + wave; t0 < NTOK; t0 += 4 * NGW) { f32x4 v[4][4]; float s[4];
#pragma unroll
        for (int q = 0; q < 4; ++q) { const f32x4* xr = (const f32x4*)(P->p.out + (size_t)(t0 + q * NGW) * DM) + lane;
#pragma unroll
            for (int j = 0; j < 4; ++j) v[q][j] = xr[64 * j]; }
#pragma unroll
        for (int q = 0; q < 4; ++q) { s[q] = 0.f;
#pragma unroll
            for (int j = 0; j < 4; ++j) s[q] += (v[q][j].x * v[q][j].x + v[q][j].y * v[q][j].y) + (v[q][j].z * v[q][j].z + v[q][j].w * v[q][j].w); }
#pragma unroll
        for (int q = 0; q < 4; ++q) s[q] = wave_sum_dpp(s[q]);
#pragma unroll
        for (int q = 0; q < 4; ++q) { const float r = 1.0f / sqrtf(s[q] * (1.f / DM) + EPS); f32x4* xr = (f32x4*)(P->p.out + (size_t)(t0 + q * NGW) * DM) + lane;
#pragma unroll
            for (int j = 0; j < 4; ++j) { f32x4 o; o.x = v[q][j].x * r * gg[j].x; o.y = v[q][j].y * r * gg[j].y; o.z = v[q][j].z * r * gg[j].z; o.w = v[q][j].w * r * gg[j].w; xr[64 * j] = o; } } }
}
#ifndef MK_N_LAUNCHES
#define MK_N_LAUNCHES 1
#endif
constexpr int PH_PER_LAYER = 13, N_PHASES = DEPTH * PH_PER_LAYER + 1;
constexpr int N_LAUNCHES = MK_N_LAUNCHES;
static_assert(N_LAUNCHES == 1 || N_LAUNCHES == N_PHASES, "MK_N_LAUNCHES is 1 or 27");

#define PH_FN static __device__ __forceinline__ void
#define DRYP , int dry = 0
#define PH_COMMON int tid_l = threadIdx.x; asm volatile("" : "+v"(tid_l)); asm volatile("" : "+s"(ka)); asm volatile("" : "+s"(L)); const int tid = tid_l, lane = tid & 63, wave = __builtin_amdgcn_readfirstlane(tid >> 6); int G_l = gridDim.x, bx_l = blockIdx.x; asm volatile("" : "+s"(G_l)); asm volatile("" : "+s"(bx_l)); const int G = G_l, bx = bx_l; \
    const int vcu = (G % 8 == 0) ? (bx % 8) * (G / 8) + bx / 8 : bx; unsigned char* ws = ka->p.ws; (void)tid; (void)lane; (void)wave; (void)vcu; (void)ws; \
    bf16_t* Z = (bf16_t*)(ws + WS_Z); bf16_t* HN = (bf16_t*)(ws + WS_HN); (void)Z; (void)HN;

PH_FN ph_A(KA ka, int L, LAS unsigned char* L3 DRYP) { PH_COMMON; KA P = ka; phaseA(P, L, L3, vcu, G, wave, lane, tid); }
PH_FN ph_B(KA ka, int L, LAS unsigned char* L3 DRYP) { PH_COMMON;
    pg8::Gemm g{HN, DM, (const bf16_t*)(ws + WS_WIN), DM, DM}; pg8::StaticOrder S; S.init(NTOK, NZT * 256, G, bx);
    pg8::EpiBf16 E{Z, ZP, 0};
    pg8::gemm_phase<pg8::EpiBf16, pg8::StaticOrder, true, true>(L3, g, S, E); }
PH_FN ph_C1a(KA ka, int L, LAS unsigned char* L3 DRYP) { PH_COMMON;
    const float* wa2 = ka->p.in[4] + (size_t)L * 16 * 256; const float* ba = ka->p.in[5] + (size_t)L * 256;
    for (int u = bx; u < 2048; u += G) gla1_unit(u, Z, wa2, ba, (bf16_t*)(ws + WS_SLOC), (float*)(ws + WS_DTAB), L3, wave, lane, tid, dry);
    for (int cu = bx; cu < 256; cu += G) conv_unit(cu, Z, ka->p.in[11] + (size_t)L * 3 * 512, wave, lane, dry);
    for (int cu = bx; cu < 256; cu += G) knorm_unit(cu, Z, (unsigned*)(ws + WS_CTL) + CW_KN + 64 * L, L3, wave, lane, tid); }
PH_FN ph_C1b(KA ka, int L, LAS unsigned char* L3 DRYP) { PH_COMMON;
    gla_scan((bf16_t*)(ws + WS_SLOC), (const float*)(ws + WS_DTAB), L3, G, bx, tid);
    const float* lp = ka->p.in[8] + (size_t)L * 256;
    const float sa = wave_sum(lp[lane] * lp[64 + lane]), sb = wave_sum(lp[128 + lane] * lp[192 + lane]);
    const float lam_init = 0.8f - 0.6f * expf(-0.3f * (float)L); const float lam = expf(sa) - expf(sb) + lam_init;
    const float* gd = ka->p.in[9] + (size_t)L * 128;
    unsigned* head = (unsigned*)(ws + WS_CTL) + CW_QHEAD + 64 * L; const unsigned* KN = (const unsigned*)(ws + WS_CTL) + CW_KN + 64 * L;
    LAS int* qslot = (LAS int*)(L3 + 69632);
#ifdef DUP_ATT
    for (int adry = 1; adry >= 0; --adry) {
    if (adry) head += 32; else head -= 32;
#else
    { const int adry = dry;
#endif
    for (;;) {
        if (tid == 0) *qslot = (int)__hip_atomic_fetch_add(head, 1u, __ATOMIC_RELAXED, __HIP_MEMORY_SCOPE_AGENT);
        __syncthreads(); const int u = __builtin_amdgcn_readfirstlane(*qslot); __syncthreads();
        if (u >= 1024) break;
        const int h = 3 - (u >> 8), r = u & 255, qb = 127 - (r >> 1), b = r & 1;
        att::unit(b, h, qb, lam, 1.0f - lam_init, __uint_as_float(KN[b * 4 + h]), Z, gd, (char*)L3, adry); }
    } }
PH_FN ph_C3(KA ka, int L, LAS unsigned char* L3 DRYP) { PH_COMMON; for (int u = bx; u < 2048; u += G) gla3_unit(u, Z, (const bf16_t*)(ws + WS_SLOC), ka->p.in[6] + (size_t)L * 128, L3, wave, lane, dry); }
PH_FN ph_D1(KA ka, int L, LAS unsigned char* L3 DRYP) { PH_COMMON;
    pg8::Gemm g{Z, ZP, (const bf16_t*)(ws + WS_WO), 512, 512}; pg8::MergeOrder S{bx, G, C_OA, 512, 0, (size_t)DM * 512};
    pg8::EpiBf16 E{Z, ZP, 1024};
    pg8::gemm_phase<pg8::EpiBf16, pg8::MergeOrder, true, true>(L3, g, S, E); }
PH_FN ph_D2(KA ka, int L, LAS unsigned char* L3 DRYP) { PH_COMMON;
    pg8::Gemm g{HN, DM, (const bf16_t*)(ws + WS_WIN), DM, DM}; pg8::MergeOrder S{bx, G, 0, 0, (size_t)NZT * 256 * DM, (size_t)4 * 256 * DM};
    pg8::EpiMerge E{Z, dry};
    pg8::gemm_phase<pg8::EpiMerge, pg8::MergeOrder, true, true>(L3, g, S, E); }
PH_FN ph_E(KA ka, int L, LAS unsigned char* L3 DRYP) { PH_COMMON;
    pg8::Gemm g{Z, ZP, (const bf16_t*)(ws + WS_WOUT), DM, DM}; pg8::StaticOrder S; S.init(NTOK, DM, G, bx);
    pg8::EpiRes E{L == 0 ? ka->p.in[0] : ka->p.out, ka->p.out, dry};
    pg8::gemm_phase<pg8::EpiRes, pg8::StaticOrder, true, true>(L3, g, S, E); }
PH_FN ph_F(KA ka, int L, LAS unsigned char* L3 DRYP) { PH_COMMON; KA P = ka; if (G == GRID) phaseF(P, L, L3, wave, lane, tid); }
PH_FN ph_G(KA ka, int L, LAS unsigned char* L3 DRYP) { PH_COMMON; KA P = ka; if (G == GRID) phaseG(P, L3, wave, lane, tid); }
PH_FN ph_H(KA ka, int L, LAS unsigned char* L3 DRYP) { PH_COMMON;
    pg8::Gemm g{(const bf16_t*)(ws + WS_HG), DM, (const bf16_t*)(ws + WS_WGU), DM, DM}; pg8::GroupOrder S{(const int*)(ws + WS_TBL), bx, G, (size_t)1024 * DM};
    pg8::EpiUp E{(bf16_t*)(ws + WS_ACT)};
    pg8::gemm_phase<pg8::EpiUp, pg8::GroupOrder, true, true>(L3, g, S, E); }
PH_FN ph_I(KA ka, int L, LAS unsigned char* L3 DRYP) { PH_COMMON;
    pg8::Gemm g{(const bf16_t*)(ws + WS_ACT), DEXP, (const bf16_t*)(ws + WS_WDN), DEXP, DEXP}; pg8::GroupOrder S{(const int*)(ws + WS_TBL), bx, G, (size_t)DM * DEXP};
    pg8::EpiDown E{(bf16_t*)(ws + WS_HG), (const float*)(ws + WS_SLOTW)};
    pg8::gemm_phase<pg8::EpiDown, pg8::GroupOrder, true, true>(L3, g, S, E); }
PH_FN ph_J(KA ka, int L, LAS unsigned char* L3 DRYP) { PH_COMMON; KA P = ka;
    phaseJ_rows(P, vcu, G, wave, lane, dry);
    pg8::Gemm g{(const bf16_t*)(ws + WS_PB), PLE, (const bf16_t*)(ws + WS_WPLE), PLE, PLE}; pg8::StaticOrder S; S.init(NTOK, DM, G, bx);
    pg8::EpiBf16 E{(bf16_t*)(ws + WS_PL), DM, 0};
    pg8::gemm_phase<pg8::EpiBf16, pg8::StaticOrder, true, true>(L3, g, S, E); }
PH_FN ph_K(KA ka, int L, LAS unsigned char* L3 DRYP) { PH_COMMON;
    pg8::Gemm g{HN, DM, (const bf16_t*)(ws + WS_WPG), DM, DM}; pg8::StaticOrder S; S.init(NTOK, DM, G, bx);
    pg8::EpiPle E{ka->p.out, ka->p.out, (const bf16_t*)(ws + WS_PL), dry};
    pg8::gemm_phase<pg8::EpiPle, pg8::StaticOrder, true, true>(L3, g, S, E); }
PH_FN ph_final(KA ka, int L, LAS unsigned char* L3 DRYP) { PH_COMMON; KA P = ka; final_rows(P, vcu, G, wave, lane); }
static __device__ __forceinline__ void grid_bar(unsigned* barw, LAS unsigned* st) { XcdBarrier b; b.bar = barw; b.x = xb_xcc_id(); b.st = (volatile LAS unsigned*)st; xcd_barrier(b); }

__global__ void __launch_bounds__(512, 2) mega_fwd(Args args) {
    extern __shared__ __attribute__((aligned(16))) unsigned char lds[];
    LAS unsigned char* L3 = (LAS unsigned char*)lds;
    KA ka = (KA)__builtin_amdgcn_kernarg_segment_ptr();
    const int tid = threadIdx.x;
    for (int u = tid; u < (LDS_BYTES - LDSCTL_OFF) / 4; u += 512) ((LAS unsigned*)(L3 + LDSCTL_OFF))[u] = 0u;
    __syncthreads();
    unsigned* barw = (unsigned*)(args.p.ws + WS_CTL) + CW_BAR; LAS unsigned* st = (LAS unsigned*)(L3 + MISC_OFF) + 8;
    if (N_LAUNCHES == 1) (void)xcd_barrier_post(barw, (volatile LAS unsigned*)st);
    const int lo = args.ph_lo, hi = args.ph_hi;
#ifndef PHASE_MASK
#define PHASE_MASK 0xFFFFFFFu
#endif
#define IN(k) (((PHASE_MASK >> ((k) % PH_PER_LAYER + ((k) == N_PHASES - 1 ? PH_PER_LAYER : 0))) & 1u) && lo <= (k) && (k) < hi)
#define SEAM(k) do { if (IN(k) && IN((k) + 1)) grid_bar(barw, st); } while (0)
    for (int L = 0; L < DEPTH; ++L) {
        const int pb = L * PH_PER_LAYER;
        if (IN(pb + 0)) {
#ifdef DUP_A
            for (int rep = 1; rep >= 0; --rep) { const int d = rep ? ka->ph_hi : 0; ph_A(ka, L, L3, d); __syncthreads(); }
#else
            ph_A(ka, L, L3);
#endif
        }
        SEAM(pb + 0);
        if (IN(pb + 1)) {
#ifdef DUP_B
            for (int rep = 1; rep >= 0; --rep) { const int d = rep ? ka->ph_hi : 0; ph_B(ka, L, L3, d); __syncthreads(); }
#else
            ph_B(ka, L, L3);
#endif
        }
        SEAM(pb + 1);
        if (IN(pb + 2)) {
#ifdef DUP_C1a
            for (int rep = 1; rep >= 0; --rep) { const int d = rep ? ka->ph_hi : 0; ph_C1a(ka, L, L3, d); __syncthreads(); }
#else
            ph_C1a(ka, L, L3);
#endif
        }
        SEAM(pb + 2);
        if (IN(pb + 3)) ph_C1b(ka, L, L3);
        SEAM(pb + 3);
        if (IN(pb + 4)) {
#ifdef DUP_C3
            for (int rep = 1; rep >= 0; --rep) { const int d = rep ? ka->ph_hi : 0; ph_C3(ka, L, L3, d); __syncthreads(); }
#else
            ph_C3(ka, L, L3);
#endif
        }
        SEAM(pb + 4);
        if (IN(pb + 5)) {
#ifdef DUP_D
            for (int rep = 1; rep >= 0; --rep) { const int d = rep ? ka->ph_hi : 0; ph_D1(ka, L, L3, d); ph_D2(ka, L, L3, d); __syncthreads(); }
#else
            ph_D1(ka, L, L3); ph_D2(ka, L, L3);
#endif
        }
        SEAM(pb + 5);
        if (IN(pb + 6)) {
#ifdef DUP_E
            for (int rep = 1; rep >= 0; --rep) { const int d = rep ? ka->ph_hi : 0; ph_E(ka, L, L3, d); __syncthreads(); }
#else
            ph_E(ka, L, L3);
#endif
        }
        SEAM(pb + 6);
        if (IN(pb + 7)) {
#ifdef DUP_F
            for (int rep = 1; rep >= 0; --rep) { const int d = rep ? ka->ph_hi : 0; ph_F(ka, L, L3, d); __syncthreads(); }
#else
            ph_F(ka, L, L3);
#endif
        }
        SEAM(pb + 7);
        if (IN(pb + 8)) {
#ifdef DUP_G
            for (int rep = 1; rep >= 0; --rep) { const int d = rep ? ka->ph_hi : 0; ph_G(ka, L, L3, d); __syncthreads(); }
#else
            ph_G(ka, L, L3);
#endif
        }
        SEAM(pb + 8);
        if (IN(pb + 9)) {
#ifdef DUP_H
            for (int rep = 1; rep >= 0; --rep) { const int d = rep ? ka->ph_hi : 0; ph_H(ka, L, L3, d); __syncthreads(); }
#else
            ph_H(ka, L, L3);
#endif
        }
        SEAM(pb + 9);
        if (IN(pb + 10)) {
#ifdef DUP_I
            for (int rep = 1; rep >= 0; --rep) { const int d = rep ? ka->ph_hi : 0; ph_I(ka, L, L3, d); __syncthreads(); }
#else
            ph_I(ka, L, L3);
#endif
        }
        SEAM(pb + 10);
        if (IN(pb + 11)) {
#ifdef DUP_J
            for (int rep = 1; rep >= 0; --rep) { const int d = rep ? ka->ph_hi : 0; ph_J(ka, L, L3, d); __syncthreads(); }
#else
            ph_J(ka, L, L3);
#endif
        }
        SEAM(pb + 11);
        if (IN(pb + 12)) {
#ifdef DUP_K
            for (int rep = 1; rep >= 0; --rep) { const int d = rep ? ka->ph_hi : 0; ph_K(ka, L, L3, d); __syncthreads(); }
#else
            ph_K(ka, L, L3);
#endif
        }
        SEAM(pb + 12);
    }
    if (IN(N_PHASES - 1)) ph_final(ka, 0, L3);
#undef IN
#undef SEAM
}

extern "C" void kernel_launch(void* const* d_in, const int* in_sizes, int n_in, void* d_out, int out_size, void* d_ws, size_t ws_size, hipStream_t stream) {
    static int grid = 0;
    if (grid == 0) {
        if (n_in != 24 || in_sizes[0] != NTOK * DM || out_size != NTOK * DM || ws_size < WS_END) {
            fprintf(stderr, "kernel_launch: built for 24 inputs, x/out of %d floats, >= %zu bytes of workspace; got n_in %d, in0 %d, out %d, ws %zu; nothing launched\n", NTOK * DM, (size_t)WS_END, n_in, n_in > 0 ? in_sizes[0] : -1, out_size, ws_size); grid = -1; return; }
        int dev = 0, cus = 0, per_cu = 0;
        if (hipGetDevice(&dev) != hipSuccess || hipDeviceGetAttribute(&cus, hipDeviceAttributeMultiprocessorCount, dev) != hipSuccess) { fprintf(stderr, "kernel_launch: device query failed\n"); grid = -1; return; }
        if (hipFuncSetAttribute((const void*)mega_fwd, hipFuncAttributeMaxDynamicSharedMemorySize, LDS_BYTES) != hipSuccess) { fprintf(stderr, "kernel_launch: hipFuncSetAttribute failed\n"); grid = -1; return; }
        if (hipOccupancyMaxActiveBlocksPerMultiprocessor(&per_cu, (const void*)mega_fwd, 512, LDS_BYTES) != hipSuccess || per_cu < 1)
            fprintf(stderr, "kernel_launch: note: occupancy query reports %d workgroups per CU\n", per_cu);
        (void)hipGetLastError();
        if (cus != GRID) { fprintf(stderr, "kernel_launch: built for a %d-CU device, found %d; nothing launched\n", GRID, cus); grid = -1; return; }
        grid = GRID;
    }
    if (grid < 0) return;
    if (hipMemsetAsync((char*)d_ws + WS_CTL, 0, CTL_ZERO_BYTES, stream) != hipSuccess) { fprintf(stderr, "kernel_launch: memset failed\n"); return; }
    Args a{};
    for (int i = 0; i < 24; ++i) a.p.in[i] = (const float*)d_in[i];
    a.p.out = (float*)d_out; a.p.ws = (unsigned char*)d_ws;
    for (int li = 0; li < N_LAUNCHES; ++li) {
        a.ph_lo = (N_LAUNCHES == 1) ? 0 : li; a.ph_hi = (N_LAUNCHES == 1) ? N_PHASES : li + 1;
        hipLaunchKernelGGL(mega_fwd, dim3(grid), dim3(512), LDS_BYTES, stream, a);
        const hipError_t le = hipPeekAtLastError();
        if (le != hipSuccess) { fprintf(stderr, "kernel_launch: launch %d failed: %s\n", li, hipGetErrorName(le)); break; }
    }
}
```

```cpp
#include <hip/hip_runtime.h>
#include <cstdio>
#include <cstdint>

#define LAS __attribute__((address_space(3)))
#define GAS __attribute__((address_space(1)))
typedef unsigned short bf16_t;
typedef short bf16x8 __attribute__((ext_vector_type(8)));
typedef short s16x4 __attribute__((ext_vector_type(4)));
typedef float f32x2 __attribute__((ext_vector_type(2)));
typedef float f32x4 __attribute__((ext_vector_type(4)));
typedef float f32x16 __attribute__((ext_vector_type(16)));
typedef unsigned u32x2 __attribute__((ext_vector_type(2)));
typedef unsigned u32x4 __attribute__((ext_vector_type(4)));
typedef __bf16 bf16x2_t __attribute__((ext_vector_type(2)));

constexpr int NB = 2, T = 16384, NTOK = NB * T, DM = 1024, DEPTH = 2, PLE = 256;
constexpr int INTOT = 7696;
constexpr int ZP = 4864;
constexpr int C_GQ = 0, C_GK = 256, C_GV = 512, C_DK = 1024, C_DV = 1536, C_CX = 2048, C_CC = 2560, C_GA = 3072, C_GG = 3328, C_DQ = 3840, C_CB = 4352;
constexpr int C_OA = C_GG, C_OB = C_DQ, C_OC = C_CB;
constexpr int NZT = 19;
constexpr int NEXP = 16, DEXP = 512;
constexpr int NSLOT = 2 * NTOK + NEXP * 256;
constexpr float EPS = 1e-6f;
constexpr int GRID = 256;
constexpr int TPW = NTOK / GRID;

__device__ __forceinline__ unsigned f2bf(float f) { unsigned u = __builtin_bit_cast(unsigned, f); return (u + 0x7fffu + ((u >> 16) & 1u)) >> 16; }
__device__ __forceinline__ unsigned pk2(float lo, float hi) { f32x2 v = {lo, hi}; bf16x2_t b = __builtin_convertvector(v, bf16x2_t); return __builtin_bit_cast(unsigned, b); }
__device__ __forceinline__ float bflo(unsigned w) { return __builtin_bit_cast(float, w << 16); }
__device__ __forceinline__ float bfhi(unsigned w) { return __builtin_bit_cast(float, w & 0xffff0000u); }
__device__ __forceinline__ float bf2f(bf16_t b) { return __builtin_bit_cast(float, (unsigned)b << 16); }
__device__ __forceinline__ float sigmoidf_(float x) { return __builtin_amdgcn_rcpf(1.0f + __builtin_amdgcn_exp2f(-1.4426950408889634f * x)); }
__device__ __forceinline__ float siluf_(float x) { return x * sigmoidf_(x); }
__device__ __forceinline__ float wave_sum(float v) {
#pragma unroll
    for (int o = 1; o < 64; o <<= 1) v += __shfl_xor(v, o);
    return v;
}
__device__ __forceinline__ float dpp_f(float x, int ctrl_sel) {
    const int xi = __builtin_bit_cast(int, x); int r;
    if (ctrl_sel == 0) r = __builtin_amdgcn_update_dpp(0, xi, 0xB1, 0xF, 0xF, true);
    else if (ctrl_sel == 1) r = __builtin_amdgcn_update_dpp(0, xi, 0x4E, 0xF, 0xF, true);
    else if (ctrl_sel == 2) r = __builtin_amdgcn_update_dpp(0, xi, 0x141, 0xF, 0xF, true);
    else r = __builtin_amdgcn_update_dpp(0, xi, 0x140, 0xF, 0xF, true);
    return __builtin_bit_cast(float, r); }
__device__ __forceinline__ float row16_sum(float x) { x += dpp_f(x, 0); x += dpp_f(x, 1); x += dpp_f(x, 2); x += dpp_f(x, 3); return x; }
__device__ __forceinline__ float rdl(float x, int l) { return __builtin_bit_cast(float, __builtin_amdgcn_readlane(__builtin_bit_cast(int, x), l)); }
__device__ __forceinline__ float wave_sum_hi(float x) { x = row16_sum(x);
    x += __builtin_bit_cast(float, __builtin_amdgcn_update_dpp(0, __builtin_bit_cast(int, x), 0x142, 0xA, 0xF, false));
    x += __builtin_bit_cast(float, __builtin_amdgcn_update_dpp(0, __builtin_bit_cast(int, x), 0x143, 0xC, 0xF, false)); return x; }
__device__ __forceinline__ float wave_sum_dpp(float x) { return rdl(wave_sum_hi(x), 63); }
template <int CTRL, int RM> __device__ __forceinline__ float dpp0(float x) { return __builtin_bit_cast(float, __builtin_amdgcn_update_dpp(0, __builtin_bit_cast(int, x), CTRL, RM, 0xF, false)); }
__device__ __forceinline__ float wave_scan_incl(float x) {
    x += dpp0<0x111, 0xF>(x); x += dpp0<0x112, 0xF>(x); x += dpp0<0x114, 0xF>(x); x += dpp0<0x118, 0xF>(x);
    x += dpp0<0x142, 0xA>(x); x += dpp0<0x143, 0xC>(x); return x; }
__device__ __forceinline__ int crow(int r, int hi) { return (r & 3) + 8 * (r >> 2) + 4 * hi; }
#define LDS_WAIT() asm volatile("s_waitcnt lgkmcnt(0)" ::: "memory")
#define VM_WAIT() asm volatile("s_waitcnt vmcnt(0)" ::: "memory")

namespace pg8 {
#define PG8_LAS __attribute__((address_space(3)))
constexpr int BM = 256, BK = 64, HALF = 128, HTB = HALF * BK * 2  , STAGE_BYTES = 8 * HTB, NXCD = 8, WGM = 8;

__host__ __device__ __forceinline__ int lds_byte(int r, int c) { const int st = (r >> 4) * 2 + (c >> 5), rr = r & 15, cc = c & 31, ob = rr * 64 + cc * 2; return st * 1024 + (ob ^ (((ob >> 9) & 1) << 5)); }
__host__ __device__ __forceinline__ void stage_rc(int b, int& R, int& C) { const int st = b / 1024, sb = b % 1024, swz = sb ^ (((sb >> 9) & 1) << 5); R = (st >> 1) * 16 + swz / 64; C = (st & 1) * 32 + (swz % 64) / 2; }
__host__ __device__ __forceinline__ int perm32(int rho) { const int n = rho >> 4, i = rho & 15; return 8 * (i >> 2) + 4 * n + (i & 3); }

struct Unit { int pm, pn; int aoff; int tag; size_t boff; };
struct Gemm { const bf16_t* A; int lda; const bf16_t* Bt; int ldb; int K; };

struct StaticOrder {
    int nM, nN, nwg, G, c;
    __device__ void init(int M, int N, int G_, int c_) { nM = M / BM; nN = N / BM; nwg = nM * nN; G = G_; c = c_; }
    __device__ bool next(int i, Unit& u) const {
        const long L = (long)i * G + c; if (L >= nwg) return false;
        int wgid = (int)L; { const int q = nwg / NXCD, r = nwg % NXCD, xcd = wgid % NXCD, off = wgid / NXCD; wgid = (xcd < r ? xcd * (q + 1) : r * (q + 1) + (xcd - r) * q) + off; }
        const int nig = WGM * nN, gid = wgid / nig, fm = gid * WGM, gsz = (nM - fm) < WGM ? (nM - fm) : WGM;
        u.pm = fm + ((wgid % nig) % gsz); u.pn = (wgid % nig) / gsz; u.aoff = 0; u.tag = 0; u.boff = 0; return true;
    }
};

struct EpiBf16 {
    static constexpr bool PERM = true;
    bf16_t* O; int ldc; int tstride;
    __device__ __forceinline__ void operator()(const f32x4 (&acc)[2][2][4][2], const Unit& u, int wr, int wc, int fr, int fq) const {
        const int row0 = u.pm * BM + wr * 64 + fr; const int col0 = u.tag * tstride + u.pn * BM + wc * 32 + 8 * fq;
#pragma unroll
        for (int ai = 0; ai < 2; ++ai)
#pragma unroll
            for (int m = 0; m < 4; ++m) { bf16_t* rowp = O + (size_t)(row0 + ai * HALF + m * 16) * ldc + col0;
#pragma unroll
                for (int bj = 0; bj < 2; ++bj) { const f32x4 v0 = acc[ai][bj][m][0], v1 = acc[ai][bj][m][1];
                    u32x4 w; w.x = pk2(v0[0], v0[1]); w.y = pk2(v0[2], v0[3]); w.z = pk2(v1[0], v1[1]); w.w = pk2(v1[2], v1[3]);
                    *(u32x4*)(rowp + bj * HALF) = w; } }
    }
};
template <class Epi, class Sched, bool ALIGN_EPI = false, bool SP2 = false>
__device__ __forceinline__ void gemm_phase(PG8_LAS unsigned char* lds, const Gemm g, const Sched& S, const Epi& E) {
    int tid_l = threadIdx.x; asm volatile("" : "+v"(tid_l)); const int tid = tid_l;
    const int wid = __builtin_amdgcn_readfirstlane(tid >> 6), lane = tid & 63, wr = wid >> 2, wc = wid & 3, fr = lane & 15, fq = lane >> 4;
    const int K = g.K, nt = K / BK;
    unsigned voffA[2], voffB[2];
#pragma unroll
    for (int i = 0; i < 2; ++i) { int R, C; stage_rc(tid * 16 + i * 8192, R, C); const int Rb = Epi::PERM ? ((R & ~31) + perm32(R & 31)) : R;
        voffA[i] = (unsigned)(R * g.lda + C) * 2u; voffB[i] = (unsigned)(Rb * g.ldb + C) * 2u; }
    const size_t kstep = (size_t)(BK * 2);
    const size_t hstepA = (size_t)HALF * g.lda * 2, hstepB = (size_t)HALF * g.ldb * 2;
    const unsigned ldsw = (unsigned)wid * 1024u;
    const int aoff = lds_byte(wr * 64 + fr, fq * 8), boff = lds_byte(wc * 32 + fr, fq * 8);
#define PG8_UA(u) ((const char*)g.A + ((size_t)(u).pm * 2 * hstepA) + (size_t)(u).aoff * 2)
#define PG8_UB(u) ((const char*)g.Bt + ((size_t)(u).pn * 2 * hstepB) + (u).boff * 2)
#define PG8_SA(b, h) (((b) * 2 + (h)) * HTB)
#define PG8_SB(b, h) ((4 + (b) * 2 + (h)) * HTB)
#define PG8_STAGE(bufoff, gbase, voff) do { _Pragma("unroll") for (int _i = 0; _i < 2; ++_i) \
        __builtin_amdgcn_global_load_lds((const unsigned*)((const char*)(gbase) + (voff)[_i]), (PG8_LAS unsigned*)(lds + (bufoff) + ldsw + _i * 8192), 16, 0, 0); } while (0)
#define PG8_LDA(dst, b, h) do { _Pragma("unroll") for (int m = 0; m < 4; ++m) _Pragma("unroll") for (int k = 0; k < 2; ++k) dst[m][k] = *(const PG8_LAS bf16x8*)(lds + PG8_SA(b, h) + aoff + m * 2048 + k * 1024); } while (0)
#define PG8_LDB(dst, b, h) do { _Pragma("unroll") for (int n = 0; n < 2; ++n) _Pragma("unroll") for (int k = 0; k < 2; ++k) dst[n][k] = *(const PG8_LAS bf16x8*)(lds + PG8_SB(b, h) + boff + n * 2048 + k * 1024); } while (0)
#define PG8_MMA(ai, bj, At, Bt) do { __builtin_amdgcn_s_setprio(1); _Pragma("unroll") for (int m = 0; m < 4; ++m) _Pragma("unroll") for (int n = 0; n < 2; ++n) _Pragma("unroll") for (int k = 0; k < 2; ++k) \
        acc[ai][bj][m][n] = __builtin_amdgcn_mfma_f32_16x16x32_bf16(Bt[n][k], At[m][k], acc[ai][bj][m][n], 0, 0, 0); __builtin_amdgcn_s_setprio(0); } while (0)
#define PG8_WAIT_V(n) asm volatile("s_waitcnt vmcnt(" #n ")" ::: "memory")
#define PG8_WAIT_L(n) asm volatile("s_waitcnt lgkmcnt(" #n ")" ::: "memory")
#define PG8_BAR __builtin_amdgcn_s_barrier()
#define PG8_SCHED __builtin_amdgcn_sched_barrier(0)
    Unit cur, nxt; int ui = 0;
    if (!S.next(0, cur)) return;
    f32x4 acc[2][2][4][2];
#pragma unroll
    for (int a = 0; a < 2; ++a)
#pragma unroll
        for (int b = 0; b < 2; ++b)
#pragma unroll
            for (int m = 0; m < 4; ++m)
#pragma unroll
                for (int n = 0; n < 2; ++n) acc[a][b][m][n] = (f32x4){0.f, 0.f, 0.f, 0.f};
    bf16x8 At[4][2], B0[2][2], B1[2][2];
    const char* cA = PG8_UA(cur); const char* cB = PG8_UB(cur);
    if constexpr (SP2) {
        PG8_STAGE(PG8_SB(0, 0), cB, voffB); PG8_STAGE(PG8_SB(0, 1), cB + hstepB, voffB); PG8_STAGE(PG8_SA(0, 0), cA, voffA); PG8_STAGE(PG8_SA(0, 1), cA + hstepA, voffA);
        if (wr == 1) PG8_BAR;
        PG8_WAIT_V(2); PG8_BAR;
        PG8_STAGE(PG8_SB(1, 0), cB + kstep, voffB); PG8_STAGE(PG8_SA(1, 0), cA + kstep, voffA); PG8_STAGE(PG8_SB(1, 1), cB + hstepB + kstep, voffB);
        PG8_WAIT_V(6); PG8_BAR;
    } else {
        PG8_STAGE(PG8_SB(0, 0), cB, voffB); PG8_STAGE(PG8_SA(0, 0), cA, voffA); PG8_STAGE(PG8_SB(0, 1), cB + hstepB, voffB); PG8_STAGE(PG8_SA(0, 1), cA + hstepA, voffA);
        if (wr == 1) PG8_BAR;
        PG8_WAIT_V(4); PG8_BAR;
        PG8_STAGE(PG8_SB(1, 0), cB + kstep, voffB); PG8_STAGE(PG8_SA(1, 0), cA + kstep, voffA); PG8_STAGE(PG8_SB(1, 1), cB + hstepB + kstep, voffB);
        PG8_WAIT_V(6); PG8_BAR;
    }
    for (;;) {
        const bool has_next = S.next(ui + 1, nxt);
        const char* nA = has_next ? PG8_UA(nxt) : cA; const char* nB = has_next ? PG8_UB(nxt) : cB;
        for (int t = 0; t < nt; t += 2) {
            const bool last = (t == nt - 2);
            const char* a1 = cA + (size_t)(t + 1) * kstep;
            const char* a2 = last ? nA : cA + (size_t)(t + 2) * kstep; const char* b2 = last ? nB : cB + (size_t)(t + 2) * kstep;
            const char* a3 = a2 + kstep; const char* b3 = b2 + kstep;
            if constexpr (SP2) {
            PG8_LDB(B0, 0, 0); PG8_LDB(B1, 0, 1); PG8_SCHED; PG8_LDA(At, 0, 0); PG8_STAGE(PG8_SA(1, 1), a1 + hstepA, voffA);
            PG8_WAIT_V(8); PG8_WAIT_L(0); PG8_BAR; PG8_MMA(0, 0, At, B0); PG8_MMA(0, 1, At, B1); PG8_BAR; PG8_SCHED;
            PG8_LDA(At, 0, 1); PG8_STAGE(PG8_SB(0, 0), b2, voffB); PG8_STAGE(PG8_SB(0, 1), b2 + hstepB, voffB); PG8_STAGE(PG8_SA(0, 0), a2, voffA);
            PG8_WAIT_V(8); PG8_WAIT_L(0); PG8_BAR; PG8_MMA(1, 0, At, B0); PG8_MMA(1, 1, At, B1); PG8_BAR; PG8_SCHED;
            PG8_LDB(B0, 1, 0); PG8_LDB(B1, 1, 1); PG8_SCHED; PG8_LDA(At, 1, 0); PG8_STAGE(PG8_SA(0, 1), a2 + hstepA, voffA);
            PG8_WAIT_V(8); PG8_WAIT_L(0); PG8_BAR; PG8_MMA(0, 0, At, B0); PG8_MMA(0, 1, At, B1); PG8_BAR; PG8_SCHED;
            PG8_LDA(At, 1, 1); PG8_STAGE(PG8_SB(1, 0), b3, voffB); PG8_STAGE(PG8_SB(1, 1), b3 + hstepB, voffB); PG8_STAGE(PG8_SA(1, 0), a3, voffA);
            PG8_WAIT_V(8); PG8_WAIT_L(0); PG8_BAR; PG8_MMA(1, 0, At, B0); PG8_MMA(1, 1, At, B1); PG8_BAR; PG8_SCHED;
            } else {
            PG8_LDB(B0, 0, 0); PG8_SCHED; PG8_LDA(At, 0, 0); PG8_STAGE(PG8_SA(1, 1), a1 + hstepA, voffA);
            PG8_WAIT_L(8); PG8_BAR; PG8_WAIT_L(0); PG8_MMA(0, 0, At, B0); PG8_BAR; PG8_SCHED;
            PG8_LDB(B1, 0, 1); PG8_STAGE(PG8_SB(0, 0), b2, voffB);
            PG8_BAR; PG8_WAIT_L(0); PG8_MMA(0, 1, At, B1); PG8_BAR;
            PG8_LDA(At, 0, 1); PG8_STAGE(PG8_SA(0, 0), a2, voffA);
            PG8_BAR; PG8_WAIT_L(0); PG8_MMA(1, 0, At, B0); PG8_BAR; PG8_SCHED;
            PG8_STAGE(PG8_SB(0, 1), b2 + hstepB, voffB);
            PG8_WAIT_V(6); PG8_BAR; PG8_MMA(1, 1, At, B1); PG8_BAR;
            PG8_LDB(B0, 1, 0); PG8_SCHED; PG8_LDA(At, 1, 0); PG8_STAGE(PG8_SA(0, 1), a2 + hstepA, voffA);
            PG8_WAIT_L(8); PG8_BAR; PG8_WAIT_L(0); PG8_MMA(0, 0, At, B0); PG8_BAR; PG8_SCHED;
            PG8_LDB(B1, 1, 1); PG8_STAGE(PG8_SB(1, 0), b3, voffB);
            PG8_BAR; PG8_WAIT_L(0); PG8_MMA(0, 1, At, B1); PG8_BAR;
            PG8_LDA(At, 1, 1); PG8_STAGE(PG8_SA(1, 0), a3, voffA);
            PG8_BAR; PG8_WAIT_L(0); PG8_MMA(1, 0, At, B0); PG8_BAR; PG8_SCHED;
            PG8_STAGE(PG8_SB(1, 1), b3 + hstepB, voffB);
            PG8_WAIT_V(6); PG8_BAR; PG8_MMA(1, 1, At, B1); PG8_BAR;
            }
        }
        if constexpr (ALIGN_EPI) { if (wr == 0) PG8_BAR; }
        E(acc, cur, wr, wc, fr, fq);
        if (!has_next) break;
#pragma unroll
        for (int a = 0; a < 2; ++a)
#pragma unroll
            for (int b = 0; b < 2; ++b)
#pragma unroll
                for (int m = 0; m < 4; ++m)
#pragma unroll
                    for (int n = 0; n < 2; ++n) acc[a][b][m][n] = (f32x4){0.f, 0.f, 0.f, 0.f};
        cur = nxt; cA = nA; cB = nB; ++ui;
        if constexpr (ALIGN_EPI) { if (wr == 1) PG8_BAR; }
    }
    PG8_WAIT_V(0);
    if constexpr (!ALIGN_EPI) { if (wr == 0) PG8_BAR; }
    PG8_BAR;
#undef PG8_UA
#undef PG8_UB
#undef PG8_SA
#undef PG8_SB
#undef PG8_STAGE
#undef PG8_LDA
#undef PG8_LDB
#undef PG8_MMA
#undef PG8_WAIT_V
#undef PG8_WAIT_L
#undef PG8_BAR
#undef PG8_SCHED
}
}

#define XB_TMO      128
#define XB_XCNT(j)  (256  + 64 * (j))
#define XB_XSUB(j)  (1280 + 64 * (j))
#define XB_XGEN(j)  (2304 + 64 * (j))
#define XB_TOP      3328
#define XB_TOPGEN   3392
#define XCD_BAR_WORDS 3456
#define XB_SPIN_CAP (1u << 18)

__device__ __forceinline__ unsigned xb_ld(unsigned* p)              { return __hip_atomic_load(p, __ATOMIC_RELAXED, __HIP_MEMORY_SCOPE_AGENT); }
__device__ __forceinline__ unsigned xb_add(unsigned* p, unsigned v) { return __hip_atomic_fetch_add(p, v, __ATOMIC_RELAXED, __HIP_MEMORY_SCOPE_AGENT); }
__device__ __forceinline__ unsigned xb_xcc_id() { return (unsigned)__builtin_amdgcn_s_getreg((3 << 11) | 20) & 0xFu; }
#define XB_SPIN(cond, bar) do { unsigned _sp = 0; while (cond) { __builtin_amdgcn_s_sleep(1); \
    if ((++_sp & 255u) == 0u) { if (xb_ld(&(bar)[XB_TMO])) break; if (_sp > XB_SPIN_CAP) { atomicAdd(&(bar)[XB_TMO], 1u); break; } } } } while (0)

struct XcdBarrier {
    unsigned* bar; unsigned x;
    volatile LAS unsigned* st;
};

__device__ __forceinline__ XcdBarrier xcd_barrier_post(unsigned* bar, volatile LAS unsigned* st) {
    XcdBarrier b; b.bar = bar; b.x = xb_xcc_id(); b.st = st;
    if (threadIdx.x == 0) (void)xb_add(&bar[XB_XCNT(b.x)], 1u);
    return b;
}
__device__ __forceinline__ void xcd_barrier_complete(unsigned* bar, unsigned x, unsigned& nloc, unsigned& nx) {
    const unsigned G = gridDim.x * gridDim.y * gridDim.z;
    unsigned sum, cnt, mine, sp = 0u;
    for (;;) {
        sum = 0u; cnt = 0u; mine = 0u;
#pragma unroll
        for (unsigned j = 0; j < 16; ++j) { const unsigned c = xb_ld(&bar[XB_XCNT(j)]); sum += c; cnt += (c > 0u) ? 1u : 0u; mine = (j == x) ? c : mine; }
        if (sum == G) break;
        __builtin_amdgcn_s_sleep(1);
        if ((++sp & 255u) == 0u) { if (xb_ld(&bar[XB_TMO])) break; if (sp > XB_SPIN_CAP) { atomicAdd(&bar[XB_TMO], 1u); break; } }
    }
    nloc = mine > 0u ? mine : 1u; nx = cnt > 0u ? cnt : 1u;
}

__device__ __forceinline__ void xcd_barrier(const XcdBarrier& b) {
    asm volatile("s_waitcnt vmcnt(0)" ::: "memory");
    __syncthreads();
    if (threadIdx.x == 0) {
        unsigned* bar = b.bar;
        __builtin_amdgcn_s_waitcnt(0);
        unsigned nloc = b.st[0], nx = b.st[1];
        if (nloc == 0u) { xcd_barrier_complete(bar, b.x, nloc, nx); b.st[0] = nloc; b.st[1] = nx; }
        const unsigned old = xb_add(&bar[XB_XSUB(b.x)], 1u);
        const unsigned gen = old / nloc;
        if (old + 1u == (gen + 1u) * nloc) {
            __builtin_amdgcn_fence(__ATOMIC_RELEASE, "agent");
            asm volatile("s_waitcnt vmcnt(0)" ::: "memory");
            const unsigned og = xb_add(&bar[XB_TOP], 1u);
            const unsigned tg = og / nx;
            if (og + 1u == (tg + 1u) * nx) xb_add(&bar[XB_TOPGEN], 1u);
            else XB_SPIN(xb_ld(&bar[XB_TOPGEN]) == tg, bar);
            __builtin_amdgcn_fence(__ATOMIC_ACQUIRE, "agent");
            xb_add(&bar[XB_XGEN(b.x)], 1u);
            asm volatile("s_waitcnt vmcnt(0)" ::: "memory");
        } else {
            XB_SPIN(xb_ld(&bar[XB_XGEN(b.x)]) == gen, bar);
            __builtin_amdgcn_fence(__ATOMIC_ACQUIRE, "agent");
            asm volatile("s_waitcnt vmcnt(0)" ::: "memory");
        }
    }
    __syncthreads();
}

constexpr size_t MiB = 1u << 20;
constexpr size_t WS_CTL = 0, CTL_ZERO_BYTES = 1 * MiB;
constexpr size_t WS_WIN = 1 * MiB;
constexpr size_t WS_WO = WS_WIN + (size_t)31 * 256 * 1024 * 2;
constexpr size_t WS_WOUT = WS_WO + (size_t)3 * 1024 * 512 * 2;
constexpr size_t WS_WPG = WS_WOUT + (size_t)1024 * 1024 * 2;
constexpr size_t WS_WPLE = WS_WPG + (size_t)1024 * 1024 * 2;
constexpr size_t WS_WGU = WS_WPLE + (size_t)1024 * 256 * 2;
constexpr size_t WS_WDN = WS_WGU + (size_t)16 * 1024 * 1024 * 2;
constexpr size_t WS_WEND = WS_WDN + (size_t)16 * 1024 * 512 * 2;
static_assert(WS_WEND <= 73 * MiB, "weights");
constexpr size_t WS_HN = 73 * MiB;
constexpr size_t WS_PB = WS_HN + (size_t)NTOK * DM * 2;
constexpr size_t WS_Z = WS_PB + (size_t)NTOK * PLE * 2;
constexpr size_t WS_ZEND = WS_Z + (size_t)NTOK * ZP * 2;
constexpr size_t WS_SLOC = WS_ZEND;
constexpr size_t WS_DTAB = WS_SLOC + (size_t)2048 * 8192 * 2;
constexpr size_t WS_ROUTE = WS_DTAB + (size_t)2048 * 64 * 4;
constexpr size_t WS_HIST = WS_ROUTE + (size_t)NTOK * 16;
constexpr size_t WS_TBL = WS_HIST + (size_t)GRID * 16 * 4;
constexpr size_t WS_TOKSLOT = WS_TBL + 256;
constexpr size_t WS_SLOTW = WS_TOKSLOT + (size_t)NTOK * 8;
constexpr size_t WS_END = WS_SLOTW + (size_t)NSLOT * 4;
constexpr size_t WS_HG = WS_Z;
constexpr size_t WS_ACT = WS_HG + (size_t)NSLOT * DM * 2;
constexpr size_t WS_PL = WS_ACT + (size_t)NSLOT * DEXP * 2;
static_assert(WS_PL + (size_t)NTOK * DM * 2 <= WS_ZEND, "MoE overlay fits inside Z");
constexpr int CW_BAR = 4096;
constexpr int CW_QHEAD = 8192, CW_KN = 8192 + 256;

constexpr int RING_BYTES = 131072;
constexpr int LDSCTL_OFF = RING_BYTES, MISC_OFF = LDSCTL_OFF + 320;
constexpr int LDS_BYTES = 147456;

__device__ __forceinline__ void tr_item(const float* W, int ldw, int col0, int K, bf16_t* WT, int nrows, int valid, LAS float* scr, int item, int lane) {
    const int nblk = nrows / 32, kb = item / nblk, nb = item % nblk, k0 = 64 * kb, n0 = 32 * nb;
    const bool ok = (n0 + (lane & 31)) < valid;
#pragma unroll 8
    for (int i = 0; i < 32; ++i) { const int kk = 2 * i + (lane >> 5); scr[kk * 33 + (lane & 31)] = ok ? W[(size_t)(k0 + kk) * ldw + col0 + n0 + (lane & 31)] : 0.f; }
    LDS_WAIT(); asm volatile("" ::: "memory");
    const int c = lane & 7;
#pragma unroll
    for (int j = 0; j < 4; ++j) { const int n = (lane >> 3) + 8 * j; const LAS float* s = scr + (8 * c) * 33 + n;
        u32x4 o; o.x = pk2(s[0 * 33], s[1 * 33]); o.y = pk2(s[2 * 33], s[3 * 33]); o.z = pk2(s[4 * 33], s[5 * 33]); o.w = pk2(s[6 * 33], s[7 * 33]);
        *(u32x4*)(WT + (size_t)(n0 + n) * K + k0 + 8 * c) = o; }
    LDS_WAIT(); asm volatile("" ::: "memory");
}
__device__ __forceinline__ int win_src_col(int t) {
    if (t < 4) return 256 * t;
    if (t < 8) return 2064 + 256 * (t - 4);
    if (t < 10) return 3088 + 256 * (t - 8);
    if (t < 12) return 4112 + 256 * (t - 10);
    if (t == 12) return 1536;
    if (t < 15) return 1024 + 256 * (t - 13);
    if (t < 17) return 1552 + 256 * (t - 15);
    if (t < 19) return 3600 + 256 * (t - 17);
    return 4624 + 256 * (t - 19);
}
template <int NR> __device__ __forceinline__ void rms_rows_bf16(const float* x, const float* g, bf16_t* o, int m0, int mstep, int lane) {
    f32x4 v[NR][4]; float s[NR];
#pragma unroll
    for (int q = 0; q < NR; ++q) { const f32x4* xr = (const f32x4*)(x + (size_t)(m0 + q * mstep) * DM) + lane;
#pragma unroll
        for (int j = 0; j < 4; ++j) v[q][j] = xr[64 * j]; }
    const f32x4* gr = (const f32x4*)g + lane; f32x4 gg[4];
#pragma unroll
    for (int j = 0; j < 4; ++j) gg[j] = gr[64 * j];
#pragma unroll
    for (int q = 0; q < NR; ++q) { s[q] = 0.f;
#pragma unroll
        for (int j = 0; j < 4; ++j) s[q] += (v[q][j].x * v[q][j].x + v[q][j].y * v[q][j].y) + (v[q][j].z * v[q][j].z + v[q][j].w * v[q][j].w); }
#pragma unroll
    for (int q = 0; q < NR; ++q) s[q] = wave_sum_dpp(s[q]);
#pragma unroll
    for (int q = 0; q < NR; ++q) { const float r = 1.0f / sqrtf(s[q] * (1.f / DM) + EPS); u32x2* o8 = (u32x2*)(o + (size_t)(m0 + q * mstep) * DM) + lane;
#pragma unroll
        for (int j = 0; j < 4; ++j) { u32x2 w; w.x = pk2(v[q][j].x * r * gg[j].x, v[q][j].y * r * gg[j].y); w.y = pk2(v[q][j].z * r * gg[j].z, v[q][j].w * r * gg[j].w); o8[64 * j] = w; } }
}

struct Ptrs { const float* in[24]; float* out; unsigned char* ws; };
struct Args { Ptrs p; int ph_lo, ph_hi; };
typedef const __attribute__((address_space(4))) Args* KA;

__device__ __forceinline__ void phaseA(KA P, int L, LAS unsigned char* lds, int vcu, int G, int wave, int lane, int tid) {
    LAS float* scr = (LAS float*)(lds + wave * 16384);
    const int gw = vcu * 8 + wave, NGW = G * 8;
    unsigned char* ws = P->p.ws;
    constexpr int I_WIN = 31 * 128, I_WO = 3 * 256, I_WOUT = 512, I_WPG = 512, I_WPLE = 128, I_WGU = 16 * 512, I_WDN = 16 * 256;
    constexpr int NITEMS = I_WIN + I_WO + I_WOUT + I_WPG + I_WPLE + I_WGU + I_WDN;
    for (int it = gw; it < NITEMS; it += NGW) {
        int r = it;
        if (r < I_WIN) { const int t = r / 128; tr_item(P->p.in[3] + (size_t)L * DM * INTOT, INTOT, win_src_col(t), DM, (bf16_t*)(ws + WS_WIN) + (size_t)t * 256 * DM, 256, t == 12 ? 16 : 256, scr, r % 128, lane); continue; } r -= I_WIN;
        if (r < I_WO) { const int j = r / 256; const float* src = (j == 0 ? P->p.in[7] : j == 1 ? P->p.in[10] : P->p.in[12]) + (size_t)L * 512 * DM;
            tr_item(src, DM, 0, 512, (bf16_t*)(ws + WS_WO) + (size_t)j * DM * 512, DM, DM, scr, r % 256, lane); continue; } r -= I_WO;
        if (r < I_WOUT) { tr_item(P->p.in[13] + (size_t)L * DM * DM, DM, 0, DM, (bf16_t*)(ws + WS_WOUT), DM, DM, scr, r, lane); continue; } r -= I_WOUT;
        if (r < I_WPG) { tr_item(P->p.in[22] + (size_t)L * DM * DM, DM, 0, DM, (bf16_t*)(ws + WS_WPG), DM, DM, scr, r, lane); continue; } r -= I_WPG;
        if (r < I_WPLE) { tr_item(P->p.in[21] + (size_t)L * PLE * DM, DM, 0, PLE, (bf16_t*)(ws + WS_WPLE), DM, DM, scr, r, lane); continue; } r -= I_WPLE;
        if (r < I_WGU) { const int e = r / 512, q = (r % 512) / 64, n = q >> 1, s = q & 1;
            tr_item(P->p.in[19] + (size_t)(L * NEXP + e) * DM * 1024, 1024, 512 * s + 128 * n, DM, (bf16_t*)(ws + WS_WGU) + (size_t)e * 1024 * DM + (size_t)(256 * n + 128 * s) * DM, 128, 128, scr, r % 64, lane); continue; } r -= I_WGU;
        { const int e = r / 256; tr_item(P->p.in[20] + (size_t)(L * NEXP + e) * DEXP * DM, DM, 0, DEXP, (bf16_t*)(ws + WS_WDN) + (size_t)e * DM * DEXP, DM, DM, scr, r % 256, lane); }
    }
    const float* xs = (L == 0) ? P->p.in[0] : P->p.out;
    for (int m = gw; m < NTOK; m += 4 * NGW) rms_rows_bf16<4>(xs, P->p.in[2] + (size_t)L * DM, (bf16_t*)(ws + WS_HN), m, NGW, lane);
    const f32x4* ps = (const f32x4*)(P->p.in[1] + (size_t)L * NTOK * PLE); u32x2* pd = (u32x2*)(ws + WS_PB);
    for (int i = vcu * 512 + tid; i < NTOK * PLE / 4; i += G * 512) { const f32x4 v = ps[i]; u32x2 w; w.x = pk2(v.x, v.y); w.y = pk2(v.z, v.w); pd[i] = w; }
}

__device__ __forceinline__ void gla1_load_w(const float* wa2, const float* ba, LAS unsigned char* lds, int tid) {
    LAS float* WA = (LAS float*)(lds + 49152); LAS float* BA = (LAS float*)(lds + 65536);
    for (int i = tid; i < 4096; i += 512) WA[i] = wa2[i];
    if (tid < 256) BA[tid] = ba[tid];
    __syncthreads();
}
__device__ __forceinline__ float logsig16_l2(float x) {
    const float a = fabsf(x) * 1.4426950408889634f; const float l = __builtin_amdgcn_logf(1.0f + __builtin_amdgcn_exp2f(-a));
    return (fminf(x, 0.f) * 1.4426950408889634f - l) * (1.0f / 16.0f); }
__device__ __forceinline__ void gla1_unit(int unit, bf16_t* Z, bf16_t* SLOCT, float* DTAB, LAS unsigned char* lds, int wid, int lane, int tid, int dry = 0) {
    const int bh = unit >> 8, c = unit & 255, b = bh >> 2, h = bh & 3; const size_t row0 = (size_t)b * T + (size_t)c * 64;
    LAS bf16_t* Qs = (LAS bf16_t*)lds; LAS bf16_t* Ks = (LAS bf16_t*)(lds + 8192); LAS bf16_t* KhT = (LAS bf16_t*)(lds + 16384); LAS bf16_t* VT = (LAS bf16_t*)(lds + 24576);
    LAS bf16_t* Am = (LAS bf16_t*)(lds + 40960); const LAS float* WA = (const LAS float*)(lds + 49152); const LAS float* BA = (const LAS float*)(lds + 65536);
    const int r32 = lane & 31, hi = lane >> 5;
    {
        const int t = lane, cb = wid * 8; const bf16_t* zr = Z + (row0 + t) * ZP;
        const u32x4 g0 = *(const u32x4*)(zr + C_GA), g1 = *(const u32x4*)(zr + C_GA + 8);
        const u32x4 qv = *(const u32x4*)(zr + C_GQ + h * 64 + cb), kv = *(const u32x4*)(zr + C_GK + h * 64 + cb);
        const u32x4 v0 = *(const u32x4*)(zr + C_GV + h * 128 + 16 * wid), v1 = *(const u32x4*)(zr + C_GV + h * 128 + 16 * wid + 8);
        float gaf[16]; gaf[0] = bflo(g0.x); gaf[1] = bfhi(g0.x); gaf[2] = bflo(g0.y); gaf[3] = bfhi(g0.y); gaf[4] = bflo(g0.z); gaf[5] = bfhi(g0.z); gaf[6] = bflo(g0.w); gaf[7] = bfhi(g0.w);
        gaf[8] = bflo(g1.x); gaf[9] = bfhi(g1.x); gaf[10] = bflo(g1.y); gaf[11] = bfhi(g1.y); gaf[12] = bflo(g1.z); gaf[13] = bfhi(g1.z); gaf[14] = bflo(g1.w); gaf[15] = bfhi(g1.w);
        float la[8];
        { const f32x4 b0 = *(const LAS f32x4*)(BA + h * 64 + cb), b1 = *(const LAS f32x4*)(BA + h * 64 + cb + 4);
          la[0] = b0.x; la[1] = b0.y; la[2] = b0.z; la[3] = b0.w; la[4] = b1.x; la[5] = b1.y; la[6] = b1.z; la[7] = b1.w; }
#pragma unroll
        for (int r = 0; r < 16; ++r) { const f32x4 w0 = *(const LAS f32x4*)(WA + r * 256 + h * 64 + cb), w1 = *(const LAS f32x4*)(WA + r * 256 + h * 64 + cb + 4);
            la[0] = fmaf(gaf[r], w0.x, la[0]); la[1] = fmaf(gaf[r], w0.y, la[1]); la[2] = fmaf(gaf[r], w0.z, la[2]); la[3] = fmaf(gaf[r], w0.w, la[3]);
            la[4] = fmaf(gaf[r], w1.x, la[4]); la[5] = fmaf(gaf[r], w1.y, la[5]); la[6] = fmaf(gaf[r], w1.z, la[6]); la[7] = fmaf(gaf[r], w1.w, la[7]); }
#pragma unroll
        for (int i = 0; i < 8; ++i) la[i] = wave_scan_incl(logsig16_l2(la[i]));
        float qf[8], kf[8];
        qf[0] = bflo(qv.x); qf[1] = bfhi(qv.x); qf[2] = bflo(qv.y); qf[3] = bfhi(qv.y); qf[4] = bflo(qv.z); qf[5] = bfhi(qv.z); qf[6] = bflo(qv.w); qf[7] = bfhi(qv.w);
        kf[0] = bflo(kv.x); kf[1] = bfhi(kv.x); kf[2] = bflo(kv.y); kf[3] = bfhi(kv.y); kf[4] = bflo(kv.z); kf[5] = bfhi(kv.z); kf[6] = bflo(kv.w); kf[7] = bfhi(kv.w);
        float qs[8], ks[8];
#pragma unroll
        for (int i = 0; i < 8; ++i) { const float bl = rdl(la[i], 63); const float eb = __builtin_amdgcn_exp2f(la[i]);
            qs[i] = qf[i] * 0.125f * eb; ks[i] = kf[i] * __builtin_amdgcn_exp2f(-la[i]);
            KhT[(cb + i) * 64 + t] = (bf16_t)f2bf(kf[i] * __builtin_amdgcn_exp2f(bl - la[i]));
            if (lane == 63) DTAB[(size_t)unit * 64 + cb + i] = eb; }
        u32x4 qw, kw; qw.x = pk2(qs[0], qs[1]); qw.y = pk2(qs[2], qs[3]); qw.z = pk2(qs[4], qs[5]); qw.w = pk2(qs[6], qs[7]);
        kw.x = pk2(ks[0], ks[1]); kw.y = pk2(ks[2], ks[3]); kw.z = pk2(ks[4], ks[5]); kw.w = pk2(ks[6], ks[7]);
        *(LAS u32x4*)(Qs + t * 64 + cb) = qw; *(LAS u32x4*)(Ks + t * 64 + cb) = kw;
        if (!dry) *(u32x4*)(Z + (row0 + t) * ZP + C_GQ + h * 64 + cb) = qw;
        LAS bf16_t* vt = VT + (16 * wid) * 64 + t;
        vt[0 * 64] = (bf16_t)(v0.x & 0xffff); vt[1 * 64] = (bf16_t)(v0.x >> 16); vt[2 * 64] = (bf16_t)(v0.y & 0xffff); vt[3 * 64] = (bf16_t)(v0.y >> 16);
        vt[4 * 64] = (bf16_t)(v0.z & 0xffff); vt[5 * 64] = (bf16_t)(v0.z >> 16); vt[6 * 64] = (bf16_t)(v0.w & 0xffff); vt[7 * 64] = (bf16_t)(v0.w >> 16);
        vt[8 * 64] = (bf16_t)(v1.x & 0xffff); vt[9 * 64] = (bf16_t)(v1.x >> 16); vt[10 * 64] = (bf16_t)(v1.y & 0xffff); vt[11 * 64] = (bf16_t)(v1.y >> 16);
        vt[12 * 64] = (bf16_t)(v1.z & 0xffff); vt[13 * 64] = (bf16_t)(v1.z >> 16); vt[14 * 64] = (bf16_t)(v1.w & 0xffff); vt[15 * 64] = (bf16_t)(v1.w >> 16);
    }
    __syncthreads();
    {
        const int vb = wid & 3, kb = wid >> 2; f32x16 acc = {};
#pragma unroll
        for (int ks = 0; ks < 4; ++ks) { const bf16x8 a = *(const LAS bf16x8*)(KhT + (32 * kb + r32) * 64 + 16 * ks + 8 * hi); const bf16x8 bb = *(const LAS bf16x8*)(VT + (32 * vb + r32) * 64 + 16 * ks + 8 * hi);
            acc = __builtin_amdgcn_mfma_f32_32x32x16_bf16(a, bb, acc, 0, 0, 0); }
        bf16_t* sp = SLOCT + (size_t)unit * 8192 + (32 * vb + r32) * 64 + 32 * kb + 4 * hi;
#pragma unroll
        for (int g = 0; g < 4; ++g) { u32x2 w; w.x = pk2(acc[4 * g], acc[4 * g + 1]); w.y = pk2(acc[4 * g + 2], acc[4 * g + 3]); *(u32x2*)(sp + 8 * g) = w; }
    }
    if (wid < 4) {
        const int sb = wid >> 1, tb = wid & 1; f32x16 acc = {};
        if (!(sb == 1 && tb == 0)) {
#pragma unroll
            for (int ks = 0; ks < 4; ++ks) { const bf16x8 a = *(const LAS bf16x8*)(Ks + (32 * sb + r32) * 64 + 16 * ks + 8 * hi); const bf16x8 bb = *(const LAS bf16x8*)(Qs + (32 * tb + r32) * 64 + 16 * ks + 8 * hi);
                acc = __builtin_amdgcn_mfma_f32_32x32x16_bf16(a, bb, acc, 0, 0, 0); }
        }
        const int t = 32 * tb + r32;
#pragma unroll
        for (int r = 0; r < 16; ++r) { const int s = 32 * sb + crow(r, hi); if (s > t) acc[r] = 0.f; }
#pragma unroll
        for (int g = 0; g < 4; ++g) { u32x2 w; w.x = pk2(acc[4 * g], acc[4 * g + 1]); w.y = pk2(acc[4 * g + 2], acc[4 * g + 3]); *(LAS u32x2*)(Am + t * 64 + 32 * sb + 8 * g + 4 * hi) = w; }
    }
    __syncthreads();
    {
        const int vb = wid & 3, tb = wid >> 2; f32x16 acc = {};
#pragma unroll
        for (int ks = 0; ks < 4; ++ks) { const bf16x8 a = *(const LAS bf16x8*)(VT + (32 * vb + r32) * 64 + 16 * ks + 8 * hi); const bf16x8 bb = *(const LAS bf16x8*)(Am + (32 * tb + r32) * 64 + 16 * ks + 8 * hi);
            acc = __builtin_amdgcn_mfma_f32_32x32x16_bf16(a, bb, acc, 0, 0, 0); }
        bf16_t* op = Z + (row0 + 32 * tb + r32) * ZP + C_GV + h * 128 + 32 * vb + 4 * hi;
#pragma unroll
        for (int g = 0; g < 4; ++g) { u32x2 w; w.x = pk2(acc[4 * g], acc[4 * g + 1]); w.y = pk2(acc[4 * g + 2], acc[4 * g + 3]); if (!dry) *(u32x2*)(op + 8 * g) = w; }
    }
    __syncthreads();
}

__device__ __forceinline__ void conv_ld_u(const bf16_t* Z, size_t row, int ch, float (&u)[8]) {
    const u32x4 a = *(const u32x4*)(Z + row * ZP + C_CX + ch), c = *(const u32x4*)(Z + row * ZP + C_CC + ch);
    u[0] = bflo(a.x) * bflo(c.x); u[1] = bfhi(a.x) * bfhi(c.x); u[2] = bflo(a.y) * bflo(c.y); u[3] = bfhi(a.y) * bfhi(c.y);
    u[4] = bflo(a.z) * bflo(c.z); u[5] = bfhi(a.z) * bfhi(c.z); u[6] = bflo(a.w) * bflo(c.w); u[7] = bfhi(a.w) * bfhi(c.w);
}
__device__ __forceinline__ void conv_unit(int cu, bf16_t* Z, const float* cw  , int wid, int lane, int dry = 0) {
    const int ch = lane * 8; const size_t r0 = (size_t)cu * 128 + (size_t)wid * 16;
    float w0[8], w1[8], w2[8];
#pragma unroll
    for (int i = 0; i < 8; ++i) { w0[i] = cw[ch + i]; w1[i] = cw[512 + ch + i]; w2[i] = cw[1024 + ch + i]; }
    float u2[8], u1[8];
    if ((r0 % T) == 0) {
#pragma unroll
        for (int i = 0; i < 8; ++i) { u2[i] = 0.f; u1[i] = 0.f; }
    } else { conv_ld_u(Z, r0 - 2, ch, u2); conv_ld_u(Z, r0 - 1, ch, u1); }
    for (int i = 0; i < 16; ++i) { const size_t row = r0 + i; float u[8]; conv_ld_u(Z, row, ch, u);
        const u32x4 bq = *(const u32x4*)(Z + row * ZP + C_CB + ch);
        float bb[8]; bb[0] = bflo(bq.x); bb[1] = bfhi(bq.x); bb[2] = bflo(bq.y); bb[3] = bfhi(bq.y); bb[4] = bflo(bq.z); bb[5] = bfhi(bq.z); bb[6] = bflo(bq.w); bb[7] = bfhi(bq.w);
        float y[8];
#pragma unroll
        for (int k = 0; k < 8; ++k) { y[k] = bb[k] * (w0[k] * u2[k] + w1[k] * u1[k] + w2[k] * u[k]); u2[k] = u1[k]; u1[k] = u[k]; }
        u32x4 o; o.x = pk2(y[0], y[1]); o.y = pk2(y[2], y[3]); o.z = pk2(y[4], y[5]); o.w = pk2(y[6], y[7]);
        if (!dry) *(u32x4*)(Z + row * ZP + C_OC + ch) = o; }
}

__device__ __forceinline__ void knorm_unit(int cu, const bf16_t* Z, unsigned* KN  , LAS unsigned char* lds, int wid, int lane, int tid) {
    const size_t r0 = (size_t)cu * 128 + (size_t)wid * 16; float mx = 0.f;
    for (int i = 0; i < 16; ++i) { const u32x4 a = *(const u32x4*)(Z + (r0 + i) * ZP + C_DK + lane * 8);
        const float f0 = bflo(a.x), f1 = bfhi(a.x), f2 = bflo(a.y), f3 = bfhi(a.y), f4 = bflo(a.z), f5 = bfhi(a.z), f6 = bflo(a.w), f7 = bfhi(a.w);
        float s = (f0 * f0 + f1 * f1) + (f2 * f2 + f3 * f3) + (f4 * f4 + f5 * f5) + (f6 * f6 + f7 * f7);
        s += __shfl_xor(s, 1); s += __shfl_xor(s, 2); s += __shfl_xor(s, 4);
        mx = fmaxf(mx, s); }
    mx = fmaxf(mx, __shfl_xor(mx, 8));
    LAS float* SC = (LAS float*)lds;
    if ((lane & 15) == 0) SC[wid * 4 + (lane >> 4)] = mx;
    __syncthreads();
    if (tid < 4) { float v = SC[tid];
#pragma unroll
        for (int w = 1; w < 8; ++w) v = fmaxf(v, SC[w * 4 + tid]);
        const int b = (int)(((size_t)cu * 128) / T);
        __hip_atomic_fetch_max(KN + b * 4 + tid, __float_as_uint(v), __ATOMIC_RELAXED, __HIP_MEMORY_SCOPE_AGENT); }
    __syncthreads();
}
namespace att {
constexpr int KVBLK = 64;
constexpr size_t SHM_V = 64 * 128 * 2, SHM_K = 64 * 128 * 2;
constexpr float C = 0.125f * 1.4426950408889634f;
constexpr float THR2 = 10.f;
constexpr float WTHR = 40.f;
#define KSWZ(row, colB) ((row) * 256 + ((colB) ^ (((row) & 7) << 4)))
#define SBAR() __builtin_amdgcn_sched_barrier(0)
__device__ __forceinline__ unsigned cvtpk(float lo, float hi) { unsigned r; asm volatile("v_cvt_pk_bf16_f32 %0, %1, %2" : "=v"(r) : "v"(lo), "v"(hi)); return r; }

__device__ __forceinline__ void partialSM(f32x16& p0, f32x16& p1, float& m_reg, float& alpha, float tc, float c32, bool band, int dlim, float mlb, bool& skip) {
    if (band) {
#pragma unroll
        for (int r = 0; r < 16; ++r) { const int cr = (r & 3) + 8 * (r >> 2); if (cr > dlim) p0[r] = -1e30f; if (cr + 32 > dlim) p1[r] = -1e30f; }
    }
    float pm0 = p0[0], pm1 = p1[0];
#pragma unroll
    for (int r = 1; r < 16; ++r) { pm0 = fmaxf(pm0, p0[r]); pm1 = fmaxf(pm1, p1[r]); }
    float pmax = fmaxf(pm0, pm1 + c32) + tc;
    { auto rr = __builtin_amdgcn_permlane32_swap(__float_as_uint(pmax), __float_as_uint(pmax), false, false);
      pmax = fmaxf(__uint_as_float(rr[0]), __uint_as_float(rr[1])); }
    skip = __all(pmax < mlb - WTHR); alpha = 1.f;
    if (skip) return;
    if (__builtin_expect(__all(pmax - m_reg <= THR2), 1)) { }
    else { const float mn = fmaxf(m_reg, pmax); alpha = __builtin_amdgcn_exp2f(m_reg - mn); m_reg = mn; }
    const float s0 = m_reg - tc, s1 = s0 - c32;
#pragma unroll
    for (int r = 0; r < 16; ++r) { p0[r] -= s0; p1[r] -= s1; }
#pragma unroll
    for (int r = 0; r < 16; ++r) p0[r] = __builtin_amdgcn_exp2f(p0[r]);
}
__device__ __forceinline__ void finishSM(f32x16& p0, f32x16& p1, float alpha, float& l_reg, bf16x8& pa0, bf16x8& pa1, bf16x8& pa2, bf16x8& pa3) {
#pragma unroll
    for (int r = 0; r < 16; ++r) p1[r] = __builtin_amdgcn_exp2f(p1[r]);
    float ps = 0;
#pragma unroll
    for (int r = 0; r < 16; ++r) ps += p0[r];
#pragma unroll
    for (int r = 0; r < 16; ++r) ps += p1[r];
    { auto rr = __builtin_amdgcn_permlane32_swap(__float_as_uint(ps), __float_as_uint(ps), false, false);
      ps = __uint_as_float(rr[0]) + __uint_as_float(rr[1]); }
    l_reg = l_reg * alpha + ps;
#define PK4(P, BASE, OUT) do { unsigned a0 = cvtpk(P[BASE + 0], P[BASE + 1]), a1 = cvtpk(P[BASE + 2], P[BASE + 3]);   \
    unsigned b0 = cvtpk(P[BASE + 4], P[BASE + 5]), b1 = cvtpk(P[BASE + 6], P[BASE + 7]);                              \
    auto r0 = __builtin_amdgcn_permlane32_swap(a0, b0, false, false); auto r1 = __builtin_amdgcn_permlane32_swap(a1, b1, false, false); \
    u32x4 w = {r0[0], r1[0], r0[1], r1[1]}; OUT = *reinterpret_cast<bf16x8*>(&w); } while (0)
    PK4(p0, 0, pa0); PK4(p0, 8, pa1); PK4(p1, 0, pa2); PK4(p1, 8, pa3);
#undef PK4
}
__device__ __forceinline__ void qkt(f32x16& p0, f32x16& p1, const char* Ks, const bf16x8* qr, const f32x16& biasv, int r32, int hi, int m) {
#pragma unroll
    for (int d0 = 0; d0 < 4; ++d0) { const int cb = ((4 * m + d0) * 16 + hi * 8) * 2;
        const bf16x8 b0 = *reinterpret_cast<const bf16x8*>(Ks + KSWZ(r32, cb));
        const bf16x8 b1 = *reinterpret_cast<const bf16x8*>(Ks + KSWZ(32 + r32, cb));
        if (d0 == 0) { p0 = __builtin_amdgcn_mfma_f32_32x32x16_bf16(b0, qr[0], biasv, 0, 0, 0); p1 = __builtin_amdgcn_mfma_f32_32x32x16_bf16(b1, qr[0], biasv, 0, 0, 0); }
        else { p0 = __builtin_amdgcn_mfma_f32_32x32x16_bf16(b0, qr[d0], p0, 0, 0, 0); p1 = __builtin_amdgcn_mfma_f32_32x32x16_bf16(b1, qr[d0], p1, 0, 0, 0); } }
}
__device__ __forceinline__ int v_st(int k, int c) { const int kk = (k & ~0xC) | ((k & 4) << 1) | ((k & 8) >> 1); return ((kk >> 3) * 4 + (c >> 5)) * 512 + ((kk & 7) * 32 + (c & 31)) * 2; }
__device__ __forceinline__ int v_rd_base(int lane) { return ((lane & 3) << 3) | (((lane >> 2) & 3) << 6) | (((lane >> 4) & 1) << 5) | (((lane >> 5) & 1) << 8); }
constexpr int v_rd_off(int d0, int ks, int half) { return d0 * 512 + ks * 4096 + half * 2048; }
template <int OFF> __device__ __forceinline__ s16x4 tr_read(int vb) {
    s16x4 r; asm volatile("ds_read_b64_tr_b16 %0, %1 offset:%2" : "=&v"(r) : "v"(vb), "i"(OFF) : "memory"); return r;
}
template <int D0> __device__ __forceinline__ void pv_one(f32x16& od, int vb, bf16x8 pa0, bf16x8 pa1, bf16x8 pa2, bf16x8 pa3) {
    const s16x4 l0 = tr_read<v_rd_off(D0, 0, 0)>(vb), h0 = tr_read<v_rd_off(D0, 0, 1)>(vb), l1 = tr_read<v_rd_off(D0, 1, 0)>(vb), h1 = tr_read<v_rd_off(D0, 1, 1)>(vb);
    const s16x4 l2 = tr_read<v_rd_off(D0, 2, 0)>(vb), h2 = tr_read<v_rd_off(D0, 2, 1)>(vb), l3 = tr_read<v_rd_off(D0, 3, 0)>(vb), h3 = tr_read<v_rd_off(D0, 3, 1)>(vb);
    asm volatile("s_waitcnt lgkmcnt(0)" ::: "memory"); SBAR();
#define PK(L, H) (bf16x8){L[0], L[1], L[2], L[3], H[0], H[1], H[2], H[3]}
    od = __builtin_amdgcn_mfma_f32_32x32x16_bf16(pa0, PK(l0, h0), od, 0, 0, 0);
    od = __builtin_amdgcn_mfma_f32_32x32x16_bf16(pa1, PK(l1, h1), od, 0, 0, 0);
    od = __builtin_amdgcn_mfma_f32_32x32x16_bf16(pa2, PK(l2, h2), od, 0, 0, 0);
    od = __builtin_amdgcn_mfma_f32_32x32x16_bf16(pa3, PK(l3, h3), od, 0, 0, 0);
#undef PK
}
__device__ __forceinline__ void pv_d0(f32x16* o, int vb, bf16x8 pa0, bf16x8 pa1, bf16x8 pa2, bf16x8 pa3) {
    pv_one<0>(o[0], vb, pa0, pa1, pa2, pa3); pv_one<1>(o[1], vb, pa0, pa1, pa2, pa3); pv_one<2>(o[2], vb, pa0, pa1, pa2, pa3); pv_one<3>(o[3], vb, pa0, pa1, pa2, pa3);
}

__device__ __forceinline__ void unit(int b, int h, int qb, float lam, float oneml, float kn2, bf16_t* Z, const float* gdiff, char* lds, int dry = 0) {
    int tid_l = threadIdx.x; asm volatile("" : "+v"(tid_l)); const int tid = tid_l;
    const int wid = tid >> 6, lane = tid & 63, r32 = lane & 31, hi = lane >> 5, m = wid >> 2, rb = wid & 3;
    const size_t rowbase = (size_t)b * T; const int q0 = qb * 128;
    const float slope2 = exp2f(-2.f * (float)(h + 1)) * 1.4426950408889634f;
    char* V_lds = lds; char* K_lds = lds + 2 * SHM_V;
    float* wsf = (float*)(lds + 2 * SHM_V + 2 * SHM_K) + wid * 64; float* li_l = wsf; float* al_l = wsf + 32;
    float m_reg = -1e30f, l_reg = 0; f32x16 o[4] = {}; bf16x8 qr[4];
    const bf16_t* Qw = Z + (rowbase + q0 + rb * 32 + r32) * ZP + C_DQ + h * 128 + m * 64 + hi * 8;
    float qss = 0.f;
#pragma unroll
    for (int d0 = 0; d0 < 4; ++d0) { const u32x4 w = *reinterpret_cast<const u32x4*>(Qw + d0 * 16);
        const float f0 = bflo(w.x), f1 = bfhi(w.x), f2 = bflo(w.y), f3 = bfhi(w.y), f4 = bflo(w.z), f5 = bfhi(w.z), f6 = bflo(w.w), f7 = bfhi(w.w);
        qss += (f0 * f0 + f1 * f1) + (f2 * f2 + f3 * f3) + (f4 * f4 + f5 * f5) + (f6 * f6 + f7 * f7);
        u32x4 s; s.x = pk2(f0 * C, f1 * C); s.y = pk2(f2 * C, f3 * C); s.z = pk2(f4 * C, f5 * C); s.w = pk2(f6 * C, f7 * C); qr[d0] = __builtin_bit_cast(bf16x8, s); }
    { auto rr = __builtin_amdgcn_permlane32_swap(__float_as_uint(qss), __float_as_uint(qss), false, false); qss = __uint_as_float(rr[0]) + __uint_as_float(rr[1]); }
#pragma unroll
    for (int x = 1; x < 32; x <<= 1) qss = fmaxf(qss, __shfl_xor(qss, x));
    const bf16_t* Kh = Z + rowbase * ZP + C_DK + h * 128; const bf16_t* Vh = Z + rowbase * ZP + C_DV + h * 128;
    const int sr = tid >> 4, sc = (tid & 15) * 8, vst0 = v_st(sr, sc), vst1 = v_st(32 + sr, sc);
    const int vb0 = (int)(uintptr_t)V_lds + v_rd_base(lane);
    const int qrel = q0 + rb * 32 + r32;
    const float c32 = 32.f * slope2;
    f32x16 biasv;
#pragma unroll
    for (int r = 0; r < 16; ++r) biasv[r] = slope2 * (float)((r & 3) + 8 * (r >> 2));
    asm volatile("" : "+v"(biasv));
    struct { bf16x8 vs0, vs1, ks0, ks1; } sr_[1];
#define SLOAD(i, k0) do { sr_[i].vs0 = *reinterpret_cast<const bf16x8*>(&Vh[(size_t)((k0) + sr) * ZP + sc]); sr_[i].vs1 = *reinterpret_cast<const bf16x8*>(&Vh[(size_t)((k0) + 32 + sr) * ZP + sc]); \
    sr_[i].ks0 = *reinterpret_cast<const bf16x8*>(&Kh[(size_t)((k0) + sr) * ZP + sc]); sr_[i].ks1 = *reinterpret_cast<const bf16x8*>(&Kh[(size_t)((k0) + 32 + sr) * ZP + sc]); } while (0)
#define SWRITE(bb, i) do { *(bf16x8*)(V_lds + (bb) * SHM_V + vst0) = sr_[i].vs0;          \
    *(bf16x8*)(V_lds + (bb) * SHM_V + vst1) = sr_[i].vs1; const int kc = sc * 2;               \
    *(bf16x8*)(K_lds + (bb) * SHM_K + KSWZ(sr, kc)) = sr_[i].ks0;                       \
    *(bf16x8*)(K_lds + (bb) * SHM_K + KSWZ(32 + sr, kc)) = sr_[i].ks1; } while (0)
    const int NT = 2 * (qb + 1);
    float mband, mlb;
    { SLOAD(0, (NT - 2) * KVBLK); asm volatile("s_waitcnt vmcnt(0)" ::: "memory"); SWRITE(0, 0); SLOAD(0, (NT - 1) * KVBLK); asm volatile("s_waitcnt vmcnt(0)" ::: "memory"); SWRITE(1, 0);
      if (lane == 0) wsf[0] = qss; asm volatile("s_waitcnt lgkmcnt(0)" ::: "memory"); __syncthreads();
      f32x16 t0, t1; float mx = -1e30f;
#pragma unroll
      for (int bt = 0; bt < 2; ++bt) { const int j = NT - 2 + bt; qkt(t0, t1, K_lds + bt * SHM_K, qr, biasv, r32, hi, m); const int dlim = qrel - 64 * j - 4 * hi;
#pragma unroll
          for (int r = 0; r < 16; ++r) { const int cr = (r & 3) + 8 * (r >> 2); if (cr > dlim) t0[r] = -1e30f; if (cr + 32 > dlim) t1[r] = -1e30f; }
          float a0 = t0[0], a1 = t1[0];
#pragma unroll
          for (int r = 1; r < 16; ++r) { a0 = fmaxf(a0, t0[r]); a1 = fmaxf(a1, t1[r]); }
          mx = fmaxf(mx, fmaxf(a0, a1 + c32) + slope2 * (float)(64 * j + 4 * hi - qrel)); }
      { auto rr = __builtin_amdgcn_permlane32_swap(__float_as_uint(mx), __float_as_uint(mx), false, false); mx = fmaxf(__uint_as_float(rr[0]), __uint_as_float(rr[1])); }
      mlb = mx;
#pragma unroll
      for (int x = 1; x < 32; x <<= 1) mx = fminf(mx, __shfl_xor(mx, x));
      mband = mx; }
    float qn2 = 0.f;
#pragma unroll
    for (int w = 0; w < 8; ++w) qn2 = fmaxf(qn2, ((float*)(lds + 2 * SHM_V + 2 * SHM_K))[w * 64]);
    __syncthreads();
    if (lane == 0) wsf[0] = mband; asm volatile("s_waitcnt lgkmcnt(0)" ::: "memory"); __syncthreads();
    float mbmin = 1e30f;
#pragma unroll
    for (int w = 0; w < 8; ++w) mbmin = fminf(mbmin, ((float*)(lds + 2 * SHM_V + 2 * SHM_K))[w * 64]);
    const float wd = (WTHR + 1.02f * sqrtf(qn2) * sqrtf(kn2) * C - mbmin) / slope2;
    int jlo = (int)floorf(((float)(q0 - 63) - wd) * (1.f / 64.f)); jlo = jlo < 0 ? 0 : (jlo & ~1);
    jlo = __builtin_amdgcn_readfirstlane(jlo);
    __syncthreads();
#define SWAIT() asm volatile("s_waitcnt vmcnt(0)" ::: "memory")
#define RESC(a) do { if (__any((a) < 1.f)) { if (hi == 0) al_l[r32] = (a); asm volatile("s_waitcnt lgkmcnt(0)" ::: "memory"); \
    _Pragma("unroll") for (int d = 0; d < 4; ++d) _Pragma("unroll") for (int r = 0; r < 16; ++r) o[d][r] *= al_l[crow(r, hi)]; } } while (0)
#define PSM(P0, P1, AL, j, SK) partialSM(P0, P1, m_reg, AL, slope2 * (float)(64 * (j) + 4 * hi - qrel), c32, (j) >= NT - 2, qrel - 64 * (j) - 4 * hi, mlb, SK)
    f32x16 pA0, pA1, pB0, pB1; float alA, alB; bf16x8 pa0, pa1, pa2, pa3; bool skA, skB;
    constexpr int SE = 0, SO = 0;
    SLOAD(SE, jlo * KVBLK); asm volatile("s_waitcnt vmcnt(0)" ::: "memory"); SWRITE(0, SE); __syncthreads();
    qkt(pA0, pA1, K_lds, qr, biasv, r32, hi, m); PSM(pA0, pA1, alA, jlo, skA);
    SLOAD(SO, (jlo + 1) * KVBLK);
    SWAIT(); SWRITE(1, SO); __syncthreads();
    for (int j = jlo + 1; j + 1 < NT; j += 2) {
        SBAR(); qkt(pB0, pB1, K_lds + SHM_K, qr, biasv, r32, hi, m);
        if (!skA) finishSM(pA0, pA1, alA, l_reg, pa0, pa1, pa2, pa3); SBAR();
        SLOAD(SO, (j + 1) * KVBLK); SBAR();
        if (!skA) pv_d0(o, vb0, pa0, pa1, pa2, pa3); PSM(pB0, pB1, alB, j, skB);
        __syncthreads(); SWAIT(); SWRITE(0, SE);
        RESC(alB); __syncthreads();
        SBAR(); qkt(pA0, pA1, K_lds, qr, biasv, r32, hi, m);
        if (!skB) finishSM(pB0, pB1, alB, l_reg, pa0, pa1, pa2, pa3); SBAR();
        SLOAD(SE, (j + 2) * KVBLK); SBAR();
        if (!skB) pv_d0(o, vb0 + (int)SHM_V, pa0, pa1, pa2, pa3); PSM(pA0, pA1, alA, j + 1, skA);
        __syncthreads(); SWAIT(); SWRITE(1, SO);
        RESC(alA); __syncthreads();
    }
    SBAR(); qkt(pB0, pB1, K_lds + SHM_K, qr, biasv, r32, hi, m);
    if (!skA) finishSM(pA0, pA1, alA, l_reg, pa0, pa1, pa2, pa3); SBAR();
    if (!skA) pv_d0(o, vb0, pa0, pa1, pa2, pa3); PSM(pB0, pB1, alB, NT - 1, skB);
    __syncthreads(); RESC(alB);
    if (!skB) { finishSM(pB0, pB1, alB, l_reg, pa0, pa1, pa2, pa3); SBAR();
    pv_d0(o, vb0 + (int)SHM_V, pa0, pa1, pa2, pa3); }
    if (hi == 0) li_l[r32] = l_reg; asm volatile("s_waitcnt lgkmcnt(0)" ::: "memory");
    float rli[16];
#pragma unroll
    for (int r = 0; r < 16; ++r) rli[r] = __builtin_amdgcn_rcpf(li_l[crow(r, hi)]);
    __syncthreads();
    float* XO = (float*)lds + rb * 4096;
    if (m == 1) {
#pragma unroll
        for (int d0 = 0; d0 < 4; ++d0)
#pragma unroll
            for (int r = 0; r < 16; ++r) XO[(d0 * 16 + r) * 64 + lane] = o[d0][r] * rli[r];
    }
    __syncthreads();
    if (m == 0) {
        float ss[16];
#pragma unroll
        for (int r = 0; r < 16; ++r) ss[r] = 0.f;
#pragma unroll
        for (int d0 = 0; d0 < 4; ++d0)
#pragma unroll
            for (int r = 0; r < 16; ++r) { const float v = o[d0][r] * rli[r] - lam * XO[(d0 * 16 + r) * 64 + lane]; o[d0][r] = v; ss[r] += v * v; }
#pragma unroll
        for (int r = 0; r < 16; ++r) {
#pragma unroll
            for (int x = 1; x < 32; x <<= 1) ss[r] += __shfl_xor(ss[r], x);
            ss[r] = oneml / sqrtf(ss[r] * (1.f / 128.f) + EPS); }
        bf16_t* Ow = Z + (rowbase + q0 + rb * 32) * ZP + C_OB + h * 128 + r32;
#pragma unroll
        for (int d0 = 0; d0 < 4; ++d0) { const float gc = gdiff[32 * d0 + r32];
#pragma unroll
            for (int r = 0; r < 16; ++r) if (!dry) Ow[(size_t)crow(r, hi) * ZP + 32 * d0] = (bf16_t)f2bf(o[d0][r] * ss[r] * gc); }
    }
    __syncthreads();
#undef SLOAD
#undef SWRITE
#undef SWAIT
#undef RESC
#undef PSM
}
#undef KSWZ
#undef SBAR
}

__device__ __forceinline__ void gla_scan(bf16_t* SLOCT, const float* DTAB, LAS unsigned char* lds, int G, int bx, int tid) {
    const int seg = tid >> 5, pl = tid & 31; LAS f32x4* PR = (LAS f32x4*)lds;
    for (int grp = bx; grp < 1024; grp += G) {
        const int pi = grp * 32 + pl, bh = pi >> 12, e2 = (pi & 4095) * 2, dk = e2 & 63;
        unsigned* sp = (unsigned*)(SLOCT + (size_t)bh * 256 * 8192 + e2) + (size_t)(seg * 16) * 4096; const float* dp = DTAB + (size_t)bh * 256 * 64 + dk + (size_t)(seg * 16) * 64;
        unsigned u[16]; f32x2 d[16];
#pragma unroll
        for (int i = 0; i < 16; ++i) { u[i] = sp[(size_t)i * 4096]; d[i] = *(const f32x2*)(dp + (size_t)i * 64); }
        float r0 = 0.f, r1 = 0.f, P0 = 1.f, P1 = 1.f;
#pragma unroll
        for (int i = 0; i < 16; ++i) { r0 = fmaf(d[i].x, r0, bflo(u[i])); r1 = fmaf(d[i].y, r1, bfhi(u[i])); P0 *= d[i].x; P1 *= d[i].y; }
        PR[seg * 32 + pl] = (f32x4){P0, P1, r0, r1};
        __syncthreads();
        float i0 = 0.f, i1 = 0.f;
        for (int s = 0; s < seg; ++s) { const f32x4 q = PR[s * 32 + pl]; i0 = fmaf(q.x, i0, q.z); i1 = fmaf(q.y, i1, q.w); }
#pragma unroll
        for (int i = 0; i < 16; ++i) { sp[(size_t)i * 4096] = pk2(i0, i1); i0 = fmaf(d[i].x, i0, bflo(u[i])); i1 = fmaf(d[i].y, i1, bfhi(u[i])); }
        __syncthreads();
    }
}

__device__ __forceinline__ void gla3_unit(int unit, bf16_t* Z, const bf16_t* SLOCT, const float* ggn, LAS unsigned char* lds, int wid, int lane, int dry = 0) {
    const int bh = unit >> 8, c = unit & 255, b = bh >> 2, h = bh & 3; const size_t row0 = (size_t)b * T + (size_t)c * 64;
    const int r32 = lane & 31, hi = lane >> 5, vb = wid & 3, tb = wid >> 2;
    LAS float* SS = (LAS float*)lds;
    const bf16_t* zr = Z + (row0 + 32 * tb + r32) * ZP;
    bf16x8 af[4], bfv[4];
#pragma unroll
    for (int ks = 0; ks < 4; ++ks) { af[ks] = *(const bf16x8*)(SLOCT + (size_t)unit * 8192 + (32 * vb + r32) * 64 + 16 * ks + 8 * hi); bfv[ks] = *(const bf16x8*)(zr + C_GQ + h * 64 + 16 * ks + 8 * hi); }
    u32x2 oi[4], gq[4]; f32x4 gn[4];
#pragma unroll
    for (int g = 0; g < 4; ++g) { oi[g] = *(const u32x2*)(zr + C_GV + h * 128 + 32 * vb + 8 * g + 4 * hi); gq[g] = *(const u32x2*)(zr + C_GG + h * 128 + 32 * vb + 8 * g + 4 * hi);
        gn[g] = *(const f32x4*)(ggn + 32 * vb + 8 * g + 4 * hi); }
    f32x16 acc = {};
#pragma unroll
    for (int ks = 0; ks < 4; ++ks) acc = __builtin_amdgcn_mfma_f32_32x32x16_bf16(af[ks], bfv[ks], acc, 0, 0, 0);
    float o[16], ss = 0.f;
#pragma unroll
    for (int g = 0; g < 4; ++g) { o[4 * g] = acc[4 * g] + bflo(oi[g].x); o[4 * g + 1] = acc[4 * g + 1] + bfhi(oi[g].x); o[4 * g + 2] = acc[4 * g + 2] + bflo(oi[g].y); o[4 * g + 3] = acc[4 * g + 3] + bfhi(oi[g].y); }
#pragma unroll
    for (int r = 0; r < 16; ++r) ss += o[r] * o[r];
    { auto rr = __builtin_amdgcn_permlane32_swap(__float_as_uint(ss), __float_as_uint(ss), false, false); ss = __uint_as_float(rr[0]) + __uint_as_float(rr[1]); }
    if (hi == 0) SS[wid * 32 + r32] = ss;
    __syncthreads();
    const float tot = (SS[(tb * 4 + 0) * 32 + r32] + SS[(tb * 4 + 1) * 32 + r32]) + (SS[(tb * 4 + 2) * 32 + r32] + SS[(tb * 4 + 3) * 32 + r32]);
    const float rstd = 1.0f / sqrtf(tot * (1.f / 128.f) + EPS);
    bf16_t* gp = Z + (row0 + 32 * tb + r32) * ZP + C_GG + h * 128 + 32 * vb + 4 * hi;
#pragma unroll
    for (int g = 0; g < 4; ++g) { const float g0 = bflo(gq[g].x), g1 = bfhi(gq[g].x), g2 = bflo(gq[g].y), g3 = bfhi(gq[g].y);
        u32x2 w; w.x = pk2(o[4 * g] * rstd * gn[g].x * siluf_(g0), o[4 * g + 1] * rstd * gn[g].y * siluf_(g1)); w.y = pk2(o[4 * g + 2] * rstd * gn[g].z * siluf_(g2), o[4 * g + 3] * rstd * gn[g].w * siluf_(g3));
        if (!dry) *(u32x2*)(gp + 8 * g) = w; }
    __syncthreads();
}
namespace pg8 {
struct EpiMerge {
    static constexpr bool PERM = true;
    bf16_t* Z; int dry;
    __device__ __forceinline__ void operator()(const f32x4 (&acc)[2][2][4][2], const Unit& u, int wr, int wc, int fr, int fq) const {
        const int j = u.tag; const int row0 = u.pm * BM + wr * 64 + fr; const int col0 = u.pn * BM + wc * 32 + 8 * fq;
#pragma unroll
        for (int ai = 0; ai < 2; ++ai)
#pragma unroll
            for (int m = 0; m < 4; ++m) { bf16_t* rowp = Z + (size_t)(row0 + ai * HALF + m * 16) * ZP + col0;
#pragma unroll
                for (int bj = 0; bj < 2; ++bj) { const f32x4 v0 = acc[ai][bj][m][0], v1 = acc[ai][bj][m][1];
                    const u32x4 y = *(const u32x4*)(rowp + bj * HALF + 1024 * j);
                    u32x4 pv = {0u, 0u, 0u, 0u}; if (j > 0) pv = *(const u32x4*)(rowp + bj * HALF);
                    u32x4 w;
                    w.x = pk2(fmaf(sigmoidf_(v0[0]), bflo(y.x), bflo(pv.x)), fmaf(sigmoidf_(v0[1]), bfhi(y.x), bfhi(pv.x)));
                    w.y = pk2(fmaf(sigmoidf_(v0[2]), bflo(y.y), bflo(pv.y)), fmaf(sigmoidf_(v0[3]), bfhi(y.y), bfhi(pv.y)));
                    w.z = pk2(fmaf(sigmoidf_(v1[0]), bflo(y.z), bflo(pv.z)), fmaf(sigmoidf_(v1[1]), bfhi(y.z), bfhi(pv.z)));
                    w.w = pk2(fmaf(sigmoidf_(v1[2]), bflo(y.w), bflo(pv.w)), fmaf(sigmoidf_(v1[3]), bfhi(y.w), bfhi(pv.w)));
                    if (!dry) *(u32x4*)(rowp + bj * HALF) = w; }
                asm volatile("" ::: "memory"); }
    }
};
struct EpiRes {
    static constexpr bool PERM = false;
    const float* base; float* out; int dry;
    __device__ __forceinline__ void operator()(const f32x4 (&acc)[2][2][4][2], const Unit& u, int wr, int wc, int fr, int fq) const {
        const int row0 = u.pm * BM + wr * 64 + fr; const int col0 = u.pn * BM + wc * 32 + 4 * fq;
#pragma unroll
        for (int ai = 0; ai < 2; ++ai)
#pragma unroll
            for (int m = 0; m < 4; ++m) { const size_t off = (size_t)(row0 + ai * HALF + m * 16) * DM + col0;
#pragma unroll
                for (int bj = 0; bj < 2; ++bj)
#pragma unroll
                    for (int n = 0; n < 2; ++n) { const f32x4 bs = *(const f32x4*)(base + off + bj * HALF + n * 16); if (!dry) *(f32x4*)(out + off + bj * HALF + n * 16) = bs + acc[ai][bj][m][n]; } }
    }
};
struct EpiPle {
    static constexpr bool PERM = false;
    const float* base; float* out; const bf16_t* PL; int dry;
    __device__ __forceinline__ void operator()(const f32x4 (&acc)[2][2][4][2], const Unit& u, int wr, int wc, int fr, int fq) const {
        const int row0 = u.pm * BM + wr * 64 + fr; const int col0 = u.pn * BM + wc * 32 + 4 * fq;
#pragma unroll
        for (int ai = 0; ai < 2; ++ai)
#pragma unroll
            for (int m = 0; m < 4; ++m) { const size_t off = (size_t)(row0 + ai * HALF + m * 16) * DM + col0;
#pragma unroll
                for (int bj = 0; bj < 2; ++bj)
#pragma unroll
                    for (int n = 0; n < 2; ++n) { const f32x4 bs = *(const f32x4*)(base + off + bj * HALF + n * 16); const u32x2 pl = *(const u32x2*)(PL + off + bj * HALF + n * 16); const f32x4 a = acc[ai][bj][m][n];
                        f32x4 o; o.x = fmaf(sigmoidf_(a.x), bflo(pl.x), bs.x); o.y = fmaf(sigmoidf_(a.y), bfhi(pl.x), bs.y); o.z = fmaf(sigmoidf_(a.z), bflo(pl.y), bs.z); o.w = fmaf(sigmoidf_(a.w), bfhi(pl.y), bs.w);
                        if (!dry) *(f32x4*)(out + off + bj * HALF + n * 16) = o; } }
    }
};
struct EpiUp {
    static constexpr bool PERM = true;
    bf16_t* ACT;
    __device__ __forceinline__ void operator()(const f32x4 (&acc)[2][2][4][2], const Unit& u, int wr, int wc, int fr, int fq) const {
        const int row0 = u.pm * BM + wr * 64 + fr; const int col0 = u.pn * HALF + wc * 32 + 8 * fq;
#pragma unroll
        for (int ai = 0; ai < 2; ++ai)
#pragma unroll
            for (int m = 0; m < 4; ++m) { const f32x4 g0 = acc[ai][0][m][0], g1 = acc[ai][0][m][1], u0 = acc[ai][1][m][0], u1 = acc[ai][1][m][1];
                u32x4 w; w.x = pk2(siluf_(g0[0]) * u0[0], siluf_(g0[1]) * u0[1]); w.y = pk2(siluf_(g0[2]) * u0[2], siluf_(g0[3]) * u0[3]);
                w.z = pk2(siluf_(g1[0]) * u1[0], siluf_(g1[1]) * u1[1]); w.w = pk2(siluf_(g1[2]) * u1[2], siluf_(g1[3]) * u1[3]);
                *(u32x4*)(ACT + (size_t)(row0 + ai * HALF + m * 16) * DEXP + col0) = w; }
    }
};
struct EpiDown {
    static constexpr bool PERM = true;
    bf16_t* Y; const float* sw;
    __device__ __forceinline__ void operator()(const f32x4 (&acc)[2][2][4][2], const Unit& u, int wr, int wc, int fr, int fq) const {
        const int row0 = u.pm * BM + wr * 64 + fr; const int col0 = u.pn * BM + wc * 32 + 8 * fq;
#pragma unroll
        for (int ai = 0; ai < 2; ++ai)
#pragma unroll
            for (int m = 0; m < 4; ++m) { const int row = row0 + ai * HALF + m * 16; const float s = sw[row]; bf16_t* rowp = Y + (size_t)row * DM + col0;
#pragma unroll
                for (int bj = 0; bj < 2; ++bj) { const f32x4 v0 = acc[ai][bj][m][0] * s, v1 = acc[ai][bj][m][1] * s;
                    u32x4 w; w.x = pk2(v0[0], v0[1]); w.y = pk2(v0[2], v0[3]); w.z = pk2(v1[0], v1[1]); w.w = pk2(v1[2], v1[3]);
                    *(u32x4*)(rowp + bj * HALF) = w; } }
    }
};
struct MergeOrder {
    int c, G; int abase, astep; size_t bbase, bstep;
    __device__ bool next(int i, Unit& u) const { const int pair = (i / 3) * G + c, j = i % 3; if (pair >= 512) return false;
        u.pm = pair >> 2; u.pn = pair & 3; u.tag = j; u.aoff = abase + j * astep; u.boff = bbase + (size_t)j * bstep; return true; }
};
struct GroupOrder {
    const int* tbl;
    int c, G; size_t bstride;
    __device__ bool next(int i, Unit& u) const {
        int L = i * G + c; int found = 0, pm = 0, pn = 0, ee = 0;
#pragma unroll
        for (int e = 0; e < NEXP; ++e) { const int nt_e = (tbl[16 + e] + 255) >> 8, nu = nt_e * 4;
            if (!found && L < nu) { found = 1; pm = (tbl[e] >> 8) + (L >> 2); pn = L & 3; ee = e; }
            if (!found) L -= nu; }
        if (!found) return false;
        u.pm = pm; u.pn = pn; u.tag = ee; u.aoff = 0; u.boff = (size_t)ee * bstride; return true; }
};
}

__device__ __forceinline__ void phaseF(KA P, int L, LAS unsigned char* lds, int wave, int lane, int tid) {
    LAS float* WR = (LAS float*)lds; LAS int* E0 = (LAS int*)(lds + 81920); LAS int* E1 = (LAS int*)(lds + 82432); LAS float* W0 = (LAS float*)(lds + 82944); LAS float* W1 = (LAS float*)(lds + 83456);
    const float* wrg = P->p.in[15] + (size_t)L * DM * 4; const float* wre = P->p.in[17] + (size_t)L * DM * 16;
    for (int i = tid; i < DM * 4; i += 512) WR[(i & 3) * 1024 + (i >> 2)] = wrg[i];
    for (int i = tid; i < DM * 16; i += 512) WR[(4 + (i & 15)) * 1024 + (i >> 4)] = wre[i];
    __syncthreads();
    const float* brg = P->p.in[16] + L * 4; const float* bre = P->p.in[18] + L * 16; const float* g = P->p.in[14] + (size_t)L * DM;
    const int tok0 = blockIdx.x * TPW;
    int* RE0 = (int*)(P->p.ws + WS_ROUTE); int* RE1 = RE0 + NTOK; float* RW0 = (float*)(RE1 + NTOK); float* RW1 = RW0 + NTOK;
    const f32x4* gr = (const f32x4*)g + lane; f32x4 gg[4];
#pragma unroll
    for (int j = 0; j < 4; ++j) gg[j] = gr[64 * j];
    float brg_[4], bre_[16];
#pragma unroll
    for (int q = 0; q < 4; ++q) brg_[q] = brg[q];
#pragma unroll
    for (int q = 0; q < 16; ++q) bre_[q] = bre[q];
    constexpr int NRB = 2;
    for (int i0 = wave * 16; i0 < wave * 16 + 16; i0 += NRB) {
        f32x4 v[NRB][4]; float s[NRB];
#pragma unroll
        for (int q = 0; q < NRB; ++q) { const f32x4* xr = (const f32x4*)(P->p.out + (size_t)(tok0 + i0 + q) * DM) + lane;
#pragma unroll
            for (int j = 0; j < 4; ++j) v[q][j] = xr[64 * j]; }
#pragma unroll
        for (int q = 0; q < NRB; ++q) { s[q] = 0.f;
#pragma unroll
            for (int j = 0; j < 4; ++j) s[q] += (v[q][j].x * v[q][j].x + v[q][j].y * v[q][j].y) + (v[q][j].z * v[q][j].z + v[q][j].w * v[q][j].w); }
#pragma unroll
        for (int q = 0; q < NRB; ++q) { const float r = 1.0f / sqrtf(wave_sum_dpp(s[q]) * (1.f / DM) + EPS);
            u32x2* o8 = (u32x2*)((bf16_t*)(P->p.ws + WS_HN) + (size_t)(tok0 + i0 + q) * DM) + lane;
#pragma unroll
            for (int j = 0; j < 4; ++j) { v[q][j].x *= r * gg[j].x; v[q][j].y *= r * gg[j].y; v[q][j].z *= r * gg[j].z; v[q][j].w *= r * gg[j].w;
                u32x2 w; w.x = pk2(v[q][j].x, v[q][j].y); w.y = pk2(v[q][j].z, v[q][j].w); o8[64 * j] = w; } }
        float lg[NRB][20];
#pragma unroll
        for (int o = 0; o < 20; ++o) { f32x4 w[4];
#pragma unroll
            for (int j = 0; j < 4; ++j) w[j] = *(const LAS f32x4*)(WR + o * 1024 + 256 * j + 4 * lane);
#pragma unroll
            for (int q = 0; q < NRB; ++q) { float a = 0.f;
#pragma unroll
                for (int j = 0; j < 4; ++j) a += (v[q][j].x * w[j].x + v[q][j].y * w[j].y) + (v[q][j].z * w[j].z + v[q][j].w * w[j].w);
                lg[q][o] = wave_sum_hi(a); }
            __builtin_amdgcn_sched_barrier(0); }
#pragma unroll
        for (int qq = 0; qq < NRB; ++qq) {
            const int i = i0 + qq, tok = tok0 + i;
            float gl[4];
#pragma unroll
            for (int q = 0; q < 4; ++q) gl[q] = lg[qq][q] + brg_[q];
            int gi = 0; float gm = gl[0];
#pragma unroll
            for (int q = 1; q < 4; ++q) if (gl[q] > gm) { gm = gl[q]; gi = q; }
            float den = 0.f;
#pragma unroll
            for (int q = 0; q < 4; ++q) den += expf(gl[q] - gm);
            const float gp = 1.0f / den;
            float wv[4];
#pragma unroll
            for (int q = 0; q < 4; ++q) { const float e0v = lg[qq][4 + q] + bre_[q], e1v = lg[qq][8 + q] + bre_[4 + q], e2v = lg[qq][12 + q] + bre_[8 + q], e3v = lg[qq][16 + q] + bre_[12 + q];
                wv[q] = gi == 0 ? e0v : gi == 1 ? e1v : gi == 2 ? e2v : e3v; }
            int i1s = 0; float m0 = wv[0];
#pragma unroll
            for (int q = 1; q < 4; ++q) if (wv[q] > m0) { m0 = wv[q]; i1s = q; }
            int i2s = -1; float m1 = 0.f;
#pragma unroll
            for (int q = 0; q < 4; ++q) if (q != i1s && (i2s < 0 || wv[q] > m1)) { m1 = wv[q]; i2s = q; }
            const float t = expf(m1 - m0); const float w0 = gp / (1.f + t), w1 = gp * t / (1.f + t);
            if (lane == 63) { const int e0 = gi * 4 + i1s, e1 = gi * 4 + i2s; E0[i] = e0; E1[i] = e1; W0[i] = w0; W1[i] = w1; RE0[tok] = e0; RE1[tok] = e1; RW0[tok] = w0; RW1[tok] = w1; } }
    }
    __syncthreads();
    if (tid < 16) { int cnt = 0; for (int i = 0; i < TPW; ++i) cnt += (E0[i] == tid) + (E1[i] == tid); ((int*)(P->p.ws + WS_HIST))[blockIdx.x * 16 + tid] = cnt; }
    __syncthreads();
}

__device__ __forceinline__ void phaseG(KA P, LAS unsigned char* lds, int wave, int lane, int tid) {
    LAS int* E0 = (LAS int*)lds; LAS int* E1 = (LAS int*)(lds + 512); LAS int* S0 = (LAS int*)(lds + 1024); LAS int* S1 = (LAS int*)(lds + 1536);
    LAS int* TOT = (LAS int*)(lds + 2048); LAS int* PRE = (LAS int*)(lds + 2112); LAS int* EB = (LAS int*)(lds + 2176);
    const int* HIST = (const int*)(P->p.ws + WS_HIST); const int tok0 = blockIdx.x * TPW;
    const int* RE0 = (const int*)(P->p.ws + WS_ROUTE); const int* RE1 = RE0 + NTOK; const float* RW0 = (const float*)(RE1 + NTOK); const float* RW1 = RW0 + NTOK;
    LAS int* PT = (LAS int*)(lds + 4096); LAS int* PP = (LAS int*)(lds + 4096 + 2048);
    { const int e = tid & 15, part = tid >> 4; int tot = 0, pre = 0;
#pragma unroll
      for (int k = 0; k < 8; ++k) { const int w = part * 8 + k; const int hv = HIST[w * 16 + e]; tot += hv; if (w < (int)blockIdx.x) pre += hv; }
      PT[part * 16 + e] = tot; PP[part * 16 + e] = pre; }
    if (tid < TPW) { E0[tid] = RE0[tok0 + tid]; E1[tid] = RE1[tok0 + tid]; }
    __syncthreads();
    if (tid < 16) { int tot = 0, pre = 0; for (int q = 0; q < 32; ++q) { tot += PT[q * 16 + tid]; pre += PP[q * 16 + tid]; } TOT[tid] = tot; PRE[tid] = pre; }
    __syncthreads();
    if (tid == 0) { int eb = 0; for (int e = 0; e < NEXP; ++e) { EB[e] = eb; eb += (TOT[e] + 255) & ~255; }
        if (blockIdx.x == 0) { int* tbl = (int*)(P->p.ws + WS_TBL); for (int e = 0; e < NEXP; ++e) { tbl[e] = EB[e]; tbl[16 + e] = TOT[e]; } } }
    __syncthreads();
    if (tid < 16) { int run = EB[tid] + PRE[tid]; for (int i = 0; i < TPW; ++i) { if (E0[i] == tid) S0[i] = run++; if (E1[i] == tid) S1[i] = run++; } }
    __syncthreads();
    const bf16_t* H2 = (const bf16_t*)(P->p.ws + WS_HN); bf16_t* HG = (bf16_t*)(P->p.ws + WS_HG); float* SW = (float*)(P->p.ws + WS_SLOTW); int* TS = (int*)(P->p.ws + WS_TOKSLOT);
    for (int i0 = wave * 16; i0 < wave * 16 + 16; i0 += 4) { u32x4 a[4], b2[4];
#pragma unroll
        for (int q = 0; q < 4; ++q) { const u32x4* src = (const u32x4*)(H2 + (size_t)(tok0 + i0 + q) * DM) + lane; a[q] = src[0]; b2[q] = src[64]; }
#pragma unroll
        for (int q = 0; q < 4; ++q) { const int i = i0 + q, tok = tok0 + i, s0 = S0[i], s1 = S1[i];
            u32x4* d0 = (u32x4*)(HG + (size_t)s0 * DM) + lane; u32x4* d1 = (u32x4*)(HG + (size_t)s1 * DM) + lane;
            d0[0] = a[q]; d0[64] = b2[q]; d1[0] = a[q]; d1[64] = b2[q];
            if (lane == 0) { SW[s0] = RW0[tok]; SW[s1] = RW1[tok]; TS[2 * tok] = s0; TS[2 * tok + 1] = s1; } } }
}

__device__ __forceinline__ void phaseJ_rows(KA P, int vcu, int G, int wave, int lane, int dry = 0) {
    const bf16_t* Y = (const bf16_t*)(P->p.ws + WS_HG); const int* TS = (const int*)(P->p.ws + WS_TOKSLOT); bf16_t* XB = (bf16_t*)(P->p.ws + WS_HN);
    for (int tok0 = vcu * 8 + wave; tok0 < NTOK; tok0 += 2 * G * 8) { f32x4 v[2][4]; u32x2 ya[2][4], yb[2][4];
#pragma unroll
        for (int q = 0; q < 2; ++q) { const int tok = tok0 + q * G * 8; const int s0 = TS[2 * tok], s1 = TS[2 * tok + 1];
            const f32x4* xr = (const f32x4*)(P->p.out + (size_t)tok * DM) + lane; const u32x2* y0 = (const u32x2*)(Y + (size_t)s0 * DM) + lane; const u32x2* y1 = (const u32x2*)(Y + (size_t)s1 * DM) + lane;
#pragma unroll
            for (int j = 0; j < 4; ++j) { v[q][j] = xr[64 * j]; ya[q][j] = y0[64 * j]; yb[q][j] = y1[64 * j]; } }
#pragma unroll
        for (int q = 0; q < 2; ++q) { const int tok = tok0 + q * G * 8; f32x4* xr = (f32x4*)(P->p.out + (size_t)tok * DM) + lane; u32x2* o8 = (u32x2*)(XB + (size_t)tok * DM) + lane;
#pragma unroll
            for (int j = 0; j < 4; ++j) { f32x4 t = v[q][j]; const u32x2 a = ya[q][j], b = yb[q][j];
                t.x += bflo(a.x) + bflo(b.x); t.y += bfhi(a.x) + bfhi(b.x); t.z += bflo(a.y) + bflo(b.y); t.w += bfhi(a.y) + bfhi(b.y);
                if (!dry) { xr[64 * j] = t; u32x2 w; w.x = pk2(t.x, t.y); w.y = pk2(t.z, t.w); o8[64 * j] = w; } } } }
}
__device__ __forceinline__ void final_rows(KA P, int vcu, int G, int wave, int lane) {
    const f32x4* gr = (const f32x4*)P->p.in[23] + lane; f32x4 gg[4];
#pragma unroll
    for (int j = 0; j < 4; ++j) gg[j] = gr[64 * j];
    const int NGW = G * 8;
    for (int t0 = vcu * 8 + wave; t0 < NTOK; t0 += 4 * NGW) { f32x4 v[4][4]; float s[4];
#pragma unroll
        for (int q = 0; q < 4; ++q) { const f32x4* xr = (const f32x4*)(P->p.out + (size_t)(t0 + q * NGW) * DM) + lane;
#pragma unroll
            for (int j = 0; j < 4; ++j) v[q][j] = xr[64 * j]; }
#pragma unroll
        for (int q = 0; q < 4; ++q) { s[q] = 0.f;
#pragma unroll
            for (int j = 0; j < 4; ++j) s[q] += (v[q][j].x * v[q][j].x + v[q][j].y * v[q][j].y) + (v[q][j].z * v[q][j].z + v[q][j].w * v[q][j].w); }
#pragma unroll
        for (int q = 0; q < 4; ++q) s[q] = wave_sum_dpp(s[q]);
#pragma unroll
        for (int q = 0; q < 4; ++q) { const float r = 1.0f / sqrtf(s[q] * (1.f / DM) + EPS); f32x4* xr = (f32x4*)(P->p.out + (size_t)(t0 + q * NGW) * DM) + lane;
#pragma unroll
            for (int j = 0; j < 4; ++j) { f32x4 o; o.x = v[q][j].x * r * gg[j].x; o.y = v[q][j].y * r * gg[j].y; o.z = v[q][j].z * r * gg[j].z; o.w = v[q][j].w * r * gg[j].w; xr[64 * j] = o; } } }
}
#ifndef MK_N_LAUNCHES
#define MK_N_LAUNCHES 1
#endif
constexpr int PH_PER_LAYER = 13, N_PHASES = DEPTH * PH_PER_LAYER + 1;
constexpr int N_LAUNCHES = MK_N_LAUNCHES;
static_assert(N_LAUNCHES == 1 || N_LAUNCHES == N_PHASES, "MK_N_LAUNCHES is 1 or 27");

#define PH_FN static __device__ __forceinline__ void
#define DRYP , int dry = 0
#define PH_COMMON int tid_l = threadIdx.x; asm volatile("" : "+v"(tid_l)); asm volatile("" : "+s"(ka)); asm volatile("" : "+s"(L)); const int tid = tid_l, lane = tid & 63, wave = __builtin_amdgcn_readfirstlane(tid >> 6); int G_l = gridDim.x, bx_l = blockIdx.x; asm volatile("" : "+s"(G_l)); asm volatile("" : "+s"(bx_l)); const int G = G_l, bx = bx_l; \
    const int vcu = (G % 8 == 0) ? (bx % 8) * (G / 8) + bx / 8 : bx; unsigned char* ws = ka->p.ws; (void)tid; (void)lane; (void)wave; (void)vcu; (void)ws; \
    bf16_t* Z = (bf16_t*)(ws + WS_Z); bf16_t* HN = (bf16_t*)(ws + WS_HN); (void)Z; (void)HN;

PH_FN ph_A(KA ka, int L, LAS unsigned char* L3 DRYP) { PH_COMMON; KA P = ka; phaseA(P, L, L3, vcu, G, wave, lane, tid); }
PH_FN ph_B(KA ka, int L, LAS unsigned char* L3 DRYP) { PH_COMMON;
    pg8::Gemm g{HN, DM, (const bf16_t*)(ws + WS_WIN), DM, DM}; pg8::StaticOrder S; S.init(NTOK, NZT * 256, G, bx);
    pg8::EpiBf16 E{Z, ZP, 0};
    pg8::gemm_phase<pg8::EpiBf16, pg8::StaticOrder, true, true>(L3, g, S, E); }
PH_FN ph_C1a(KA ka, int L, LAS unsigned char* L3 DRYP) { PH_COMMON;
    gla1_load_w(ka->p.in[4] + (size_t)L * 16 * 256, ka->p.in[5] + (size_t)L * 256, L3, tid);
    for (int u = bx; u < 2048; u += G) gla1_unit(u, Z, (bf16_t*)(ws + WS_SLOC), (float*)(ws + WS_DTAB), L3, wave, lane, tid, dry);
    for (int cu = bx; cu < 256; cu += G) conv_unit(cu, Z, ka->p.in[11] + (size_t)L * 3 * 512, wave, lane, dry);
    for (int cu = bx; cu < 256; cu += G) knorm_unit(cu, Z, (unsigned*)(ws + WS_CTL) + CW_KN + 64 * L, L3, wave, lane, tid); }
PH_FN ph_C1b(KA ka, int L, LAS unsigned char* L3 DRYP) { PH_COMMON;
    gla_scan((bf16_t*)(ws + WS_SLOC), (const float*)(ws + WS_DTAB), L3, G, bx, tid);
    const float* lp = ka->p.in[8] + (size_t)L * 256;
    const float sa = wave_sum(lp[lane] * lp[64 + lane]), sb = wave_sum(lp[128 + lane] * lp[192 + lane]);
    const float lam_init = 0.8f - 0.6f * expf(-0.3f * (float)L); const float lam = expf(sa) - expf(sb) + lam_init;
    const float* gd = ka->p.in[9] + (size_t)L * 128;
    unsigned* head = (unsigned*)(ws + WS_CTL) + CW_QHEAD + 64 * L; const unsigned* KN = (const unsigned*)(ws + WS_CTL) + CW_KN + 64 * L;
    LAS int* qslot = (LAS int*)(L3 + 69632);
#ifdef DUP_ATT
    for (int adry = 1; adry >= 0; --adry) {
    if (adry) head += 32; else head -= 32;
#else
    { const int adry = dry;
#endif
    for (;;) {
        if (tid == 0) *qslot = (int)__hip_atomic_fetch_add(head, 1u, __ATOMIC_RELAXED, __HIP_MEMORY_SCOPE_AGENT);
        __syncthreads(); const int u = __builtin_amdgcn_readfirstlane(*qslot); __syncthreads();
        if (u >= 1024) break;
        const int h = 3 - (u >> 8), r = u & 255, qb = 127 - (r >> 1), b = r & 1;
        att::unit(b, h, qb, lam, 1.0f - lam_init, __uint_as_float(KN[b * 4 + h]), Z, gd, (char*)L3, adry); }
    } }
PH_FN ph_C3(KA ka, int L, LAS unsigned char* L3 DRYP) { PH_COMMON; for (int u = bx; u < 2048; u += G) gla3_unit(u, Z, (const bf16_t*)(ws + WS_SLOC), ka->p.in[6] + (size_t)L * 128, L3, wave, lane, dry); }
PH_FN ph_D1(KA ka, int L, LAS unsigned char* L3 DRYP) { PH_COMMON;
    pg8::Gemm g{Z, ZP, (const bf16_t*)(ws + WS_WO), 512, 512}; pg8::MergeOrder S{bx, G, C_OA, 512, 0, (size_t)DM * 512};
    pg8::EpiBf16 E{Z, ZP, 1024};
    pg8::gemm_phase<pg8::EpiBf16, pg8::MergeOrder, true, true>(L3, g, S, E); }
PH_FN ph_D2(KA ka, int L, LAS unsigned char* L3 DRYP) { PH_COMMON;
    pg8::Gemm g{HN, DM, (const bf16_t*)(ws + WS_WIN), DM, DM}; pg8::MergeOrder S{bx, G, 0, 0, (size_t)NZT * 256 * DM, (size_t)4 * 256 * DM};
    pg8::EpiMerge E{Z, dry};
    pg8::gemm_phase<pg8::EpiMerge, pg8::MergeOrder, true, true>(L3, g, S, E); }
PH_FN ph_E(KA ka, int L, LAS unsigned char* L3 DRYP) { PH_COMMON;
    pg8::Gemm g{Z, ZP, (const bf16_t*)(ws + WS_WOUT), DM, DM}; pg8::StaticOrder S; S.init(NTOK, DM, G, bx);
    pg8::EpiRes E{L == 0 ? ka->p.in[0] : ka->p.out, ka->p.out, dry};
    pg8::gemm_phase<pg8::EpiRes, pg8::StaticOrder, true, true>(L3, g, S, E); }
PH_FN ph_F(KA ka, int L, LAS unsigned char* L3 DRYP) { PH_COMMON; KA P = ka; if (G == GRID) phaseF(P, L, L3, wave, lane, tid); }
PH_FN ph_G(KA ka, int L, LAS unsigned char* L3 DRYP) { PH_COMMON; KA P = ka; if (G == GRID) phaseG(P, L3, wave, lane, tid); }
PH_FN ph_H(KA ka, int L, LAS unsigned char* L3 DRYP) { PH_COMMON;
    { pg8::Gemm g{(const bf16_t*)(ws + WS_HG), DM, (const bf16_t*)(ws + WS_WGU), DM, DM}; pg8::GroupOrder S{(const int*)(ws + WS_TBL), bx, G, (size_t)1024 * DM};
      pg8::EpiUp E{(bf16_t*)(ws + WS_ACT)};
      pg8::gemm_phase<pg8::EpiUp, pg8::GroupOrder, true, true>(L3, g, S, E); }
    {
      pg8::Gemm g{(const bf16_t*)(ws + WS_PB), PLE, (const bf16_t*)(ws + WS_WPLE), PLE, PLE}; pg8::StaticOrder S; S.init(NTOK, DM, G, bx);
      pg8::EpiBf16 E{(bf16_t*)(ws + WS_PL), DM, 0};
      pg8::gemm_phase<pg8::EpiBf16, pg8::StaticOrder, true, true>(L3, g, S, E); } }
PH_FN ph_I(KA ka, int L, LAS unsigned char* L3 DRYP) { PH_COMMON;
    pg8::Gemm g{(const bf16_t*)(ws + WS_ACT), DEXP, (const bf16_t*)(ws + WS_WDN), DEXP, DEXP}; pg8::GroupOrder S{(const int*)(ws + WS_TBL), bx, G, (size_t)DM * DEXP};
    pg8::EpiDown E{(bf16_t*)(ws + WS_HG), (const float*)(ws + WS_SLOTW)};
    pg8::gemm_phase<pg8::EpiDown, pg8::GroupOrder, true, true>(L3, g, S, E); }
PH_FN ph_J(KA ka, int L, LAS unsigned char* L3 DRYP) { PH_COMMON; KA P = ka;
    phaseJ_rows(P, vcu, G, wave, lane, dry); }
PH_FN ph_K(KA ka, int L, LAS unsigned char* L3 DRYP) { PH_COMMON;
    pg8::Gemm g{HN, DM, (const bf16_t*)(ws + WS_WPG), DM, DM}; pg8::StaticOrder S; S.init(NTOK, DM, G, bx);
    pg8::EpiPle E{ka->p.out, ka->p.out, (const bf16_t*)(ws + WS_PL), dry};
    pg8::gemm_phase<pg8::EpiPle, pg8::StaticOrder, true, true>(L3, g, S, E); }
PH_FN ph_final(KA ka, int L, LAS unsigned char* L3 DRYP) { PH_COMMON; KA P = ka; final_rows(P, vcu, G, wave, lane); }
static __device__ __forceinline__ void grid_bar(unsigned* barw, LAS unsigned* st) { XcdBarrier b; b.bar = barw; b.x = xb_xcc_id(); b.st = (volatile LAS unsigned*)st; xcd_barrier(b); }

__global__ void __launch_bounds__(512, 2) mega_fwd(Args args) {
    extern __shared__ __attribute__((aligned(16))) unsigned char lds[];
    LAS unsigned char* L3 = (LAS unsigned char*)lds;
    KA ka = (KA)__builtin_amdgcn_kernarg_segment_ptr();
    const int tid = threadIdx.x;
    for (int u = tid; u < (LDS_BYTES - LDSCTL_OFF) / 4; u += 512) ((LAS unsigned*)(L3 + LDSCTL_OFF))[u] = 0u;
    __syncthreads();
    unsigned* barw = (unsigned*)(args.p.ws + WS_CTL) + CW_BAR; LAS unsigned* st = (LAS unsigned*)(L3 + MISC_OFF) + 8;
    if (N_LAUNCHES == 1) (void)xcd_barrier_post(barw, (volatile LAS unsigned*)st);
    const int lo = args.ph_lo, hi = args.ph_hi;
#ifndef PHASE_MASK
#define PHASE_MASK 0xFFFFFFFu
#endif
#define IN(k) (((PHASE_MASK >> ((k) % PH_PER_LAYER + ((k) == N_PHASES - 1 ? PH_PER_LAYER : 0))) & 1u) && lo <= (k) && (k) < hi)
#ifdef DUP_BAR
#define SEAM(k) do { if (IN(k) && IN((k) + 1)) { grid_bar(barw, st); grid_bar(barw, st); } } while (0)
#else
#define SEAM(k) do { if (IN(k) && IN((k) + 1)) grid_bar(barw, st); } while (0)
#endif
    for (int L = 0; L < DEPTH; ++L) {
        const int pb = L * PH_PER_LAYER;
        if (IN(pb + 0)) {
#ifdef DUP_A
            for (int rep = 1; rep >= 0; --rep) { const int d = rep ? ka->ph_hi : 0; ph_A(ka, L, L3, d); __syncthreads(); }
#else
            ph_A(ka, L, L3);
#endif
        }
        SEAM(pb + 0);
        if (IN(pb + 1)) {
#ifdef DUP_B
            for (int rep = 1; rep >= 0; --rep) { const int d = rep ? ka->ph_hi : 0; ph_B(ka, L, L3, d); __syncthreads(); }
#else
            ph_B(ka, L, L3);
#endif
        }
        SEAM(pb + 1);
        if (IN(pb + 2)) {
#ifdef DUP_C1a
            for (int rep = 1; rep >= 0; --rep) { const int d = rep ? ka->ph_hi : 0; ph_C1a(ka, L, L3, d); __syncthreads(); }
#else
            ph_C1a(ka, L, L3);
#endif
        }
        SEAM(pb + 2);
        if (IN(pb + 3)) ph_C1b(ka, L, L3);
        SEAM(pb + 3);
        if (IN(pb + 4)) {
#ifdef DUP_C3
            for (int rep = 1; rep >= 0; --rep) { const int d = rep ? ka->ph_hi : 0; ph_C3(ka, L, L3, d); __syncthreads(); }
#else
            ph_C3(ka, L, L3);
#endif
        }
        SEAM(pb + 4);
        if (IN(pb + 5)) {
#ifdef DUP_D
            for (int rep = 1; rep >= 0; --rep) { const int d = rep ? ka->ph_hi : 0; ph_D1(ka, L, L3, d); ph_D2(ka, L, L3, d); __syncthreads(); }
#else
            ph_D1(ka, L, L3); ph_D2(ka, L, L3);
#endif
        }
        SEAM(pb + 5);
        if (IN(pb + 6)) {
#ifdef DUP_E
            for (int rep = 1; rep >= 0; --rep) { const int d = rep ? ka->ph_hi : 0; ph_E(ka, L, L3, d); __syncthreads(); }
#else
            ph_E(ka, L, L3);
#endif
        }
        SEAM(pb + 6);
        if (IN(pb + 7)) {
#ifdef DUP_F
            for (int rep = 1; rep >= 0; --rep) { const int d = rep ? ka->ph_hi : 0; ph_F(ka, L, L3, d); __syncthreads(); }
#else
            ph_F(ka, L, L3);
#endif
        }
        SEAM(pb + 7);
        if (IN(pb + 8)) {
#ifdef DUP_G
            for (int rep = 1; rep >= 0; --rep) { const int d = rep ? ka->ph_hi : 0; ph_G(ka, L, L3, d); __syncthreads(); }
#else
            ph_G(ka, L, L3);
#endif
        }
        SEAM(pb + 8);
        if (IN(pb + 9)) {
#ifdef DUP_H
            for (int rep = 1; rep >= 0; --rep) { const int d = rep ? ka->ph_hi : 0; ph_H(ka, L, L3, d); __syncthreads(); }
#else
            ph_H(ka, L, L3);
#endif
        }
        SEAM(pb + 9);
        if (IN(pb + 10)) {
#ifdef DUP_I
            for (int rep = 1; rep >= 0; --rep) { const int d = rep ? ka->ph_hi : 0; ph_I(ka, L, L3, d); __syncthreads(); }
#else
            ph_I(ka, L, L3);
#endif
        }
        SEAM(pb + 10);
        if (IN(pb + 11)) {
#ifdef DUP_J
            for (int rep = 1; rep >= 0; --rep) { const int d = rep ? ka->ph_hi : 0; ph_J(ka, L, L3, d); __syncthreads(); }
#else
            ph_J(ka, L, L3);
#endif
        }
        SEAM(pb + 11);
        if (IN(pb + 12)) {
#ifdef DUP_K
            for (int rep = 1; rep >= 0; --rep) { const int d = rep ? ka->ph_hi : 0; ph_K(ka, L, L3, d); __syncthreads(); }
#else
            ph_K(ka, L, L3);
#endif
        }
        SEAM(pb + 12);
    }
    if (IN(N_PHASES - 1)) ph_final(ka, 0, L3);
#undef IN
#undef SEAM
}

extern "C" void kernel_launch(void* const* d_in, const int* in_sizes, int n_in, void* d_out, int out_size, void* d_ws, size_t ws_size, hipStream_t stream) {
    static int grid = 0;
    if (grid == 0) {
        if (n_in != 24 || in_sizes[0] != NTOK * DM || out_size != NTOK * DM || ws_size < WS_END) {
            fprintf(stderr, "kernel_launch: built for 24 inputs, x/out of %d floats, >= %zu bytes of workspace; got n_in %d, in0 %d, out %d, ws %zu; nothing launched\n", NTOK * DM, (size_t)WS_END, n_in, n_in > 0 ? in_sizes[0] : -1, out_size, ws_size); grid = -1; return; }
        int dev = 0, cus = 0, per_cu = 0;
        if (hipGetDevice(&dev) != hipSuccess || hipDeviceGetAttribute(&cus, hipDeviceAttributeMultiprocessorCount, dev) != hipSuccess) { fprintf(stderr, "kernel_launch: device query failed\n"); grid = -1; return; }
        if (hipFuncSetAttribute((const void*)mega_fwd, hipFuncAttributeMaxDynamicSharedMemorySize, LDS_BYTES) != hipSuccess) { fprintf(stderr, "kernel_launch: hipFuncSetAttribute failed\n"); grid = -1; return; }
        if (hipOccupancyMaxActiveBlocksPerMultiprocessor(&per_cu, (const void*)mega_fwd, 512, LDS_BYTES) != hipSuccess || per_cu < 1)
            fprintf(stderr, "kernel_launch: note: occupancy query reports %d workgroups per CU\n", per_cu);
        (void)hipGetLastError();
        if (cus != GRID) { fprintf(stderr, "kernel_launch: built for a %d-CU device, found %d; nothing launched\n", GRID, cus); grid = -1; return; }
        grid = GRID;
    }
    if (grid < 0) return;
    if (hipMemsetAsync((char*)d_ws + WS_CTL, 0, CTL_ZERO_BYTES, stream) != hipSuccess) { fprintf(stderr, "kernel_launch: memset failed\n"); return; }
    Args a{};
    for (int i = 0; i < 24; ++i) a.p.in[i] = (const float*)d_in[i];
    a.p.out = (float*)d_out; a.p.ws = (unsigned char*)d_ws;
    for (int li = 0; li < N_LAUNCHES; ++li) {
        a.ph_lo = (N_LAUNCHES == 1) ? 0 : li; a.ph_hi = (N_LAUNCHES == 1) ? N_PHASES : li + 1;
        hipLaunchKernelGGL(mega_fwd, dim3(grid), dim3(512), LDS_BYTES, stream, a);
        const hipError_t le = hipPeekAtLastError();
        if (le != hipSuccess) { fprintf(stderr, "kernel_launch: launch %d failed: %s\n", li, hipGetErrorName(le)); break; }
    }
}
```

```cpp
#include <hip/hip_runtime.h>
#include <cstdio>
#include <cstdint>

#define LAS __attribute__((address_space(3)))
#define GAS __attribute__((address_space(1)))
typedef unsigned short bf16_t;
typedef short bf16x8 __attribute__((ext_vector_type(8)));
typedef short s16x4 __attribute__((ext_vector_type(4)));
typedef float f32x2 __attribute__((ext_vector_type(2)));
typedef float f32x4 __attribute__((ext_vector_type(4)));
typedef float f32x16 __attribute__((ext_vector_type(16)));
typedef unsigned u32x2 __attribute__((ext_vector_type(2)));
typedef unsigned u32x4 __attribute__((ext_vector_type(4)));
typedef __bf16 bf16x2_t __attribute__((ext_vector_type(2)));

constexpr int NB = 2, T = 16384, NTOK = NB * T, DM = 1024, DEPTH = 2, PLE = 256;
constexpr int INTOT = 7696;
constexpr int ZP = 4864;
constexpr int C_GQ = 0, C_GK = 256, C_GV = 512, C_DK = 1024, C_DV = 1536, C_CX = 2048, C_CC = 2560, C_GA = 3072, C_GG = 3328, C_DQ = 3840, C_CB = 4352;
constexpr int C_OA = C_GG, C_OB = C_DQ, C_OC = C_CB;
constexpr int NZT = 19;
constexpr int NEXP = 16, DEXP = 512;
constexpr int NBK = 24;
constexpr int NSLOT = NTOK + NBK * 256;
constexpr float EPS = 1e-6f;
constexpr int GRID = 256;
constexpr int TPW = NTOK / GRID;

__device__ __forceinline__ unsigned f2bf(float f) { unsigned u = __builtin_bit_cast(unsigned, f); return (u + 0x7fffu + ((u >> 16) & 1u)) >> 16; }
__device__ __forceinline__ unsigned pk2(float lo, float hi) { f32x2 v = {lo, hi}; bf16x2_t b = __builtin_convertvector(v, bf16x2_t); return __builtin_bit_cast(unsigned, b); }
__device__ __forceinline__ float bflo(unsigned w) { return __builtin_bit_cast(float, w << 16); }
__device__ __forceinline__ float bfhi(unsigned w) { return __builtin_bit_cast(float, w & 0xffff0000u); }
__device__ __forceinline__ float bf2f(bf16_t b) { return __builtin_bit_cast(float, (unsigned)b << 16); }
__device__ __forceinline__ float sigmoidf_(float x) { return __builtin_amdgcn_rcpf(1.0f + __builtin_amdgcn_exp2f(-1.4426950408889634f * x)); }
__device__ __forceinline__ float siluf_(float x) { return x * sigmoidf_(x); }
__device__ __forceinline__ int lane_id_v() { int l; asm volatile("v_mbcnt_lo_u32_b32 %0, -1, 0\n\tv_mbcnt_hi_u32_b32 %0, -1, %0" : "=v"(l)); return l; }
template <int X> __device__ __forceinline__ float xor_lane(float v) { return __builtin_bit_cast(float, __builtin_amdgcn_ds_swizzle(__builtin_bit_cast(int, v), (X << 10) | 0x1F)); }
#define BFLY32(v, OP) do { v = OP(v, xor_lane<1>(v)); v = OP(v, xor_lane<2>(v)); v = OP(v, xor_lane<4>(v)); v = OP(v, xor_lane<8>(v)); v = OP(v, xor_lane<16>(v)); } while (0)
__device__ __forceinline__ float opadd_(float a, float b) { return a + b; }
__device__ __forceinline__ float wave_sum(float v) {
    BFLY32(v, opadd_);
    return __builtin_bit_cast(float, __builtin_amdgcn_readlane(__builtin_bit_cast(int, v), 0)) + __builtin_bit_cast(float, __builtin_amdgcn_readlane(__builtin_bit_cast(int, v), 32));
}
__device__ __forceinline__ float dpp_f(float x, int ctrl_sel) {
    const int xi = __builtin_bit_cast(int, x); int r;
    if (ctrl_sel == 0) r = __builtin_amdgcn_update_dpp(0, xi, 0xB1, 0xF, 0xF, true);
    else if (ctrl_sel == 1) r = __builtin_amdgcn_update_dpp(0, xi, 0x4E, 0xF, 0xF, true);
    else if (ctrl_sel == 2) r = __builtin_amdgcn_update_dpp(0, xi, 0x141, 0xF, 0xF, true);
    else r = __builtin_amdgcn_update_dpp(0, xi, 0x140, 0xF, 0xF, true);
    return __builtin_bit_cast(float, r); }
__device__ __forceinline__ float row16_sum(float x) { x += dpp_f(x, 0); x += dpp_f(x, 1); x += dpp_f(x, 2); x += dpp_f(x, 3); return x; }
__device__ __forceinline__ float rdl(float x, int l) { return __builtin_bit_cast(float, __builtin_amdgcn_readlane(__builtin_bit_cast(int, x), l)); }
__device__ __forceinline__ float wave_sum_hi(float x) { x = row16_sum(x);
    x += __builtin_bit_cast(float, __builtin_amdgcn_update_dpp(0, __builtin_bit_cast(int, x), 0x142, 0xA, 0xF, false));
    x += __builtin_bit_cast(float, __builtin_amdgcn_update_dpp(0, __builtin_bit_cast(int, x), 0x143, 0xC, 0xF, false)); return x; }
__device__ __forceinline__ float wave_sum_dpp(float x) { return rdl(wave_sum_hi(x), 63); }
template <int CTRL, int RM> __device__ __forceinline__ float dpp0(float x) { return __builtin_bit_cast(float, __builtin_amdgcn_update_dpp(0, __builtin_bit_cast(int, x), CTRL, RM, 0xF, false)); }
__device__ __forceinline__ float wave_scan_incl(float x) {
    x += dpp0<0x111, 0xF>(x); x += dpp0<0x112, 0xF>(x); x += dpp0<0x114, 0xF>(x); x += dpp0<0x118, 0xF>(x);
    x += dpp0<0x142, 0xA>(x); x += dpp0<0x143, 0xC>(x); return x; }
__device__ __forceinline__ int crow(int r, int hi) { return (r & 3) + 8 * (r >> 2) + 4 * hi; }
#define LDS_WAIT() asm volatile("s_waitcnt lgkmcnt(0)" ::: "memory")
#define VM_WAIT() asm volatile("s_waitcnt vmcnt(0)" ::: "memory")

namespace pg8 {
#define PG8_LAS __attribute__((address_space(3)))
constexpr int BM = 256, BK = 64, HALF = 128, HTB = HALF * BK * 2  , STAGE_BYTES = 8 * HTB, NXCD = 8, WGM = 8;

__host__ __device__ __forceinline__ int lds_byte(int r, int c) { const int st = (r >> 4) * 2 + (c >> 5), rr = r & 15, cc = c & 31, ob = rr * 64 + cc * 2; return st * 1024 + (ob ^ (((ob >> 9) & 1) << 5)); }
__host__ __device__ __forceinline__ void stage_rc(int b, int& R, int& C) { const int st = b / 1024, sb = b % 1024, swz = sb ^ (((sb >> 9) & 1) << 5); R = (st >> 1) * 16 + swz / 64; C = (st & 1) * 32 + (swz % 64) / 2; }
__host__ __device__ __forceinline__ int perm32(int rho) { const int n = rho >> 4, i = rho & 15; return 8 * (i >> 2) + 4 * n + (i & 3); }

struct Unit { int pm, pn; int aoff; int tag; size_t boff; };
struct Gemm { const bf16_t* A; int lda; const bf16_t* Bt; int ldb; int K; };

struct StaticOrder {
    int nM, nN, nwg, G, c;
    __device__ void init(int M, int N, int G_, int c_) { nM = M / BM; nN = N / BM; nwg = nM * nN; G = G_; c = c_; }
    __device__ bool next(int i, Unit& u) const {
        const long L = (long)i * G + c; if (L >= nwg) return false;
        int wgid = (int)L; { const int q = nwg / NXCD, r = nwg % NXCD, xcd = wgid % NXCD, off = wgid / NXCD; wgid = (xcd < r ? xcd * (q + 1) : r * (q + 1) + (xcd - r) * q) + off; }
        const int nig = WGM * nN, gid = wgid / nig, fm = gid * WGM, gsz = (nM - fm) < WGM ? (nM - fm) : WGM;
        u.pm = fm + ((wgid % nig) % gsz); u.pn = (wgid % nig) / gsz; u.aoff = 0; u.tag = 0; u.boff = 0; return true;
    }
};

struct EpiBf16 {
    static constexpr bool PERM = true; static __device__ __forceinline__ bool keep(const Unit&) { return false; }
    bf16_t* O; int ldc; int tstride;
    __device__ __forceinline__ void operator()(f32x4 (&acc)[2][2][4][2], const Unit& u, int wr, int wc, int fr, int fq) const {
        const int row0 = u.pm * BM + wr * 64 + fr; const int col0 = u.tag * tstride + u.pn * BM + wc * 32 + 8 * fq;
#pragma unroll
        for (int ai = 0; ai < 2; ++ai)
#pragma unroll
            for (int m = 0; m < 4; ++m) { bf16_t* rowp = O + (size_t)(row0 + ai * HALF + m * 16) * ldc + col0;
#pragma unroll
                for (int bj = 0; bj < 2; ++bj) { const f32x4 v0 = acc[ai][bj][m][0], v1 = acc[ai][bj][m][1];
                    u32x4 w; w.x = pk2(v0[0], v0[1]); w.y = pk2(v0[2], v0[3]); w.z = pk2(v1[0], v1[1]); w.w = pk2(v1[2], v1[3]);
                    *(u32x4*)(rowp + bj * HALF) = w; } }
    }
};
struct EpiKV {
    static constexpr bool PERM = true; static __device__ __forceinline__ bool keep(const Unit&) { return false; }
    bf16_t* KV;
    __device__ __forceinline__ void operator()(f32x4 (&acc)[2][2][4][2], const Unit& u, int wr, int wc, int fr, int fq) const {
        const int bb = (u.pm * BM) / T;
        bf16_t* o0 = KV + ((size_t)(bb * 4 + 2 * (u.pn & 1)) * T + (size_t)(u.pm * BM - bb * T + wr * 64 + fr)) * 256 + ((u.pn >> 1) & 1) * 128 + wc * 32 + 8 * fq;
#pragma unroll
        for (int ai = 0; ai < 2; ++ai)
#pragma unroll
            for (int m = 0; m < 4; ++m) { bf16_t* rowp = o0 + (size_t)(ai * HALF + m * 16) * 256;
#pragma unroll
                for (int bj = 0; bj < 2; ++bj) { const f32x4 v0 = acc[ai][bj][m][0], v1 = acc[ai][bj][m][1];
                    u32x4 w; w.x = pk2(v0[0], v0[1]); w.y = pk2(v0[2], v0[3]); w.z = pk2(v1[0], v1[1]); w.w = pk2(v1[2], v1[3]);
                    *(u32x4*)(rowp + (size_t)bj * T * 256) = w; } }
    }
};
struct ColMapOrder {
    StaticOrder S; int from, by;
    __device__ bool next(int i, Unit& u) const { if (!S.next(i, u)) return false; if (u.pn >= from) u.pn += by; return true; }
};
template <class Epi, class Sched, bool ALIGN_EPI = false, bool SP2 = false, bool GATHER = false>
__device__ __forceinline__ void gemm_phase(int tid_in, PG8_LAS unsigned char* lds, const Gemm g, const Sched& S, const Epi& E, const int* rowidx = nullptr) {
    int tid_l = tid_in; asm volatile("" : "+v"(tid_l)); const int tid = tid_l;
    const int wid = __builtin_amdgcn_readfirstlane(tid >> 6), lane = tid & 63, wr = wid >> 2, wc = wid & 3, fr = lane & 15, fq = lane >> 4;
    const int K = g.K, nt = K / BK;
    unsigned voffA[2], voffB[2];
#pragma unroll
    for (int i = 0; i < 2; ++i) { int R, C; stage_rc(tid * 16 + i * 8192, R, C); const int Rb = Epi::PERM ? ((R & ~31) + perm32(R & 31)) : R;
        voffA[i] = (unsigned)(R * g.lda + C) * 2u; voffB[i] = (unsigned)(Rb * g.ldb + C) * 2u; }
    const size_t kstep = (size_t)(BK * 2);
    const size_t hstepA = (size_t)HALF * g.lda * 2, hstepB = (size_t)HALF * g.ldb * 2;
    const unsigned ldsw = (unsigned)wid * 1024u;
    const int aoff = lds_byte(wr * 64 + fr, fq * 8), boff = lds_byte(wc * 32 + fr, fq * 8);
#define PG8_UA(u) ((const char*)g.A + (GATHER ? (size_t)0 : ((size_t)(u).pm * 2 * hstepA)) + (size_t)(u).aoff * 2)
#define PG8_GV(dst, u) do { _Pragma("unroll") for (int h_ = 0; h_ < 2; ++h_) _Pragma("unroll") for (int i_ = 0; i_ < 2; ++i_) { int R_, C_; stage_rc(tid * 16 + i_ * 8192, R_, C_); \
        const unsigned tok_ = (unsigned)rowidx[(u).pm * 256 + h_ * 128 + R_] & (unsigned)(NTOK - 1); dst[h_][i_] = (tok_ * (unsigned)g.lda + (unsigned)C_) * 2u; } } while (0)
#define PG8_STAGE_A(b, h, ptr, nx) do { if constexpr (GATHER) { const unsigned gv_[2] = {(nx) ? nv[h][0] : cv[h][0], (nx) ? nv[h][1] : cv[h][1]}; PG8_STAGE(PG8_SA(b, h), ptr, gv_); } \
        else { PG8_STAGE(PG8_SA(b, h), (ptr) + ((h) ? hstepA : 0), voffA); } } while (0)
#define PG8_UB(u) ((const char*)g.Bt + ((size_t)(u).pn * 2 * hstepB) + (u).boff * 2)
#define PG8_SA(b, h) (((b) * 2 + (h)) * HTB)
#define PG8_SB(b, h) ((4 + (b) * 2 + (h)) * HTB)
#define PG8_STAGE(bufoff, gbase, voff) do { _Pragma("unroll") for (int _i = 0; _i < 2; ++_i) \
        __builtin_amdgcn_global_load_lds((const unsigned*)((const char*)(gbase) + (voff)[_i]), (PG8_LAS unsigned*)(lds + (bufoff) + ldsw + _i * 8192), 16, 0, 0); } while (0)
#define PG8_LDA(dst, b, h) do { _Pragma("unroll") for (int m = 0; m < 4; ++m) _Pragma("unroll") for (int k = 0; k < 2; ++k) dst[m][k] = *(const PG8_LAS bf16x8*)(lds + PG8_SA(b, h) + aoff + m * 2048 + k * 1024); } while (0)
#define PG8_LDB(dst, b, h) do { _Pragma("unroll") for (int n = 0; n < 2; ++n) _Pragma("unroll") for (int k = 0; k < 2; ++k) dst[n][k] = *(const PG8_LAS bf16x8*)(lds + PG8_SB(b, h) + boff + n * 2048 + k * 1024); } while (0)
#define PG8_MMA(ai, bj, At, Bt) do { __builtin_amdgcn_s_setprio(1); _Pragma("unroll") for (int m = 0; m < 4; ++m) _Pragma("unroll") for (int n = 0; n < 2; ++n) _Pragma("unroll") for (int k = 0; k < 2; ++k) \
        acc[ai][bj][m][n] = __builtin_amdgcn_mfma_f32_16x16x32_bf16(Bt[n][k], At[m][k], acc[ai][bj][m][n], 0, 0, 0); __builtin_amdgcn_s_setprio(0); } while (0)
#define PG8_WAIT_V(n) asm volatile("s_waitcnt vmcnt(" #n ")" ::: "memory")
#define PG8_WAIT_L(n) asm volatile("s_waitcnt lgkmcnt(" #n ")" ::: "memory")
#define PG8_BAR __builtin_amdgcn_s_barrier()
#define PG8_SCHED __builtin_amdgcn_sched_barrier(0)
    Unit cur, nxt; int ui = 0;
    if (!S.next(0, cur)) return;
    f32x4 acc[2][2][4][2];
#pragma unroll
    for (int a = 0; a < 2; ++a)
#pragma unroll
        for (int b = 0; b < 2; ++b)
#pragma unroll
            for (int m = 0; m < 4; ++m)
#pragma unroll
                for (int n = 0; n < 2; ++n) acc[a][b][m][n] = (f32x4){0.f, 0.f, 0.f, 0.f};
    bf16x8 At[4][2], B0[2][2], B1[2][2];
    const char* cA = PG8_UA(cur); const char* cB = PG8_UB(cur);
    unsigned cv[2][2] = {{0u, 0u}, {0u, 0u}}, nv[2][2] = {{0u, 0u}, {0u, 0u}}; (void)cv; (void)nv;
    if constexpr (GATHER) PG8_GV(cv, cur);
    if constexpr (SP2) {
        PG8_STAGE(PG8_SB(0, 0), cB, voffB); PG8_STAGE(PG8_SB(0, 1), cB + hstepB, voffB); PG8_STAGE_A(0, 0, cA, false); PG8_STAGE_A(0, 1, cA, false);
        if (wr == 1) PG8_BAR;
        PG8_WAIT_V(2); PG8_BAR;
        PG8_STAGE(PG8_SB(1, 0), cB + kstep, voffB); PG8_STAGE_A(1, 0, cA + kstep, false); PG8_STAGE(PG8_SB(1, 1), cB + hstepB + kstep, voffB);
        PG8_WAIT_V(6); PG8_BAR;
    } else {
        PG8_STAGE(PG8_SB(0, 0), cB, voffB); PG8_STAGE_A(0, 0, cA, false); PG8_STAGE(PG8_SB(0, 1), cB + hstepB, voffB); PG8_STAGE_A(0, 1, cA, false);
        if (wr == 1) PG8_BAR;
        PG8_WAIT_V(4); PG8_BAR;
        PG8_STAGE(PG8_SB(1, 0), cB + kstep, voffB); PG8_STAGE_A(1, 0, cA + kstep, false); PG8_STAGE(PG8_SB(1, 1), cB + hstepB + kstep, voffB);
        PG8_WAIT_V(6); PG8_BAR;
    }
    for (;;) {
        const bool has_next = S.next(ui + 1, nxt);
        const char* nA = has_next ? PG8_UA(nxt) : cA; const char* nB = has_next ? PG8_UB(nxt) : cB;
        if constexpr (GATHER) { if (has_next) PG8_GV(nv, nxt); }
        for (int t = 0; t < nt; t += 2) {
            const bool last = (t == nt - 2);
            const char* a1 = cA + (size_t)(t + 1) * kstep;
            const char* a2 = last ? nA : cA + (size_t)(t + 2) * kstep; const char* b2 = last ? nB : cB + (size_t)(t + 2) * kstep;
            const char* a3 = a2 + kstep; const char* b3 = b2 + kstep; const bool nx2 = last && has_next; (void)nx2;
            asm volatile("" : "+s"(a1), "+s"(a2), "+s"(b2), "+s"(a3), "+s"(b3));
            if constexpr (SP2) {
            PG8_LDB(B0, 0, 0); PG8_LDB(B1, 0, 1); PG8_SCHED; PG8_LDA(At, 0, 0); PG8_STAGE_A(1, 1, a1, false);
            PG8_WAIT_V(8); PG8_WAIT_L(0); PG8_BAR; PG8_MMA(0, 0, At, B0); PG8_MMA(0, 1, At, B1); PG8_BAR; PG8_SCHED;
            PG8_LDA(At, 0, 1); PG8_STAGE(PG8_SB(0, 0), b2, voffB); PG8_STAGE(PG8_SB(0, 1), b2 + hstepB, voffB); PG8_STAGE_A(0, 0, a2, nx2);
            PG8_WAIT_V(8); PG8_WAIT_L(0); PG8_BAR; PG8_MMA(1, 0, At, B0); PG8_MMA(1, 1, At, B1); PG8_BAR; PG8_SCHED;
            PG8_LDB(B0, 1, 0); PG8_LDB(B1, 1, 1); PG8_SCHED; PG8_LDA(At, 1, 0); PG8_STAGE_A(0, 1, a2, nx2);
            PG8_WAIT_V(8); PG8_WAIT_L(0); PG8_BAR; PG8_MMA(0, 0, At, B0); PG8_MMA(0, 1, At, B1); PG8_BAR; PG8_SCHED;
            PG8_LDA(At, 1, 1); PG8_STAGE(PG8_SB(1, 0), b3, voffB); PG8_STAGE(PG8_SB(1, 1), b3 + hstepB, voffB); PG8_STAGE_A(1, 0, a3, nx2);
            PG8_WAIT_V(8); PG8_WAIT_L(0); PG8_BAR; PG8_MMA(1, 0, At, B0); PG8_MMA(1, 1, At, B1); PG8_BAR; PG8_SCHED;
            } else {
            PG8_LDB(B0, 0, 0); PG8_SCHED; PG8_LDA(At, 0, 0); PG8_STAGE_A(1, 1, a1, false);
            PG8_WAIT_L(8); PG8_BAR; PG8_WAIT_L(0); PG8_MMA(0, 0, At, B0); PG8_BAR; PG8_SCHED;
            PG8_LDB(B1, 0, 1); PG8_STAGE(PG8_SB(0, 0), b2, voffB);
            PG8_BAR; PG8_WAIT_L(0); PG8_MMA(0, 1, At, B1); PG8_BAR;
            PG8_LDA(At, 0, 1); PG8_STAGE_A(0, 0, a2, nx2);
            PG8_BAR; PG8_WAIT_L(0); PG8_MMA(1, 0, At, B0); PG8_BAR; PG8_SCHED;
            PG8_STAGE(PG8_SB(0, 1), b2 + hstepB, voffB);
            PG8_WAIT_V(6); PG8_BAR; PG8_MMA(1, 1, At, B1); PG8_BAR;
            PG8_LDB(B0, 1, 0); PG8_SCHED; PG8_LDA(At, 1, 0); PG8_STAGE_A(0, 1, a2, nx2);
            PG8_WAIT_L(8); PG8_BAR; PG8_WAIT_L(0); PG8_MMA(0, 0, At, B0); PG8_BAR; PG8_SCHED;
            PG8_LDB(B1, 1, 1); PG8_STAGE(PG8_SB(1, 0), b3, voffB);
            PG8_BAR; PG8_WAIT_L(0); PG8_MMA(0, 1, At, B1); PG8_BAR;
            PG8_LDA(At, 1, 1); PG8_STAGE_A(1, 0, a3, nx2);
            PG8_BAR; PG8_WAIT_L(0); PG8_MMA(1, 0, At, B0); PG8_BAR; PG8_SCHED;
            PG8_STAGE(PG8_SB(1, 1), b3 + hstepB, voffB);
            PG8_WAIT_V(6); PG8_BAR; PG8_MMA(1, 1, At, B1); PG8_BAR;
            }
        }
        if constexpr (ALIGN_EPI) { if (wr == 0) PG8_BAR; }
        { const int l2 = lane_id_v(); E(acc, cur, wr, wc, l2 & 15, l2 >> 4); }
        if (!has_next) break;
        if (!Epi::keep(cur)) {
#pragma unroll
        for (int a = 0; a < 2; ++a)
#pragma unroll
            for (int b = 0; b < 2; ++b)
#pragma unroll
                for (int m = 0; m < 4; ++m)
#pragma unroll
                    for (int n = 0; n < 2; ++n) acc[a][b][m][n] = (f32x4){0.f, 0.f, 0.f, 0.f};
        }
        cur = nxt; cA = nA; cB = nB; ++ui;
        if constexpr (GATHER) { cv[0][0] = nv[0][0]; cv[0][1] = nv[0][1]; cv[1][0] = nv[1][0]; cv[1][1] = nv[1][1]; }
        if constexpr (ALIGN_EPI) { if (wr == 1) PG8_BAR; }
    }
    PG8_WAIT_V(0);
    if constexpr (!ALIGN_EPI) { if (wr == 0) PG8_BAR; }
    PG8_BAR;
#undef PG8_UA
#undef PG8_GV
#undef PG8_STAGE_A
#undef PG8_UB
#undef PG8_SA
#undef PG8_SB
#undef PG8_STAGE
#undef PG8_LDA
#undef PG8_LDB
#undef PG8_MMA
#undef PG8_WAIT_V
#undef PG8_WAIT_L
#undef PG8_BAR
#undef PG8_SCHED
}
}

#define XB_TMO      128
#define XB_XCNT(j)  (256  + 64 * (j))
#define XB_XSUB(j)  (1280 + 64 * (j))
#define XB_XGEN(j)  (2304 + 64 * (j))
#define XB_TOP      3328
#define XB_TOPGEN   3392
#define XCD_BAR_WORDS 3456
#define XB_SPIN_CAP (1u << 18)

__device__ __forceinline__ unsigned xb_ld(unsigned* p)              { return __hip_atomic_load(p, __ATOMIC_RELAXED, __HIP_MEMORY_SCOPE_AGENT); }
__device__ __forceinline__ unsigned xb_add(unsigned* p, unsigned v) { return __hip_atomic_fetch_add(p, v, __ATOMIC_RELAXED, __HIP_MEMORY_SCOPE_AGENT); }
__device__ __forceinline__ unsigned xb_xcc_id() { return (unsigned)__builtin_amdgcn_s_getreg((3 << 11) | 20) & 0xFu; }
#define XB_SPIN(cond, bar) do { unsigned _sp = 0; while (cond) { __builtin_amdgcn_s_sleep(1); \
    if ((++_sp & 255u) == 0u) { if (xb_ld(&(bar)[XB_TMO])) break; if (_sp > XB_SPIN_CAP) { atomicAdd(&(bar)[XB_TMO], 1u); break; } } } } while (0)

struct XcdBarrier {
    unsigned* bar; unsigned x;
    volatile LAS unsigned* st;
};

__device__ __forceinline__ XcdBarrier xcd_barrier_post(unsigned* bar, volatile LAS unsigned* st) {
    XcdBarrier b; b.bar = bar; b.x = xb_xcc_id(); b.st = st;
    if (threadIdx.x == 0) (void)xb_add(&bar[XB_XCNT(b.x)], 1u);
    return b;
}
__device__ __forceinline__ void xcd_barrier_complete(unsigned* bar, unsigned x, unsigned& nloc, unsigned& nx) {
    const unsigned G = gridDim.x * gridDim.y * gridDim.z;
    unsigned sum, cnt, mine, sp = 0u;
    for (;;) {
        sum = 0u; cnt = 0u; mine = 0u;
#pragma unroll
        for (unsigned j = 0; j < 16; ++j) { const unsigned c = xb_ld(&bar[XB_XCNT(j)]); sum += c; cnt += (c > 0u) ? 1u : 0u; mine = (j == x) ? c : mine; }
        if (sum == G) break;
        __builtin_amdgcn_s_sleep(1);
        if ((++sp & 255u) == 0u) { if (xb_ld(&bar[XB_TMO])) break; if (sp > XB_SPIN_CAP) { atomicAdd(&bar[XB_TMO], 1u); break; } }
    }
    nloc = mine > 0u ? mine : 1u; nx = cnt > 0u ? cnt : 1u;
}

__device__ __forceinline__ void xcd_barrier(const XcdBarrier& b) {
    asm volatile("s_waitcnt vmcnt(0)" ::: "memory");
    __syncthreads();
    if (threadIdx.x == 0) {
        unsigned* bar = b.bar;
        __builtin_amdgcn_s_waitcnt(0);
        unsigned nloc = b.st[0], nx = b.st[1];
        if (nloc == 0u) { xcd_barrier_complete(bar, b.x, nloc, nx); b.st[0] = nloc; b.st[1] = nx; }
        const unsigned old = xb_add(&bar[XB_XSUB(b.x)], 1u);
        const unsigned gen = old / nloc;
        if (old + 1u == (gen + 1u) * nloc) {
            __builtin_amdgcn_fence(__ATOMIC_RELEASE, "agent");
            asm volatile("s_waitcnt vmcnt(0)" ::: "memory");
            const unsigned og = xb_add(&bar[XB_TOP], 1u);
            const unsigned tg = og / nx;
            if (og + 1u == (tg + 1u) * nx) xb_add(&bar[XB_TOPGEN], 1u);
            else XB_SPIN(xb_ld(&bar[XB_TOPGEN]) == tg, bar);
            __builtin_amdgcn_fence(__ATOMIC_ACQUIRE, "agent");
            xb_add(&bar[XB_XGEN(b.x)], 1u);
            asm volatile("s_waitcnt vmcnt(0)" ::: "memory");
        } else {
            XB_SPIN(xb_ld(&bar[XB_XGEN(b.x)]) == gen, bar);
            __builtin_amdgcn_fence(__ATOMIC_ACQUIRE, "agent");
            asm volatile("s_waitcnt vmcnt(0)" ::: "memory");
        }
    }
    __syncthreads();
}

constexpr size_t MiB = 1u << 20;
constexpr size_t WS_CTL = 0, CTL_ZERO_BYTES = 64 * 1024;
constexpr size_t WS_WIN = 1 * MiB;
constexpr size_t WS_WO = WS_WIN + (size_t)31 * 256 * 1024 * 2;
constexpr size_t WS_WOUT = WS_WO + (size_t)3 * 1024 * 512 * 2;
constexpr size_t WS_WPG = WS_WOUT + (size_t)1024 * 1024 * 2;
constexpr size_t WS_WPLE = WS_WPG + (size_t)1024 * 1024 * 2;
constexpr size_t WS_WGU = WS_WPLE + (size_t)1024 * 256 * 2;
constexpr size_t WS_WDN = WS_WGU + (size_t)16 * 1024 * 1024 * 2;
constexpr size_t WS_WEND = WS_WDN + (size_t)16 * 1024 * 512 * 2;
static_assert(WS_WEND <= 73 * MiB, "weights");
constexpr size_t WS_HN = 73 * MiB;
constexpr size_t WS_PB = WS_HN + (size_t)NTOK * DM * 2;
constexpr size_t WS_Z = WS_PB + (size_t)NTOK * PLE * 2;
constexpr size_t WS_ZEND = WS_Z + (size_t)NTOK * ZP * 2;
constexpr size_t WS_SLOC = WS_ZEND;
constexpr size_t WS_DTAB = WS_SLOC + (size_t)2048 * 8192 * 2;
constexpr size_t WS_ROUTE = WS_DTAB + (size_t)2048 * 64 * 4;
constexpr size_t WS_HIST = WS_ROUTE + (size_t)NTOK * 16;
constexpr size_t WS_TBL = WS_HIST + (size_t)GRID * 32 * 4;
constexpr size_t WS_SLOTW = WS_TBL + 1024;
constexpr size_t WS_S2T = WS_SLOTW + (size_t)NSLOT * 8;
constexpr size_t WS_END = WS_S2T + (size_t)NSLOT * 4;
constexpr size_t WS_ACT = WS_Z;
constexpr size_t WS_PL = WS_ACT + (size_t)NSLOT * DM * 2;
static_assert(WS_PL + (size_t)NTOK * DM * 2 <= WS_ZEND, "MoE overlay fits inside Z");
constexpr int CW_BAR = 4096;
constexpr int CW_QHEAD = 8192, CW_KN = 8192 + 256;

constexpr int RING_BYTES = 131072;
constexpr int LDSCTL_OFF = 143360, MISC_OFF = LDSCTL_OFF + 320;
constexpr int LDS_BYTES = 147456;

__device__ __forceinline__ void tr_item(const float* W, int ldw, int col0, int K, bf16_t* WT, int nrows, int valid, LAS float* scr, int item, int lane) {
    const int nblk = nrows / 32, kb = item / nblk, nb = item % nblk, k0 = 64 * kb, n0 = 32 * nb;
    const int kk = lane >> 3, c4 = (lane & 7) * 4;
    const bool ok = (n0 + c4) < valid;
    f32x4 v[8];
#pragma unroll
    for (int i = 0; i < 8; ++i) v[i] = ok ? *(const f32x4*)(W + (size_t)(k0 + 8 * i + kk) * ldw + col0 + n0 + c4) : (f32x4){0.f, 0.f, 0.f, 0.f};
#pragma unroll
    for (int i = 0; i < 8; ++i) { LAS float* d = scr + (8 * i + kk) * 33 + c4; d[0] = v[i].x; d[1] = v[i].y; d[2] = v[i].z; d[3] = v[i].w; }
    LDS_WAIT(); asm volatile("" ::: "memory");
    const int c = lane & 7;
#pragma unroll
    for (int j = 0; j < 4; ++j) { const int n = (lane >> 3) + 8 * j; const LAS float* s = scr + (8 * c) * 33 + n;
        u32x4 o; o.x = pk2(s[0 * 33], s[1 * 33]); o.y = pk2(s[2 * 33], s[3 * 33]); o.z = pk2(s[4 * 33], s[5 * 33]); o.w = pk2(s[6 * 33], s[7 * 33]);
        *(u32x4*)(WT + (size_t)(n0 + n) * K + k0 + 8 * c) = o; }
    LDS_WAIT(); asm volatile("" ::: "memory");
}
__device__ __forceinline__ int win_src_col(int t) {
    if (t < 4) return 256 * t;
    if (t < 8) return 2064 + 256 * (t - 4);
    if (t < 10) return 3088 + 256 * (t - 8);
    if (t < 12) return 4112 + 256 * (t - 10);
    if (t == 12) return 1536;
    if (t < 15) return 1024 + 256 * (t - 13);
    if (t < 17) return 1552 + 256 * (t - 15);
    if (t < 19) return 3600 + 256 * (t - 17);
    return 4624 + 256 * (t - 19);
}
__device__ __forceinline__ f32x4 ld_x16(const bf16_t* row, int j, int lane) { const u32x2 w = ((const u32x2*)row)[64 * j + lane]; return (f32x4){bflo(w.x), bfhi(w.x), bflo(w.y), bfhi(w.y)}; }
template <int NR> __device__ __forceinline__ void rms_rows_bf16(const float* x, const bf16_t* x16, const float* g, bf16_t* o, int m0, int mstep, int lane) {
    f32x4 v[NR][4]; float s[NR];
    if (x16) {
#pragma unroll
        for (int q = 0; q < NR; ++q)
#pragma unroll
            for (int j = 0; j < 4; ++j) v[q][j] = ld_x16(x16 + (size_t)(m0 + q * mstep) * DM, j, lane);
    } else {
#pragma unroll
    for (int q = 0; q < NR; ++q) { const f32x4* xr = (const f32x4*)(x + (size_t)(m0 + q * mstep) * DM) + lane;
#pragma unroll
        for (int j = 0; j < 4; ++j) v[q][j] = xr[64 * j]; }
    }
    const f32x4* gr = (const f32x4*)g + lane; f32x4 gg[4];
#pragma unroll
    for (int j = 0; j < 4; ++j) gg[j] = gr[64 * j];
#pragma unroll
    for (int q = 0; q < NR; ++q) { s[q] = 0.f;
#pragma unroll
        for (int j = 0; j < 4; ++j) s[q] += (v[q][j].x * v[q][j].x + v[q][j].y * v[q][j].y) + (v[q][j].z * v[q][j].z + v[q][j].w * v[q][j].w); }
#pragma unroll
    for (int q = 0; q < NR; ++q) s[q] = wave_sum_dpp(s[q]);
#pragma unroll
    for (int q = 0; q < NR; ++q) { const float r = 1.0f / sqrtf(s[q] * (1.f / DM) + EPS); u32x2* o8 = (u32x2*)(o + (size_t)(m0 + q * mstep) * DM) + lane;
#pragma unroll
        for (int j = 0; j < 4; ++j) { u32x2 w; w.x = pk2(v[q][j].x * r * gg[j].x, v[q][j].y * r * gg[j].y); w.y = pk2(v[q][j].z * r * gg[j].z, v[q][j].w * r * gg[j].w); o8[64 * j] = w; } }
}

struct Ptrs { const float* in[24]; float* out; unsigned char* ws; };
struct Args { Ptrs p; int ph_lo, ph_hi; };
typedef const __attribute__((address_space(4))) Args* KA;

constexpr int TRG_N0 = 31 * 128, TRG_N1 = 3 * 256, TRG_N2 = 512, TRG_N3 = 512, TRG_N4 = 128, TRG_N5 = 16 * 512, TRG_N6 = 16 * 256;
__device__ __forceinline__ void tr_group_item(KA P, int L, int grp, int r, LAS float* scr, int lane) {
    unsigned char* ws = P->p.ws;
    if (grp == 0) { const int t = r / 128; tr_item(P->p.in[3] + (size_t)L * DM * INTOT, INTOT, win_src_col(t), DM, (bf16_t*)(ws + WS_WIN) + (size_t)t * 256 * DM, 256, t == 12 ? 16 : 256, scr, r % 128, lane); }
    else if (grp == 1) { const int j = r / 256; const float* src = (j == 0 ? P->p.in[7] : j == 1 ? P->p.in[10] : P->p.in[12]) + (size_t)L * 512 * DM;
        tr_item(src, DM, 0, 512, (bf16_t*)(ws + WS_WO) + (size_t)j * DM * 512, DM, DM, scr, r % 256, lane); }
    else if (grp == 2) tr_item(P->p.in[13] + (size_t)L * DM * DM, DM, 0, DM, (bf16_t*)(ws + WS_WOUT), DM, DM, scr, r, lane);
    else if (grp == 3) tr_item(P->p.in[22] + (size_t)L * DM * DM, DM, 0, DM, (bf16_t*)(ws + WS_WPG), DM, DM, scr, r, lane);
    else if (grp == 4) tr_item(P->p.in[21] + (size_t)L * PLE * DM, DM, 0, PLE, (bf16_t*)(ws + WS_WPLE), DM, DM, scr, r, lane);
    else if (grp == 5) { const int e = r / 512, q = (r % 512) / 64, n = q >> 1, s = q & 1;
        tr_item(P->p.in[19] + (size_t)(L * NEXP + e) * DM * 1024, 1024, 512 * s + 128 * n, DM, (bf16_t*)(ws + WS_WGU) + (size_t)e * 1024 * DM + (size_t)(256 * n + 128 * s) * DM, 128, 128, scr, r % 64, lane); }
    else { const int e = r / 256; tr_item(P->p.in[20] + (size_t)(L * NEXP + e) * DEXP * DM, DM, 0, DEXP, (bf16_t*)(ws + WS_WDN) + (size_t)e * DM * DEXP, DM, DM, scr, r % 256, lane); }
}
__device__ __forceinline__ void tr_groups(KA P, int L, unsigned mask, LAS float* scr, int gw, int NGW, int lane) {
    const int n[7] = {TRG_N0, TRG_N1, TRG_N2, TRG_N3, TRG_N4, TRG_N5, TRG_N6}; int total = 0;
#pragma unroll
    for (int g = 0; g < 7; ++g) if (mask & (1u << g)) total += n[g];
    for (int it = gw; it < total; it += NGW) { int r = it; bool done = false;
#pragma unroll
        for (int g = 0; g < 7; ++g) if (mask & (1u << g)) { if (!done && r < n[g]) { tr_group_item(P, L, g, r, scr, lane); done = true; } if (!done) r -= n[g]; } }
}
__device__ __forceinline__ void phaseA(KA P, int L, LAS unsigned char* lds, int vcu, int G, int wave, int lane, int tid) {
    LAS float* scr = (LAS float*)(lds + wave * 16384);
    const int gw = vcu * 8 + wave, NGW = G * 8;
    unsigned char* ws = P->p.ws;
    if (L == 0) tr_groups(P, L, 0x07u, scr, gw, NGW, lane);
    for (int m = gw; m < NTOK; m += 4 * NGW) rms_rows_bf16<4>(P->p.in[0], L == 0 ? (const bf16_t*)nullptr : (const bf16_t*)P->p.out, P->p.in[2] + (size_t)L * DM, (bf16_t*)(ws + WS_HN), m, NGW, lane);
    const f32x4* ps = (const f32x4*)(P->p.in[1] + (size_t)L * NTOK * PLE); u32x2* pd = (u32x2*)(ws + WS_PB);
    for (int i = vcu * 512 + tid; i < NTOK * PLE / 4; i += 8 * G * 512) { f32x4 v[8];
#pragma unroll
        for (int q = 0; q < 8; ++q) v[q] = ps[i + q * G * 512];
#pragma unroll
        for (int q = 0; q < 8; ++q) { u32x2 w; w.x = pk2(v[q].x, v[q].y); w.y = pk2(v[q].z, v[q].w); pd[i + q * G * 512] = w; } }
}

__device__ __forceinline__ void gla1_load_w(const float* wa2, const float* ba, LAS unsigned char* lds, int tid) {
    LAS float* WA = (LAS float*)(lds + 49152); LAS float* BA = (LAS float*)(lds + 65536);
    for (int i = tid; i < 4096; i += 512) WA[i] = wa2[i];
    if (tid < 256) BA[tid] = ba[tid];
    __syncthreads();
}
__device__ __forceinline__ float logsig16_l2(float x) {
    const float a = fabsf(x) * 1.4426950408889634f; const float l = __builtin_amdgcn_logf(1.0f + __builtin_amdgcn_exp2f(-a));
    return (fminf(x, 0.f) * 1.4426950408889634f - l) * (1.0f / 16.0f); }
struct Gla1In { u32x4 g0, g1, qv, kv, v0, v1; };
__device__ __forceinline__ void gla1_load(int unit, const bf16_t* Z, int wid, int lane, Gla1In& I) {
    const int bh = unit >> 8, c = unit & 255, b = bh >> 2, h = bh & 3; const size_t row0 = (size_t)b * T + (size_t)c * 64; const int cb = wid * 8; const bf16_t* zr = Z + (row0 + lane) * ZP;
    I.g0 = *(const u32x4*)(zr + C_GA); I.g1 = *(const u32x4*)(zr + C_GA + 8); I.qv = *(const u32x4*)(zr + C_GQ + h * 64 + cb); I.kv = *(const u32x4*)(zr + C_GK + h * 64 + cb);
    I.v0 = *(const u32x4*)(zr + C_GV + h * 128 + 16 * wid); I.v1 = *(const u32x4*)(zr + C_GV + h * 128 + 16 * wid + 8); }
__device__ __forceinline__ void gla1_unit(int unit, const Gla1In& I, bf16_t* Z, bf16_t* SLOCT, float* DTAB, LAS unsigned char* lds, int wid, int lane, int tid, int dry = 0) {
    const int bh = unit >> 8, c = unit & 255, b = bh >> 2, h = bh & 3; const size_t row0 = (size_t)b * T + (size_t)c * 64;
    LAS bf16_t* Qs = (LAS bf16_t*)lds; LAS bf16_t* Ks = (LAS bf16_t*)(lds + 8192); LAS bf16_t* KhT = (LAS bf16_t*)(lds + 16384); LAS bf16_t* VT = (LAS bf16_t*)(lds + 24576);
    LAS bf16_t* Am = (LAS bf16_t*)(lds + 40960); const LAS float* WA = (const LAS float*)(lds + 49152); const LAS float* BA = (const LAS float*)(lds + 65536);
    const int r32 = lane & 31, hi = lane >> 5;
    {
        const int t = lane, cb = wid * 8;
        const u32x4 g0 = I.g0, g1 = I.g1, qv = I.qv, kv = I.kv, v0 = I.v0, v1 = I.v1;
        float gaf[16]; gaf[0] = bflo(g0.x); gaf[1] = bfhi(g0.x); gaf[2] = bflo(g0.y); gaf[3] = bfhi(g0.y); gaf[4] = bflo(g0.z); gaf[5] = bfhi(g0.z); gaf[6] = bflo(g0.w); gaf[7] = bfhi(g0.w);
        gaf[8] = bflo(g1.x); gaf[9] = bfhi(g1.x); gaf[10] = bflo(g1.y); gaf[11] = bfhi(g1.y); gaf[12] = bflo(g1.z); gaf[13] = bfhi(g1.z); gaf[14] = bflo(g1.w); gaf[15] = bfhi(g1.w);
        float la[8];
        { const f32x4 b0 = *(const LAS f32x4*)(BA + h * 64 + cb), b1 = *(const LAS f32x4*)(BA + h * 64 + cb + 4);
          la[0] = b0.x; la[1] = b0.y; la[2] = b0.z; la[3] = b0.w; la[4] = b1.x; la[5] = b1.y; la[6] = b1.z; la[7] = b1.w; }
#pragma unroll
        for (int r = 0; r < 16; ++r) { const f32x4 w0 = *(const LAS f32x4*)(WA + r * 256 + h * 64 + cb), w1 = *(const LAS f32x4*)(WA + r * 256 + h * 64 + cb + 4);
            la[0] = fmaf(gaf[r], w0.x, la[0]); la[1] = fmaf(gaf[r], w0.y, la[1]); la[2] = fmaf(gaf[r], w0.z, la[2]); la[3] = fmaf(gaf[r], w0.w, la[3]);
            la[4] = fmaf(gaf[r], w1.x, la[4]); la[5] = fmaf(gaf[r], w1.y, la[5]); la[6] = fmaf(gaf[r], w1.z, la[6]); la[7] = fmaf(gaf[r], w1.w, la[7]); }
#pragma unroll
        for (int i = 0; i < 8; ++i) la[i] = wave_scan_incl(logsig16_l2(la[i]));
        float qf[8], kf[8];
        qf[0] = bflo(qv.x); qf[1] = bfhi(qv.x); qf[2] = bflo(qv.y); qf[3] = bfhi(qv.y); qf[4] = bflo(qv.z); qf[5] = bfhi(qv.z); qf[6] = bflo(qv.w); qf[7] = bfhi(qv.w);
        kf[0] = bflo(kv.x); kf[1] = bfhi(kv.x); kf[2] = bflo(kv.y); kf[3] = bfhi(kv.y); kf[4] = bflo(kv.z); kf[5] = bfhi(kv.z); kf[6] = bflo(kv.w); kf[7] = bfhi(kv.w);
        float qs[8], ks[8];
#pragma unroll
        for (int i = 0; i < 8; ++i) { const float bl = rdl(la[i], 63); const float eb = __builtin_amdgcn_exp2f(la[i]);
            qs[i] = qf[i] * 0.125f * eb; ks[i] = kf[i] * __builtin_amdgcn_exp2f(-la[i]);
            KhT[(cb + i) * 64 + t] = (bf16_t)f2bf(kf[i] * __builtin_amdgcn_exp2f(bl - la[i]));
            if (lane == 63) DTAB[(size_t)unit * 64 + cb + i] = eb; }
        u32x4 qw, kw; qw.x = pk2(qs[0], qs[1]); qw.y = pk2(qs[2], qs[3]); qw.z = pk2(qs[4], qs[5]); qw.w = pk2(qs[6], qs[7]);
        kw.x = pk2(ks[0], ks[1]); kw.y = pk2(ks[2], ks[3]); kw.z = pk2(ks[4], ks[5]); kw.w = pk2(ks[6], ks[7]);
        *(LAS u32x4*)(Qs + t * 64 + cb) = qw; *(LAS u32x4*)(Ks + t * 64 + cb) = kw;
        if (!dry) *(u32x4*)(Z + (row0 + t) * ZP + C_GQ + h * 64 + cb) = qw;
        LAS bf16_t* vt = VT + (16 * wid) * 64 + t;
        vt[0 * 64] = (bf16_t)(v0.x & 0xffff); vt[1 * 64] = (bf16_t)(v0.x >> 16); vt[2 * 64] = (bf16_t)(v0.y & 0xffff); vt[3 * 64] = (bf16_t)(v0.y >> 16);
        vt[4 * 64] = (bf16_t)(v0.z & 0xffff); vt[5 * 64] = (bf16_t)(v0.z >> 16); vt[6 * 64] = (bf16_t)(v0.w & 0xffff); vt[7 * 64] = (bf16_t)(v0.w >> 16);
        vt[8 * 64] = (bf16_t)(v1.x & 0xffff); vt[9 * 64] = (bf16_t)(v1.x >> 16); vt[10 * 64] = (bf16_t)(v1.y & 0xffff); vt[11 * 64] = (bf16_t)(v1.y >> 16);
        vt[12 * 64] = (bf16_t)(v1.z & 0xffff); vt[13 * 64] = (bf16_t)(v1.z >> 16); vt[14 * 64] = (bf16_t)(v1.w & 0xffff); vt[15 * 64] = (bf16_t)(v1.w >> 16);
    }
    __syncthreads();
    {
        const int vb = wid & 3, kb = wid >> 2; f32x16 acc = {};
#pragma unroll
        for (int ks = 0; ks < 4; ++ks) { const bf16x8 a = *(const LAS bf16x8*)(KhT + (32 * kb + r32) * 64 + 16 * ks + 8 * hi); const bf16x8 bb = *(const LAS bf16x8*)(VT + (32 * vb + r32) * 64 + 16 * ks + 8 * hi);
            acc = __builtin_amdgcn_mfma_f32_32x32x16_bf16(a, bb, acc, 0, 0, 0); }
        bf16_t* sp = SLOCT + (size_t)unit * 8192 + (32 * vb + r32) * 64 + 32 * kb + 4 * hi;
#pragma unroll
        for (int g = 0; g < 4; ++g) { u32x2 w; w.x = pk2(acc[4 * g], acc[4 * g + 1]); w.y = pk2(acc[4 * g + 2], acc[4 * g + 3]); *(u32x2*)(sp + 8 * g) = w; }
    }
    if (wid < 4) {
        const int sb = wid >> 1, tb = wid & 1; f32x16 acc = {};
        if (!(sb == 1 && tb == 0)) {
#pragma unroll
            for (int ks = 0; ks < 4; ++ks) { const bf16x8 a = *(const LAS bf16x8*)(Ks + (32 * sb + r32) * 64 + 16 * ks + 8 * hi); const bf16x8 bb = *(const LAS bf16x8*)(Qs + (32 * tb + r32) * 64 + 16 * ks + 8 * hi);
                acc = __builtin_amdgcn_mfma_f32_32x32x16_bf16(a, bb, acc, 0, 0, 0); }
        }
        const int t = 32 * tb + r32;
#pragma unroll
        for (int r = 0; r < 16; ++r) { const int s = 32 * sb + crow(r, hi); if (s > t) acc[r] = 0.f; }
#pragma unroll
        for (int g = 0; g < 4; ++g) { u32x2 w; w.x = pk2(acc[4 * g], acc[4 * g + 1]); w.y = pk2(acc[4 * g + 2], acc[4 * g + 3]); *(LAS u32x2*)(Am + t * 64 + 32 * sb + 8 * g + 4 * hi) = w; }
    }
    __syncthreads();
    {
        const int vb = wid & 3, tb = wid >> 2; f32x16 acc = {};
#pragma unroll
        for (int ks = 0; ks < 4; ++ks) { const bf16x8 a = *(const LAS bf16x8*)(VT + (32 * vb + r32) * 64 + 16 * ks + 8 * hi); const bf16x8 bb = *(const LAS bf16x8*)(Am + (32 * tb + r32) * 64 + 16 * ks + 8 * hi);
            acc = __builtin_amdgcn_mfma_f32_32x32x16_bf16(a, bb, acc, 0, 0, 0); }
        bf16_t* op = Z + (row0 + 32 * tb + r32) * ZP + C_GV + h * 128 + 32 * vb + 4 * hi;
#pragma unroll
        for (int g = 0; g < 4; ++g) { u32x2 w; w.x = pk2(acc[4 * g], acc[4 * g + 1]); w.y = pk2(acc[4 * g + 2], acc[4 * g + 3]); if (!dry) *(u32x2*)(op + 8 * g) = w; }
    }
    __syncthreads();
}

__device__ __forceinline__ void conv_ld_u(const bf16_t* Z, size_t row, int ch, float (&u)[8]) {
    const u32x4 a = *(const u32x4*)(Z + row * ZP + C_CX + ch), c = *(const u32x4*)(Z + row * ZP + C_CC + ch);
    u[0] = bflo(a.x) * bflo(c.x); u[1] = bfhi(a.x) * bfhi(c.x); u[2] = bflo(a.y) * bflo(c.y); u[3] = bfhi(a.y) * bfhi(c.y);
    u[4] = bflo(a.z) * bflo(c.z); u[5] = bfhi(a.z) * bfhi(c.z); u[6] = bflo(a.w) * bflo(c.w); u[7] = bfhi(a.w) * bfhi(c.w);
}
__device__ __forceinline__ void conv_unit(int cu, bf16_t* Z, const float* cw  , int wid, int lane, int dry = 0) {
    const int ch = lane * 8; const size_t r0 = (size_t)cu * 128 + (size_t)wid * 16;
    float w0[8], w1[8], w2[8];
#pragma unroll
    for (int i = 0; i < 8; ++i) { w0[i] = cw[ch + i]; w1[i] = cw[512 + ch + i]; w2[i] = cw[1024 + ch + i]; }
    float u2[8], u1[8];
    if ((r0 % T) == 0) {
#pragma unroll
        for (int i = 0; i < 8; ++i) { u2[i] = 0.f; u1[i] = 0.f; }
    } else { conv_ld_u(Z, r0 - 2, ch, u2); conv_ld_u(Z, r0 - 1, ch, u1); }
    for (int i0 = 0; i0 < 16; i0 += 4) {
        u32x4 xa[4], ca[4], ba[4];
#pragma unroll
        for (int q = 0; q < 4; ++q) { const size_t row = r0 + i0 + q; xa[q] = *(const u32x4*)(Z + row * ZP + C_CX + ch); ca[q] = *(const u32x4*)(Z + row * ZP + C_CC + ch); ba[q] = *(const u32x4*)(Z + row * ZP + C_CB + ch); }
        asm volatile("" ::: "memory");
#pragma unroll
        for (int q = 0; q < 4; ++q) { const size_t row = r0 + i0 + q; const u32x4 a = xa[q], c = ca[q], bq = ba[q]; float u[8], bb[8], y[8];
            u[0] = bflo(a.x) * bflo(c.x); u[1] = bfhi(a.x) * bfhi(c.x); u[2] = bflo(a.y) * bflo(c.y); u[3] = bfhi(a.y) * bfhi(c.y);
            u[4] = bflo(a.z) * bflo(c.z); u[5] = bfhi(a.z) * bfhi(c.z); u[6] = bflo(a.w) * bflo(c.w); u[7] = bfhi(a.w) * bfhi(c.w);
            bb[0] = bflo(bq.x); bb[1] = bfhi(bq.x); bb[2] = bflo(bq.y); bb[3] = bfhi(bq.y); bb[4] = bflo(bq.z); bb[5] = bfhi(bq.z); bb[6] = bflo(bq.w); bb[7] = bfhi(bq.w);
#pragma unroll
            for (int k = 0; k < 8; ++k) { y[k] = bb[k] * (w0[k] * u2[k] + w1[k] * u1[k] + w2[k] * u[k]); u2[k] = u1[k]; u1[k] = u[k]; }
            u32x4 o; o.x = pk2(y[0], y[1]); o.y = pk2(y[2], y[3]); o.z = pk2(y[4], y[5]); o.w = pk2(y[6], y[7]);
            if (!dry) *(u32x4*)(Z + row * ZP + C_OC + ch) = o; }
        asm volatile("" ::: "memory"); }
}

__device__ __forceinline__ void knorm_unit(int cu, const bf16_t* KV, unsigned* KN  , LAS unsigned char* lds, int wid, int lane, int tid) {
    const size_t r0 = (size_t)cu * 128 + (size_t)wid * 16; float mx = 0.f;
    const int kb_ = (int)(r0 / T); const size_t t0_ = r0 - (size_t)kb_ * T;
#ifdef NO_KV
    for (int i = 0; i < 16; ++i) { const u32x4 a = *(const u32x4*)(KV + (r0 + i) * ZP + C_DK + lane * 8);
#else
    for (int i = 0; i < 16; ++i) { const u32x4 a = *(const u32x4*)(KV + ((size_t)(kb_ * 4 + (lane >> 4)) * T + t0_ + i) * 256 + (lane & 15) * 8);
#endif
        const float f0 = bflo(a.x), f1 = bfhi(a.x), f2 = bflo(a.y), f3 = bfhi(a.y), f4 = bflo(a.z), f5 = bfhi(a.z), f6 = bflo(a.w), f7 = bfhi(a.w);
        float s = (f0 * f0 + f1 * f1) + (f2 * f2 + f3 * f3) + (f4 * f4 + f5 * f5) + (f6 * f6 + f7 * f7);
        s += xor_lane<1>(s); s += xor_lane<2>(s); s += xor_lane<4>(s);
        mx = fmaxf(mx, s); }
    mx = fmaxf(mx, xor_lane<8>(mx));
    LAS float* SC = (LAS float*)lds;
    if ((lane & 15) == 0) SC[wid * 4 + (lane >> 4)] = mx;
    __syncthreads();
    if (tid < 4) { float v = SC[tid];
#pragma unroll
        for (int w = 1; w < 8; ++w) v = fmaxf(v, SC[w * 4 + tid]);
        const int b = (int)(((size_t)cu * 128) / T);
        __hip_atomic_fetch_max(KN + b * 4 + tid, __float_as_uint(v), __ATOMIC_RELAXED, __HIP_MEMORY_SCOPE_AGENT); }
    __syncthreads();
}
namespace att {
constexpr int KVBLK = 64;
constexpr float C = 0.125f * 1.4426950408889634f;
constexpr float WTHR = 26.f;
#define KSWZ(row, colB) ((row) * 256 + ((colB) ^ (((row) & 7) << 4)))
#define SBAR() __builtin_amdgcn_sched_barrier(0)
#define SGB(mask, n) __builtin_amdgcn_sched_group_barrier(mask, n, 0)
__device__ __forceinline__ unsigned cvtpk(float lo, float hi) { unsigned r; asm volatile("v_cvt_pk_bf16_f32 %0, %1, %2" : "=v"(r) : "v"(lo), "v"(hi)); return r; }

__device__ __forceinline__ float addf(float a, float b) { float r; asm("v_add_f32 %0, %1, %2" : "=v"(r) : "v"(a), "v"(b)); return r; }
__device__ __forceinline__ bool psm_test(f32x16& p0, f32x16& p1, bool band, int dlim, float thr, bool test) {
    if (band) {
#pragma unroll
        for (int r = 0; r < 16; ++r) { const int cr = (r & 3) + 8 * (r >> 2); if (cr > dlim) p0[r] = -1e30f; if (cr + 32 > dlim) p1[r] = -1e30f; }
    }
    if (!test) return false;
    float pm0 = p0[0], pm1 = p1[0];
#pragma unroll
    for (int r = 1; r < 16; ++r) { pm0 = fmaxf(pm0, p0[r]); pm1 = fmaxf(pm1, p1[r]); }
    float pmax = fmaxf(pm0, pm1);
    { auto rr = __builtin_amdgcn_permlane32_swap(__float_as_uint(pmax), __float_as_uint(pmax), false, false);
      pmax = fmaxf(__uint_as_float(rr[0]), __uint_as_float(rr[1])); }
    return __all(pmax < thr);
}
__device__ __forceinline__ void partialSM(f32x16& p0, f32x16& p1, bool band, int dlim, float thr, bool test, bool& skip) {
    skip = psm_test(p0, p1, band, dlim, thr, test);
    if (skip) return;
#pragma unroll
    for (int r = 0; r < 16; ++r) p0[r] = __builtin_amdgcn_exp2f(p0[r]);
}
__device__ __forceinline__ void finishSM(f32x16& p0, f32x16& p1, float& l_reg, bf16x8& pa0, bf16x8& pa1, bf16x8& pa2, bf16x8& pa3) {
#pragma unroll
    for (int r = 0; r < 16; ++r) p1[r] = __builtin_amdgcn_exp2f(p1[r]);
    float s0 = addf(p0[0], p0[1]), s1 = addf(p0[2], p0[3]), s2 = addf(p1[0], p1[1]), s3 = addf(p1[2], p1[3]);
#pragma unroll
    for (int r = 4; r < 16; r += 4) { s0 = addf(s0, p0[r]); s1 = addf(s1, p0[r + 1]); s2 = addf(s2, p1[r]); s3 = addf(s3, p1[r + 1]); s0 = addf(s0, p0[r + 2]); s1 = addf(s1, p0[r + 3]); s2 = addf(s2, p1[r + 2]); s3 = addf(s3, p1[r + 3]); }
    l_reg = addf(l_reg, addf(addf(s0, s1), addf(s2, s3)));
#define PK4(P, BASE, OUT) do { unsigned a0 = cvtpk(P[BASE + 0], P[BASE + 1]), a1 = cvtpk(P[BASE + 2], P[BASE + 3]);   \
    unsigned b0 = cvtpk(P[BASE + 4], P[BASE + 5]), b1 = cvtpk(P[BASE + 6], P[BASE + 7]);                              \
    auto r0 = __builtin_amdgcn_permlane32_swap(a0, b0, false, false); auto r1 = __builtin_amdgcn_permlane32_swap(a1, b1, false, false); \
    u32x4 w = {r0[0], r1[0], r0[1], r1[1]}; OUT = *reinterpret_cast<bf16x8*>(&w); } while (0)
    PK4(p0, 0, pa0); PK4(p0, 8, pa1); PK4(p1, 0, pa2); PK4(p1, 8, pa3);
#undef PK4
}
__device__ __forceinline__ void qkt(f32x16& p0, f32x16& p1, const char* Ks, const bf16x8* qr, int r32, int hi, int m) {
    bf16x8 b0[4], b1[4];
#pragma unroll
    for (int d0 = 0; d0 < 4; ++d0) { const int cb = ((4 * m + d0) * 16 + hi * 8) * 2;
        b0[d0] = *reinterpret_cast<const bf16x8*>(Ks + KSWZ(r32, cb)); b1[d0] = *reinterpret_cast<const bf16x8*>(Ks + KSWZ(32 + r32, cb)); }
    __builtin_amdgcn_s_setprio(1);
#pragma unroll
    for (int d0 = 0; d0 < 4; ++d0) { p0 = __builtin_amdgcn_mfma_f32_32x32x16_bf16(b0[d0], qr[d0], p0, 0, 0, 0); p1 = __builtin_amdgcn_mfma_f32_32x32x16_bf16(b1[d0], qr[d0], p1, 0, 0, 0); }
    __builtin_amdgcn_s_setprio(0);
    SGB(0x100, 4); SGB(0x008, 1); SGB(0x100, 1); SGB(0x008, 1); SGB(0x100, 1); SGB(0x008, 1); SGB(0x100, 1); SGB(0x008, 1); SGB(0x100, 1); SGB(0x008, 4);
}
__device__ __forceinline__ void cinit(f32x16& p0, f32x16& p1, const f32x16& cb, float t0, float t1) {
#pragma unroll
    for (int r = 0; r < 16; ++r) { p0[r] = addf(cb[r], t0); p1[r] = addf(cb[r], t1); }
}
__device__ __forceinline__ int v_st(int k, int c) { const int kk = (k & ~0xC) | ((k & 4) << 1) | ((k & 8) >> 1); return ((kk >> 3) * 4 + (c >> 5)) * 512 + ((kk & 7) * 32 + (c & 31)) * 2; }
__device__ __forceinline__ int v_rd_base(int lane) { return ((lane & 3) << 3) | (((lane >> 2) & 3) << 6) | (((lane >> 4) & 1) << 5) | (((lane >> 5) & 1) << 8); }
constexpr int v_rd_off(int d0, int ks, int half) { return d0 * 512 + ks * 4096 + half * 2048; }
typedef short v4i16_t __attribute__((ext_vector_type(4)));
template <int OFF> __device__ __forceinline__ s16x4 tr_read(int vb) { s16x4 r; asm volatile("ds_read_b64_tr_b16 %0, %1 offset:%2" : "=v"(r) : "v"(vb), "n"(OFF)); return r; }
struct VFrag { s16x4 l0, h0, l1, h1, l2, h2, l3, h3; };
template <int D0> __device__ __forceinline__ void v_load(VFrag& f, int vb) {
    f.l0 = tr_read<v_rd_off(D0, 0, 0)>(vb); f.h0 = tr_read<v_rd_off(D0, 0, 1)>(vb); f.l1 = tr_read<v_rd_off(D0, 1, 0)>(vb); f.h1 = tr_read<v_rd_off(D0, 1, 1)>(vb);
    f.l2 = tr_read<v_rd_off(D0, 2, 0)>(vb); f.h2 = tr_read<v_rd_off(D0, 2, 1)>(vb); f.l3 = tr_read<v_rd_off(D0, 3, 0)>(vb); f.h3 = tr_read<v_rd_off(D0, 3, 1)>(vb); }
__device__ __forceinline__ void v_wait(VFrag& f) { asm volatile("s_waitcnt lgkmcnt(0)" : "+v"(f.l0), "+v"(f.h0), "+v"(f.l1), "+v"(f.h1), "+v"(f.l2), "+v"(f.h2), "+v"(f.l3), "+v"(f.h3)); }
__device__ __forceinline__ void pv_mma(f32x16& od, const VFrag& f, bf16x8 pa0, bf16x8 pa1, bf16x8 pa2, bf16x8 pa3) {
#define PK(L, H) (bf16x8){L[0], L[1], L[2], L[3], H[0], H[1], H[2], H[3]}
    od = __builtin_amdgcn_mfma_f32_32x32x16_bf16(pa0, PK(f.l0, f.h0), od, 0, 0, 0);
    od = __builtin_amdgcn_mfma_f32_32x32x16_bf16(pa1, PK(f.l1, f.h1), od, 0, 0, 0);
    od = __builtin_amdgcn_mfma_f32_32x32x16_bf16(pa2, PK(f.l2, f.h2), od, 0, 0, 0);
    od = __builtin_amdgcn_mfma_f32_32x32x16_bf16(pa3, PK(f.l3, f.h3), od, 0, 0, 0);
#undef PK
}
__device__ __forceinline__ void pv_d0(f32x16* o, int vb, bf16x8 pa0, bf16x8 pa1, bf16x8 pa2, bf16x8 pa3) {
    VFrag A, B;
    v_load<0>(A, vb);
    __builtin_amdgcn_s_setprio(1);
    v_wait(A); v_load<1>(B, vb); pv_mma(o[0], A, pa0, pa1, pa2, pa3);
    v_wait(B); v_load<2>(A, vb); pv_mma(o[1], B, pa0, pa1, pa2, pa3);
    v_wait(A); v_load<3>(B, vb); pv_mma(o[2], A, pa0, pa1, pa2, pa3);
    v_wait(B); pv_mma(o[3], B, pa0, pa1, pa2, pa3);
    __builtin_amdgcn_s_setprio(0);
}

constexpr int SLOT = 32768, NSLOTS = 4, WSF_OFF = NSLOTS * SLOT;
__device__ __forceinline__ void unit(int tid_in, int b, int h, int qb, float lam, float oneml, float kn2, bf16_t* Z, const bf16_t* KV, const float* gdiff, char* lds, int dry = 0) {
    int tid_l = tid_in; asm volatile("" : "+v"(tid_l)); const int tid = tid_l;
    const int wid = __builtin_amdgcn_readfirstlane(tid >> 6), lane = tid & 63, r32 = lane & 31, hi = lane >> 5, m = wid >> 2, rb = wid & 3;
    const size_t rowbase = (size_t)b * T; const int q0 = qb * 128;
    const float slope2 = exp2f(-2.f * (float)(h + 1)) * 1.4426950408889634f;
    LAS unsigned char* ldsL = (LAS unsigned char*)lds;
    float* wsf = (float*)(lds + WSF_OFF) + wid * 64; float* li_l = wsf;
    float l_reg = 0; f32x16 o[4] = {}; bf16x8 qr[4];
    const bf16_t* Qw = Z + (rowbase + q0 + rb * 32 + r32) * ZP + C_DQ + h * 128 + m * 64 + hi * 8;
    float qss = 0.f;
#pragma unroll
    for (int d0 = 0; d0 < 4; ++d0) { const u32x4 w = *reinterpret_cast<const u32x4*>(Qw + d0 * 16);
        const float f0 = bflo(w.x), f1 = bfhi(w.x), f2 = bflo(w.y), f3 = bfhi(w.y), f4 = bflo(w.z), f5 = bfhi(w.z), f6 = bflo(w.w), f7 = bfhi(w.w);
        qss += (f0 * f0 + f1 * f1) + (f2 * f2 + f3 * f3) + (f4 * f4 + f5 * f5) + (f6 * f6 + f7 * f7);
        u32x4 s; s.x = pk2(f0 * C, f1 * C); s.y = pk2(f2 * C, f3 * C); s.z = pk2(f4 * C, f5 * C); s.w = pk2(f6 * C, f7 * C); qr[d0] = __builtin_bit_cast(bf16x8, s); }
    { auto rr = __builtin_amdgcn_permlane32_swap(__float_as_uint(qss), __float_as_uint(qss), false, false); qss = __uint_as_float(rr[0]) + __uint_as_float(rr[1]); }
    const float ubrow = 1.02f * sqrtf(qss) * sqrtf(kn2) * C;
    BFLY32(qss, fmaxf);
#ifdef NO_KV
#define KVP (ZP * 2)
    const char* Kh = (const char*)(Z + rowbase * ZP + C_DK + h * 128); const char* Vh = (const char*)(Z + rowbase * ZP + C_DV + h * 128);
#else
#define KVP 512
    const char* Kh = (const char*)(KV + (size_t)(b * 4 + h) * T * 256); const char* Vh = Kh + 256;
#endif
    unsigned kofs[2], vofs[2];
#pragma unroll
    for (int i = 0; i < 2; ++i) { const int ob = (2 * wid + i) * 1024 + lane * 16;
        { const int row = ob >> 8, cb = (ob & 255) ^ ((row & 7) << 4); kofs[i] = (unsigned)(row * KVP + cb); }
        { const int sub = ob >> 9, kkh = sub >> 2, cblk = sub & 3, w16 = (ob & 511) >> 1, kkl = w16 >> 5, cc = w16 & 31, kk = kkh * 8 + kkl;
          const int k = (kk & ~0xC) | ((kk & 4) << 1) | ((kk & 8) >> 1); vofs[i] = (unsigned)(k * KVP + (cblk * 32 + cc) * 2); } }
#define DMA_TILE(j_, so_) do { const char* kb_ = Kh + (size_t)(j_) * (size_t)(64 * KVP); const char* vb_ = Vh + (size_t)(j_) * (size_t)(64 * KVP); \
    _Pragma("unroll") for (int i_ = 0; i_ < 2; ++i_) { \
        __builtin_amdgcn_global_load_lds((const unsigned*)(kb_ + kofs[i_]), (LAS unsigned*)(ldsL + (so_) + 16384 + (2 * wid + i_) * 1024), 16, 0, 0); \
        __builtin_amdgcn_global_load_lds((const unsigned*)(vb_ + vofs[i_]), (LAS unsigned*)(ldsL + (so_) + (2 * wid + i_) * 1024), 16, 0, 0); } } while (0)
#define WAITBAR() asm volatile("s_waitcnt vmcnt(0) lgkmcnt(0)\n\ts_barrier" ::: "memory")
#define WAITBAR4() asm volatile("s_waitcnt vmcnt(4) lgkmcnt(0)\n\ts_barrier" ::: "memory")
    const int vb0 = (int)(uintptr_t)lds + v_rd_base(lane);
    const int qrel = q0 + rb * 32 + r32;
    const float c32 = 32.f * slope2;
    f32x16 cb;
#pragma unroll
    for (int r = 0; r < 16; ++r) cb[r] = slope2 * (float)((r & 3) + 8 * (r >> 2) + 4 * hi - (rb * 32 + r32));
    asm volatile("" : "+v"(cb));
#define TJ(j) (slope2 * (float)(64 * (j) - q0))
    const int NT = 2 * (qb + 1);
    float mband, mlb;
    { DMA_TILE(NT - 2, 0); DMA_TILE(NT - 1, SLOT);
      if (lane == 0) wsf[0] = qss; WAITBAR();
      f32x16 t0, t1; float mx = -1e30f;
#pragma unroll
      for (int bt = 0; bt < 2; ++bt) { const int j = NT - 2 + bt; cinit(t0, t1, cb, TJ(j), TJ(j) + c32); qkt(t0, t1, lds + bt * SLOT + 16384, qr, r32, hi, m); const int dlim = qrel - 64 * j - 4 * hi;
#pragma unroll
          for (int r = 0; r < 16; ++r) { const int cr = (r & 3) + 8 * (r >> 2); if (cr > dlim) t0[r] = -1e30f; if (cr + 32 > dlim) t1[r] = -1e30f; }
          float a0 = t0[0], a1 = t1[0];
#pragma unroll
          for (int r = 1; r < 16; ++r) { a0 = fmaxf(a0, t0[r]); a1 = fmaxf(a1, t1[r]); }
          mx = fmaxf(mx, fmaxf(a0, a1)); }
      { auto rr = __builtin_amdgcn_permlane32_swap(__float_as_uint(mx), __float_as_uint(mx), false, false); mx = fmaxf(__uint_as_float(rr[0]), __uint_as_float(rr[1])); }
      mlb = mx;
      BFLY32(mx, fminf);
      mband = mx; }
    float qn2 = 0.f;
#pragma unroll
    for (int w = 0; w < 8; ++w) qn2 = fmaxf(qn2, ((float*)(lds + WSF_OFF))[w * 64]);
    WAITBAR();
    if (lane == 0) wsf[0] = mband; WAITBAR();
    float mbmin = 1e30f;
#pragma unroll
    for (int w = 0; w < 8; ++w) mbmin = fminf(mbmin, ((float*)(lds + WSF_OFF))[w * 64]);
    const float wd = (WTHR + 1.02f * sqrtf(qn2) * sqrtf(kn2) * C - mbmin) / slope2;
    int jlo = (int)floorf(((float)(q0 - 63) - wd) * (1.f / 64.f)); jlo = jlo < 0 ? 0 : (jlo & ~1);
    jlo = __builtin_amdgcn_readfirstlane(jlo);
    DMA_TILE(jlo, 0); DMA_TILE(jlo + 1, SLOT); if (jlo + 2 < NT) DMA_TILE(jlo + 2, 2 * SLOT);
    int jfar = (int)floorf(((float)(q0 - 63) - (WTHR + 0.25f * sqrtf(qn2) * sqrtf(kn2) * C - mbmin) / slope2) * (1.f / 64.f)) + 1; jfar = __builtin_amdgcn_readfirstlane(jfar);
    const float mexp = fmaxf(mlb, ubrow - 100.f);
    const float thr = mlb - mexp - WTHR;
#pragma unroll
    for (int r = 0; r < 16; ++r) cb[r] -= mexp;
    asm volatile("" : "+v"(cb));
#define PSM(P0, P1, j, SK) partialSM(P0, P1, (j) >= NT - 2, qrel - 64 * (j) - 4 * hi, thr, (j) < jfar || (j) >= NT - 2, SK)
#define QKT(P0, P1, j) do { cinit(P0, P1, cb, TJ(j), TJ(j) + c32); qkt(P0, P1, lds + sl_cur + 16384, qr, r32, hi, m); } while (0)
#define ROT() do { sl_prev = sl_cur; sl_cur = sl_next; sl_next = sl_n2; sl_n2 = (sl_n2 == (NSLOTS - 1) * SLOT) ? 0 : sl_n2 + SLOT; } while (0)
    f32x16 pA0, pA1, pB0, pB1; bf16x8 pa0, pa1, pa2, pa3; bool skA, skB;
    int sl_prev = 0, sl_cur = 0, sl_next = SLOT, sl_n2 = 2 * SLOT;
    WAITBAR();
    QKT(pA0, pA1, jlo); PSM(pA0, pA1, jlo, skA);
    ROT();
    for (int j = jlo + 1; j + 1 < NT; j += 2) {
        if (j + 2 < NT) DMA_TILE(j + 2, sl_n2);
        SBAR(); QKT(pB0, pB1, j);
        if (!skA) finishSM(pA0, pA1, l_reg, pa0, pa1, pa2, pa3); SBAR();
        if (!skA) pv_d0(o, vb0 + sl_prev, pa0, pa1, pa2, pa3); PSM(pB0, pB1, j, skB);
        if (j + 2 < NT) WAITBAR4(); else WAITBAR();
        ROT();
        if (j + 3 < NT) DMA_TILE(j + 3, sl_n2);
        SBAR(); QKT(pA0, pA1, j + 1);
        if (!skB) finishSM(pB0, pB1, l_reg, pa0, pa1, pa2, pa3); SBAR();
        if (!skB) pv_d0(o, vb0 + sl_prev, pa0, pa1, pa2, pa3); PSM(pA0, pA1, j + 1, skA);
        if (j + 3 < NT) WAITBAR4(); else WAITBAR();
        ROT();
    }
    SBAR(); QKT(pB0, pB1, NT - 1);
    if (!skA) finishSM(pA0, pA1, l_reg, pa0, pa1, pa2, pa3); SBAR();
    if (!skA) pv_d0(o, vb0 + sl_prev, pa0, pa1, pa2, pa3); PSM(pB0, pB1, NT - 1, skB);
    if (!skB) { finishSM(pB0, pB1, l_reg, pa0, pa1, pa2, pa3); SBAR();
    pv_d0(o, vb0 + sl_cur, pa0, pa1, pa2, pa3); }
    { auto rr = __builtin_amdgcn_permlane32_swap(__float_as_uint(l_reg), __float_as_uint(l_reg), false, false); l_reg = __uint_as_float(rr[0]) + __uint_as_float(rr[1]); }
    if (hi == 0) li_l[r32] = l_reg; asm volatile("s_waitcnt lgkmcnt(0)" ::: "memory");
    float rli[16];
#pragma unroll
    for (int r = 0; r < 16; ++r) rli[r] = __builtin_amdgcn_rcpf(li_l[crow(r, hi)]);
    WAITBAR();
    float* XO = (float*)lds + rb * 4096;
    if (m == 1) {
#pragma unroll
        for (int d0 = 0; d0 < 4; ++d0)
#pragma unroll
            for (int r = 0; r < 16; ++r) XO[(d0 * 16 + r) * 64 + lane] = o[d0][r] * rli[r];
    }
    WAITBAR();
    if (m == 0) {
        float ss[16];
#pragma unroll
        for (int r = 0; r < 16; ++r) ss[r] = 0.f;
#pragma unroll
        for (int d0 = 0; d0 < 4; ++d0)
#pragma unroll
            for (int r = 0; r < 16; ++r) { const float v = o[d0][r] * rli[r] - lam * XO[(d0 * 16 + r) * 64 + lane]; o[d0][r] = v; ss[r] += v * v; }
#pragma unroll
        for (int r = 0; r < 16; ++r) {
            BFLY32(ss[r], opadd_);
            ss[r] = oneml / sqrtf(ss[r] * (1.f / 128.f) + EPS); }
        bf16_t* Ow = Z + (rowbase + q0 + rb * 32) * ZP + C_OB + h * 128 + r32;
#pragma unroll
        for (int d0 = 0; d0 < 4; ++d0) { const float gc = gdiff[32 * d0 + r32];
#pragma unroll
            for (int r = 0; r < 16; ++r) if (!dry) Ow[(size_t)crow(r, hi) * ZP + 32 * d0] = (bf16_t)f2bf(o[d0][r] * ss[r] * gc); }
    }
    WAITBAR();
#undef DMA_TILE
#undef WAITBAR
#undef WAITBAR4
#undef PSM
#undef QKT
#undef TJ
#undef ROT
}
#undef KSWZ
#undef SBAR
}

__device__ __forceinline__ void gla_scan(bf16_t* SLOCT, const float* DTAB, LAS unsigned char* lds, int G, int bx, int tid) {
    const int seg = tid >> 5, pl = tid & 31; LAS f32x4* PR = (LAS f32x4*)lds;
    for (int grp = bx; grp < 1024; grp += G) {
        const int pi = grp * 32 + pl, bh = pi >> 12, e2 = (pi & 4095) * 2, dk = e2 & 63;
        unsigned* sp = (unsigned*)(SLOCT + (size_t)bh * 256 * 8192 + e2) + (size_t)(seg * 16) * 4096; const float* dp = DTAB + (size_t)bh * 256 * 64 + dk + (size_t)(seg * 16) * 64;
        unsigned u[16]; f32x2 d[16];
#pragma unroll
        for (int i = 0; i < 16; ++i) { u[i] = sp[(size_t)i * 4096]; d[i] = *(const f32x2*)(dp + (size_t)i * 64); }
        float r0 = 0.f, r1 = 0.f, P0 = 1.f, P1 = 1.f;
#pragma unroll
        for (int i = 0; i < 16; ++i) { r0 = fmaf(d[i].x, r0, bflo(u[i])); r1 = fmaf(d[i].y, r1, bfhi(u[i])); P0 *= d[i].x; P1 *= d[i].y; }
        PR[seg * 32 + pl] = (f32x4){P0, P1, r0, r1};
        __syncthreads();
        float i0 = 0.f, i1 = 0.f;
        for (int s = 0; s < seg; ++s) { const f32x4 q = PR[s * 32 + pl]; i0 = fmaf(q.x, i0, q.z); i1 = fmaf(q.y, i1, q.w); }
#pragma unroll
        for (int i = 0; i < 16; ++i) { sp[(size_t)i * 4096] = pk2(i0, i1); i0 = fmaf(d[i].x, i0, bflo(u[i])); i1 = fmaf(d[i].y, i1, bfhi(u[i])); }
        __syncthreads();
    }
}

struct Gla3In { bf16x8 af[4], bfv[4]; u32x2 oi[4], gq[4]; };
__device__ __forceinline__ void gla3_load(int unit, const bf16_t* Z, const bf16_t* SLOCT, int wid, int lane, Gla3In& I) {
    const int bh = unit >> 8, c = unit & 255, b = bh >> 2, h = bh & 3; const size_t row0 = (size_t)b * T + (size_t)c * 64;
    const int r32 = lane & 31, hi = lane >> 5, vb = wid & 3, tb = wid >> 2; const bf16_t* zr = Z + (row0 + 32 * tb + r32) * ZP;
#pragma unroll
    for (int ks = 0; ks < 4; ++ks) { I.af[ks] = *(const bf16x8*)(SLOCT + (size_t)unit * 8192 + (32 * vb + r32) * 64 + 16 * ks + 8 * hi); I.bfv[ks] = *(const bf16x8*)(zr + C_GQ + h * 64 + 16 * ks + 8 * hi); }
#pragma unroll
    for (int g = 0; g < 4; ++g) { I.oi[g] = *(const u32x2*)(zr + C_GV + h * 128 + 32 * vb + 8 * g + 4 * hi); I.gq[g] = *(const u32x2*)(zr + C_GG + h * 128 + 32 * vb + 8 * g + 4 * hi); }
}
__device__ __forceinline__ void gla3_unit(int unit, const Gla3In& I, bf16_t* Z, const float* ggn, LAS unsigned char* lds, int wid, int lane, int dry = 0) {
    const int bh = unit >> 8, c = unit & 255, b = bh >> 2, h = bh & 3; const size_t row0 = (size_t)b * T + (size_t)c * 64;
    const int r32 = lane & 31, hi = lane >> 5, vb = wid & 3, tb = wid >> 2;
    LAS float* SS = (LAS float*)lds;
    f32x4 gn[4];
#pragma unroll
    for (int g = 0; g < 4; ++g) gn[g] = *(const f32x4*)(ggn + 32 * vb + 8 * g + 4 * hi);
    f32x16 acc = {};
#pragma unroll
    for (int ks = 0; ks < 4; ++ks) acc = __builtin_amdgcn_mfma_f32_32x32x16_bf16(I.af[ks], I.bfv[ks], acc, 0, 0, 0);
    float o[16], ss = 0.f;
#pragma unroll
    for (int g = 0; g < 4; ++g) { o[4 * g] = acc[4 * g] + bflo(I.oi[g].x); o[4 * g + 1] = acc[4 * g + 1] + bfhi(I.oi[g].x); o[4 * g + 2] = acc[4 * g + 2] + bflo(I.oi[g].y); o[4 * g + 3] = acc[4 * g + 3] + bfhi(I.oi[g].y); }
#pragma unroll
    for (int r = 0; r < 16; ++r) ss += o[r] * o[r];
    { auto rr = __builtin_amdgcn_permlane32_swap(__float_as_uint(ss), __float_as_uint(ss), false, false); ss = __uint_as_float(rr[0]) + __uint_as_float(rr[1]); }
    if (hi == 0) SS[wid * 32 + r32] = ss;
    __syncthreads();
    const float tot = (SS[(tb * 4 + 0) * 32 + r32] + SS[(tb * 4 + 1) * 32 + r32]) + (SS[(tb * 4 + 2) * 32 + r32] + SS[(tb * 4 + 3) * 32 + r32]);
    const float rstd = 1.0f / sqrtf(tot * (1.f / 128.f) + EPS);
    bf16_t* gp = Z + (row0 + 32 * tb + r32) * ZP + C_GG + h * 128 + 32 * vb + 4 * hi;
#pragma unroll
    for (int g = 0; g < 4; ++g) { const float g0 = bflo(I.gq[g].x), g1 = bfhi(I.gq[g].x), g2 = bflo(I.gq[g].y), g3 = bfhi(I.gq[g].y);
        u32x2 w; w.x = pk2(o[4 * g] * rstd * gn[g].x * siluf_(g0), o[4 * g + 1] * rstd * gn[g].y * siluf_(g1)); w.y = pk2(o[4 * g + 2] * rstd * gn[g].z * siluf_(g2), o[4 * g + 3] * rstd * gn[g].w * siluf_(g3));
        if (!dry) *(u32x2*)(gp + 8 * g) = w; }
    __syncthreads();
}
namespace pg8 {
constexpr int S8_OFF = 2048;
struct EpiSig8 {
    static constexpr bool PERM = true; static __device__ __forceinline__ bool keep(const Unit&) { return false; }
    unsigned char* Zb;
    __device__ __forceinline__ void operator()(f32x4 (&acc)[2][2][4][2], const Unit& u, int wr, int wc, int fr, int fq) const {
        const int row0 = u.pm * BM + wr * 64 + fr; const int col0 = u.tag * 1024 + u.pn * BM + wc * 32 + 8 * fq;
#pragma unroll
        for (int ai = 0; ai < 2; ++ai)
#pragma unroll
            for (int m = 0; m < 4; ++m) { unsigned char* rowp = Zb + (size_t)(row0 + ai * HALF + m * 16) * (ZP * 2) + S8_OFF + col0;
#pragma unroll
                for (int bj = 0; bj < 2; ++bj) { const f32x4 v0 = acc[ai][bj][m][0], v1 = acc[ai][bj][m][1]; u32x2 w;
                    w.x = (unsigned)(sigmoidf_(v0[0]) * 255.f + 0.5f) | ((unsigned)(sigmoidf_(v0[1]) * 255.f + 0.5f) << 8) | ((unsigned)(sigmoidf_(v0[2]) * 255.f + 0.5f) << 16) | ((unsigned)(sigmoidf_(v0[3]) * 255.f + 0.5f) << 24);
                    w.y = (unsigned)(sigmoidf_(v1[0]) * 255.f + 0.5f) | ((unsigned)(sigmoidf_(v1[1]) * 255.f + 0.5f) << 8) | ((unsigned)(sigmoidf_(v1[2]) * 255.f + 0.5f) << 16) | ((unsigned)(sigmoidf_(v1[3]) * 255.f + 0.5f) << 24);
                    *(u32x2*)(rowp + bj * HALF) = w; } }
    }
};
struct EpiMerge8 {
    static constexpr bool PERM = true; static __device__ __forceinline__ bool keep(const Unit& u) { return u.tag < 2; }
    bf16_t* Z; int dry;
    static __device__ __forceinline__ float g8(unsigned w, int sh) { const unsigned q = (w >> sh) & 255u; return (float)(q ? q : 1u); }
    __device__ __forceinline__ void operator()(f32x4 (&acc)[2][2][4][2], const Unit& u, int wr, int wc, int fr, int fq) const {
        const int j = u.tag; const int row0 = u.pm * BM + wr * 64 + fr; const int col0 = u.pn * BM + wc * 32 + 8 * fq;
#pragma unroll
        for (int ai = 0; ai < 2; ++ai)
#pragma unroll
            for (int mp = 0; mp < 2; ++mp) { u32x2 sa[2][2], sb[2][2];
#pragma unroll
                for (int mm = 0; mm < 2; ++mm)
#pragma unroll
                    for (int bj = 0; bj < 2; ++bj) { const unsigned char* sp = (const unsigned char*)Z + (size_t)(row0 + ai * HALF + (2 * mp + mm) * 16) * (ZP * 2) + S8_OFF + col0 + bj * HALF;
                        sa[mm][bj] = *(const u32x2*)(sp + j * 1024); sb[mm][bj] = (u32x2){0u, 0u}; if (j < 2) sb[mm][bj] = *(const u32x2*)(sp + (j + 1) * 1024); }
                asm volatile("" ::: "memory");
#pragma unroll
                for (int mm = 0; mm < 2; ++mm)
#pragma unroll
                    for (int bj = 0; bj < 2; ++bj) { const int m = 2 * mp + mm; const u32x2 a = sa[mm][bj], b = sb[mm][bj]; float f[8];
#pragma unroll
                        for (int q = 0; q < 4; ++q) { const float n0 = g8(a.x, 8 * q), n1 = g8(a.y, 8 * q);
                            f[q] = j < 2 ? n0 * __builtin_amdgcn_rcpf(g8(b.x, 8 * q)) : n0 * (1.0f / 255.0f); f[4 + q] = j < 2 ? n1 * __builtin_amdgcn_rcpf(g8(b.y, 8 * q)) : n1 * (1.0f / 255.0f); }
                        f32x4& v0 = acc[ai][bj][m][0]; f32x4& v1 = acc[ai][bj][m][1];
                        v0[0] *= f[0]; v0[1] *= f[1]; v0[2] *= f[2]; v0[3] *= f[3]; v1[0] *= f[4]; v1[1] *= f[5]; v1[2] *= f[6]; v1[3] *= f[7];
                        if (j == 2) { bf16_t* rowp = Z + (size_t)(row0 + ai * HALF + m * 16) * ZP + col0 + bj * HALF;
                            u32x4 w; w.x = pk2(v0[0], v0[1]); w.y = pk2(v0[2], v0[3]); w.z = pk2(v1[0], v1[1]); w.w = pk2(v1[2], v1[3]);
                            if (!dry) *(u32x4*)rowp = w; } }
                asm volatile("" ::: "memory"); }
    }
};
struct EpiRes {
    static constexpr bool PERM = true; static __device__ __forceinline__ bool keep(const Unit&) { return false; }
    const float* basef; const bf16_t* base16; bf16_t* out; int dry;
    __device__ __forceinline__ void operator()(f32x4 (&acc)[2][2][4][2], const Unit& u, int wr, int wc, int fr, int fq) const {
        const int row0 = u.pm * BM + wr * 64 + fr; const int col0 = u.pn * BM + wc * 32 + 8 * fq;
#pragma unroll
        for (int ai = 0; ai < 2; ++ai)
#pragma unroll
            for (int mp = 0; mp < 2; ++mp) { f32x4 b0[2][2], b1[2][2];
#pragma unroll
                for (int mm = 0; mm < 2; ++mm)
#pragma unroll
                    for (int bj = 0; bj < 2; ++bj) { const size_t off = (size_t)(row0 + ai * HALF + (2 * mp + mm) * 16) * DM + col0 + bj * HALF;
                        if (base16) { const u32x4 w = *(const u32x4*)(base16 + off); b0[mm][bj] = (f32x4){bflo(w.x), bfhi(w.x), bflo(w.y), bfhi(w.y)}; b1[mm][bj] = (f32x4){bflo(w.z), bfhi(w.z), bflo(w.w), bfhi(w.w)}; }
                        else { b0[mm][bj] = *(const f32x4*)(basef + off); b1[mm][bj] = *(const f32x4*)(basef + off + 4); } }
                asm volatile("" ::: "memory");
#pragma unroll
                for (int mm = 0; mm < 2; ++mm)
#pragma unroll
                    for (int bj = 0; bj < 2; ++bj) { const int m = 2 * mp + mm; const size_t off = (size_t)(row0 + ai * HALF + m * 16) * DM + col0 + bj * HALF;
                        const f32x4 v0 = b0[mm][bj] + acc[ai][bj][m][0], v1 = b1[mm][bj] + acc[ai][bj][m][1];
                        u32x4 w; w.x = pk2(v0[0], v0[1]); w.y = pk2(v0[2], v0[3]); w.z = pk2(v1[0], v1[1]); w.w = pk2(v1[2], v1[3]);
                        if (!dry) *(u32x4*)(out + off) = w; }
                asm volatile("" ::: "memory"); }
    }
};
struct EpiPle {
    static constexpr bool PERM = true; static __device__ __forceinline__ bool keep(const Unit&) { return false; }
    const bf16_t* xb; bf16_t* out; const bf16_t* PL; int dry;
    __device__ __forceinline__ void operator()(f32x4 (&acc)[2][2][4][2], const Unit& u, int wr, int wc, int fr, int fq) const {
        const int row0 = u.pm * BM + wr * 64 + fr; const int col0 = u.pn * BM + wc * 32 + 8 * fq;
#pragma unroll
        for (int ai = 0; ai < 2; ++ai)
#pragma unroll
            for (int mp = 0; mp < 2; ++mp) { u32x4 bs[2][2], pl[2][2];
#pragma unroll
                for (int mm = 0; mm < 2; ++mm)
#pragma unroll
                    for (int bj = 0; bj < 2; ++bj) { const size_t off = (size_t)(row0 + ai * HALF + (2 * mp + mm) * 16) * DM + col0 + bj * HALF; bs[mm][bj] = *(const u32x4*)(xb + off); pl[mm][bj] = *(const u32x4*)(PL + off); }
                asm volatile("" ::: "memory");
#pragma unroll
                for (int mm = 0; mm < 2; ++mm)
#pragma unroll
                    for (int bj = 0; bj < 2; ++bj) { const int m = 2 * mp + mm; const size_t off = (size_t)(row0 + ai * HALF + m * 16) * DM + col0 + bj * HALF;
                        const f32x4 a0 = acc[ai][bj][m][0], a1 = acc[ai][bj][m][1]; const u32x4 b = bs[mm][bj], p = pl[mm][bj]; u32x4 w;
                        w.x = pk2(fmaf(sigmoidf_(a0[0]), bflo(p.x), bflo(b.x)), fmaf(sigmoidf_(a0[1]), bfhi(p.x), bfhi(b.x)));
                        w.y = pk2(fmaf(sigmoidf_(a0[2]), bflo(p.y), bflo(b.y)), fmaf(sigmoidf_(a0[3]), bfhi(p.y), bfhi(b.y)));
                        w.z = pk2(fmaf(sigmoidf_(a1[0]), bflo(p.z), bflo(b.z)), fmaf(sigmoidf_(a1[1]), bfhi(p.z), bfhi(b.z)));
                        w.w = pk2(fmaf(sigmoidf_(a1[2]), bflo(p.w), bflo(b.w)), fmaf(sigmoidf_(a1[3]), bfhi(p.w), bfhi(b.w)));
                        if (!dry) *(u32x4*)(out + off) = w; }
                asm volatile("" ::: "memory"); }
    }
};
struct EpiUp {
    static constexpr bool PERM = true; static __device__ __forceinline__ bool keep(const Unit&) { return false; }
    bf16_t* ACT; const float* sw;
    __device__ __forceinline__ void operator()(f32x4 (&acc)[2][2][4][2], const Unit& u, int wr, int wc, int fr, int fq) const {
        const int row0 = u.pm * BM + wr * 64 + fr; const int col0 = u.tag * DEXP + u.pn * HALF + wc * 32 + 8 * fq; const float* swj = sw + (size_t)u.tag * NSLOT;
        float sv[2][4];
#pragma unroll
        for (int ai = 0; ai < 2; ++ai)
#pragma unroll
            for (int m = 0; m < 4; ++m) sv[ai][m] = swj[row0 + ai * HALF + m * 16];
#pragma unroll
        for (int ai = 0; ai < 2; ++ai)
#pragma unroll
            for (int m = 0; m < 4; ++m) { const f32x4 g0 = acc[ai][0][m][0], g1 = acc[ai][0][m][1], u0 = acc[ai][1][m][0] * sv[ai][m], u1 = acc[ai][1][m][1] * sv[ai][m];
                u32x4 w; w.x = pk2(siluf_(g0[0]) * u0[0], siluf_(g0[1]) * u0[1]); w.y = pk2(siluf_(g0[2]) * u0[2], siluf_(g0[3]) * u0[3]);
                w.z = pk2(siluf_(g1[0]) * u1[0], siluf_(g1[1]) * u1[1]); w.w = pk2(siluf_(g1[2]) * u1[2], siluf_(g1[3]) * u1[3]);
                *(u32x4*)(ACT + (size_t)(row0 + ai * HALF + m * 16) * DM + col0) = w; }
    }
};
struct EpiDownRes {
    static constexpr bool PERM = true; static __device__ __forceinline__ bool keep(const Unit& u) { return (u.tag & 1) == 0; }
    const bf16_t* X16; bf16_t* XB; const int* s2t; int dry;
    __device__ __forceinline__ void operator()(f32x4 (&acc)[2][2][4][2], const Unit& u, int wr, int wc, int fr, int fq) const {
        if ((u.tag & 1) == 0) return;
        const int nvalid = u.tag >> 1; const int rl0 = wr * 64 + fr; const int col0 = u.pn * BM + wc * 32 + 8 * fq;
        int tk[2][4];
#pragma unroll
        for (int ai = 0; ai < 2; ++ai)
#pragma unroll
            for (int m = 0; m < 4; ++m) { const int rl = rl0 + ai * HALF + m * 16; tk[ai][m] = rl < nvalid ? s2t[u.pm * BM + rl] : -1; }
#pragma unroll
        for (int ai = 0; ai < 2; ++ai)
#pragma unroll
            for (int mp = 0; mp < 2; ++mp) { u32x4 bs[2][2];
#pragma unroll
                for (int mm = 0; mm < 2; ++mm)
#pragma unroll
                    for (int bj = 0; bj < 2; ++bj) { const int t = tk[ai][2 * mp + mm]; bs[mm][bj] = *(const u32x4*)(X16 + (size_t)(t < 0 ? 0 : t) * DM + col0 + bj * HALF); }
                asm volatile("" ::: "memory");
#pragma unroll
                for (int mm = 0; mm < 2; ++mm)
#pragma unroll
                    for (int bj = 0; bj < 2; ++bj) { const int m = 2 * mp + mm; const int t = tk[ai][m]; const u32x4 b = bs[mm][bj];
                        const f32x4 a0 = acc[ai][bj][m][0], a1 = acc[ai][bj][m][1]; u32x4 w;
                        w.x = pk2(bflo(b.x) + a0[0], bfhi(b.x) + a0[1]); w.y = pk2(bflo(b.y) + a0[2], bfhi(b.y) + a0[3]);
                        w.z = pk2(bflo(b.z) + a1[0], bfhi(b.z) + a1[1]); w.w = pk2(bflo(b.w) + a1[2], bfhi(b.w) + a1[3]);
                        if (t >= 0 && !dry) *(u32x4*)(XB + (size_t)t * DM + col0 + bj * HALF) = w; }
                asm volatile("" ::: "memory"); }
    }
};
struct MergeOrder {
    int c, G; int abase, astep; size_t bbase, bstep;
    __device__ bool next(int i, Unit& u) const { const int pair = (i / 3) * G + c, j = i % 3; if (pair >= 512) return false;
        u.pm = pair >> 2; u.pn = pair & 3; u.tag = j; u.aoff = abase + j * astep; u.boff = bbase + (size_t)j * bstep; return true; }
};
__device__ __forceinline__ int pair_expert(int k, int j) { const int g = (k * 43) >> 8, q = k - 6 * g; return g * 4 + (((j ? 0x332321 : 0x211000) >> (4 * q)) & 15); }
struct PairUpOrder {
    const int* tbl; int c, G; size_t bstride;
    __device__ bool next(int i, Unit& u) const {
        const int L = i * G + c, pm = L >> 3; if (pm >= tbl[62]) return false;
        const int j = (L >> 2) & 1, k = tbl[64 + pm] & 255;
        u.pm = pm; u.pn = L & 3; u.tag = j; u.aoff = 0; u.boff = (size_t)pair_expert(k, j) * bstride; return true; }
};
struct PairDownOrder {
    const int* tbl; int c, G; size_t bstride;
    __device__ bool next(int i, Unit& u) const {
        const int j = i & 1, L = (i >> 1) * G + c, pm = L >> 2; if (pm >= tbl[62]) return false;
        const int d = tbl[64 + pm];
        u.pm = pm; u.pn = L & 3; u.tag = j | ((d >> 8) << 1); u.aoff = j * DEXP; u.boff = (size_t)pair_expert(d & 255, j) * bstride; return true; }
};
}

__device__ __forceinline__ void phaseF(KA P, int L, LAS unsigned char* lds, int wave, int lane, int tid) {
    LAS float* WR = (LAS float*)lds; LAS int* E0 = (LAS int*)(lds + 81920);
    const float* wrg = P->p.in[15] + (size_t)L * DM * 4; const float* wre = P->p.in[17] + (size_t)L * DM * 16;
    for (int i = tid; i < DM * 4; i += 512) WR[(i & 3) * 1024 + (i >> 2)] = wrg[i];
    for (int i = tid; i < DM * 16; i += 512) WR[(4 + (i & 15)) * 1024 + (i >> 4)] = wre[i];
    __syncthreads();
    const float* brg = P->p.in[16] + L * 4; const float* bre = P->p.in[18] + L * 16; const float* g = P->p.in[14] + (size_t)L * DM;
    const int tok0 = blockIdx.x * TPW;
    int* RB = (int*)(P->p.ws + WS_ROUTE); float* RWA = (float*)(RB + NTOK); float* RWB = RWA + NTOK;
    const f32x4* gr = (const f32x4*)g + lane; f32x4 gg[4];
#pragma unroll
    for (int j = 0; j < 4; ++j) gg[j] = gr[64 * j];
    float brg_[4];
#pragma unroll
    for (int q = 0; q < 4; ++q) brg_[q] = brg[q];
    constexpr int NRB = 4;
    u32x2 nx_[NRB][4];
#pragma unroll
    for (int q = 0; q < NRB; ++q)
#pragma unroll
        for (int j = 0; j < 4; ++j) nx_[q][j] = ((const u32x2*)((const bf16_t*)P->p.out + (size_t)(tok0 + wave * 16 + q) * DM))[64 * j + lane];
    for (int i0 = wave * 16; i0 < wave * 16 + 16; i0 += NRB) {
        f32x4 v[NRB][4]; float s[NRB];
#pragma unroll
        for (int q = 0; q < NRB; ++q)
#pragma unroll
            for (int j = 0; j < 4; ++j) { const u32x2 w = nx_[q][j]; v[q][j] = (f32x4){bflo(w.x), bfhi(w.x), bflo(w.y), bfhi(w.y)}; }
        { const int in_ = (i0 + NRB < wave * 16 + 16) ? i0 + NRB : i0;
#pragma unroll
          for (int q = 0; q < NRB; ++q)
#pragma unroll
              for (int j = 0; j < 4; ++j) nx_[q][j] = ((const u32x2*)((const bf16_t*)P->p.out + (size_t)(tok0 + in_ + q) * DM))[64 * j + lane]; }
#pragma unroll
        for (int q = 0; q < NRB; ++q) { s[q] = 0.f;
#pragma unroll
            for (int j = 0; j < 4; ++j) s[q] += (v[q][j].x * v[q][j].x + v[q][j].y * v[q][j].y) + (v[q][j].z * v[q][j].z + v[q][j].w * v[q][j].w); }
#pragma unroll
        for (int q = 0; q < NRB; ++q) { const float r = 1.0f / sqrtf(wave_sum_dpp(s[q]) * (1.f / DM) + EPS);
            u32x2* o8 = (u32x2*)((bf16_t*)(P->p.ws + WS_HN) + (size_t)(tok0 + i0 + q) * DM) + lane;
#pragma unroll
            for (int j = 0; j < 4; ++j) { v[q][j].x *= r * gg[j].x; v[q][j].y *= r * gg[j].y; v[q][j].z *= r * gg[j].z; v[q][j].w *= r * gg[j].w;
                u32x2 w; w.x = pk2(v[q][j].x, v[q][j].y); w.y = pk2(v[q][j].z, v[q][j].w); o8[64 * j] = w; } }
        float gl[NRB][4];
#pragma unroll
        for (int o = 0; o < 4; ++o) { f32x4 w[4];
#pragma unroll
            for (int j = 0; j < 4; ++j) w[j] = *(const LAS f32x4*)(WR + o * 1024 + 256 * j + 4 * lane);
#pragma unroll
            for (int q = 0; q < NRB; ++q) { float a = 0.f;
#pragma unroll
                for (int j = 0; j < 4; ++j) a += (v[q][j].x * w[j].x + v[q][j].y * w[j].y) + (v[q][j].z * w[j].z + v[q][j].w * w[j].w);
                gl[q][o] = rdl(wave_sum_hi(a), 63) + brg_[o]; }
            __builtin_amdgcn_sched_barrier(0); }
#pragma unroll
        for (int qq = 0; qq < NRB; ++qq) {
            const int i = i0 + qq, tok = tok0 + i;
            int gi = 0; float gm = gl[qq][0];
#pragma unroll
            for (int q = 1; q < 4; ++q) if (gl[qq][q] > gm) { gm = gl[qq][q]; gi = q; }
            float den = 0.f;
#pragma unroll
            for (int q = 0; q < 4; ++q) den += expf(gl[qq][q] - gm);
            const float gp = 1.0f / den;
            float wv[4];
#pragma unroll
            for (int q = 0; q < 4; ++q) { const LAS float* wr = WR + (4 + gi * 4 + q) * 1024 + 4 * lane; float a = 0.f;
#pragma unroll
                for (int j = 0; j < 4; ++j) { const f32x4 w = *(const LAS f32x4*)(wr + 256 * j); a += (v[qq][j].x * w.x + v[qq][j].y * w.y) + (v[qq][j].z * w.z + v[qq][j].w * w.w); }
                wv[q] = wave_sum_hi(a) + bre[gi * 4 + q]; }
            int i1s = 0; float m0 = wv[0];
#pragma unroll
            for (int q = 1; q < 4; ++q) if (wv[q] > m0) { m0 = wv[q]; i1s = q; }
            int i2s = -1; float m1 = 0.f;
#pragma unroll
            for (int q = 0; q < 4; ++q) if (q != i1s && (i2s < 0 || wv[q] > m1)) { m1 = wv[q]; i2s = q; }
            const float t = expf(m1 - m0); const float w0 = gp / (1.f + t), w1 = gp * t / (1.f + t);
            if (lane == 63) { const bool lo1 = i1s < i2s; const int a = lo1 ? i1s : i2s, b = lo1 ? i2s : i1s; const int k = gi * 6 + (a == 0 ? b - 1 : (a == 1 ? b + 1 : 5));
                E0[i] = k; RB[tok] = k; RWA[tok] = lo1 ? w0 : w1; RWB[tok] = lo1 ? w1 : w0; } }
    }
    __syncthreads();
    {
        LAS int* HC = (LAS int*)(lds + 84992);
        if (tid < TPW) { const int k0 = E0[tid];
#pragma unroll
            for (int k = 0; k < NBK; ++k) { const int c = __popcll(__ballot(k0 == k)); if (lane == 0) HC[wave * 32 + k] = c; } }
        __syncthreads();
        if (tid < NBK) ((int*)(P->p.ws + WS_HIST))[blockIdx.x * 32 + tid] = HC[tid] + HC[32 + tid]; }
    __syncthreads();
}

__device__ __forceinline__ void phaseG(KA P, LAS unsigned char* lds, int wave, int lane, int tid) {
    LAS int* E0 = (LAS int*)lds; LAS int* S0 = (LAS int*)(lds + 1024);
    LAS int* TOT = (LAS int*)(lds + 2048); LAS int* PRE = (LAS int*)(lds + 2176); LAS int* EB = (LAS int*)(lds + 2304);
    const int* HIST = (const int*)(P->p.ws + WS_HIST); const int tok0 = blockIdx.x * TPW;
    const int* RB = (const int*)(P->p.ws + WS_ROUTE); const float* RWA = (const float*)(RB + NTOK); const float* RWB = RWA + NTOK;
    LAS int* PT = (LAS int*)(lds + 4096); LAS int* PP = (LAS int*)(lds + 4096 + 2048);
    { const int k = tid & 31, part = tid >> 5; int tot = 0, pre = 0;
#pragma unroll
      for (int q = 0; q < 16; ++q) { const int w = part * 16 + q; const int hv = k < NBK ? HIST[w * 32 + k] : 0; tot += hv; if (w < (int)blockIdx.x) pre += hv; }
      PT[part * 32 + k] = tot; PP[part * 32 + k] = pre; }
    if (tid < TPW) E0[tid] = RB[tok0 + tid];
    __syncthreads();
    if (tid < 32) { int tot = 0, pre = 0; for (int q = 0; q < 16; ++q) { tot += PT[q * 32 + tid]; pre += PP[q * 32 + tid]; } TOT[tid] = tot; PRE[tid] = pre; }
    __syncthreads();
    if (tid == 0) { int eb = 0; for (int k = 0; k < NBK; ++k) { EB[k] = eb; eb += (TOT[k] + 255) & ~255; }
        if (blockIdx.x == 0) ((int*)(P->p.ws + WS_TBL))[62] = eb >> 8; }
    __syncthreads();
    if (blockIdx.x == 0 && tid < NBK) { int* tk = (int*)(P->p.ws + WS_TBL) + 64 + (EB[tid] >> 8); const int tot = TOT[tid];
        for (int i = 0; i * 256 < tot; ++i) tk[i] = tid | ((tot - i * 256 > 256 ? 256 : tot - i * 256) << 8); }
    {
        LAS int* W0T = (LAS int*)(lds + 3072);
        int r0 = 0; const int k0 = tid < TPW ? E0[tid] : -1;
        if (tid < TPW) { const unsigned long long lt = (1ull << lane) - 1ull;
#pragma unroll
            for (int k = 0; k < NBK; ++k) { const unsigned long long m0 = __ballot(k0 == k);
                if (k0 == k) r0 = __popcll(m0 & lt); if (wave == 0 && lane == 0) W0T[k] = __popcll(m0); } }
        __syncthreads();
        if (tid < TPW) S0[tid] = EB[k0] + PRE[k0] + (wave == 1 ? W0T[k0] : 0) + r0; }
    __syncthreads();
    float* SW = (float*)(P->p.ws + WS_SLOTW); int* S2T = (int*)(P->p.ws + WS_S2T);
    if (tid < TPW) { const int tok = tok0 + tid, s0 = S0[tid]; SW[s0] = RWA[tok]; SW[NSLOT + s0] = RWB[tok]; S2T[s0] = tok; }
}

__device__ __forceinline__ void final_rows(KA P, int vcu, int G, int wave, int lane) {
    const f32x4* gr = (const f32x4*)P->p.in[23] + lane; f32x4 gg[4];
#pragma unroll
    for (int j = 0; j < 4; ++j) gg[j] = gr[64 * j];
    const int NGW = G * 8;
    for (int t0 = vcu * 8 + wave; t0 < NTOK; t0 += 4 * NGW) { f32x4 v[4][4]; float s[4];
#pragma unroll
        for (int q = 0; q < 4; ++q)
#pragma unroll
            for (int j = 0; j < 4; ++j) v[q][j] = ld_x16((const bf16_t*)(P->p.ws + WS_PL) + (size_t)(t0 + q * NGW) * DM, j, lane);
#pragma unroll
        for (int q = 0; q < 4; ++q) { s[q] = 0.f;
#pragma unroll
            for (int j = 0; j < 4; ++j) s[q] += (v[q][j].x * v[q][j].x + v[q][j].y * v[q][j].y) + (v[q][j].z * v[q][j].z + v[q][j].w * v[q][j].w); }
#pragma unroll
        for (int q = 0; q < 4; ++q) s[q] = wave_sum_dpp(s[q]);
#pragma unroll
        for (int q = 0; q < 4; ++q) { const float r = 1.0f / sqrtf(s[q] * (1.f / DM) + EPS); f32x4* xr = (f32x4*)(P->p.out + (size_t)(t0 + q * NGW) * DM) + lane;
#pragma unroll
            for (int j = 0; j < 4; ++j) { f32x4 o; o.x = v[q][j].x * r * gg[j].x; o.y = v[q][j].y * r * gg[j].y; o.z = v[q][j].z * r * gg[j].z; o.w = v[q][j].w * r * gg[j].w; xr[64 * j] = o; } } }
}
#ifndef MK_N_LAUNCHES
#define MK_N_LAUNCHES 1
#endif
constexpr int PH_PER_LAYER = 12, N_PHASES = DEPTH * PH_PER_LAYER + 1;
constexpr int N_LAUNCHES = MK_N_LAUNCHES;
static_assert(N_LAUNCHES == 1 || N_LAUNCHES == N_PHASES, "MK_N_LAUNCHES is 1 or N_PHASES");

#ifdef NO_KV
#define KVBUF ((const bf16_t*)Z)
#else
#define KVBUF ((const bf16_t*)ka->p.out + (size_t)NTOK * DM)
#endif
#define PH_FN static __device__ __forceinline__ void
#define DRYP , int dry = 0
#define PH_COMMON int tid_l = WV * 64 + lane_id_v(); asm volatile("" : "+v"(tid_l)); asm volatile("" : "+s"(ka)); asm volatile("" : "+s"(L)); const int tid = tid_l, lane = tid & 63, wave = __builtin_amdgcn_readfirstlane(tid >> 6); int G_l = gridDim.x, bx_l = blockIdx.x; asm volatile("" : "+s"(G_l)); asm volatile("" : "+s"(bx_l)); const int G = G_l, bx = bx_l; \
    const int vcu = (G % 8 == 0) ? (bx % 8) * (G / 8) + bx / 8 : bx; unsigned char* ws = ka->p.ws; (void)tid; (void)lane; (void)wave; (void)vcu; (void)ws; \
    bf16_t* Z = (bf16_t*)(ws + WS_Z); bf16_t* HN = (bf16_t*)(ws + WS_HN); (void)Z; (void)HN;

PH_FN ph_A(KA ka, int L, LAS unsigned char* L3, int WV DRYP) { PH_COMMON; KA P = ka; phaseA(P, L, L3, vcu, G, wave, lane, tid); }
PH_FN ph_B(KA ka, int L, LAS unsigned char* L3, int WV DRYP) { PH_COMMON;
#ifdef NO_KV
    pg8::Gemm g{HN, DM, (const bf16_t*)(ws + WS_WIN), DM, DM}; pg8::StaticOrder S; S.init(NTOK, NZT * 256, G, bx);
    pg8::EpiBf16 E{Z, ZP, 0};
    pg8::gemm_phase<pg8::EpiBf16, pg8::StaticOrder, true, true>(tid, L3, g, S, E);
#else
    pg8::Gemm g{HN, DM, (const bf16_t*)(ws + WS_WIN), DM, DM};
    { pg8::ColMapOrder S; S.S.init(NTOK, 4 * 256, G, bx); S.from = 0; S.by = 4;
      pg8::EpiKV E{(bf16_t*)ka->p.out + (size_t)NTOK * DM};
      pg8::gemm_phase<pg8::EpiKV, pg8::ColMapOrder, true, true>(tid, L3, g, S, E); }
    { pg8::ColMapOrder S; S.S.init(NTOK, (NZT - 4) * 256, G, bx); S.from = 4; S.by = 4;
      pg8::EpiBf16 E{Z, ZP, 0};
      pg8::gemm_phase<pg8::EpiBf16, pg8::ColMapOrder, true, true>(tid, L3, g, S, E); }
#endif
    {
#ifdef NO_KV
        const int nunits = (NTOK / 256) * NZT, nheavy = nunits % G;
#else
        const int nunits = (NTOK / 256) * (NZT - 4), nheavy = nunits % G;
#endif
        if (L == 0 && bx >= nheavy) tr_groups(ka, L, 0x20u, (LAS float*)(L3 + wave * 16384), (bx - nheavy) * 8 + wave, (G - nheavy) * 8, lane); } }
PH_FN ph_C1a(KA ka, int L, LAS unsigned char* L3, int WV DRYP) { PH_COMMON;
    gla1_load_w(ka->p.in[4] + (size_t)L * 16 * 256, ka->p.in[5] + (size_t)L * 256, L3, tid);
    {
        Gla1In IA, IB; int u = bx;
        if (u < 2048) gla1_load(u, Z, wave, lane, IA);
        for (; u < 2048; u += 2 * G) {
            if (u + G < 2048) gla1_load(u + G, Z, wave, lane, IB);
            gla1_unit(u, IA, Z, (bf16_t*)(ws + WS_SLOC), (float*)(ws + WS_DTAB), L3, wave, lane, tid, dry);
            if (u + G < 2048) { if (u + 2 * G < 2048) gla1_load(u + 2 * G, Z, wave, lane, IA);
                gla1_unit(u + G, IB, Z, (bf16_t*)(ws + WS_SLOC), (float*)(ws + WS_DTAB), L3, wave, lane, tid, dry); } } }
    for (int cu = bx; cu < 256; cu += G) conv_unit(cu, Z, ka->p.in[11] + (size_t)L * 3 * 512, wave, lane, dry);
    for (int cu = bx; cu < 256; cu += G) knorm_unit(cu, KVBUF, (unsigned*)(ws + WS_CTL) + CW_KN + 64 * L, L3, wave, lane, tid); }
PH_FN ph_C1b(KA ka, int L, LAS unsigned char* L3, int WV DRYP) { PH_COMMON;
    gla_scan((bf16_t*)(ws + WS_SLOC), (const float*)(ws + WS_DTAB), L3, G, bx, tid);
    const float* lp = ka->p.in[8] + (size_t)L * 256;
    const float sa = wave_sum(lp[lane] * lp[64 + lane]), sb = wave_sum(lp[128 + lane] * lp[192 + lane]);
    const float lam_init = 0.8f - 0.6f * expf(-0.3f * (float)L); const float lam = expf(sa) - expf(sb) + lam_init;
    const float* gd = ka->p.in[9] + (size_t)L * 128;
    unsigned* heads = (unsigned*)(ws + WS_CTL) + CW_QHEAD + 64 * L; const unsigned* KN = (const unsigned*)(ws + WS_CTL) + CW_KN + 64 * L;
    LAS int* qslot = (LAS int*)(L3 + 134144);
    const int xcd = (int)(xb_xcc_id() & 7u); int qi = 0;
    for (;;) {
        const int qx = (xcd + qi) & 7;
        if (tid == 0) *qslot = (int)__hip_atomic_fetch_add(heads + 8 * qx, 1u, __ATOMIC_RELAXED, __HIP_MEMORY_SCOPE_AGENT);
        __syncthreads(); const int v = __builtin_amdgcn_readfirstlane(*qslot); __syncthreads();
        if (v >= 128) { if (++qi == 8) break; continue; }
        const int h = 3 - (v >> 5), qb = 32 * (qx >> 1) + 31 - (v & 31), b = qx & 1;
        att::unit(tid, b, h, qb, lam, 1.0f - lam_init, __uint_as_float(KN[b * 4 + h]), Z, KVBUF, gd, (char*)L3, dry); } }
PH_FN ph_C3(KA ka, int L, LAS unsigned char* L3, int WV DRYP) { PH_COMMON;
    const bf16_t* SL = (const bf16_t*)(ws + WS_SLOC); const float* ggn = ka->p.in[6] + (size_t)L * 128;
    Gla3In IA, IB; int u = bx;
    if (u < 2048) gla3_load(u, Z, SL, wave, lane, IA);
    for (; u < 2048; u += 2 * G) {
        if (u + G < 2048) gla3_load(u + G, Z, SL, wave, lane, IB);
        gla3_unit(u, IA, Z, ggn, L3, wave, lane, dry);
        if (u + G < 2048) { if (u + 2 * G < 2048) gla3_load(u + 2 * G, Z, SL, wave, lane, IA);
            gla3_unit(u + G, IB, Z, ggn, L3, wave, lane, dry); } } }
PH_FN ph_D1(KA ka, int L, LAS unsigned char* L3, int WV DRYP) { PH_COMMON;
    pg8::Gemm g{HN, DM, (const bf16_t*)(ws + WS_WIN), DM, DM}; pg8::MergeOrder S{bx, G, 0, 0, (size_t)NZT * 256 * DM, (size_t)4 * 256 * DM};
    pg8::EpiSig8 E{(unsigned char*)Z};
    pg8::gemm_phase<pg8::EpiSig8, pg8::MergeOrder, true, true>(tid, L3, g, S, E); }
PH_FN ph_D2(KA ka, int L, LAS unsigned char* L3, int WV DRYP) { PH_COMMON;
    pg8::Gemm g{Z, ZP, (const bf16_t*)(ws + WS_WO), 512, 512}; pg8::MergeOrder S{bx, G, C_OA, 512, 0, (size_t)DM * 512};
    pg8::EpiMerge8 E{Z, dry};
    pg8::gemm_phase<pg8::EpiMerge8, pg8::MergeOrder, true, true>(tid, L3, g, S, E); }
PH_FN ph_E(KA ka, int L, LAS unsigned char* L3, int WV DRYP) { PH_COMMON;
    if (bx & 1) tr_groups(ka, L, 0x58u, (LAS float*)(L3 + wave * 16384), (bx >> 1) * 8 + wave, (G >> 1) * 8, lane);
    __syncthreads();
    pg8::Gemm g{Z, ZP, (const bf16_t*)(ws + WS_WOUT), DM, DM}; pg8::StaticOrder S; S.init(NTOK, DM, G, bx);
    pg8::EpiRes E{ka->p.in[0], L == 0 ? (const bf16_t*)nullptr : (const bf16_t*)ka->p.out, (bf16_t*)ka->p.out, dry};
    pg8::gemm_phase<pg8::EpiRes, pg8::StaticOrder, true, true>(tid, L3, g, S, E); }
PH_FN ph_F(KA ka, int L, LAS unsigned char* L3, int WV DRYP) { PH_COMMON; KA P = ka; if (G == GRID) phaseF(P, L, L3, wave, lane, tid); }
PH_FN ph_G(KA ka, int L, LAS unsigned char* L3, int WV DRYP) { PH_COMMON; KA P = ka; if (G == GRID) phaseG(P, L3, wave, lane, tid); }
PH_FN ph_H(KA ka, int L, LAS unsigned char* L3, int WV DRYP) { PH_COMMON;
    { pg8::Gemm g{HN, DM, (const bf16_t*)(ws + WS_WGU), DM, DM}; pg8::PairUpOrder S{(const int*)(ws + WS_TBL), bx, G, (size_t)1024 * DM};
      pg8::EpiUp E{(bf16_t*)(ws + WS_ACT), (const float*)(ws + WS_SLOTW)};
      pg8::gemm_phase<pg8::EpiUp, pg8::PairUpOrder, true, true, true>(tid, L3, g, S, E, (const int*)(ws + WS_S2T)); }
    {
      const int U = ((const int*)(ws + WS_TBL))[62] * 8;
      int nheavy = U % G;
      if (nheavy > G / 2) nheavy = 0;
      pg8::Gemm g{(const bf16_t*)(ws + WS_PB), PLE, (const bf16_t*)(ws + WS_WPLE), PLE, PLE}; pg8::StaticOrder S; S.init(NTOK, DM, G - nheavy, bx - nheavy);
      pg8::EpiBf16 E{(bf16_t*)(ws + WS_PL), DM, 0};
      if (bx >= nheavy) pg8::gemm_phase<pg8::EpiBf16, pg8::StaticOrder, true, true>(tid, L3, g, S, E); } }
PH_FN ph_I(KA ka, int L, LAS unsigned char* L3, int WV DRYP) { PH_COMMON;
    pg8::Gemm g{(const bf16_t*)(ws + WS_ACT), DM, (const bf16_t*)(ws + WS_WDN), DEXP, DEXP}; pg8::PairDownOrder S{(const int*)(ws + WS_TBL), bx, G, (size_t)DM * DEXP};
    pg8::EpiDownRes E{(const bf16_t*)ka->p.out, HN, (const int*)(ws + WS_S2T), dry};
    pg8::gemm_phase<pg8::EpiDownRes, pg8::PairDownOrder, true, true>(tid, L3, g, S, E);
    if (L + 1 < DEPTH) {
        const int U = ((const int*)(ws + WS_TBL))[62] * 4;
        int nheavy = U % G; if (nheavy > G / 2) nheavy = 0;
        if (bx >= nheavy) tr_groups(ka, L + 1, 0x07u, (LAS float*)(L3 + wave * 16384), (bx - nheavy) * 8 + wave, (G - nheavy) * 8, lane); } }
PH_FN ph_K(KA ka, int L, LAS unsigned char* L3, int WV DRYP) { PH_COMMON;
    if ((bx & 1) && L + 1 < DEPTH) tr_groups(ka, L + 1, 0x20u, (LAS float*)(L3 + wave * 16384), (bx >> 1) * 8 + wave, (G >> 1) * 8, lane);
    __syncthreads();
    pg8::Gemm g{HN, DM, (const bf16_t*)(ws + WS_WPG), DM, DM}; pg8::StaticOrder S; S.init(NTOK, DM, G, bx);
    pg8::EpiPle E{HN, L + 1 < DEPTH ? (bf16_t*)ka->p.out : (bf16_t*)(ws + WS_PL), (const bf16_t*)(ws + WS_PL), dry};
    pg8::gemm_phase<pg8::EpiPle, pg8::StaticOrder, true, true>(tid, L3, g, S, E); }
PH_FN ph_final(KA ka, int L, LAS unsigned char* L3, int WV DRYP) { PH_COMMON; KA P = ka; final_rows(P, vcu, G, wave, lane); }
static __device__ __forceinline__ void grid_bar(unsigned* barw, LAS unsigned* st) { XcdBarrier b; b.bar = barw; b.x = xb_xcc_id(); b.st = (volatile LAS unsigned*)st; xcd_barrier(b); }

__global__ void __launch_bounds__(512, 2) mega_fwd(Args args) {
    extern __shared__ __attribute__((aligned(16))) unsigned char lds[];
    LAS unsigned char* L3 = (LAS unsigned char*)lds;
    KA ka = (KA)__builtin_amdgcn_kernarg_segment_ptr();
    const int WV = __builtin_amdgcn_readfirstlane((int)threadIdx.x >> 6);
    const int tid = WV * 64 + lane_id_v();
    for (int u = tid; u < (LDS_BYTES - LDSCTL_OFF) / 4; u += 512) ((LAS unsigned*)(L3 + LDSCTL_OFF))[u] = 0u;
    __syncthreads();
    unsigned* barw = (unsigned*)(args.p.ws + WS_CTL) + CW_BAR; LAS unsigned* st = (LAS unsigned*)(L3 + MISC_OFF) + 8;
    if (N_LAUNCHES == 1) (void)xcd_barrier_post(barw, (volatile LAS unsigned*)st);
    const int lo = args.ph_lo, hi = args.ph_hi;
#ifdef DIAG_SEL
    unsigned long long dg_t = __builtin_amdgcn_s_memrealtime(), dg_acc = 0ull; int dg_ph = 0;
#define DG_MARK(isbar) do { const unsigned long long n_ = __builtin_amdgcn_s_memrealtime(); if ((DIAG_SEL == 99 && (isbar)) || (DIAG_SEL >= 100 && (isbar) && dg_ph == DIAG_SEL - 100) || (DIAG_SEL < 99 && !(isbar) && dg_ph == DIAG_SEL)) dg_acc += n_ - dg_t; dg_t = n_; } while (0)
#else
#define DG_MARK(isbar) do { } while (0)
#endif
#ifndef PHASE_MASK
#define PHASE_MASK 0xFFFFFFFu
#endif
#define IN(k) (((PHASE_MASK >> ((k) % PH_PER_LAYER + ((k) == N_PHASES - 1 ? PH_PER_LAYER : 0))) & 1u) && lo <= (k) && (k) < hi)
#ifdef DIAG_SEL
#define SEAM(k) do { if (IN(k) && IN((k) + 1)) { dg_ph = (k) % PH_PER_LAYER; DG_MARK(0); grid_bar(barw, st); DG_MARK(1); } } while (0)
#elif defined(DUP_BAR)
#define SEAM(k) do { if (IN(k) && IN((k) + 1)) { grid_bar(barw, st); grid_bar(barw, st); } } while (0)
#else
#define SEAM(k) do { if (IN(k) && IN((k) + 1)) grid_bar(barw, st); } while (0)
#endif
    for (int L = 0; L < DEPTH; ++L) {
        const int pb = L * PH_PER_LAYER;
        if (IN(pb + 0)) {
#ifdef DUP_A
            for (int rep = 1; rep >= 0; --rep) { const int d = rep ? ka->ph_hi : 0; ph_A(ka, L, L3, WV, d); __syncthreads(); }
#else
            ph_A(ka, L, L3, WV);
#endif
        }
        SEAM(pb + 0);
        if (IN(pb + 1)) {
#ifdef DUP_B
            for (int rep = 1; rep >= 0; --rep) { const int d = rep ? ka->ph_hi : 0; ph_B(ka, L, L3, WV, d); __syncthreads(); }
#else
            ph_B(ka, L, L3, WV);
#endif
        }
        SEAM(pb + 1);
        if (IN(pb + 2)) {
#ifdef DUP_C1a
            for (int rep = 1; rep >= 0; --rep) { const int d = rep ? ka->ph_hi : 0; ph_C1a(ka, L, L3, WV, d); __syncthreads(); }
#else
            ph_C1a(ka, L, L3, WV);
#endif
        }
        SEAM(pb + 2);
        if (IN(pb + 3)) ph_C1b(ka, L, L3, WV);
        SEAM(pb + 3);
        if (IN(pb + 4)) { ph_C3(ka, L, L3, WV); __syncthreads(); ph_D1(ka, L, L3, WV); }
        SEAM(pb + 4);
        if (IN(pb + 5)) ph_D2(ka, L, L3, WV);
        SEAM(pb + 5);
        if (IN(pb + 6)) {
#ifdef DUP_E
            for (int rep = 1; rep >= 0; --rep) { const int d = rep ? ka->ph_hi : 0; ph_E(ka, L, L3, WV, d); __syncthreads(); }
#else
            ph_E(ka, L, L3, WV);
#endif
        }
        SEAM(pb + 6);
        if (IN(pb + 7)) {
#ifdef DUP_F
            for (int rep = 1; rep >= 0; --rep) { const int d = rep ? ka->ph_hi : 0; ph_F(ka, L, L3, WV, d); __syncthreads(); }
#else
            ph_F(ka, L, L3, WV);
#endif
        }
        SEAM(pb + 7);
        if (IN(pb + 8)) {
#ifdef DUP_G
            for (int rep = 1; rep >= 0; --rep) { const int d = rep ? ka->ph_hi : 0; ph_G(ka, L, L3, WV, d); __syncthreads(); }
#else
            ph_G(ka, L, L3, WV);
#endif
        }
        SEAM(pb + 8);
        if (IN(pb + 9)) {
#ifdef DUP_H
            for (int rep = 1; rep >= 0; --rep) { const int d = rep ? ka->ph_hi : 0; ph_H(ka, L, L3, WV, d); __syncthreads(); }
#else
            ph_H(ka, L, L3, WV);
#endif
        }
        SEAM(pb + 9);
        if (IN(pb + 10)) {
#ifdef DUP_I
            for (int rep = 1; rep >= 0; --rep) { const int d = rep ? ka->ph_hi : 0; ph_I(ka, L, L3, WV, d); __syncthreads(); }
#else
            ph_I(ka, L, L3, WV);
#endif
        }
        SEAM(pb + 10);
        if (IN(pb + 11)) {
#ifdef DUP_K
            for (int rep = 1; rep >= 0; --rep) { const int d = rep ? ka->ph_hi : 0; ph_K(ka, L, L3, WV, d); __syncthreads(); }
#else
            ph_K(ka, L, L3, WV);
#endif
        }
        SEAM(pb + 11);
    }
#ifdef DIAG_SEL
    if (IN(N_PHASES - 1)) ph_final(ka, 0, L3, WV);
    if (blockIdx.x == DIAG_BLK) { const unsigned long long t0_ = __builtin_amdgcn_s_memrealtime(); while (__builtin_amdgcn_s_memrealtime() - t0_ < 8ull * dg_acc) __builtin_amdgcn_s_sleep(8); }
#else
    if (IN(N_PHASES - 1)) ph_final(ka, 0, L3, WV);
#endif
#undef IN
#undef SEAM
}

extern "C" void kernel_launch(void* const* d_in, const int* in_sizes, int n_in, void* d_out, int out_size, void* d_ws, size_t ws_size, hipStream_t stream) {
    static int grid = 0;
    if (grid == 0) {
        if (n_in != 24 || in_sizes[0] != NTOK * DM || out_size != NTOK * DM || ws_size < WS_END) {
            fprintf(stderr, "kernel_launch: built for 24 inputs, x/out of %d floats, >= %zu bytes of workspace; got n_in %d, in0 %d, out %d, ws %zu; nothing launched\n", NTOK * DM, (size_t)WS_END, n_in, n_in > 0 ? in_sizes[0] : -1, out_size, ws_size); grid = -1; return; }
        int dev = 0, cus = 0, per_cu = 0;
        if (hipGetDevice(&dev) != hipSuccess || hipDeviceGetAttribute(&cus, hipDeviceAttributeMultiprocessorCount, dev) != hipSuccess) { fprintf(stderr, "kernel_launch: device query failed\n"); grid = -1; return; }
        if (hipFuncSetAttribute((const void*)mega_fwd, hipFuncAttributeMaxDynamicSharedMemorySize, LDS_BYTES) != hipSuccess) { fprintf(stderr, "kernel_launch: hipFuncSetAttribute failed\n"); grid = -1; return; }
        if (hipOccupancyMaxActiveBlocksPerMultiprocessor(&per_cu, (const void*)mega_fwd, 512, LDS_BYTES) != hipSuccess || per_cu < 1)
            fprintf(stderr, "kernel_launch: note: occupancy query reports %d workgroups per CU\n", per_cu);
        (void)hipGetLastError();
        if (cus != GRID) { fprintf(stderr, "kernel_launch: built for a %d-CU device, found %d; nothing launched\n", GRID, cus); grid = -1; return; }
        grid = GRID;
    }
    if (grid < 0) return;
    if (hipMemsetAsync((char*)d_ws + WS_CTL, 0, CTL_ZERO_BYTES, stream) != hipSuccess) { fprintf(stderr, "kernel_launch: memset failed\n"); return; }
    Args a{};
    for (int i = 0; i < 24; ++i) a.p.in[i] = (const float*)d_in[i];
    a.p.out = (float*)d_out; a.p.ws = (unsigned char*)d_ws;
    for (int li = 0; li < N_LAUNCHES; ++li) {
        a.ph_lo = (N_LAUNCHES == 1) ? 0 : li; a.ph_hi = (N_LAUNCHES == 1) ? N_PHASES : li + 1;
        hipLaunchKernelGGL(mega_fwd, dim3(grid), dim3(512), LDS_BYTES, stream, a);
        const hipError_t le = hipPeekAtLastError();
        if (le != hipSuccess) { fprintf(stderr, "kernel_launch: launch %d failed: %s\n", li, hipGetErrorName(le)); break; }
    }
}
```

```cpp
#include <hip/hip_runtime.h>
#include <cstdio>
#include <cstdint>

#define LAS __attribute__((address_space(3)))
#define GAS __attribute__((address_space(1)))
typedef unsigned short bf16_t;
typedef short bf16x8 __attribute__((ext_vector_type(8)));
typedef short s16x4 __attribute__((ext_vector_type(4)));
typedef float f32x2 __attribute__((ext_vector_type(2)));
typedef float f32x4 __attribute__((ext_vector_type(4)));
typedef float f32x16 __attribute__((ext_vector_type(16)));
typedef unsigned u32x2 __attribute__((ext_vector_type(2)));
typedef unsigned u32x4 __attribute__((ext_vector_type(4)));
typedef __bf16 bf16x2_t __attribute__((ext_vector_type(2)));

constexpr int NB = 2, T = 16384, NTOK = NB * T, DM = 1024, DEPTH = 2, PLE = 256;
constexpr int INTOT = 7696;
constexpr int ZP = 4864;
constexpr int C_GQ = 0, C_GK = 256, C_GV = 512, C_DK = 1024, C_DV = 1536, C_CX = 2048, C_CC = 2560, C_GA = 3072, C_GG = 3328, C_DQ = 3840, C_CB = 4352;
constexpr int C_OA = C_GG, C_OB = C_DQ, C_OC = C_CB;
constexpr int NZT = 19;
constexpr int NEXP = 16, DEXP = 512;
constexpr int NBK = 24;
constexpr int NSLOT = NTOK + NBK * 256;
constexpr float EPS = 1e-6f;
constexpr int GRID = 256;
constexpr int TPW = NTOK / GRID;

__device__ __forceinline__ unsigned f2bf(float f) { unsigned u = __builtin_bit_cast(unsigned, f); return (u + 0x7fffu + ((u >> 16) & 1u)) >> 16; }
__device__ __forceinline__ unsigned pk2(float lo, float hi) { f32x2 v = {lo, hi}; bf16x2_t b = __builtin_convertvector(v, bf16x2_t); return __builtin_bit_cast(unsigned, b); }
__device__ __forceinline__ float bflo(unsigned w) { return __builtin_bit_cast(float, w << 16); }
__device__ __forceinline__ float bfhi(unsigned w) { return __builtin_bit_cast(float, w & 0xffff0000u); }
__device__ __forceinline__ float bf2f(bf16_t b) { return __builtin_bit_cast(float, (unsigned)b << 16); }
__device__ __forceinline__ float sigmoidf_(float x) { return __builtin_amdgcn_rcpf(1.0f + __builtin_amdgcn_exp2f(-1.4426950408889634f * x)); }
__device__ __forceinline__ float siluf_(float x) { return x * sigmoidf_(x); }
__device__ __forceinline__ int lane_id_v() { int l; asm volatile("v_mbcnt_lo_u32_b32 %0, -1, 0\n\tv_mbcnt_hi_u32_b32 %0, -1, %0" : "=v"(l)); return l; }
template <int X> __device__ __forceinline__ float xor_lane(float v) { return __builtin_bit_cast(float, __builtin_amdgcn_ds_swizzle(__builtin_bit_cast(int, v), (X << 10) | 0x1F)); }
#define BFLY32(v, OP) do { v = OP(v, xor_lane<1>(v)); v = OP(v, xor_lane<2>(v)); v = OP(v, xor_lane<4>(v)); v = OP(v, xor_lane<8>(v)); v = OP(v, xor_lane<16>(v)); } while (0)
__device__ __forceinline__ float opadd_(float a, float b) { return a + b; }
__device__ __forceinline__ float wave_sum(float v) {
    BFLY32(v, opadd_);
    return __builtin_bit_cast(float, __builtin_amdgcn_readlane(__builtin_bit_cast(int, v), 0)) + __builtin_bit_cast(float, __builtin_amdgcn_readlane(__builtin_bit_cast(int, v), 32));
}
__device__ __forceinline__ float dpp_f(float x, int ctrl_sel) {
    const int xi = __builtin_bit_cast(int, x); int r;
    if (ctrl_sel == 0) r = __builtin_amdgcn_update_dpp(0, xi, 0xB1, 0xF, 0xF, true);
    else if (ctrl_sel == 1) r = __builtin_amdgcn_update_dpp(0, xi, 0x4E, 0xF, 0xF, true);
    else if (ctrl_sel == 2) r = __builtin_amdgcn_update_dpp(0, xi, 0x141, 0xF, 0xF, true);
    else r = __builtin_amdgcn_update_dpp(0, xi, 0x140, 0xF, 0xF, true);
    return __builtin_bit_cast(float, r); }
__device__ __forceinline__ float row16_sum(float x) { x += dpp_f(x, 0); x += dpp_f(x, 1); x += dpp_f(x, 2); x += dpp_f(x, 3); return x; }
__device__ __forceinline__ float rdl(float x, int l) { return __builtin_bit_cast(float, __builtin_amdgcn_readlane(__builtin_bit_cast(int, x), l)); }
__device__ __forceinline__ float wave_sum_hi(float x) { x = row16_sum(x);
    x += __builtin_bit_cast(float, __builtin_amdgcn_update_dpp(0, __builtin_bit_cast(int, x), 0x142, 0xA, 0xF, false));
    x += __builtin_bit_cast(float, __builtin_amdgcn_update_dpp(0, __builtin_bit_cast(int, x), 0x143, 0xC, 0xF, false)); return x; }
__device__ __forceinline__ float wave_sum_dpp(float x) { return rdl(wave_sum_hi(x), 63); }
template <int CTRL, int RM> __device__ __forceinline__ float dpp0(float x) { return __builtin_bit_cast(float, __builtin_amdgcn_update_dpp(0, __builtin_bit_cast(int, x), CTRL, RM, 0xF, false)); }
__device__ __forceinline__ float wave_scan_incl(float x) {
    x += dpp0<0x111, 0xF>(x); x += dpp0<0x112, 0xF>(x); x += dpp0<0x114, 0xF>(x); x += dpp0<0x118, 0xF>(x);
    x += dpp0<0x142, 0xA>(x); x += dpp0<0x143, 0xC>(x); return x; }
__device__ __forceinline__ int crow(int r, int hi) { return (r & 3) + 8 * (r >> 2) + 4 * hi; }
#define LDS_WAIT() asm volatile("s_waitcnt lgkmcnt(0)" ::: "memory")
#define VM_WAIT() asm volatile("s_waitcnt vmcnt(0)" ::: "memory")

namespace pg8 {
#define PG8_LAS __attribute__((address_space(3)))
constexpr int BM = 256, BK = 64, HALF = 128, HTB = HALF * BK * 2  , STAGE_BYTES = 8 * HTB, NXCD = 8, WGM = 8;

__host__ __device__ __forceinline__ int lds_byte(int r, int c) { const int st = (r >> 4) * 2 + (c >> 5), rr = r & 15, cc = c & 31, ob = rr * 64 + cc * 2; return st * 1024 + (ob ^ (((ob >> 9) & 1) << 5)); }
__host__ __device__ __forceinline__ void stage_rc(int b, int& R, int& C) { const int st = b / 1024, sb = b % 1024, swz = sb ^ (((sb >> 9) & 1) << 5); R = (st >> 1) * 16 + swz / 64; C = (st & 1) * 32 + (swz % 64) / 2; }
__host__ __device__ __forceinline__ int perm32(int rho) { const int n = rho >> 4, i = rho & 15; return 8 * (i >> 2) + 4 * n + (i & 3); }

struct Unit { int pm, pn; int aoff; int tag; size_t boff; };
struct Gemm { const bf16_t* A; int lda; const bf16_t* Bt; int ldb; int K; };

struct StaticOrder {
    int nM, nN, nwg, G, c;
    __device__ void init(int M, int N, int G_, int c_) { nM = M / BM; nN = N / BM; nwg = nM * nN; G = G_; c = c_; }
    __device__ bool next(int i, Unit& u) const {
        const long L = (long)i * G + c; if (L >= nwg) return false;
        int wgid = (int)L; { const int q = nwg / NXCD, r = nwg % NXCD, xcd = wgid % NXCD, off = wgid / NXCD; wgid = (xcd < r ? xcd * (q + 1) : r * (q + 1) + (xcd - r) * q) + off; }
        const int nig = WGM * nN, gid = wgid / nig, fm = gid * WGM, gsz = (nM - fm) < WGM ? (nM - fm) : WGM;
        u.pm = fm + ((wgid % nig) % gsz); u.pn = (wgid % nig) / gsz; u.aoff = 0; u.tag = 0; u.boff = 0; return true;
    }
};

struct EpiBf16 {
    static constexpr bool PERM = true; static __device__ __forceinline__ bool keep(const Unit&) { return false; }
    bf16_t* O; int ldc; int tstride;
    __device__ __forceinline__ void operator()(f32x4 (&acc)[2][2][4][2], const Unit& u, int wr, int wc, int fr, int fq) const {
        const int row0 = u.pm * BM + wr * 64 + fr; const int col0 = u.tag * tstride + u.pn * BM + wc * 32 + 8 * fq;
#pragma unroll
        for (int ai = 0; ai < 2; ++ai)
#pragma unroll
            for (int m = 0; m < 4; ++m) { bf16_t* rowp = O + (size_t)(row0 + ai * HALF + m * 16) * ldc + col0;
#pragma unroll
                for (int bj = 0; bj < 2; ++bj) { const f32x4 v0 = acc[ai][bj][m][0], v1 = acc[ai][bj][m][1];
                    u32x4 w; w.x = pk2(v0[0], v0[1]); w.y = pk2(v0[2], v0[3]); w.z = pk2(v1[0], v1[1]); w.w = pk2(v1[2], v1[3]);
                    *(u32x4*)(rowp + bj * HALF) = w; } }
    }
};
struct EpiKV {
    static constexpr bool PERM = true; static __device__ __forceinline__ bool keep(const Unit&) { return false; }
    bf16_t* KV;
    __device__ __forceinline__ void operator()(f32x4 (&acc)[2][2][4][2], const Unit& u, int wr, int wc, int fr, int fq) const {
        const int bb = (u.pm * BM) / T;
        bf16_t* o0 = KV + ((size_t)(bb * 4 + 2 * (u.pn & 1)) * T + (size_t)(u.pm * BM - bb * T + wr * 64 + fr)) * 256 + ((u.pn >> 1) & 1) * 128 + wc * 32 + 8 * fq;
#pragma unroll
        for (int ai = 0; ai < 2; ++ai)
#pragma unroll
            for (int m = 0; m < 4; ++m) { bf16_t* rowp = o0 + (size_t)(ai * HALF + m * 16) * 256;
#pragma unroll
                for (int bj = 0; bj < 2; ++bj) { const f32x4 v0 = acc[ai][bj][m][0], v1 = acc[ai][bj][m][1];
                    u32x4 w; w.x = pk2(v0[0], v0[1]); w.y = pk2(v0[2], v0[3]); w.z = pk2(v1[0], v1[1]); w.w = pk2(v1[2], v1[3]);
                    *(u32x4*)(rowp + (size_t)bj * T * 256) = w; } }
    }
};
struct ColMapOrder {
    StaticOrder S; int from, by;
    __device__ bool next(int i, Unit& u) const { if (!S.next(i, u)) return false; if (u.pn >= from) u.pn += by; return true; }
};
template <class Epi, class Sched, bool ALIGN_EPI = false, bool SP2 = false, bool GATHER = false>
__device__ __forceinline__ void gemm_phase(int tid_in, PG8_LAS unsigned char* lds, const Gemm g, const Sched& S, const Epi& E, const int* rowidx = nullptr) {
    int tid_l = tid_in; asm volatile("" : "+v"(tid_l)); const int tid = tid_l;
    const int wid = __builtin_amdgcn_readfirstlane(tid >> 6), lane = tid & 63, wr = wid >> 2, wc = wid & 3, fr = lane & 15, fq = lane >> 4;
    const int K = g.K, nt = K / BK;
    unsigned voffA[2], voffB[2];
#pragma unroll
    for (int i = 0; i < 2; ++i) { int R, C; stage_rc(tid * 16 + i * 8192, R, C); const int Rb = Epi::PERM ? ((R & ~31) + perm32(R & 31)) : R;
        voffA[i] = (unsigned)(R * g.lda + C) * 2u; voffB[i] = (unsigned)(Rb * g.ldb + C) * 2u; }
    const size_t kstep = (size_t)(BK * 2);
    const size_t hstepA = (size_t)HALF * g.lda * 2, hstepB = (size_t)HALF * g.ldb * 2;
    const unsigned ldsw = (unsigned)wid * 1024u;
    const int aoff = lds_byte(wr * 64 + fr, fq * 8), boff = lds_byte(wc * 32 + fr, fq * 8);
#define PG8_UA(u) ((const char*)g.A + (GATHER ? (size_t)0 : ((size_t)(u).pm * 2 * hstepA)) + (size_t)(u).aoff * 2)
#define PG8_GV(dst, u) do { _Pragma("unroll") for (int h_ = 0; h_ < 2; ++h_) _Pragma("unroll") for (int i_ = 0; i_ < 2; ++i_) { int R_, C_; stage_rc(tid * 16 + i_ * 8192, R_, C_); \
        const unsigned tok_ = (unsigned)rowidx[(u).pm * 256 + h_ * 128 + R_] & (unsigned)(NTOK - 1); dst[h_][i_] = (tok_ * (unsigned)g.lda + (unsigned)C_) * 2u; } } while (0)
#define PG8_STAGE_A(b, h, ptr, nx) do { if constexpr (GATHER) { const unsigned gv_[2] = {(nx) ? nv[h][0] : cv[h][0], (nx) ? nv[h][1] : cv[h][1]}; PG8_STAGE(PG8_SA(b, h), ptr, gv_); } \
        else { PG8_STAGE(PG8_SA(b, h), (ptr) + ((h) ? hstepA : 0), voffA); } } while (0)
#define PG8_UB(u) ((const char*)g.Bt + ((size_t)(u).pn * 2 * hstepB) + (u).boff * 2)
#define PG8_SA(b, h) (((b) * 2 + (h)) * HTB)
#define PG8_SB(b, h) ((4 + (b) * 2 + (h)) * HTB)
#define PG8_STAGE(bufoff, gbase, voff) do { _Pragma("unroll") for (int _i = 0; _i < 2; ++_i) \
        __builtin_amdgcn_global_load_lds((const unsigned*)((const char*)(gbase) + (voff)[_i]), (PG8_LAS unsigned*)(lds + (bufoff) + ldsw + _i * 8192), 16, 0, 0); } while (0)
#define PG8_LDA(dst, b, h) do { _Pragma("unroll") for (int m = 0; m < 4; ++m) _Pragma("unroll") for (int k = 0; k < 2; ++k) dst[m][k] = *(const PG8_LAS bf16x8*)(lds + PG8_SA(b, h) + aoff + m * 2048 + k * 1024); } while (0)
#define PG8_LDB(dst, b, h) do { _Pragma("unroll") for (int n = 0; n < 2; ++n) _Pragma("unroll") for (int k = 0; k < 2; ++k) dst[n][k] = *(const PG8_LAS bf16x8*)(lds + PG8_SB(b, h) + boff + n * 2048 + k * 1024); } while (0)
#define PG8_MMA(ai, bj, At, Bt) do { __builtin_amdgcn_s_setprio(1); _Pragma("unroll") for (int m = 0; m < 4; ++m) _Pragma("unroll") for (int n = 0; n < 2; ++n) _Pragma("unroll") for (int k = 0; k < 2; ++k) \
        acc[ai][bj][m][n] = __builtin_amdgcn_mfma_f32_16x16x32_bf16(Bt[n][k], At[m][k], acc[ai][bj][m][n], 0, 0, 0); __builtin_amdgcn_s_setprio(0); } while (0)
#define PG8_WAIT_V(n) asm volatile("s_waitcnt vmcnt(" #n ")" ::: "memory")
#define PG8_WAIT_L(n) asm volatile("s_waitcnt lgkmcnt(" #n ")" ::: "memory")
#define PG8_BAR __builtin_amdgcn_s_barrier()
#define PG8_SCHED __builtin_amdgcn_sched_barrier(0)
    Unit cur, nxt; int ui = 0;
    if (!S.next(0, cur)) return;
    f32x4 acc[2][2][4][2];
#pragma unroll
    for (int a = 0; a < 2; ++a)
#pragma unroll
        for (int b = 0; b < 2; ++b)
#pragma unroll
            for (int m = 0; m < 4; ++m)
#pragma unroll
                for (int n = 0; n < 2; ++n) acc[a][b][m][n] = (f32x4){0.f, 0.f, 0.f, 0.f};
    bf16x8 At[4][2], B0[2][2], B1[2][2];
    const char* cA = PG8_UA(cur); const char* cB = PG8_UB(cur);
    unsigned cv[2][2] = {{0u, 0u}, {0u, 0u}}, nv[2][2] = {{0u, 0u}, {0u, 0u}}; (void)cv; (void)nv;
    if constexpr (GATHER) PG8_GV(cv, cur);
    if constexpr (SP2) {
        PG8_STAGE(PG8_SB(0, 0), cB, voffB); PG8_STAGE(PG8_SB(0, 1), cB + hstepB, voffB); PG8_STAGE_A(0, 0, cA, false); PG8_STAGE_A(0, 1, cA, false);
        if (wr == 1) PG8_BAR;
        PG8_WAIT_V(2); PG8_BAR;
        PG8_STAGE(PG8_SB(1, 0), cB + kstep, voffB); PG8_STAGE_A(1, 0, cA + kstep, false); PG8_STAGE(PG8_SB(1, 1), cB + hstepB + kstep, voffB);
        PG8_WAIT_V(6); PG8_BAR;
    } else {
        PG8_STAGE(PG8_SB(0, 0), cB, voffB); PG8_STAGE_A(0, 0, cA, false); PG8_STAGE(PG8_SB(0, 1), cB + hstepB, voffB); PG8_STAGE_A(0, 1, cA, false);
        if (wr == 1) PG8_BAR;
        PG8_WAIT_V(4); PG8_BAR;
        PG8_STAGE(PG8_SB(1, 0), cB + kstep, voffB); PG8_STAGE_A(1, 0, cA + kstep, false); PG8_STAGE(PG8_SB(1, 1), cB + hstepB + kstep, voffB);
        PG8_WAIT_V(6); PG8_BAR;
    }
    for (;;) {
        const bool has_next = S.next(ui + 1, nxt);
        const char* nA = has_next ? PG8_UA(nxt) : cA; const char* nB = has_next ? PG8_UB(nxt) : cB;
        if constexpr (GATHER) { if (has_next) PG8_GV(nv, nxt); }
        for (int t = 0; t < nt; t += 2) {
            const bool last = (t == nt - 2);
            const char* a1 = cA + (size_t)(t + 1) * kstep;
            const char* a2 = last ? nA : cA + (size_t)(t + 2) * kstep; const char* b2 = last ? nB : cB + (size_t)(t + 2) * kstep;
            const char* a3 = a2 + kstep; const char* b3 = b2 + kstep; const bool nx2 = last && has_next; (void)nx2;
            asm volatile("" : "+s"(a1), "+s"(a2), "+s"(b2), "+s"(a3), "+s"(b3));
            if constexpr (SP2) {
            PG8_LDB(B0, 0, 0); PG8_LDB(B1, 0, 1); PG8_SCHED; PG8_LDA(At, 0, 0); PG8_STAGE_A(1, 1, a1, false);
            PG8_WAIT_V(8); PG8_WAIT_L(0); PG8_BAR; PG8_MMA(0, 0, At, B0); PG8_MMA(0, 1, At, B1); PG8_BAR; PG8_SCHED;
            PG8_LDA(At, 0, 1); PG8_STAGE(PG8_SB(0, 0), b2, voffB); PG8_STAGE(PG8_SB(0, 1), b2 + hstepB, voffB); PG8_STAGE_A(0, 0, a2, nx2);
            PG8_WAIT_V(8); PG8_WAIT_L(0); PG8_BAR; PG8_MMA(1, 0, At, B0); PG8_MMA(1, 1, At, B1); PG8_BAR; PG8_SCHED;
            PG8_LDB(B0, 1, 0); PG8_LDB(B1, 1, 1); PG8_SCHED; PG8_LDA(At, 1, 0); PG8_STAGE_A(0, 1, a2, nx2);
            PG8_WAIT_V(8); PG8_WAIT_L(0); PG8_BAR; PG8_MMA(0, 0, At, B0); PG8_MMA(0, 1, At, B1); PG8_BAR; PG8_SCHED;
            PG8_LDA(At, 1, 1); PG8_STAGE(PG8_SB(1, 0), b3, voffB); PG8_STAGE(PG8_SB(1, 1), b3 + hstepB, voffB); PG8_STAGE_A(1, 0, a3, nx2);
            PG8_WAIT_V(8); PG8_WAIT_L(0); PG8_BAR; PG8_MMA(1, 0, At, B0); PG8_MMA(1, 1, At, B1); PG8_BAR; PG8_SCHED;
            } else {
            PG8_LDB(B0, 0, 0); PG8_SCHED; PG8_LDA(At, 0, 0); PG8_STAGE_A(1, 1, a1, false);
            PG8_WAIT_L(8); PG8_BAR; PG8_WAIT_L(0); PG8_MMA(0, 0, At, B0); PG8_BAR; PG8_SCHED;
            PG8_LDB(B1, 0, 1); PG8_STAGE(PG8_SB(0, 0), b2, voffB);
            PG8_BAR; PG8_WAIT_L(0); PG8_MMA(0, 1, At, B1); PG8_BAR;
            PG8_LDA(At, 0, 1); PG8_STAGE_A(0, 0, a2, nx2);
            PG8_BAR; PG8_WAIT_L(0); PG8_MMA(1, 0, At, B0); PG8_BAR; PG8_SCHED;
            PG8_STAGE(PG8_SB(0, 1), b2 + hstepB, voffB);
            PG8_WAIT_V(6); PG8_BAR; PG8_MMA(1, 1, At, B1); PG8_BAR;
            PG8_LDB(B0, 1, 0); PG8_SCHED; PG8_LDA(At, 1, 0); PG8_STAGE_A(0, 1, a2, nx2);
            PG8_WAIT_L(8); PG8_BAR; PG8_WAIT_L(0); PG8_MMA(0, 0, At, B0); PG8_BAR; PG8_SCHED;
            PG8_LDB(B1, 1, 1); PG8_STAGE(PG8_SB(1, 0), b3, voffB);
            PG8_BAR; PG8_WAIT_L(0); PG8_MMA(0, 1, At, B1); PG8_BAR;
            PG8_LDA(At, 1, 1); PG8_STAGE_A(1, 0, a3, nx2);
            PG8_BAR; PG8_WAIT_L(0); PG8_MMA(1, 0, At, B0); PG8_BAR; PG8_SCHED;
            PG8_STAGE(PG8_SB(1, 1), b3 + hstepB, voffB);
            PG8_WAIT_V(6); PG8_BAR; PG8_MMA(1, 1, At, B1); PG8_BAR;
            }
        }
        if constexpr (ALIGN_EPI) { if (wr == 0) PG8_BAR; }
        { const int l2 = lane_id_v(); E(acc, cur, wr, wc, l2 & 15, l2 >> 4); }
        if (!has_next) break;
        if (!Epi::keep(cur)) {
#pragma unroll
        for (int a = 0; a < 2; ++a)
#pragma unroll
            for (int b = 0; b < 2; ++b)
#pragma unroll
                for (int m = 0; m < 4; ++m)
#pragma unroll
                    for (int n = 0; n < 2; ++n) acc[a][b][m][n] = (f32x4){0.f, 0.f, 0.f, 0.f};
        }
        cur = nxt; cA = nA; cB = nB; ++ui;
        if constexpr (GATHER) { cv[0][0] = nv[0][0]; cv[0][1] = nv[0][1]; cv[1][0] = nv[1][0]; cv[1][1] = nv[1][1]; }
        if constexpr (ALIGN_EPI) { if (wr == 1) PG8_BAR; }
    }
    PG8_WAIT_V(0);
    if constexpr (!ALIGN_EPI) { if (wr == 0) PG8_BAR; }
    PG8_BAR;
#undef PG8_UA
#undef PG8_GV
#undef PG8_STAGE_A
#undef PG8_UB
#undef PG8_SA
#undef PG8_SB
#undef PG8_STAGE
#undef PG8_LDA
#undef PG8_LDB
#undef PG8_MMA
#undef PG8_WAIT_V
#undef PG8_WAIT_L
#undef PG8_BAR
#undef PG8_SCHED
}
}

#define XB_TMO      128
#define XB_XCNT(j)  (256  + 64 * (j))
#define XB_XSUB(j)  (1280 + 64 * (j))
#define XB_XGEN(j)  (2304 + 64 * (j))
#define XB_TOP      3328
#define XB_TOPGEN   3392
#define XCD_BAR_WORDS 3456
#define XB_SPIN_CAP (1u << 18)

__device__ __forceinline__ unsigned xb_ld(unsigned* p)              { return __hip_atomic_load(p, __ATOMIC_RELAXED, __HIP_MEMORY_SCOPE_AGENT); }
__device__ __forceinline__ unsigned xb_add(unsigned* p, unsigned v) { return __hip_atomic_fetch_add(p, v, __ATOMIC_RELAXED, __HIP_MEMORY_SCOPE_AGENT); }
__device__ __forceinline__ unsigned xb_xcc_id() { return (unsigned)__builtin_amdgcn_s_getreg((3 << 11) | 20) & 0xFu; }
#define XB_SPIN(cond, bar) do { unsigned _sp = 0; while (cond) { __builtin_amdgcn_s_sleep(1); \
    if ((++_sp & 255u) == 0u) { if (xb_ld(&(bar)[XB_TMO])) break; if (_sp > XB_SPIN_CAP) { atomicAdd(&(bar)[XB_TMO], 1u); break; } } } } while (0)

struct XcdBarrier {
    unsigned* bar; unsigned x;
    volatile LAS unsigned* st;
};

__device__ __forceinline__ XcdBarrier xcd_barrier_post(unsigned* bar, volatile LAS unsigned* st) {
    XcdBarrier b; b.bar = bar; b.x = xb_xcc_id(); b.st = st;
    if (threadIdx.x == 0) (void)xb_add(&bar[XB_XCNT(b.x)], 1u);
    return b;
}
__device__ __forceinline__ void xcd_barrier_complete(unsigned* bar, unsigned x, unsigned& nloc, unsigned& nx) {
    const unsigned G = gridDim.x * gridDim.y * gridDim.z;
    unsigned sum, cnt, mine, sp = 0u;
    for (;;) {
        sum = 0u; cnt = 0u; mine = 0u;
#pragma unroll
        for (unsigned j = 0; j < 16; ++j) { const unsigned c = xb_ld(&bar[XB_XCNT(j)]); sum += c; cnt += (c > 0u) ? 1u : 0u; mine = (j == x) ? c : mine; }
        if (sum == G) break;
        __builtin_amdgcn_s_sleep(1);
        if ((++sp & 255u) == 0u) { if (xb_ld(&bar[XB_TMO])) break; if (sp > XB_SPIN_CAP) { atomicAdd(&bar[XB_TMO], 1u); break; } }
    }
    nloc = mine > 0u ? mine : 1u; nx = cnt > 0u ? cnt : 1u;
}

__device__ __forceinline__ void xcd_barrier(const XcdBarrier& b) {
    asm volatile("s_waitcnt vmcnt(0)" ::: "memory");
    __syncthreads();
    if (threadIdx.x == 0) {
        unsigned* bar = b.bar;
        __builtin_amdgcn_s_waitcnt(0);
        unsigned nloc = b.st[0], nx = b.st[1];
        if (nloc == 0u) { xcd_barrier_complete(bar, b.x, nloc, nx); b.st[0] = nloc; b.st[1] = nx; }
        const unsigned old = xb_add(&bar[XB_XSUB(b.x)], 1u);
        const unsigned gen = old / nloc;
        if (old + 1u == (gen + 1u) * nloc) {
            __builtin_amdgcn_fence(__ATOMIC_RELEASE, "agent");
            asm volatile("s_waitcnt vmcnt(0)" ::: "memory");
            const unsigned og = xb_add(&bar[XB_TOP], 1u);
            const unsigned tg = og / nx;
            if (og + 1u == (tg + 1u) * nx) xb_add(&bar[XB_TOPGEN], 1u);
            else XB_SPIN(xb_ld(&bar[XB_TOPGEN]) == tg, bar);
            __builtin_amdgcn_fence(__ATOMIC_ACQUIRE, "agent");
            xb_add(&bar[XB_XGEN(b.x)], 1u);
            asm volatile("s_waitcnt vmcnt(0)" ::: "memory");
        } else {
            XB_SPIN(xb_ld(&bar[XB_XGEN(b.x)]) == gen, bar);
            __builtin_amdgcn_fence(__ATOMIC_ACQUIRE, "agent");
            asm volatile("s_waitcnt vmcnt(0)" ::: "memory");
        }
    }
    __syncthreads();
}

constexpr size_t MiB = 1u << 20;
constexpr size_t WS_CTL = 0, CTL_ZERO_BYTES = 64 * 1024;
constexpr size_t WS_WIN = 1 * MiB;
constexpr size_t WS_WO = WS_WIN + (size_t)31 * 256 * 1024 * 2;
constexpr size_t WS_WOUT = WS_WO + (size_t)3 * 1024 * 512 * 2;
constexpr size_t WS_WPG = WS_WOUT + (size_t)1024 * 1024 * 2;
constexpr size_t WS_WPLE = WS_WPG + (size_t)1024 * 1024 * 2;
constexpr size_t WS_WGU = WS_WPLE + (size_t)1024 * 256 * 2;
constexpr size_t WS_WDN = WS_WGU + (size_t)16 * 1024 * 1024 * 2;
constexpr size_t WS_WEND = WS_WDN + (size_t)16 * 1024 * 512 * 2;
static_assert(WS_WEND <= 73 * MiB, "weights");
constexpr size_t WS_HN = 73 * MiB;
constexpr size_t WS_PB = WS_HN + (size_t)NTOK * DM * 2;
constexpr size_t WS_Z = WS_PB + (size_t)NTOK * PLE * 2;
constexpr size_t WS_ZEND = WS_Z + (size_t)NTOK * ZP * 2;
constexpr size_t WS_SLOC = WS_ZEND;
constexpr size_t WS_DTAB = WS_SLOC + (size_t)2048 * 8192 * 2;
constexpr size_t WS_ROUTE = WS_DTAB + (size_t)2048 * 64 * 4;
constexpr size_t WS_HIST = WS_ROUTE + (size_t)NTOK * 16;
constexpr size_t WS_TBL = WS_HIST + (size_t)GRID * 32 * 4;
constexpr size_t WS_SLOTW = WS_TBL + 1024;
constexpr size_t WS_S2T = WS_SLOTW + (size_t)NSLOT * 8;
constexpr size_t WS_END = WS_S2T + (size_t)NSLOT * 4;
constexpr size_t WS_ACT = WS_Z;
constexpr size_t WS_PL = WS_ACT + (size_t)NSLOT * DM * 2;
static_assert(WS_PL + (size_t)NTOK * DM * 2 <= WS_ZEND, "MoE overlay fits inside Z");
constexpr int CW_BAR = 4096;
constexpr int CW_QHEAD = 8192, CW_KN = 8192 + 256;

constexpr int RING_BYTES = 131072;
constexpr int LDSCTL_OFF = 143360, MISC_OFF = LDSCTL_OFF + 320;
constexpr int LDS_BYTES = 147456;

__device__ __forceinline__ void tr_item(const float* W, int ldw, int col0, int K, bf16_t* WT, int nrows, int valid, LAS float* scr, int item, int lane) {
    const int nblk = nrows / 32, kb = item / nblk, nb = item % nblk, k0 = 64 * kb, n0 = 32 * nb;
    const int kk = lane >> 3, c4 = (lane & 7) * 4;
    const bool ok = (n0 + c4) < valid;
    f32x4 v[8];
#pragma unroll
    for (int i = 0; i < 8; ++i) v[i] = ok ? *(const f32x4*)(W + (size_t)(k0 + 8 * i + kk) * ldw + col0 + n0 + c4) : (f32x4){0.f, 0.f, 0.f, 0.f};
#pragma unroll
    for (int i = 0; i < 8; ++i) { LAS float* d = scr + (8 * i + kk) * 33 + c4; d[0] = v[i].x; d[1] = v[i].y; d[2] = v[i].z; d[3] = v[i].w; }
    LDS_WAIT(); asm volatile("" ::: "memory");
    const int c = lane & 7;
#pragma unroll
    for (int j = 0; j < 4; ++j) { const int n = (lane >> 3) + 8 * j; const LAS float* s = scr + (8 * c) * 33 + n;
        u32x4 o; o.x = pk2(s[0 * 33], s[1 * 33]); o.y = pk2(s[2 * 33], s[3 * 33]); o.z = pk2(s[4 * 33], s[5 * 33]); o.w = pk2(s[6 * 33], s[7 * 33]);
        *(u32x4*)(WT + (size_t)(n0 + n) * K + k0 + 8 * c) = o; }
    LDS_WAIT(); asm volatile("" ::: "memory");
}
__device__ __forceinline__ int win_src_col(int t) {
    if (t < 4) return 256 * t;
    if (t < 8) return 2064 + 256 * (t - 4);
    if (t < 10) return 3088 + 256 * (t - 8);
    if (t < 12) return 4112 + 256 * (t - 10);
    if (t == 12) return 1536;
    if (t < 15) return 1024 + 256 * (t - 13);
    if (t < 17) return 1552 + 256 * (t - 15);
    if (t < 19) return 3600 + 256 * (t - 17);
    return 4624 + 256 * (t - 19);
}
__device__ __forceinline__ f32x4 ld_x16(const bf16_t* row, int j, int lane) { const u32x2 w = ((const u32x2*)row)[64 * j + lane]; return (f32x4){bflo(w.x), bfhi(w.x), bflo(w.y), bfhi(w.y)}; }
template <int NR> __device__ __forceinline__ void rms_rows_bf16(const float* x, const bf16_t* x16, const float* g, bf16_t* o, int m0, int mstep, int lane) {
    f32x4 v[NR][4]; float s[NR];
    if (x16) {
#pragma unroll
        for (int q = 0; q < NR; ++q)
#pragma unroll
            for (int j = 0; j < 4; ++j) v[q][j] = ld_x16(x16 + (size_t)(m0 + q * mstep) * DM, j, lane);
    } else {
#pragma unroll
    for (int q = 0; q < NR; ++q) { const f32x4* xr = (const f32x4*)(x + (size_t)(m0 + q * mstep) * DM) + lane;
#pragma unroll
        for (int j = 0; j < 4; ++j) v[q][j] = xr[64 * j]; }
    }
    const f32x4* gr = (const f32x4*)g + lane; f32x4 gg[4];
#pragma unroll
    for (int j = 0; j < 4; ++j) gg[j] = gr[64 * j];
#pragma unroll
    for (int q = 0; q < NR; ++q) { s[q] = 0.f;
#pragma unroll
        for (int j = 0; j < 4; ++j) s[q] += (v[q][j].x * v[q][j].x + v[q][j].y * v[q][j].y) + (v[q][j].z * v[q][j].z + v[q][j].w * v[q][j].w); }
#pragma unroll
    for (int q = 0; q < NR; ++q) s[q] = wave_sum_dpp(s[q]);
#pragma unroll
    for (int q = 0; q < NR; ++q) { const float r = 1.0f / sqrtf(s[q] * (1.f / DM) + EPS); u32x2* o8 = (u32x2*)(o + (size_t)(m0 + q * mstep) * DM) + lane;
#pragma unroll
        for (int j = 0; j < 4; ++j) { u32x2 w; w.x = pk2(v[q][j].x * r * gg[j].x, v[q][j].y * r * gg[j].y); w.y = pk2(v[q][j].z * r * gg[j].z, v[q][j].w * r * gg[j].w); o8[64 * j] = w; } }
}

struct Ptrs { const float* in[24]; float* out; unsigned char* ws; };
struct Args { Ptrs p; int ph_lo, ph_hi; };
typedef const __attribute__((address_space(4))) Args* KA;

constexpr int TRG_N0 = 31 * 128, TRG_N1 = 3 * 256, TRG_N2 = 512, TRG_N3 = 512, TRG_N4 = 128, TRG_N5 = 16 * 512, TRG_N6 = 16 * 256;
__device__ __forceinline__ void tr_group_item(KA P, int L, int grp, int r, LAS float* scr, int lane) {
    unsigned char* ws = P->p.ws;
    if (grp == 0) { const int t = r / 128; tr_item(P->p.in[3] + (size_t)L * DM * INTOT, INTOT, win_src_col(t), DM, (bf16_t*)(ws + WS_WIN) + (size_t)t * 256 * DM, 256, t == 12 ? 16 : 256, scr, r % 128, lane); }
    else if (grp == 1) { const int j = r / 256; const float* src = (j == 0 ? P->p.in[7] : j == 1 ? P->p.in[10] : P->p.in[12]) + (size_t)L * 512 * DM;
        tr_item(src, DM, 0, 512, (bf16_t*)(ws + WS_WO) + (size_t)j * DM * 512, DM, DM, scr, r % 256, lane); }
    else if (grp == 2) tr_item(P->p.in[13] + (size_t)L * DM * DM, DM, 0, DM, (bf16_t*)(ws + WS_WOUT), DM, DM, scr, r, lane);
    else if (grp == 3) tr_item(P->p.in[22] + (size_t)L * DM * DM, DM, 0, DM, (bf16_t*)(ws + WS_WPG), DM, DM, scr, r, lane);
    else if (grp == 4) tr_item(P->p.in[21] + (size_t)L * PLE * DM, DM, 0, PLE, (bf16_t*)(ws + WS_WPLE), DM, DM, scr, r, lane);
    else if (grp == 5) { const int e = r / 512, q = (r % 512) / 64, n = q >> 1, s = q & 1;
        tr_item(P->p.in[19] + (size_t)(L * NEXP + e) * DM * 1024, 1024, 512 * s + 128 * n, DM, (bf16_t*)(ws + WS_WGU) + (size_t)e * 1024 * DM + (size_t)(256 * n + 128 * s) * DM, 128, 128, scr, r % 64, lane); }
    else { const int e = r / 256; tr_item(P->p.in[20] + (size_t)(L * NEXP + e) * DEXP * DM, DM, 0, DEXP, (bf16_t*)(ws + WS_WDN) + (size_t)e * DM * DEXP, DM, DM, scr, r % 256, lane); }
}
__device__ __forceinline__ void tr_groups(KA P, int L, unsigned mask, LAS float* scr, int gw, int NGW, int lane) {
    const int n[7] = {TRG_N0, TRG_N1, TRG_N2, TRG_N3, TRG_N4, TRG_N5, TRG_N6}; int total = 0;
#pragma unroll
    for (int g = 0; g < 7; ++g) if (mask & (1u << g)) total += n[g];
    for (int it = gw; it < total; it += NGW) { int r = it; bool done = false;
#pragma unroll
        for (int g = 0; g < 7; ++g) if (mask & (1u << g)) { if (!done && r < n[g]) { tr_group_item(P, L, g, r, scr, lane); done = true; } if (!done) r -= n[g]; } }
}
__device__ __forceinline__ void phaseA(KA P, int L, LAS unsigned char* lds, int vcu, int G, int wave, int lane, int tid) {
    LAS float* scr = (LAS float*)(lds + wave * 16384);
    const int gw = vcu * 8 + wave, NGW = G * 8;
    unsigned char* ws = P->p.ws;
    if (L == 0) tr_groups(P, L, 0x07u, scr, gw, NGW, lane);
    for (int m = gw; m < NTOK; m += 4 * NGW) rms_rows_bf16<4>(P->p.in[0], L == 0 ? (const bf16_t*)nullptr : (const bf16_t*)P->p.out, P->p.in[2] + (size_t)L * DM, (bf16_t*)(ws + WS_HN), m, NGW, lane);
    const f32x4* ps = (const f32x4*)(P->p.in[1] + (size_t)L * NTOK * PLE); u32x2* pd = (u32x2*)(ws + WS_PB);
    for (int i = vcu * 512 + tid; i < NTOK * PLE / 4; i += 8 * G * 512) { f32x4 v[8];
#pragma unroll
        for (int q = 0; q < 8; ++q) v[q] = ps[i + q * G * 512];
#pragma unroll
        for (int q = 0; q < 8; ++q) { u32x2 w; w.x = pk2(v[q].x, v[q].y); w.y = pk2(v[q].z, v[q].w); pd[i + q * G * 512] = w; } }
}

__device__ __forceinline__ void gla1_load_w(const float* wa2, const float* ba, LAS unsigned char* lds, int tid) {
    LAS float* WA = (LAS float*)(lds + 49152); LAS float* BA = (LAS float*)(lds + 65536);
    for (int i = tid; i < 4096; i += 512) WA[i] = wa2[i];
    if (tid < 256) BA[tid] = ba[tid];
    __syncthreads();
}
__device__ __forceinline__ float logsig16_l2(float x) {
    const float a = fabsf(x) * 1.4426950408889634f; const float l = __builtin_amdgcn_logf(1.0f + __builtin_amdgcn_exp2f(-a));
    return (fminf(x, 0.f) * 1.4426950408889634f - l) * (1.0f / 16.0f); }
struct Gla1In { u32x4 g0, g1, qv, kv, v0, v1; };
__device__ __forceinline__ void gla1_load(int unit, const bf16_t* Z, int wid, int lane, Gla1In& I) {
    const int bh = unit >> 8, c = unit & 255, b = bh >> 2, h = bh & 3; const size_t row0 = (size_t)b * T + (size_t)c * 64; const int cb = wid * 8; const bf16_t* zr = Z + (row0 + lane) * ZP;
    I.g0 = *(const u32x4*)(zr + C_GA); I.g1 = *(const u32x4*)(zr + C_GA + 8); I.qv = *(const u32x4*)(zr + C_GQ + h * 64 + cb); I.kv = *(const u32x4*)(zr + C_GK + h * 64 + cb);
    I.v0 = *(const u32x4*)(zr + C_GV + h * 128 + 16 * wid); I.v1 = *(const u32x4*)(zr + C_GV + h * 128 + 16 * wid + 8); }
__device__ __forceinline__ void gla1_unit(int unit, const Gla1In& I, bf16_t* Z, bf16_t* SLOCT, float* DTAB, LAS unsigned char* lds, int wid, int lane, int tid, int dry = 0) {
    const int bh = unit >> 8, c = unit & 255, b = bh >> 2, h = bh & 3; const size_t row0 = (size_t)b * T + (size_t)c * 64;
    LAS bf16_t* Qs = (LAS bf16_t*)lds; LAS bf16_t* Ks = (LAS bf16_t*)(lds + 8192); LAS bf16_t* KhT = (LAS bf16_t*)(lds + 16384); LAS bf16_t* VT = (LAS bf16_t*)(lds + 24576);
    LAS bf16_t* Am = (LAS bf16_t*)(lds + 40960); const LAS float* WA = (const LAS float*)(lds + 49152); const LAS float* BA = (const LAS float*)(lds + 65536);
    const int r32 = lane & 31, hi = lane >> 5;
    {
        const int t = lane, cb = wid * 8;
        const u32x4 g0 = I.g0, g1 = I.g1, qv = I.qv, kv = I.kv, v0 = I.v0, v1 = I.v1;
        float gaf[16]; gaf[0] = bflo(g0.x); gaf[1] = bfhi(g0.x); gaf[2] = bflo(g0.y); gaf[3] = bfhi(g0.y); gaf[4] = bflo(g0.z); gaf[5] = bfhi(g0.z); gaf[6] = bflo(g0.w); gaf[7] = bfhi(g0.w);
        gaf[8] = bflo(g1.x); gaf[9] = bfhi(g1.x); gaf[10] = bflo(g1.y); gaf[11] = bfhi(g1.y); gaf[12] = bflo(g1.z); gaf[13] = bfhi(g1.z); gaf[14] = bflo(g1.w); gaf[15] = bfhi(g1.w);
        float la[8];
        { const f32x4 b0 = *(const LAS f32x4*)(BA + h * 64 + cb), b1 = *(const LAS f32x4*)(BA + h * 64 + cb + 4);
          la[0] = b0.x; la[1] = b0.y; la[2] = b0.z; la[3] = b0.w; la[4] = b1.x; la[5] = b1.y; la[6] = b1.z; la[7] = b1.w; }
#pragma unroll
        for (int r = 0; r < 16; ++r) { const f32x4 w0 = *(const LAS f32x4*)(WA + r * 256 + h * 64 + cb), w1 = *(const LAS f32x4*)(WA + r * 256 + h * 64 + cb + 4);
            la[0] = fmaf(gaf[r], w0.x, la[0]); la[1] = fmaf(gaf[r], w0.y, la[1]); la[2] = fmaf(gaf[r], w0.z, la[2]); la[3] = fmaf(gaf[r], w0.w, la[3]);
            la[4] = fmaf(gaf[r], w1.x, la[4]); la[5] = fmaf(gaf[r], w1.y, la[5]); la[6] = fmaf(gaf[r], w1.z, la[6]); la[7] = fmaf(gaf[r], w1.w, la[7]); }
#pragma unroll
        for (int i = 0; i < 8; ++i) la[i] = wave_scan_incl(logsig16_l2(la[i]));
        float qf[8], kf[8];
        qf[0] = bflo(qv.x); qf[1] = bfhi(qv.x); qf[2] = bflo(qv.y); qf[3] = bfhi(qv.y); qf[4] = bflo(qv.z); qf[5] = bfhi(qv.z); qf[6] = bflo(qv.w); qf[7] = bfhi(qv.w);
        kf[0] = bflo(kv.x); kf[1] = bfhi(kv.x); kf[2] = bflo(kv.y); kf[3] = bfhi(kv.y); kf[4] = bflo(kv.z); kf[5] = bfhi(kv.z); kf[6] = bflo(kv.w); kf[7] = bfhi(kv.w);
        float qs[8], ks[8];
#pragma unroll
        for (int i = 0; i < 8; ++i) { const float bl = rdl(la[i], 63); const float eb = __builtin_amdgcn_exp2f(la[i]);
            qs[i] = qf[i] * 0.125f * eb; ks[i] = kf[i] * __builtin_amdgcn_exp2f(-la[i]);
            KhT[(cb + i) * 64 + t] = (bf16_t)f2bf(kf[i] * __builtin_amdgcn_exp2f(bl - la[i]));
            if (lane == 63) DTAB[(size_t)unit * 64 + cb + i] = eb; }
        u32x4 qw, kw; qw.x = pk2(qs[0], qs[1]); qw.y = pk2(qs[2], qs[3]); qw.z = pk2(qs[4], qs[5]); qw.w = pk2(qs[6], qs[7]);
        kw.x = pk2(ks[0], ks[1]); kw.y = pk2(ks[2], ks[3]); kw.z = pk2(ks[4], ks[5]); kw.w = pk2(ks[6], ks[7]);
        *(LAS u32x4*)(Qs + t * 64 + cb) = qw; *(LAS u32x4*)(Ks + t * 64 + cb) = kw;
        if (!dry) *(u32x4*)(Z + (row0 + t) * ZP + C_GQ + h * 64 + cb) = qw;
        LAS bf16_t* vt = VT + (16 * wid) * 64 + t;
        vt[0 * 64] = (bf16_t)(v0.x & 0xffff); vt[1 * 64] = (bf16_t)(v0.x >> 16); vt[2 * 64] = (bf16_t)(v0.y & 0xffff); vt[3 * 64] = (bf16_t)(v0.y >> 16);
        vt[4 * 64] = (bf16_t)(v0.z & 0xffff); vt[5 * 64] = (bf16_t)(v0.z >> 16); vt[6 * 64] = (bf16_t)(v0.w & 0xffff); vt[7 * 64] = (bf16_t)(v0.w >> 16);
        vt[8 * 64] = (bf16_t)(v1.x & 0xffff); vt[9 * 64] = (bf16_t)(v1.x >> 16); vt[10 * 64] = (bf16_t)(v1.y & 0xffff); vt[11 * 64] = (bf16_t)(v1.y >> 16);
        vt[12 * 64] = (bf16_t)(v1.z & 0xffff); vt[13 * 64] = (bf16_t)(v1.z >> 16); vt[14 * 64] = (bf16_t)(v1.w & 0xffff); vt[15 * 64] = (bf16_t)(v1.w >> 16);
    }
    __syncthreads();
    {
        const int vb = wid & 3, kb = wid >> 2; f32x16 acc = {};
#pragma unroll
        for (int ks = 0; ks < 4; ++ks) { const bf16x8 a = *(const LAS bf16x8*)(KhT + (32 * kb + r32) * 64 + 16 * ks + 8 * hi); const bf16x8 bb = *(const LAS bf16x8*)(VT + (32 * vb + r32) * 64 + 16 * ks + 8 * hi);
            acc = __builtin_amdgcn_mfma_f32_32x32x16_bf16(a, bb, acc, 0, 0, 0); }
        bf16_t* sp = SLOCT + (size_t)unit * 8192 + (32 * vb + r32) * 64 + 32 * kb + 4 * hi;
#pragma unroll
        for (int g = 0; g < 4; ++g) { u32x2 w; w.x = pk2(acc[4 * g], acc[4 * g + 1]); w.y = pk2(acc[4 * g + 2], acc[4 * g + 3]); *(u32x2*)(sp + 8 * g) = w; }
    }
    if (wid < 4) {
        const int sb = wid >> 1, tb = wid & 1; f32x16 acc = {};
        if (!(sb == 1 && tb == 0)) {
#pragma unroll
            for (int ks = 0; ks < 4; ++ks) { const bf16x8 a = *(const LAS bf16x8*)(Ks + (32 * sb + r32) * 64 + 16 * ks + 8 * hi); const bf16x8 bb = *(const LAS bf16x8*)(Qs + (32 * tb + r32) * 64 + 16 * ks + 8 * hi);
                acc = __builtin_amdgcn_mfma_f32_32x32x16_bf16(a, bb, acc, 0, 0, 0); }
        }
        const int t = 32 * tb + r32;
#pragma unroll
        for (int r = 0; r < 16; ++r) { const int s = 32 * sb + crow(r, hi); if (s > t) acc[r] = 0.f; }
#pragma unroll
        for (int g = 0; g < 4; ++g) { u32x2 w; w.x = pk2(acc[4 * g], acc[4 * g + 1]); w.y = pk2(acc[4 * g + 2], acc[4 * g + 3]); *(LAS u32x2*)(Am + t * 64 + 32 * sb + 8 * g + 4 * hi) = w; }
    }
    __syncthreads();
    {
        const int vb = wid & 3, tb = wid >> 2; f32x16 acc = {};
#pragma unroll
        for (int ks = 0; ks < 4; ++ks) { const bf16x8 a = *(const LAS bf16x8*)(VT + (32 * vb + r32) * 64 + 16 * ks + 8 * hi); const bf16x8 bb = *(const LAS bf16x8*)(Am + (32 * tb + r32) * 64 + 16 * ks + 8 * hi);
            acc = __builtin_amdgcn_mfma_f32_32x32x16_bf16(a, bb, acc, 0, 0, 0); }
        bf16_t* op = Z + (row0 + 32 * tb + r32) * ZP + C_GV + h * 128 + 32 * vb + 4 * hi;
#pragma unroll
        for (int g = 0; g < 4; ++g) { u32x2 w; w.x = pk2(acc[4 * g], acc[4 * g + 1]); w.y = pk2(acc[4 * g + 2], acc[4 * g + 3]); if (!dry) *(u32x2*)(op + 8 * g) = w; }
    }
    __syncthreads();
}

__device__ __forceinline__ void conv_ld_u(const bf16_t* Z, size_t row, int ch, float (&u)[8]) {
    const u32x4 a = *(const u32x4*)(Z + row * ZP + C_CX + ch), c = *(const u32x4*)(Z + row * ZP + C_CC + ch);
    u[0] = bflo(a.x) * bflo(c.x); u[1] = bfhi(a.x) * bfhi(c.x); u[2] = bflo(a.y) * bflo(c.y); u[3] = bfhi(a.y) * bfhi(c.y);
    u[4] = bflo(a.z) * bflo(c.z); u[5] = bfhi(a.z) * bfhi(c.z); u[6] = bflo(a.w) * bflo(c.w); u[7] = bfhi(a.w) * bfhi(c.w);
}
__device__ __forceinline__ void conv_unit(int cu, bf16_t* Z, const float* cw  , int wid, int lane, int dry = 0) {
    const int ch = lane * 8; const size_t r0 = (size_t)cu * 128 + (size_t)wid * 16;
    float w0[8], w1[8], w2[8];
#pragma unroll
    for (int i = 0; i < 8; ++i) { w0[i] = cw[ch + i]; w1[i] = cw[512 + ch + i]; w2[i] = cw[1024 + ch + i]; }
    float u2[8], u1[8];
    if ((r0 % T) == 0) {
#pragma unroll
        for (int i = 0; i < 8; ++i) { u2[i] = 0.f; u1[i] = 0.f; }
    } else { conv_ld_u(Z, r0 - 2, ch, u2); conv_ld_u(Z, r0 - 1, ch, u1); }
    for (int i0 = 0; i0 < 16; i0 += 8) {
        u32x4 xa[8], ca[8], ba[8];
#pragma unroll
        for (int q = 0; q < 8; ++q) { const size_t row = r0 + i0 + q; xa[q] = *(const u32x4*)(Z + row * ZP + C_CX + ch); ca[q] = *(const u32x4*)(Z + row * ZP + C_CC + ch); ba[q] = *(const u32x4*)(Z + row * ZP + C_CB + ch); }
        asm volatile("" ::: "memory");
#pragma unroll
        for (int q = 0; q < 8; ++q) { const size_t row = r0 + i0 + q; const u32x4 a = xa[q], c = ca[q], bq = ba[q]; float u[8], bb[8], y[8];
            u[0] = bflo(a.x) * bflo(c.x); u[1] = bfhi(a.x) * bfhi(c.x); u[2] = bflo(a.y) * bflo(c.y); u[3] = bfhi(a.y) * bfhi(c.y);
            u[4] = bflo(a.z) * bflo(c.z); u[5] = bfhi(a.z) * bfhi(c.z); u[6] = bflo(a.w) * bflo(c.w); u[7] = bfhi(a.w) * bfhi(c.w);
            bb[0] = bflo(bq.x); bb[1] = bfhi(bq.x); bb[2] = bflo(bq.y); bb[3] = bfhi(bq.y); bb[4] = bflo(bq.z); bb[5] = bfhi(bq.z); bb[6] = bflo(bq.w); bb[7] = bfhi(bq.w);
#pragma unroll
            for (int k = 0; k < 8; ++k) { y[k] = bb[k] * (w0[k] * u2[k] + w1[k] * u1[k] + w2[k] * u[k]); u2[k] = u1[k]; u1[k] = u[k]; }
            u32x4 o; o.x = pk2(y[0], y[1]); o.y = pk2(y[2], y[3]); o.z = pk2(y[4], y[5]); o.w = pk2(y[6], y[7]);
            if (!dry) *(u32x4*)(Z + row * ZP + C_OC + ch) = o; }
        asm volatile("" ::: "memory"); }
}

__device__ __forceinline__ void knorm_unit(int cu, const bf16_t* KV, unsigned* KN  , LAS unsigned char* lds, int wid, int lane, int tid) {
    const size_t r0 = (size_t)cu * 128 + (size_t)wid * 16; float mx = 0.f;
    const int kb_ = (int)(r0 / T); const size_t t0_ = r0 - (size_t)kb_ * T;
    u32x4 kr[16];
#pragma unroll
    for (int i = 0; i < 16; ++i) kr[i] = *(const u32x4*)(KV + ((size_t)(kb_ * 4 + (lane >> 4)) * T + t0_ + i) * 256 + (lane & 15) * 8);
#pragma unroll
    for (int i = 0; i < 16; ++i) { const u32x4 a = kr[i];
        const float f0 = bflo(a.x), f1 = bfhi(a.x), f2 = bflo(a.y), f3 = bfhi(a.y), f4 = bflo(a.z), f5 = bfhi(a.z), f6 = bflo(a.w), f7 = bfhi(a.w);
        float s = (f0 * f0 + f1 * f1) + (f2 * f2 + f3 * f3) + (f4 * f4 + f5 * f5) + (f6 * f6 + f7 * f7);
        s += xor_lane<1>(s); s += xor_lane<2>(s); s += xor_lane<4>(s);
        mx = fmaxf(mx, s); }
    mx = fmaxf(mx, xor_lane<8>(mx));
    LAS float* SC = (LAS float*)lds;
    if ((lane & 15) == 0) SC[wid * 4 + (lane >> 4)] = mx;
    __syncthreads();
    if (tid < 4) { float v = SC[tid];
#pragma unroll
        for (int w = 1; w < 8; ++w) v = fmaxf(v, SC[w * 4 + tid]);
        const int b = (int)(((size_t)cu * 128) / T);
        __hip_atomic_fetch_max(KN + b * 4 + tid, __float_as_uint(v), __ATOMIC_RELAXED, __HIP_MEMORY_SCOPE_AGENT); }
    __syncthreads();
}
namespace att {
constexpr int KVBLK = 64;
constexpr float C = 0.125f * 1.4426950408889634f;
constexpr float WTHR = 26.f;
#define KSWZ(row, colB) ((row) * 256 + ((colB) ^ (((row) & 7) << 4)))
#define SBAR() __builtin_amdgcn_sched_barrier(0)
#define SGB(mask, n) __builtin_amdgcn_sched_group_barrier(mask, n, 0)
__device__ __forceinline__ unsigned cvtpk(float lo, float hi) { unsigned r; asm volatile("v_cvt_pk_bf16_f32 %0, %1, %2" : "=v"(r) : "v"(lo), "v"(hi)); return r; }

__device__ __forceinline__ float addf(float a, float b) { float r; asm("v_add_f32 %0, %1, %2" : "=v"(r) : "v"(a), "v"(b)); return r; }
__device__ __forceinline__ bool psm_test(f32x16& p0, f32x16& p1, bool band, int dlim, float thr, bool test) {
    if (band) {
#pragma unroll
        for (int r = 0; r < 16; ++r) { const int cr = (r & 3) + 8 * (r >> 2); if (cr > dlim) p0[r] = -1e30f; if (cr + 32 > dlim) p1[r] = -1e30f; }
    }
    if (!test) return false;
    float pm0 = p0[0], pm1 = p1[0];
#pragma unroll
    for (int r = 1; r < 16; ++r) { pm0 = fmaxf(pm0, p0[r]); pm1 = fmaxf(pm1, p1[r]); }
    float pmax = fmaxf(pm0, pm1);
    { auto rr = __builtin_amdgcn_permlane32_swap(__float_as_uint(pmax), __float_as_uint(pmax), false, false);
      pmax = fmaxf(__uint_as_float(rr[0]), __uint_as_float(rr[1])); }
    return __all(pmax < thr);
}
__device__ __forceinline__ void partialSM(f32x16& p0, f32x16& p1, bool band, int dlim, float thr, bool test, bool& skip) {
    skip = psm_test(p0, p1, band, dlim, thr, test);
    if (skip) return;
#pragma unroll
    for (int r = 0; r < 16; ++r) p0[r] = __builtin_amdgcn_exp2f(p0[r]);
}
__device__ __forceinline__ void finishSM(f32x16& p0, f32x16& p1, float& l_reg, bf16x8& pa0, bf16x8& pa1, bf16x8& pa2, bf16x8& pa3) {
#pragma unroll
    for (int r = 0; r < 16; ++r) p1[r] = __builtin_amdgcn_exp2f(p1[r]);
    float s0 = addf(p0[0], p0[1]), s1 = addf(p0[2], p0[3]), s2 = addf(p1[0], p1[1]), s3 = addf(p1[2], p1[3]);
#pragma unroll
    for (int r = 4; r < 16; r += 4) { s0 = addf(s0, p0[r]); s1 = addf(s1, p0[r + 1]); s2 = addf(s2, p1[r]); s3 = addf(s3, p1[r + 1]); s0 = addf(s0, p0[r + 2]); s1 = addf(s1, p0[r + 3]); s2 = addf(s2, p1[r + 2]); s3 = addf(s3, p1[r + 3]); }
    l_reg = addf(l_reg, addf(addf(s0, s1), addf(s2, s3)));
#define PK4(P, BASE, OUT) do { unsigned a0 = cvtpk(P[BASE + 0], P[BASE + 1]), a1 = cvtpk(P[BASE + 2], P[BASE + 3]);   \
    unsigned b0 = cvtpk(P[BASE + 4], P[BASE + 5]), b1 = cvtpk(P[BASE + 6], P[BASE + 7]);                              \
    auto r0 = __builtin_amdgcn_permlane32_swap(a0, b0, false, false); auto r1 = __builtin_amdgcn_permlane32_swap(a1, b1, false, false); \
    u32x4 w = {r0[0], r1[0], r0[1], r1[1]}; OUT = *reinterpret_cast<bf16x8*>(&w); } while (0)
    PK4(p0, 0, pa0); PK4(p0, 8, pa1); PK4(p1, 0, pa2); PK4(p1, 8, pa3);
#undef PK4
}
__device__ __forceinline__ void qkt(f32x16& p0, f32x16& p1, const char* Ks, const bf16x8* qr, int r32, int hi, int m) {
    bf16x8 b0[4], b1[4];
#pragma unroll
    for (int d0 = 0; d0 < 4; ++d0) { const int cb = ((4 * m + d0) * 16 + hi * 8) * 2;
        b0[d0] = *reinterpret_cast<const bf16x8*>(Ks + KSWZ(r32, cb)); b1[d0] = *reinterpret_cast<const bf16x8*>(Ks + KSWZ(32 + r32, cb)); }
#pragma unroll
    for (int d0 = 0; d0 < 4; ++d0) { p0 = __builtin_amdgcn_mfma_f32_32x32x16_bf16(b0[d0], qr[d0], p0, 0, 0, 0); p1 = __builtin_amdgcn_mfma_f32_32x32x16_bf16(b1[d0], qr[d0], p1, 0, 0, 0); }
    SGB(0x100, 4); SGB(0x008, 1); SGB(0x100, 1); SGB(0x008, 1); SGB(0x100, 1); SGB(0x008, 1); SGB(0x100, 1); SGB(0x008, 1); SGB(0x100, 1); SGB(0x008, 4);
}
__device__ __forceinline__ void cinit(f32x16& p0, f32x16& p1, const f32x16& cb, float t0, float t1) {
#pragma unroll
    for (int r = 0; r < 16; ++r) { p0[r] = addf(cb[r], t0); p1[r] = addf(cb[r], t1); }
}
__device__ __forceinline__ int v_st(int k, int c) { const int kk = (k & ~0xC) | ((k & 4) << 1) | ((k & 8) >> 1); return ((kk >> 3) * 4 + (c >> 5)) * 512 + ((kk & 7) * 32 + (c & 31)) * 2; }
__device__ __forceinline__ int v_rd_base(int lane) { return ((lane & 3) << 3) | (((lane >> 2) & 3) << 6) | (((lane >> 4) & 1) << 5) | (((lane >> 5) & 1) << 8); }
constexpr int v_rd_off(int d0, int ks, int half) { return d0 * 512 + ks * 4096 + half * 2048; }
typedef short v4i16_t __attribute__((ext_vector_type(4)));
template <int OFF> __device__ __forceinline__ s16x4 tr_read(int vb) { s16x4 r; asm volatile("ds_read_b64_tr_b16 %0, %1 offset:%2" : "=v"(r) : "v"(vb), "n"(OFF)); return r; }
struct VFrag { s16x4 l0, h0, l1, h1, l2, h2, l3, h3; };
template <int D0> __device__ __forceinline__ void v_load(VFrag& f, int vb) {
    f.l0 = tr_read<v_rd_off(D0, 0, 0)>(vb); f.h0 = tr_read<v_rd_off(D0, 0, 1)>(vb); f.l1 = tr_read<v_rd_off(D0, 1, 0)>(vb); f.h1 = tr_read<v_rd_off(D0, 1, 1)>(vb);
    f.l2 = tr_read<v_rd_off(D0, 2, 0)>(vb); f.h2 = tr_read<v_rd_off(D0, 2, 1)>(vb); f.l3 = tr_read<v_rd_off(D0, 3, 0)>(vb); f.h3 = tr_read<v_rd_off(D0, 3, 1)>(vb); }
__device__ __forceinline__ void v_wait(VFrag& f) { asm volatile("s_waitcnt lgkmcnt(0)" : "+v"(f.l0), "+v"(f.h0), "+v"(f.l1), "+v"(f.h1), "+v"(f.l2), "+v"(f.h2), "+v"(f.l3), "+v"(f.h3)); }
__device__ __forceinline__ void pv_mma(f32x16& od, const VFrag& f, bf16x8 pa0, bf16x8 pa1, bf16x8 pa2, bf16x8 pa3) {
#define PK(L, H) (bf16x8){L[0], L[1], L[2], L[3], H[0], H[1], H[2], H[3]}
    od = __builtin_amdgcn_mfma_f32_32x32x16_bf16(pa0, PK(f.l0, f.h0), od, 0, 0, 0);
    od = __builtin_amdgcn_mfma_f32_32x32x16_bf16(pa1, PK(f.l1, f.h1), od, 0, 0, 0);
    od = __builtin_amdgcn_mfma_f32_32x32x16_bf16(pa2, PK(f.l2, f.h2), od, 0, 0, 0);
    od = __builtin_amdgcn_mfma_f32_32x32x16_bf16(pa3, PK(f.l3, f.h3), od, 0, 0, 0);
#undef PK
}
__device__ __forceinline__ void pv_d0(f32x16* o, int vb, bf16x8 pa0, bf16x8 pa1, bf16x8 pa2, bf16x8 pa3) {
    VFrag A, B;
    v_load<0>(A, vb);
    __builtin_amdgcn_s_setprio(1);
    v_wait(A); v_load<1>(B, vb); pv_mma(o[0], A, pa0, pa1, pa2, pa3);
    v_wait(B); v_load<2>(A, vb); pv_mma(o[1], B, pa0, pa1, pa2, pa3);
    v_wait(A); v_load<3>(B, vb); pv_mma(o[2], A, pa0, pa1, pa2, pa3);
    v_wait(B); pv_mma(o[3], B, pa0, pa1, pa2, pa3);
    __builtin_amdgcn_s_setprio(0);
}

constexpr int SLOT = 32768, NSLOTS = 4, WSF_OFF = NSLOTS * SLOT;
__device__ __forceinline__ void unit(int tid_in, int b, int h, int qb, float lam, float oneml, float kn2, bf16_t* Z, const bf16_t* KV, const float* gdiff, char* lds, int dry = 0) {
    int tid_l = tid_in; asm volatile("" : "+v"(tid_l)); const int tid = tid_l;
    const int wid = __builtin_amdgcn_readfirstlane(tid >> 6), lane = tid & 63, r32 = lane & 31, hi = lane >> 5, m = wid >> 2, rb = wid & 3;
    const size_t rowbase = (size_t)b * T; const int q0 = qb * 128;
    const float slope2 = exp2f(-2.f * (float)(h + 1)) * 1.4426950408889634f;
    LAS unsigned char* ldsL = (LAS unsigned char*)lds;
    float* wsf = (float*)(lds + WSF_OFF) + wid * 64; float* li_l = wsf;
    float l_reg = 0; f32x16 o[4] = {}; bf16x8 qr[4];
    const int NT = 2 * (qb + 1);
#ifdef NO_KV
#define KVP (ZP * 2)
    const char* Kh = (const char*)(Z + rowbase * ZP + C_DK + h * 128); const char* Vh = (const char*)(Z + rowbase * ZP + C_DV + h * 128);
#else
#define KVP 512
    const char* Kh = (const char*)(KV + (size_t)(b * 4 + h) * T * 256); const char* Vh = Kh + 256;
#endif
    unsigned kofs[2], vofs[2];
#pragma unroll
    for (int i = 0; i < 2; ++i) { const int ob = (2 * wid + i) * 1024 + lane * 16;
        { const int row = ob >> 8, cb = (ob & 255) ^ ((row & 7) << 4); kofs[i] = (unsigned)(row * KVP + cb); }
        { const int sub = ob >> 9, kkh = sub >> 2, cblk = sub & 3, w16 = (ob & 511) >> 1, kkl = w16 >> 5, cc = w16 & 31, kk = kkh * 8 + kkl;
          const int k = (kk & ~0xC) | ((kk & 4) << 1) | ((kk & 8) >> 1); vofs[i] = (unsigned)(k * KVP + (cblk * 32 + cc) * 2); } }
#define DMA_TILE(j_, so_) do { const char* kb_ = Kh + (size_t)(j_) * (size_t)(64 * KVP); const char* vb_ = Vh + (size_t)(j_) * (size_t)(64 * KVP); \
    _Pragma("unroll") for (int i_ = 0; i_ < 2; ++i_) { \
        __builtin_amdgcn_global_load_lds((const unsigned*)(kb_ + kofs[i_]), (LAS unsigned*)(ldsL + (so_) + 16384 + (2 * wid + i_) * 1024), 16, 0, 0); \
        __builtin_amdgcn_global_load_lds((const unsigned*)(vb_ + vofs[i_]), (LAS unsigned*)(ldsL + (so_) + (2 * wid + i_) * 1024), 16, 0, 0); } } while (0)
#define WAITBAR() asm volatile("s_waitcnt vmcnt(0) lgkmcnt(0)\n\ts_barrier" ::: "memory")
#define WAITBAR4() asm volatile("s_waitcnt vmcnt(4) lgkmcnt(0)\n\ts_barrier" ::: "memory")
    DMA_TILE(NT - 2, 0); DMA_TILE(NT - 1, SLOT);
    const bf16_t* Qw = Z + (rowbase + q0 + rb * 32 + r32) * ZP + C_DQ + h * 128 + m * 64 + hi * 8;
    float qss = 0.f;
#pragma unroll
    for (int d0 = 0; d0 < 4; ++d0) { const u32x4 w = *reinterpret_cast<const u32x4*>(Qw + d0 * 16);
        const float f0 = bflo(w.x), f1 = bfhi(w.x), f2 = bflo(w.y), f3 = bfhi(w.y), f4 = bflo(w.z), f5 = bfhi(w.z), f6 = bflo(w.w), f7 = bfhi(w.w);
        qss += (f0 * f0 + f1 * f1) + (f2 * f2 + f3 * f3) + (f4 * f4 + f5 * f5) + (f6 * f6 + f7 * f7);
        u32x4 s; s.x = pk2(f0 * C, f1 * C); s.y = pk2(f2 * C, f3 * C); s.z = pk2(f4 * C, f5 * C); s.w = pk2(f6 * C, f7 * C); qr[d0] = __builtin_bit_cast(bf16x8, s); }
    { auto rr = __builtin_amdgcn_permlane32_swap(__float_as_uint(qss), __float_as_uint(qss), false, false); qss = __uint_as_float(rr[0]) + __uint_as_float(rr[1]); }
    const float ubrow = 1.02f * sqrtf(qss) * sqrtf(kn2) * C;
    BFLY32(qss, fmaxf);
    const int vb0 = (int)(uintptr_t)lds + v_rd_base(lane);
    const int qrel = q0 + rb * 32 + r32;
    const float c32 = 32.f * slope2;
    f32x16 cb;
#pragma unroll
    for (int r = 0; r < 16; ++r) cb[r] = slope2 * (float)((r & 3) + 8 * (r >> 2) + 4 * hi - (rb * 32 + r32));
    asm volatile("" : "+v"(cb));
#define TJ(j) (slope2 * (float)(64 * (j) - q0))
    float mband, mlb;
    { if (lane == 0) wsf[0] = qss; WAITBAR();
      f32x16 t0, t1; float mx = -1e30f;
#pragma unroll
      for (int bt = 0; bt < 2; ++bt) { const int j = NT - 2 + bt; cinit(t0, t1, cb, TJ(j), TJ(j) + c32); qkt(t0, t1, lds + bt * SLOT + 16384, qr, r32, hi, m); const int dlim = qrel - 64 * j - 4 * hi;
#pragma unroll
          for (int r = 0; r < 16; ++r) { const int cr = (r & 3) + 8 * (r >> 2); if (cr > dlim) t0[r] = -1e30f; if (cr + 32 > dlim) t1[r] = -1e30f; }
          float a0 = t0[0], a1 = t1[0];
#pragma unroll
          for (int r = 1; r < 16; ++r) { a0 = fmaxf(a0, t0[r]); a1 = fmaxf(a1, t1[r]); }
          mx = fmaxf(mx, fmaxf(a0, a1)); }
      { auto rr = __builtin_amdgcn_permlane32_swap(__float_as_uint(mx), __float_as_uint(mx), false, false); mx = fmaxf(__uint_as_float(rr[0]), __uint_as_float(rr[1])); }
      mlb = mx;
      BFLY32(mx, fminf);
      mband = mx; }
    float qn2 = 0.f;
#pragma unroll
    for (int w = 0; w < 8; ++w) qn2 = fmaxf(qn2, ((float*)(lds + WSF_OFF))[w * 64]);
    WAITBAR();
    if (lane == 0) wsf[0] = mband; WAITBAR();
    float mbmin = 1e30f;
#pragma unroll
    for (int w = 0; w < 8; ++w) mbmin = fminf(mbmin, ((float*)(lds + WSF_OFF))[w * 64]);
    const float wd = (WTHR + 1.02f * sqrtf(qn2) * sqrtf(kn2) * C - mbmin) / slope2;
    int jlo = (int)floorf(((float)(q0 - 63) - wd) * (1.f / 64.f)); jlo = jlo < 0 ? 0 : (jlo & ~1);
    jlo = __builtin_amdgcn_readfirstlane(jlo);
    DMA_TILE(jlo, 0); DMA_TILE(jlo + 1, SLOT); if (jlo + 2 < NT) DMA_TILE(jlo + 2, 2 * SLOT);
    int jfar = (int)floorf(((float)(q0 - 63) - (WTHR + 0.25f * sqrtf(qn2) * sqrtf(kn2) * C - mbmin) / slope2) * (1.f / 64.f)) + 1; jfar = __builtin_amdgcn_readfirstlane(jfar);
    const float mexp = fmaxf(mlb, ubrow - 100.f);
    const float thr = mlb - mexp - WTHR;
#pragma unroll
    for (int r = 0; r < 16; ++r) cb[r] -= mexp;
    asm volatile("" : "+v"(cb));
#define PSM(P0, P1, j, SK) partialSM(P0, P1, (j) >= NT - 2, qrel - 64 * (j) - 4 * hi, thr, (j) < jfar || (j) >= NT - 2, SK)
#define QKT(P0, P1, j) do { cinit(P0, P1, cb, TJ(j), TJ(j) + c32); qkt(P0, P1, lds + sl_cur + 16384, qr, r32, hi, m); } while (0)
#define ROT() do { sl_prev = sl_cur; sl_cur = sl_next; sl_next = sl_n2; sl_n2 = (sl_n2 == (NSLOTS - 1) * SLOT) ? 0 : sl_n2 + SLOT; } while (0)
    f32x16 pA0, pA1, pB0, pB1; bf16x8 pa0, pa1, pa2, pa3; bool skA, skB;
    int sl_prev = 0, sl_cur = 0, sl_next = SLOT, sl_n2 = 2 * SLOT;
    WAITBAR();
    QKT(pA0, pA1, jlo); PSM(pA0, pA1, jlo, skA);
    ROT();
    for (int j = jlo + 1; j + 1 < NT; j += 2) {
        if (j + 2 < NT) DMA_TILE(j + 2, sl_n2);
        SBAR(); QKT(pB0, pB1, j);
        if (!skA) finishSM(pA0, pA1, l_reg, pa0, pa1, pa2, pa3); SBAR();
        if (!skA) pv_d0(o, vb0 + sl_prev, pa0, pa1, pa2, pa3); PSM(pB0, pB1, j, skB);
        if (j + 2 < NT) WAITBAR4(); else WAITBAR();
        ROT();
        if (j + 3 < NT) DMA_TILE(j + 3, sl_n2);
        SBAR(); QKT(pA0, pA1, j + 1);
        if (!skB) finishSM(pB0, pB1, l_reg, pa0, pa1, pa2, pa3); SBAR();
        if (!skB) pv_d0(o, vb0 + sl_prev, pa0, pa1, pa2, pa3); PSM(pA0, pA1, j + 1, skA);
        if (j + 3 < NT) WAITBAR4(); else WAITBAR();
        ROT();
    }
    SBAR(); QKT(pB0, pB1, NT - 1);
    if (!skA) finishSM(pA0, pA1, l_reg, pa0, pa1, pa2, pa3); SBAR();
    if (!skA) pv_d0(o, vb0 + sl_prev, pa0, pa1, pa2, pa3); PSM(pB0, pB1, NT - 1, skB);
    if (!skB) { finishSM(pB0, pB1, l_reg, pa0, pa1, pa2, pa3); SBAR();
    pv_d0(o, vb0 + sl_cur, pa0, pa1, pa2, pa3); }
    { auto rr = __builtin_amdgcn_permlane32_swap(__float_as_uint(l_reg), __float_as_uint(l_reg), false, false); l_reg = __uint_as_float(rr[0]) + __uint_as_float(rr[1]); }
    if (hi == 0) li_l[r32] = l_reg; asm volatile("s_waitcnt lgkmcnt(0)" ::: "memory");
    float rli[16];
#pragma unroll
    for (int r = 0; r < 16; ++r) rli[r] = __builtin_amdgcn_rcpf(li_l[crow(r, hi)]);
    WAITBAR();
    float* XO = (float*)lds + rb * 4096;
    if (m == 1) {
#pragma unroll
        for (int d0 = 0; d0 < 4; ++d0)
#pragma unroll
            for (int r = 0; r < 16; ++r) XO[(d0 * 16 + r) * 64 + lane] = o[d0][r] * rli[r];
    }
    WAITBAR();
    if (m == 0) {
        float ss[16];
#pragma unroll
        for (int r = 0; r < 16; ++r) ss[r] = 0.f;
#pragma unroll
        for (int d0 = 0; d0 < 4; ++d0)
#pragma unroll
            for (int r = 0; r < 16; ++r) { const float v = o[d0][r] * rli[r] - lam * XO[(d0 * 16 + r) * 64 + lane]; o[d0][r] = v; ss[r] += v * v; }
#pragma unroll
        for (int r = 0; r < 16; ++r) {
            BFLY32(ss[r], opadd_);
            ss[r] = oneml / sqrtf(ss[r] * (1.f / 128.f) + EPS); }
        bf16_t* Ow = Z + (rowbase + q0 + rb * 32) * ZP + C_OB + h * 128 + r32;
#pragma unroll
        for (int d0 = 0; d0 < 4; ++d0) { const float gc = gdiff[32 * d0 + r32];
#pragma unroll
            for (int r = 0; r < 16; ++r) if (!dry) Ow[(size_t)crow(r, hi) * ZP + 32 * d0] = (bf16_t)f2bf(o[d0][r] * ss[r] * gc); }
    }
    WAITBAR();
#undef DMA_TILE
#undef WAITBAR
#undef WAITBAR4
#undef PSM
#undef QKT
#undef TJ
#undef ROT
}
#undef KSWZ
#undef SBAR
}

__device__ __forceinline__ void gla_scan(bf16_t* SLOCT, const float* DTAB, LAS unsigned char* lds, int G, int bx, int tid) {
    const int seg = tid >> 5, pl = tid & 31; LAS f32x4* PR = (LAS f32x4*)lds;
    for (int grp = bx; grp < 1024; grp += G) {
        const int pi = grp * 32 + pl, bh = pi >> 12, e2 = (pi & 4095) * 2, dk = e2 & 63;
        unsigned* sp = (unsigned*)(SLOCT + (size_t)bh * 256 * 8192 + e2) + (size_t)(seg * 16) * 4096; const float* dp = DTAB + (size_t)bh * 256 * 64 + dk + (size_t)(seg * 16) * 64;
        unsigned u[16]; f32x2 d[16];
#pragma unroll
        for (int i = 0; i < 16; ++i) { u[i] = sp[(size_t)i * 4096]; d[i] = *(const f32x2*)(dp + (size_t)i * 64); }
        float r0 = 0.f, r1 = 0.f, P0 = 1.f, P1 = 1.f;
#pragma unroll
        for (int i = 0; i < 16; ++i) { r0 = fmaf(d[i].x, r0, bflo(u[i])); r1 = fmaf(d[i].y, r1, bfhi(u[i])); P0 *= d[i].x; P1 *= d[i].y; }
        PR[seg * 32 + pl] = (f32x4){P0, P1, r0, r1};
        __syncthreads();
        float i0 = 0.f, i1 = 0.f;
        for (int s = 0; s < seg; ++s) { const f32x4 q = PR[s * 32 + pl]; i0 = fmaf(q.x, i0, q.z); i1 = fmaf(q.y, i1, q.w); }
#pragma unroll
        for (int i = 0; i < 16; ++i) { sp[(size_t)i * 4096] = pk2(i0, i1); i0 = fmaf(d[i].x, i0, bflo(u[i])); i1 = fmaf(d[i].y, i1, bfhi(u[i])); }
        __syncthreads();
    }
}

struct Gla3In { bf16x8 af[4], bfv[4]; u32x2 oi[4], gq[4]; };
__device__ __forceinline__ void gla3_load(int unit, const bf16_t* Z, const bf16_t* SLOCT, int wid, int lane, Gla3In& I) {
    const int bh = unit >> 8, c = unit & 255, b = bh >> 2, h = bh & 3; const size_t row0 = (size_t)b * T + (size_t)c * 64;
    const int r32 = lane & 31, hi = lane >> 5, vb = wid & 3, tb = wid >> 2; const bf16_t* zr = Z + (row0 + 32 * tb + r32) * ZP;
#pragma unroll
    for (int ks = 0; ks < 4; ++ks) { I.af[ks] = *(const bf16x8*)(SLOCT + (size_t)unit * 8192 + (32 * vb + r32) * 64 + 16 * ks + 8 * hi); I.bfv[ks] = *(const bf16x8*)(zr + C_GQ + h * 64 + 16 * ks + 8 * hi); }
#pragma unroll
    for (int g = 0; g < 4; ++g) { I.oi[g] = *(const u32x2*)(zr + C_GV + h * 128 + 32 * vb + 8 * g + 4 * hi); I.gq[g] = *(const u32x2*)(zr + C_GG + h * 128 + 32 * vb + 8 * g + 4 * hi); }
}
__device__ __forceinline__ void gla3_unit(int unit, const Gla3In& I, bf16_t* Z, const float* ggn, LAS unsigned char* lds, int wid, int lane, int dry = 0) {
    const int bh = unit >> 8, c = unit & 255, b = bh >> 2, h = bh & 3; const size_t row0 = (size_t)b * T + (size_t)c * 64;
    const int r32 = lane & 31, hi = lane >> 5, vb = wid & 3, tb = wid >> 2;
    LAS float* SS = (LAS float*)lds;
    f32x4 gn[4];
#pragma unroll
    for (int g = 0; g < 4; ++g) gn[g] = *(const f32x4*)(ggn + 32 * vb + 8 * g + 4 * hi);
    f32x16 acc = {};
#pragma unroll
    for (int ks = 0; ks < 4; ++ks) acc = __builtin_amdgcn_mfma_f32_32x32x16_bf16(I.af[ks], I.bfv[ks], acc, 0, 0, 0);
    float o[16], ss = 0.f;
#pragma unroll
    for (int g = 0; g < 4; ++g) { o[4 * g] = acc[4 * g] + bflo(I.oi[g].x); o[4 * g + 1] = acc[4 * g + 1] + bfhi(I.oi[g].x); o[4 * g + 2] = acc[4 * g + 2] + bflo(I.oi[g].y); o[4 * g + 3] = acc[4 * g + 3] + bfhi(I.oi[g].y); }
#pragma unroll
    for (int r = 0; r < 16; ++r) ss += o[r] * o[r];
    { auto rr = __builtin_amdgcn_permlane32_swap(__float_as_uint(ss), __float_as_uint(ss), false, false); ss = __uint_as_float(rr[0]) + __uint_as_float(rr[1]); }
    if (hi == 0) SS[wid * 32 + r32] = ss;
    __syncthreads();
    const float tot = (SS[(tb * 4 + 0) * 32 + r32] + SS[(tb * 4 + 1) * 32 + r32]) + (SS[(tb * 4 + 2) * 32 + r32] + SS[(tb * 4 + 3) * 32 + r32]);
    const float rstd = 1.0f / sqrtf(tot * (1.f / 128.f) + EPS);
    bf16_t* gp = Z + (row0 + 32 * tb + r32) * ZP + C_GG + h * 128 + 32 * vb + 4 * hi;
#pragma unroll
    for (int g = 0; g < 4; ++g) { const float g0 = bflo(I.gq[g].x), g1 = bfhi(I.gq[g].x), g2 = bflo(I.gq[g].y), g3 = bfhi(I.gq[g].y);
        u32x2 w; w.x = pk2(o[4 * g] * rstd * gn[g].x * siluf_(g0), o[4 * g + 1] * rstd * gn[g].y * siluf_(g1)); w.y = pk2(o[4 * g + 2] * rstd * gn[g].z * siluf_(g2), o[4 * g + 3] * rstd * gn[g].w * siluf_(g3));
        if (!dry) *(u32x2*)(gp + 8 * g) = w; }
    __syncthreads();
}
namespace pg8 {
constexpr int S8_OFF = 2048;
struct EpiSig8 {
    static constexpr bool PERM = true; static __device__ __forceinline__ bool keep(const Unit&) { return false; }
    unsigned char* Zb;
    __device__ __forceinline__ void operator()(f32x4 (&acc)[2][2][4][2], const Unit& u, int wr, int wc, int fr, int fq) const {
        const int row0 = u.pm * BM + wr * 64 + fr; const int col0 = u.tag * 1024 + u.pn * BM + wc * 32 + 8 * fq;
#pragma unroll
        for (int ai = 0; ai < 2; ++ai)
#pragma unroll
            for (int m = 0; m < 4; ++m) { unsigned char* rowp = Zb + (size_t)(row0 + ai * HALF + m * 16) * (ZP * 2) + S8_OFF + col0;
#pragma unroll
                for (int bj = 0; bj < 2; ++bj) { const f32x4 v0 = acc[ai][bj][m][0], v1 = acc[ai][bj][m][1]; u32x2 w;
                    w.x = (unsigned)(sigmoidf_(v0[0]) * 255.f + 0.5f) | ((unsigned)(sigmoidf_(v0[1]) * 255.f + 0.5f) << 8) | ((unsigned)(sigmoidf_(v0[2]) * 255.f + 0.5f) << 16) | ((unsigned)(sigmoidf_(v0[3]) * 255.f + 0.5f) << 24);
                    w.y = (unsigned)(sigmoidf_(v1[0]) * 255.f + 0.5f) | ((unsigned)(sigmoidf_(v1[1]) * 255.f + 0.5f) << 8) | ((unsigned)(sigmoidf_(v1[2]) * 255.f + 0.5f) << 16) | ((unsigned)(sigmoidf_(v1[3]) * 255.f + 0.5f) << 24);
                    *(u32x2*)(rowp + bj * HALF) = w; } }
    }
};
struct EpiMerge8 {
    static constexpr bool PERM = true; static __device__ __forceinline__ bool keep(const Unit& u) { return u.tag < 2; }
    bf16_t* Z; int dry;
    static __device__ __forceinline__ float g8(unsigned w, int sh) { const unsigned q = (w >> sh) & 255u; return (float)(q ? q : 1u); }
    __device__ __forceinline__ void operator()(f32x4 (&acc)[2][2][4][2], const Unit& u, int wr, int wc, int fr, int fq) const {
        const int j = u.tag; const int row0 = u.pm * BM + wr * 64 + fr; const int col0 = u.pn * BM + wc * 32 + 8 * fq;
#pragma unroll
        for (int ai = 0; ai < 2; ++ai)
#pragma unroll
            for (int mp = 0; mp < 2; ++mp) { u32x2 sa[2][2], sb[2][2];
#pragma unroll
                for (int mm = 0; mm < 2; ++mm)
#pragma unroll
                    for (int bj = 0; bj < 2; ++bj) { const unsigned char* sp = (const unsigned char*)Z + (size_t)(row0 + ai * HALF + (2 * mp + mm) * 16) * (ZP * 2) + S8_OFF + col0 + bj * HALF;
                        sa[mm][bj] = *(const u32x2*)(sp + j * 1024); sb[mm][bj] = (u32x2){0u, 0u}; if (j < 2) sb[mm][bj] = *(const u32x2*)(sp + (j + 1) * 1024); }
                asm volatile("" ::: "memory");
#pragma unroll
                for (int mm = 0; mm < 2; ++mm)
#pragma unroll
                    for (int bj = 0; bj < 2; ++bj) { const int m = 2 * mp + mm; const u32x2 a = sa[mm][bj], b = sb[mm][bj]; float f[8];
#pragma unroll
                        for (int q = 0; q < 4; ++q) { const float n0 = g8(a.x, 8 * q), n1 = g8(a.y, 8 * q);
                            f[q] = j < 2 ? n0 * __builtin_amdgcn_rcpf(g8(b.x, 8 * q)) : n0 * (1.0f / 255.0f); f[4 + q] = j < 2 ? n1 * __builtin_amdgcn_rcpf(g8(b.y, 8 * q)) : n1 * (1.0f / 255.0f); }
                        f32x4& v0 = acc[ai][bj][m][0]; f32x4& v1 = acc[ai][bj][m][1];
                        v0[0] *= f[0]; v0[1] *= f[1]; v0[2] *= f[2]; v0[3] *= f[3]; v1[0] *= f[4]; v1[1] *= f[5]; v1[2] *= f[6]; v1[3] *= f[7];
                        if (j == 2) { bf16_t* rowp = Z + (size_t)(row0 + ai * HALF + m * 16) * ZP + col0 + bj * HALF;
                            u32x4 w; w.x = pk2(v0[0], v0[1]); w.y = pk2(v0[2], v0[3]); w.z = pk2(v1[0], v1[1]); w.w = pk2(v1[2], v1[3]);
                            if (!dry) *(u32x4*)rowp = w; } }
                asm volatile("" ::: "memory"); }
    }
};
struct EpiRes {
    static constexpr bool PERM = true; static __device__ __forceinline__ bool keep(const Unit&) { return false; }
    const float* basef; const bf16_t* base16; bf16_t* out; int dry;
    __device__ __forceinline__ void operator()(f32x4 (&acc)[2][2][4][2], const Unit& u, int wr, int wc, int fr, int fq) const {
        const int row0 = u.pm * BM + wr * 64 + fr; const int col0 = u.pn * BM + wc * 32 + 8 * fq;
        if (base16) {
#pragma unroll
            for (int ai = 0; ai < 2; ++ai) { u32x4 bw[4][2];
#pragma unroll
                for (int m = 0; m < 4; ++m)
#pragma unroll
                    for (int bj = 0; bj < 2; ++bj) bw[m][bj] = *(const u32x4*)(base16 + (size_t)(row0 + ai * HALF + m * 16) * DM + col0 + bj * HALF);
                asm volatile("" ::: "memory");
#pragma unroll
                for (int m = 0; m < 4; ++m)
#pragma unroll
                    for (int bj = 0; bj < 2; ++bj) { const size_t off = (size_t)(row0 + ai * HALF + m * 16) * DM + col0 + bj * HALF; const u32x4 w0 = bw[m][bj];
                        const f32x4 c0 = {bflo(w0.x), bfhi(w0.x), bflo(w0.y), bfhi(w0.y)}, c1 = {bflo(w0.z), bfhi(w0.z), bflo(w0.w), bfhi(w0.w)};
                        const f32x4 v0 = c0 + acc[ai][bj][m][0], v1 = c1 + acc[ai][bj][m][1];
                        u32x4 w; w.x = pk2(v0[0], v0[1]); w.y = pk2(v0[2], v0[3]); w.z = pk2(v1[0], v1[1]); w.w = pk2(v1[2], v1[3]);
                        if (!dry) *(u32x4*)(out + off) = w; }
                asm volatile("" ::: "memory"); }
            return; }
#pragma unroll
        for (int ai = 0; ai < 2; ++ai)
#pragma unroll
            for (int mp = 0; mp < 2; ++mp) { f32x4 b0[2][2], b1[2][2];
#pragma unroll
                for (int mm = 0; mm < 2; ++mm)
#pragma unroll
                    for (int bj = 0; bj < 2; ++bj) { const size_t off = (size_t)(row0 + ai * HALF + (2 * mp + mm) * 16) * DM + col0 + bj * HALF;
                        b0[mm][bj] = *(const f32x4*)(basef + off); b1[mm][bj] = *(const f32x4*)(basef + off + 4); }
                asm volatile("" ::: "memory");
#pragma unroll
                for (int mm = 0; mm < 2; ++mm)
#pragma unroll
                    for (int bj = 0; bj < 2; ++bj) { const int m = 2 * mp + mm; const size_t off = (size_t)(row0 + ai * HALF + m * 16) * DM + col0 + bj * HALF;
                        const f32x4 v0 = b0[mm][bj] + acc[ai][bj][m][0], v1 = b1[mm][bj] + acc[ai][bj][m][1];
                        u32x4 w; w.x = pk2(v0[0], v0[1]); w.y = pk2(v0[2], v0[3]); w.z = pk2(v1[0], v1[1]); w.w = pk2(v1[2], v1[3]);
                        if (!dry) *(u32x4*)(out + off) = w; }
                asm volatile("" ::: "memory"); }
    }
};
struct EpiPle {
    static constexpr bool PERM = true; static __device__ __forceinline__ bool keep(const Unit&) { return false; }
    const bf16_t* xb; bf16_t* out; const bf16_t* PL; int dry;
    __device__ __forceinline__ void operator()(f32x4 (&acc)[2][2][4][2], const Unit& u, int wr, int wc, int fr, int fq) const {
        const int row0 = u.pm * BM + wr * 64 + fr; const int col0 = u.pn * BM + wc * 32 + 8 * fq;
#pragma unroll
        for (int ai = 0; ai < 2; ++ai)
#pragma unroll
            for (int mp = 0; mp < 2; ++mp) { u32x4 bs[2][2], pl[2][2];
#pragma unroll
                for (int mm = 0; mm < 2; ++mm)
#pragma unroll
                    for (int bj = 0; bj < 2; ++bj) { const size_t off = (size_t)(row0 + ai * HALF + (2 * mp + mm) * 16) * DM + col0 + bj * HALF; bs[mm][bj] = *(const u32x4*)(xb + off); pl[mm][bj] = *(const u32x4*)(PL + off); }
                asm volatile("" ::: "memory");
#pragma unroll
                for (int mm = 0; mm < 2; ++mm)
#pragma unroll
                    for (int bj = 0; bj < 2; ++bj) { const int m = 2 * mp + mm; const size_t off = (size_t)(row0 + ai * HALF + m * 16) * DM + col0 + bj * HALF;
                        const f32x4 a0 = acc[ai][bj][m][0], a1 = acc[ai][bj][m][1]; const u32x4 b = bs[mm][bj], p = pl[mm][bj]; u32x4 w;
                        w.x = pk2(fmaf(sigmoidf_(a0[0]), bflo(p.x), bflo(b.x)), fmaf(sigmoidf_(a0[1]), bfhi(p.x), bfhi(b.x)));
                        w.y = pk2(fmaf(sigmoidf_(a0[2]), bflo(p.y), bflo(b.y)), fmaf(sigmoidf_(a0[3]), bfhi(p.y), bfhi(b.y)));
                        w.z = pk2(fmaf(sigmoidf_(a1[0]), bflo(p.z), bflo(b.z)), fmaf(sigmoidf_(a1[1]), bfhi(p.z), bfhi(b.z)));
                        w.w = pk2(fmaf(sigmoidf_(a1[2]), bflo(p.w), bflo(b.w)), fmaf(sigmoidf_(a1[3]), bfhi(p.w), bfhi(b.w)));
                        if (!dry) *(u32x4*)(out + off) = w; }
                asm volatile("" ::: "memory"); }
    }
};
struct EpiUp {
    static constexpr bool PERM = true; static __device__ __forceinline__ bool keep(const Unit&) { return false; }
    bf16_t* ACT; const float* sw;
    __device__ __forceinline__ void operator()(f32x4 (&acc)[2][2][4][2], const Unit& u, int wr, int wc, int fr, int fq) const {
        const int row0 = u.pm * BM + wr * 64 + fr; const int col0 = u.tag * DEXP + u.pn * HALF + wc * 32 + 8 * fq; const float* swj = sw + (size_t)u.tag * NSLOT;
        float sv[2][4];
#pragma unroll
        for (int ai = 0; ai < 2; ++ai)
#pragma unroll
            for (int m = 0; m < 4; ++m) sv[ai][m] = swj[row0 + ai * HALF + m * 16];
#pragma unroll
        for (int ai = 0; ai < 2; ++ai)
#pragma unroll
            for (int m = 0; m < 4; ++m) { const f32x4 g0 = acc[ai][0][m][0], g1 = acc[ai][0][m][1], u0 = acc[ai][1][m][0] * sv[ai][m], u1 = acc[ai][1][m][1] * sv[ai][m];
                u32x4 w; w.x = pk2(siluf_(g0[0]) * u0[0], siluf_(g0[1]) * u0[1]); w.y = pk2(siluf_(g0[2]) * u0[2], siluf_(g0[3]) * u0[3]);
                w.z = pk2(siluf_(g1[0]) * u1[0], siluf_(g1[1]) * u1[1]); w.w = pk2(siluf_(g1[2]) * u1[2], siluf_(g1[3]) * u1[3]);
                *(u32x4*)(ACT + (size_t)(row0 + ai * HALF + m * 16) * DM + col0) = w; }
    }
};
struct EpiDownRes {
    static constexpr bool PERM = true; static __device__ __forceinline__ bool keep(const Unit& u) { return (u.tag & 1) == 0; }
    const bf16_t* X16; bf16_t* XB; const int* s2t; int dry;
    __device__ __forceinline__ void operator()(f32x4 (&acc)[2][2][4][2], const Unit& u, int wr, int wc, int fr, int fq) const {
        if ((u.tag & 1) == 0) return;
        const int nvalid = u.tag >> 1; const int rl0 = wr * 64 + fr; const int col0 = u.pn * BM + wc * 32 + 8 * fq;
        int tk[2][4];
#pragma unroll
        for (int ai = 0; ai < 2; ++ai)
#pragma unroll
            for (int m = 0; m < 4; ++m) { const int rl = rl0 + ai * HALF + m * 16; tk[ai][m] = rl < nvalid ? s2t[u.pm * BM + rl] : -1; }
#pragma unroll
        for (int ai = 0; ai < 2; ++ai) { u32x4 bs[4][2];
#pragma unroll
            for (int m = 0; m < 4; ++m)
#pragma unroll
                for (int bj = 0; bj < 2; ++bj) { const int t = tk[ai][m]; bs[m][bj] = *(const u32x4*)(X16 + (size_t)(t < 0 ? 0 : t) * DM + col0 + bj * HALF); }
            asm volatile("" ::: "memory");
#pragma unroll
            for (int m = 0; m < 4; ++m)
#pragma unroll
                for (int bj = 0; bj < 2; ++bj) { const int t = tk[ai][m]; const u32x4 b = bs[m][bj];
                    const f32x4 a0 = acc[ai][bj][m][0], a1 = acc[ai][bj][m][1]; u32x4 w;
                    w.x = pk2(bflo(b.x) + a0[0], bfhi(b.x) + a0[1]); w.y = pk2(bflo(b.y) + a0[2], bfhi(b.y) + a0[3]);
                    w.z = pk2(bflo(b.z) + a1[0], bfhi(b.z) + a1[1]); w.w = pk2(bflo(b.w) + a1[2], bfhi(b.w) + a1[3]);
                    if (t >= 0 && !dry) *(u32x4*)(XB + (size_t)t * DM + col0 + bj * HALF) = w; }
            asm volatile("" ::: "memory"); }
    }
};
struct MergeOrder {
    int c, G; int abase, astep; size_t bbase, bstep;
    __device__ bool next(int i, Unit& u) const { const int pair = (i / 3) * G + c, j = i % 3; if (pair >= 512) return false;
        u.pm = pair >> 2; u.pn = pair & 3; u.tag = j; u.aoff = abase + j * astep; u.boff = bbase + (size_t)j * bstep; return true; }
};
__device__ __forceinline__ int pair_expert(int k, int j) { const int g = (k * 43) >> 8, q = k - 6 * g; return g * 4 + (((j ? 0x332321 : 0x211000) >> (4 * q)) & 15); }
struct PairUpOrder {
    const int* tbl; int c, G; size_t bstride;
    __device__ bool next(int i, Unit& u) const {
        const int L = i * G + c, pm = L >> 3; if (pm >= tbl[62]) return false;
        const int j = (L >> 2) & 1, k = tbl[64 + pm] & 255;
        u.pm = pm; u.pn = L & 3; u.tag = j; u.aoff = 0; u.boff = (size_t)pair_expert(k, j) * bstride; return true; }
};
struct PairDownOrder {
    const int* tbl; int c, G; size_t bstride;
    __device__ bool next(int i, Unit& u) const {
        const int j = i & 1, L = (i >> 1) * G + c, pm = L >> 2; if (pm >= tbl[62]) return false;
        const int d = tbl[64 + pm];
        u.pm = pm; u.pn = L & 3; u.tag = j | ((d >> 8) << 1); u.aoff = j * DEXP; u.boff = (size_t)pair_expert(d & 255, j) * bstride; return true; }
};
}

__device__ __forceinline__ void phaseF(KA P, int L, LAS unsigned char* lds, int wave, int lane, int tid) {
    LAS float* WR = (LAS float*)lds; LAS int* E0 = (LAS int*)(lds + 81920);
    const float* wrg = P->p.in[15] + (size_t)L * DM * 4; const float* wre = P->p.in[17] + (size_t)L * DM * 16;
    for (int i = tid; i < DM * 4; i += 512) WR[(i & 3) * 1024 + (i >> 2)] = wrg[i];
    for (int i = tid; i < DM * 16; i += 512) WR[(4 + (i & 15)) * 1024 + (i >> 4)] = wre[i];
    __syncthreads();
    const float* brg = P->p.in[16] + L * 4; const float* bre = P->p.in[18] + L * 16; const float* g = P->p.in[14] + (size_t)L * DM;
    const int tok0 = blockIdx.x * TPW;
    int* RB = (int*)(P->p.ws + WS_ROUTE); float* RWA = (float*)(RB + NTOK); float* RWB = RWA + NTOK;
    const f32x4* gr = (const f32x4*)g + lane; f32x4 gg[4];
#pragma unroll
    for (int j = 0; j < 4; ++j) gg[j] = gr[64 * j];
    float brg_[4];
#pragma unroll
    for (int q = 0; q < 4; ++q) brg_[q] = brg[q];
    constexpr int NRB = 4;
    u32x2 nx_[NRB][4];
#pragma unroll
    for (int q = 0; q < NRB; ++q)
#pragma unroll
        for (int j = 0; j < 4; ++j) nx_[q][j] = ((const u32x2*)((const bf16_t*)P->p.out + (size_t)(tok0 + wave * 16 + q) * DM))[64 * j + lane];
    for (int i0 = wave * 16; i0 < wave * 16 + 16; i0 += NRB) {
        f32x4 v[NRB][4]; float s[NRB];
#pragma unroll
        for (int q = 0; q < NRB; ++q)
#pragma unroll
            for (int j = 0; j < 4; ++j) { const u32x2 w = nx_[q][j]; v[q][j] = (f32x4){bflo(w.x), bfhi(w.x), bflo(w.y), bfhi(w.y)}; }
        { const int in_ = (i0 + NRB < wave * 16 + 16) ? i0 + NRB : i0;
#pragma unroll
          for (int q = 0; q < NRB; ++q)
#pragma unroll
              for (int j = 0; j < 4; ++j) nx_[q][j] = ((const u32x2*)((const bf16_t*)P->p.out + (size_t)(tok0 + in_ + q) * DM))[64 * j + lane]; }
#pragma unroll
        for (int q = 0; q < NRB; ++q) { s[q] = 0.f;
#pragma unroll
            for (int j = 0; j < 4; ++j) s[q] += (v[q][j].x * v[q][j].x + v[q][j].y * v[q][j].y) + (v[q][j].z * v[q][j].z + v[q][j].w * v[q][j].w); }
#pragma unroll
        for (int q = 0; q < NRB; ++q) { const float r = 1.0f / sqrtf(wave_sum_dpp(s[q]) * (1.f / DM) + EPS);
            u32x2* o8 = (u32x2*)((bf16_t*)(P->p.ws + WS_HN) + (size_t)(tok0 + i0 + q) * DM) + lane;
#pragma unroll
            for (int j = 0; j < 4; ++j) { v[q][j].x *= r * gg[j].x; v[q][j].y *= r * gg[j].y; v[q][j].z *= r * gg[j].z; v[q][j].w *= r * gg[j].w;
                u32x2 w; w.x = pk2(v[q][j].x, v[q][j].y); w.y = pk2(v[q][j].z, v[q][j].w); o8[64 * j] = w; } }
        float gl[NRB][4];
#pragma unroll
        for (int o = 0; o < 4; ++o) { f32x4 w[4];
#pragma unroll
            for (int j = 0; j < 4; ++j) w[j] = *(const LAS f32x4*)(WR + o * 1024 + 256 * j + 4 * lane);
#pragma unroll
            for (int q = 0; q < NRB; ++q) { float a = 0.f;
#pragma unroll
                for (int j = 0; j < 4; ++j) a += (v[q][j].x * w[j].x + v[q][j].y * w[j].y) + (v[q][j].z * w[j].z + v[q][j].w * w[j].w);
                gl[q][o] = rdl(wave_sum_hi(a), 63) + brg_[o]; }
            __builtin_amdgcn_sched_barrier(0); }
#pragma unroll
        for (int qq = 0; qq < NRB; ++qq) {
            const int i = i0 + qq, tok = tok0 + i;
            int gi = 0; float gm = gl[qq][0];
#pragma unroll
            for (int q = 1; q < 4; ++q) if (gl[qq][q] > gm) { gm = gl[qq][q]; gi = q; }
            float den = 0.f;
#pragma unroll
            for (int q = 0; q < 4; ++q) den += expf(gl[qq][q] - gm);
            const float gp = 1.0f / den;
            float wv[4];
#pragma unroll
            for (int q = 0; q < 4; ++q) { const LAS float* wr = WR + (4 + gi * 4 + q) * 1024 + 4 * lane; float a = 0.f;
#pragma unroll
                for (int j = 0; j < 4; ++j) { const f32x4 w = *(const LAS f32x4*)(wr + 256 * j); a += (v[qq][j].x * w.x + v[qq][j].y * w.y) + (v[qq][j].z * w.z + v[qq][j].w * w.w); }
                wv[q] = wave_sum_hi(a) + bre[gi * 4 + q]; }
            int i1s = 0; float m0 = wv[0];
#pragma unroll
            for (int q = 1; q < 4; ++q) if (wv[q] > m0) { m0 = wv[q]; i1s = q; }
            int i2s = -1; float m1 = 0.f;
#pragma unroll
            for (int q = 0; q < 4; ++q) if (q != i1s && (i2s < 0 || wv[q] > m1)) { m1 = wv[q]; i2s = q; }
            const float t = expf(m1 - m0); const float w0 = gp / (1.f + t), w1 = gp * t / (1.f + t);
            if (lane == 63) { const bool lo1 = i1s < i2s; const int a = lo1 ? i1s : i2s, b = lo1 ? i2s : i1s; const int k = gi * 6 + (a == 0 ? b - 1 : (a == 1 ? b + 1 : 5));
                E0[i] = k; RB[tok] = k; RWA[tok] = lo1 ? w0 : w1; RWB[tok] = lo1 ? w1 : w0; } }
    }
    __syncthreads();
    {
        LAS int* HC = (LAS int*)(lds + 84992);
        if (tid < TPW) { const int k0 = E0[tid];
#pragma unroll
            for (int k = 0; k < NBK; ++k) { const int c = __popcll(__ballot(k0 == k)); if (lane == 0) HC[wave * 32 + k] = c; } }
        __syncthreads();
        if (tid < NBK) ((int*)(P->p.ws + WS_HIST))[blockIdx.x * 32 + tid] = HC[tid] + HC[32 + tid]; }
    __syncthreads();
}

__device__ __forceinline__ void phaseG(KA P, LAS unsigned char* lds, int wave, int lane, int tid) {
    LAS int* E0 = (LAS int*)lds; LAS int* S0 = (LAS int*)(lds + 1024);
    LAS int* TOT = (LAS int*)(lds + 2048); LAS int* PRE = (LAS int*)(lds + 2176); LAS int* EB = (LAS int*)(lds + 2304);
    const int* HIST = (const int*)(P->p.ws + WS_HIST); const int tok0 = blockIdx.x * TPW;
    const int* RB = (const int*)(P->p.ws + WS_ROUTE); const float* RWA = (const float*)(RB + NTOK); const float* RWB = RWA + NTOK;
    LAS int* PT = (LAS int*)(lds + 4096); LAS int* PP = (LAS int*)(lds + 4096 + 2048);
    { const int k = tid & 31, part = tid >> 5; int tot = 0, pre = 0;
#pragma unroll
      for (int q = 0; q < 16; ++q) { const int w = part * 16 + q; const int hv = k < NBK ? HIST[w * 32 + k] : 0; tot += hv; if (w < (int)blockIdx.x) pre += hv; }
      PT[part * 32 + k] = tot; PP[part * 32 + k] = pre; }
    if (tid < TPW) E0[tid] = RB[tok0 + tid];
    __syncthreads();
    if (tid < 32) { int tot = 0, pre = 0; for (int q = 0; q < 16; ++q) { tot += PT[q * 32 + tid]; pre += PP[q * 32 + tid]; } TOT[tid] = tot; PRE[tid] = pre; }
    __syncthreads();
    if (tid == 0) { int eb = 0; for (int k = 0; k < NBK; ++k) { EB[k] = eb; eb += (TOT[k] + 255) & ~255; }
        if (blockIdx.x == 0) ((int*)(P->p.ws + WS_TBL))[62] = eb >> 8; }
    __syncthreads();
    if (blockIdx.x == 0 && tid < NBK) { int* tk = (int*)(P->p.ws + WS_TBL) + 64 + (EB[tid] >> 8); const int tot = TOT[tid];
        for (int i = 0; i * 256 < tot; ++i) tk[i] = tid | ((tot - i * 256 > 256 ? 256 : tot - i * 256) << 8); }
    {
        LAS int* W0T = (LAS int*)(lds + 3072);
        int r0 = 0; const int k0 = tid < TPW ? E0[tid] : -1;
        if (tid < TPW) { const unsigned long long lt = (1ull << lane) - 1ull;
#pragma unroll
            for (int k = 0; k < NBK; ++k) { const unsigned long long m0 = __ballot(k0 == k);
                if (k0 == k) r0 = __popcll(m0 & lt); if (wave == 0 && lane == 0) W0T[k] = __popcll(m0); } }
        __syncthreads();
        if (tid < TPW) S0[tid] = EB[k0] + PRE[k0] + (wave == 1 ? W0T[k0] : 0) + r0; }
    __syncthreads();
    float* SW = (float*)(P->p.ws + WS_SLOTW); int* S2T = (int*)(P->p.ws + WS_S2T);
    if (tid < TPW) { const int tok = tok0 + tid, s0 = S0[tid]; SW[s0] = RWA[tok]; SW[NSLOT + s0] = RWB[tok]; S2T[s0] = tok; }
}

__device__ __forceinline__ void final_rows(KA P, int vcu, int G, int wave, int lane) {
    const f32x4* gr = (const f32x4*)P->p.in[23] + lane; f32x4 gg[4];
#pragma unroll
    for (int j = 0; j < 4; ++j) gg[j] = gr[64 * j];
    const int NGW = G * 8;
    for (int t0 = vcu * 8 + wave; t0 < NTOK; t0 += 4 * NGW) { f32x4 v[4][4]; float s[4];
#pragma unroll
        for (int q = 0; q < 4; ++q)
#pragma unroll
            for (int j = 0; j < 4; ++j) v[q][j] = ld_x16((const bf16_t*)(P->p.ws + WS_PL) + (size_t)(t0 + q * NGW) * DM, j, lane);
#pragma unroll
        for (int q = 0; q < 4; ++q) { s[q] = 0.f;
#pragma unroll
            for (int j = 0; j < 4; ++j) s[q] += (v[q][j].x * v[q][j].x + v[q][j].y * v[q][j].y) + (v[q][j].z * v[q][j].z + v[q][j].w * v[q][j].w); }
#pragma unroll
        for (int q = 0; q < 4; ++q) s[q] = wave_sum_dpp(s[q]);
#pragma unroll
        for (int q = 0; q < 4; ++q) { const float r = 1.0f / sqrtf(s[q] * (1.f / DM) + EPS); f32x4* xr = (f32x4*)(P->p.out + (size_t)(t0 + q * NGW) * DM) + lane;
#pragma unroll
            for (int j = 0; j < 4; ++j) { f32x4 o; o.x = v[q][j].x * r * gg[j].x; o.y = v[q][j].y * r * gg[j].y; o.z = v[q][j].z * r * gg[j].z; o.w = v[q][j].w * r * gg[j].w; xr[64 * j] = o; } } }
}
#ifndef MK_N_LAUNCHES
#define MK_N_LAUNCHES 1
#endif
constexpr int PH_PER_LAYER = 12, N_PHASES = DEPTH * PH_PER_LAYER + 1;
constexpr int N_LAUNCHES = MK_N_LAUNCHES;
static_assert(N_LAUNCHES == 1 || N_LAUNCHES == N_PHASES, "MK_N_LAUNCHES is 1 or N_PHASES");

#ifdef NO_KV
#define KVBUF ((const bf16_t*)Z)
#else
#define KVBUF ((const bf16_t*)ka->p.out + (size_t)NTOK * DM)
#endif
#define PH_FN static __device__ __forceinline__ void
#define DRYP , int dry = 0
#define PH_COMMON int tid_l = WV * 64 + lane_id_v(); asm volatile("" : "+v"(tid_l)); asm volatile("" : "+s"(ka)); asm volatile("" : "+s"(L)); const int tid = tid_l, lane = tid & 63, wave = __builtin_amdgcn_readfirstlane(tid >> 6); int G_l = gridDim.x, bx_l = blockIdx.x; asm volatile("" : "+s"(G_l)); asm volatile("" : "+s"(bx_l)); const int G = G_l, bx = bx_l; \
    const int vcu = (G % 8 == 0) ? (bx % 8) * (G / 8) + bx / 8 : bx; unsigned char* ws = ka->p.ws; (void)tid; (void)lane; (void)wave; (void)vcu; (void)ws; \
    bf16_t* Z = (bf16_t*)(ws + WS_Z); bf16_t* HN = (bf16_t*)(ws + WS_HN); (void)Z; (void)HN;

PH_FN ph_A(KA ka, int L, LAS unsigned char* L3, int WV DRYP) { PH_COMMON; KA P = ka; phaseA(P, L, L3, vcu, G, wave, lane, tid); }
PH_FN ph_B(KA ka, int L, LAS unsigned char* L3, int WV DRYP) { PH_COMMON;
#ifdef NO_KV
    pg8::Gemm g{HN, DM, (const bf16_t*)(ws + WS_WIN), DM, DM}; pg8::StaticOrder S; S.init(NTOK, NZT * 256, G, bx);
    pg8::EpiBf16 E{Z, ZP, 0};
    pg8::gemm_phase<pg8::EpiBf16, pg8::StaticOrder, true, true>(tid, L3, g, S, E);
#else
    pg8::Gemm g{HN, DM, (const bf16_t*)(ws + WS_WIN), DM, DM};
    { pg8::ColMapOrder S; S.S.init(NTOK, 4 * 256, G, bx); S.from = 0; S.by = 4;
      pg8::EpiKV E{(bf16_t*)ka->p.out + (size_t)NTOK * DM};
      pg8::gemm_phase<pg8::EpiKV, pg8::ColMapOrder, true, true>(tid, L3, g, S, E); }
    { pg8::ColMapOrder S; S.S.init(NTOK, (NZT - 4) * 256, G, bx); S.from = 4; S.by = 4;
      pg8::EpiBf16 E{Z, ZP, 0};
      pg8::gemm_phase<pg8::EpiBf16, pg8::ColMapOrder, false, true>(tid, L3, g, S, E); }
#endif
    {
#ifdef NO_KV
        const int nunits = (NTOK / 256) * NZT, nheavy = nunits % G;
#else
        const int nunits = (NTOK / 256) * (NZT - 4), nheavy = nunits % G;
#endif
        if (L == 0 && bx >= nheavy) tr_groups(ka, L, 0x20u, (LAS float*)(L3 + wave * 16384), (bx - nheavy) * 8 + wave, (G - nheavy) * 8, lane);
        if (L != 0 && bx >= nheavy) tr_groups(ka, L, 0x58u, (LAS float*)(L3 + wave * 16384), (bx - nheavy) * 8 + wave, (G - nheavy) * 8, lane); } }
PH_FN ph_C1a(KA ka, int L, LAS unsigned char* L3, int WV DRYP) { PH_COMMON;
    gla1_load_w(ka->p.in[4] + (size_t)L * 16 * 256, ka->p.in[5] + (size_t)L * 256, L3, tid);
    {
        Gla1In IA, IB; int u = bx;
        if (u < 2048) gla1_load(u, Z, wave, lane, IA);
        for (; u < 2048; u += 2 * G) {
            if (u + G < 2048) gla1_load(u + G, Z, wave, lane, IB);
            gla1_unit(u, IA, Z, (bf16_t*)(ws + WS_SLOC), (float*)(ws + WS_DTAB), L3, wave, lane, tid, dry);
            if (u + G < 2048) { if (u + 2 * G < 2048) gla1_load(u + 2 * G, Z, wave, lane, IA);
                gla1_unit(u + G, IB, Z, (bf16_t*)(ws + WS_SLOC), (float*)(ws + WS_DTAB), L3, wave, lane, tid, dry); } } }
    for (int cu = bx; cu < 256; cu += G) conv_unit(cu, Z, ka->p.in[11] + (size_t)L * 3 * 512, wave, lane, dry);
    for (int cu = bx; cu < 256; cu += G) knorm_unit(cu, KVBUF, (unsigned*)(ws + WS_CTL) + CW_KN + 64 * L, L3, wave, lane, tid); }
PH_FN ph_C1b(KA ka, int L, LAS unsigned char* L3, int WV DRYP) { PH_COMMON;
    gla_scan((bf16_t*)(ws + WS_SLOC), (const float*)(ws + WS_DTAB), L3, G, bx, tid);
    const float* lp = ka->p.in[8] + (size_t)L * 256;
    const float sa = wave_sum(lp[lane] * lp[64 + lane]), sb = wave_sum(lp[128 + lane] * lp[192 + lane]);
    const float lam_init = 0.8f - 0.6f * expf(-0.3f * (float)L); const float lam = expf(sa) - expf(sb) + lam_init;
    const float* gd = ka->p.in[9] + (size_t)L * 128;
    unsigned* heads = (unsigned*)(ws + WS_CTL) + CW_QHEAD + 64 * L; const unsigned* KN = (const unsigned*)(ws + WS_CTL) + CW_KN + 64 * L;
    LAS int* qslot = (LAS int*)(L3 + 134144);
    const int xcd = (int)(xb_xcc_id() & 7u); int qi = 0;
    for (;;) {
        const int qx = (xcd + qi) & 7;
        if (tid == 0) *qslot = (int)__hip_atomic_fetch_add(heads + 8 * qx, 1u, __ATOMIC_RELAXED, __HIP_MEMORY_SCOPE_AGENT);
        __syncthreads(); const int v = __builtin_amdgcn_readfirstlane(*qslot); __syncthreads();
        if (v >= 128) { if (++qi == 8) break; continue; }
        const int h = 3 - (v >> 5), qb = 32 * (qx >> 1) + 31 - (v & 31), b = qx & 1;
        att::unit(tid, b, h, qb, lam, 1.0f - lam_init, __uint_as_float(KN[b * 4 + h]), Z, KVBUF, gd, (char*)L3, dry); } }
PH_FN ph_C3(KA ka, int L, LAS unsigned char* L3, int WV DRYP) { PH_COMMON;
    const bf16_t* SL = (const bf16_t*)(ws + WS_SLOC); const float* ggn = ka->p.in[6] + (size_t)L * 128;
    Gla3In IA, IB; int u = bx;
    if (u < 2048) gla3_load(u, Z, SL, wave, lane, IA);
    for (; u < 2048; u += 2 * G) {
        if (u + G < 2048) gla3_load(u + G, Z, SL, wave, lane, IB);
        gla3_unit(u, IA, Z, ggn, L3, wave, lane, dry);
        if (u + G < 2048) { if (u + 2 * G < 2048) gla3_load(u + 2 * G, Z, SL, wave, lane, IA);
            gla3_unit(u + G, IB, Z, ggn, L3, wave, lane, dry); } } }
PH_FN ph_D1(KA ka, int L, LAS unsigned char* L3, int WV DRYP) { PH_COMMON;
    pg8::Gemm g{HN, DM, (const bf16_t*)(ws + WS_WIN), DM, DM}; pg8::MergeOrder S{vcu, G, 0, 0, (size_t)NZT * 256 * DM, (size_t)4 * 256 * DM};
    pg8::EpiSig8 E{(unsigned char*)Z};
    pg8::gemm_phase<pg8::EpiSig8, pg8::MergeOrder, false, true>(tid, L3, g, S, E); }
PH_FN ph_D2(KA ka, int L, LAS unsigned char* L3, int WV DRYP) { PH_COMMON;
    pg8::Gemm g{Z, ZP, (const bf16_t*)(ws + WS_WO), 512, 512}; pg8::MergeOrder S{vcu, G, C_OA, 512, 0, (size_t)DM * 512};
    pg8::EpiMerge8 E{Z, dry};
    pg8::gemm_phase<pg8::EpiMerge8, pg8::MergeOrder, true, true>(tid, L3, g, S, E); }
PH_FN ph_E(KA ka, int L, LAS unsigned char* L3, int WV DRYP) { PH_COMMON;
    if ((bx & 1) && L == 0) tr_groups(ka, L, 0x58u, (LAS float*)(L3 + wave * 16384), (bx >> 1) * 8 + wave, (G >> 1) * 8, lane);
    __syncthreads();
    pg8::Gemm g{Z, ZP, (const bf16_t*)(ws + WS_WOUT), DM, DM}; pg8::StaticOrder S; S.init(NTOK, DM, G, bx);
    pg8::EpiRes E{ka->p.in[0], L == 0 ? (const bf16_t*)nullptr : (const bf16_t*)ka->p.out, (bf16_t*)ka->p.out, dry};
    pg8::gemm_phase<pg8::EpiRes, pg8::StaticOrder, true, true>(tid, L3, g, S, E); }
PH_FN ph_F(KA ka, int L, LAS unsigned char* L3, int WV DRYP) { PH_COMMON; KA P = ka; if (G == GRID) phaseF(P, L, L3, wave, lane, tid); }
PH_FN ph_G(KA ka, int L, LAS unsigned char* L3, int WV DRYP) { PH_COMMON; KA P = ka; if (G == GRID) phaseG(P, L3, wave, lane, tid); }
PH_FN ph_H(KA ka, int L, LAS unsigned char* L3, int WV DRYP) { PH_COMMON;
    { pg8::Gemm g{HN, DM, (const bf16_t*)(ws + WS_WGU), DM, DM}; pg8::PairUpOrder S{(const int*)(ws + WS_TBL), vcu, G, (size_t)1024 * DM};
      pg8::EpiUp E{(bf16_t*)(ws + WS_ACT), (const float*)(ws + WS_SLOTW)};
      pg8::gemm_phase<pg8::EpiUp, pg8::PairUpOrder, true, true, true>(tid, L3, g, S, E, (const int*)(ws + WS_S2T)); }
    {
      const int U = ((const int*)(ws + WS_TBL))[62] * 8;
      int nheavy = U % G;
      if (nheavy > G / 2) nheavy = 0;
      pg8::Gemm g{(const bf16_t*)(ws + WS_PB), PLE, (const bf16_t*)(ws + WS_WPLE), PLE, PLE}; pg8::StaticOrder S; S.init(NTOK, DM, G - nheavy, vcu - nheavy);
      pg8::EpiBf16 E{(bf16_t*)(ws + WS_PL), DM, 0};
      if (vcu >= nheavy) pg8::gemm_phase<pg8::EpiBf16, pg8::StaticOrder, true, true>(tid, L3, g, S, E); } }
PH_FN ph_I(KA ka, int L, LAS unsigned char* L3, int WV DRYP) { PH_COMMON;
    pg8::Gemm g{(const bf16_t*)(ws + WS_ACT), DM, (const bf16_t*)(ws + WS_WDN), DEXP, DEXP}; pg8::PairDownOrder S{(const int*)(ws + WS_TBL), vcu, G, (size_t)DM * DEXP};
    pg8::EpiDownRes E{(const bf16_t*)ka->p.out, HN, (const int*)(ws + WS_S2T), dry};
    pg8::gemm_phase<pg8::EpiDownRes, pg8::PairDownOrder, true, true>(tid, L3, g, S, E);
    if (L + 1 < DEPTH) {
        const int U = ((const int*)(ws + WS_TBL))[62] * 4;
        int nheavy = U % G; if (nheavy > G / 2) nheavy = 0;
        if (vcu >= nheavy) tr_groups(ka, L + 1, 0x27u, (LAS float*)(L3 + wave * 16384), (vcu - nheavy) * 8 + wave, (G - nheavy) * 8, lane); } }
PH_FN ph_K(KA ka, int L, LAS unsigned char* L3, int WV DRYP) { PH_COMMON;
    pg8::Gemm g{HN, DM, (const bf16_t*)(ws + WS_WPG), DM, DM}; pg8::StaticOrder S; S.init(NTOK, DM, G, bx);
    pg8::EpiPle E{HN, L + 1 < DEPTH ? (bf16_t*)ka->p.out : (bf16_t*)(ws + WS_PL), (const bf16_t*)(ws + WS_PL), dry};
    pg8::gemm_phase<pg8::EpiPle, pg8::StaticOrder, true, true>(tid, L3, g, S, E); }
PH_FN ph_final(KA ka, int L, LAS unsigned char* L3, int WV DRYP) { PH_COMMON; KA P = ka; final_rows(P, vcu, G, wave, lane); }
static __device__ __forceinline__ void grid_bar(unsigned* barw, LAS unsigned* st) { XcdBarrier b; b.bar = barw; b.x = xb_xcc_id(); b.st = (volatile LAS unsigned*)st; xcd_barrier(b); }

__global__ void __launch_bounds__(512, 2) mega_fwd(Args args) {
    extern __shared__ __attribute__((aligned(16))) unsigned char lds[];
    LAS unsigned char* L3 = (LAS unsigned char*)lds;
    KA ka = (KA)__builtin_amdgcn_kernarg_segment_ptr();
    const int WV = __builtin_amdgcn_readfirstlane((int)threadIdx.x >> 6);
    const int tid = WV * 64 + lane_id_v();
    for (int u = tid; u < (LDS_BYTES - LDSCTL_OFF) / 4; u += 512) ((LAS unsigned*)(L3 + LDSCTL_OFF))[u] = 0u;
    __syncthreads();
    unsigned* barw = (unsigned*)(args.p.ws + WS_CTL) + CW_BAR; LAS unsigned* st = (LAS unsigned*)(L3 + MISC_OFF) + 8;
    if (N_LAUNCHES == 1) (void)xcd_barrier_post(barw, (volatile LAS unsigned*)st);
    const int lo = args.ph_lo, hi = args.ph_hi;
#ifdef DIAG_SEL
    unsigned long long dg_t = __builtin_amdgcn_s_memrealtime(), dg_acc = 0ull; int dg_ph = 0;
#define DG_MARK(isbar) do { const unsigned long long n_ = __builtin_amdgcn_s_memrealtime(); if ((DIAG_SEL == 99 && (isbar)) || (DIAG_SEL >= 100 && (isbar) && dg_ph == DIAG_SEL - 100) || (DIAG_SEL < 99 && !(isbar) && dg_ph == DIAG_SEL)) dg_acc += n_ - dg_t; dg_t = n_; } while (0)
#else
#define DG_MARK(isbar) do { } while (0)
#endif
#ifndef PHASE_MASK
#define PHASE_MASK 0xFFFFFFFu
#endif
#define IN(k) (((PHASE_MASK >> ((k) % PH_PER_LAYER + ((k) == N_PHASES - 1 ? PH_PER_LAYER : 0))) & 1u) && lo <= (k) && (k) < hi)
#ifdef DIAG_SEL
#define SEAM(k) do { if (IN(k) && IN((k) + 1)) { dg_ph = (k) % PH_PER_LAYER; DG_MARK(0); grid_bar(barw, st); DG_MARK(1); } } while (0)
#elif defined(DUP_BAR)
#define SEAM(k) do { if (IN(k) && IN((k) + 1)) { grid_bar(barw, st); grid_bar(barw, st); } } while (0)
#else
#define SEAM(k) do { if (IN(k) && IN((k) + 1)) grid_bar(barw, st); } while (0)
#endif
    for (int L = 0; L < DEPTH; ++L) {
        const int pb = L * PH_PER_LAYER;
        if (IN(pb + 0)) {
#ifdef DUP_A
            for (int rep = 1; rep >= 0; --rep) { const int d = rep ? ka->ph_hi : 0; ph_A(ka, L, L3, WV, d); __syncthreads(); }
#else
            ph_A(ka, L, L3, WV);
#endif
        }
        SEAM(pb + 0);
        if (IN(pb + 1)) {
#ifdef DUP_B
            for (int rep = 1; rep >= 0; --rep) { const int d = rep ? ka->ph_hi : 0; ph_B(ka, L, L3, WV, d); __syncthreads(); }
#else
            ph_B(ka, L, L3, WV);
#endif
        }
        SEAM(pb + 1);
        if (IN(pb + 2)) {
#ifdef DUP_C1a
            for (int rep = 1; rep >= 0; --rep) { const int d = rep ? ka->ph_hi : 0; ph_C1a(ka, L, L3, WV, d); __syncthreads(); }
#else
            ph_C1a(ka, L, L3, WV);
#endif
        }
        SEAM(pb + 2);
        if (IN(pb + 3)) ph_C1b(ka, L, L3, WV);
        SEAM(pb + 3);
        if (IN(pb + 4)) { ph_C3(ka, L, L3, WV); __syncthreads(); ph_D1(ka, L, L3, WV); }
        SEAM(pb + 4);
        if (IN(pb + 5)) ph_D2(ka, L, L3, WV);
        SEAM(pb + 5);
        if (IN(pb + 6)) {
#ifdef DUP_E
            for (int rep = 1; rep >= 0; --rep) { const int d = rep ? ka->ph_hi : 0; ph_E(ka, L, L3, WV, d); __syncthreads(); }
#else
            ph_E(ka, L, L3, WV);
#endif
        }
        SEAM(pb + 6);
        if (IN(pb + 7)) {
#ifdef DUP_F
            for (int rep = 1; rep >= 0; --rep) { const int d = rep ? ka->ph_hi : 0; ph_F(ka, L, L3, WV, d); __syncthreads(); }
#else
            ph_F(ka, L, L3, WV);
#endif
        }
        SEAM(pb + 7);
        if (IN(pb + 8)) {
#ifdef DUP_G
            for (int rep = 1; rep >= 0; --rep) { const int d = rep ? ka->ph_hi : 0; ph_G(ka, L, L3, WV, d); __syncthreads(); }
#else
            ph_G(ka, L, L3, WV);
#endif
        }
        SEAM(pb + 8);
        if (IN(pb + 9)) {
#ifdef DUP_H
            for (int rep = 1; rep >= 0; --rep) { const int d = rep ? ka->ph_hi : 0; ph_H(ka, L, L3, WV, d); __syncthreads(); }
#else
            ph_H(ka, L, L3, WV);
#endif
        }
        SEAM(pb + 9);
        if (IN(pb + 10)) {
#ifdef DUP_I
            for (int rep = 1; rep >= 0; --rep) { const int d = rep ? ka->ph_hi : 0; ph_I(ka, L, L3, WV, d); __syncthreads(); }
#else
            ph_I(ka, L, L3, WV);
#endif
        }
        SEAM(pb + 10);
        if (IN(pb + 11)) {
#ifdef DUP_K
            for (int rep = 1; rep >= 0; --rep) { const int d = rep ? ka->ph_hi : 0; ph_K(ka, L, L3, WV, d); __syncthreads(); }
#else
            ph_K(ka, L, L3, WV);
#endif
        }
        SEAM(pb + 11);
    }
#ifdef DIAG_SEL
    if (IN(N_PHASES - 1)) ph_final(ka, 0, L3, WV);
    if (blockIdx.x == DIAG_BLK) { const unsigned long long t0_ = __builtin_amdgcn_s_memrealtime(); while (__builtin_amdgcn_s_memrealtime() - t0_ < 8ull * dg_acc) __builtin_amdgcn_s_sleep(8); }
#else
    if (IN(N_PHASES - 1)) ph_final(ka, 0, L3, WV);
#endif
#undef IN
#undef SEAM
}

extern "C" void kernel_launch(void* const* d_in, const int* in_sizes, int n_in, void* d_out, int out_size, void* d_ws, size_t ws_size, hipStream_t stream) {
    static int grid = 0;
    if (grid == 0) {
        if (n_in != 24 || in_sizes[0] != NTOK * DM || out_size != NTOK * DM || ws_size < WS_END) {
            fprintf(stderr, "kernel_launch: built for 24 inputs, x/out of %d floats, >= %zu bytes of workspace; got n_in %d, in0 %d, out %d, ws %zu; nothing launched\n", NTOK * DM, (size_t)WS_END, n_in, n_in > 0 ? in_sizes[0] : -1, out_size, ws_size); grid = -1; return; }
        int dev = 0, cus = 0, per_cu = 0;
        if (hipGetDevice(&dev) != hipSuccess || hipDeviceGetAttribute(&cus, hipDeviceAttributeMultiprocessorCount, dev) != hipSuccess) { fprintf(stderr, "kernel_launch: device query failed\n"); grid = -1; return; }
        if (hipFuncSetAttribute((const void*)mega_fwd, hipFuncAttributeMaxDynamicSharedMemorySize, LDS_BYTES) != hipSuccess) { fprintf(stderr, "kernel_launch: hipFuncSetAttribute failed\n"); grid = -1; return; }
        if (hipOccupancyMaxActiveBlocksPerMultiprocessor(&per_cu, (const void*)mega_fwd, 512, LDS_BYTES) != hipSuccess || per_cu < 1)
            fprintf(stderr, "kernel_launch: note: occupancy query reports %d workgroups per CU\n", per_cu);
        (void)hipGetLastError();
        if (cus != GRID) { fprintf(stderr, "kernel_launch: built for a %d-CU device, found %d; nothing launched\n", GRID, cus); grid = -1; return; }
        grid = GRID;
    }
    if (grid < 0) return;
    if (hipMemsetAsync((char*)d_ws + WS_CTL, 0, CTL_ZERO_BYTES, stream) != hipSuccess) { fprintf(stderr, "kernel_launch: memset failed\n"); return; }
    Args a{};
    for (int i = 0; i < 24; ++i) a.p.in[i] = (const float*)d_in[i];
    a.p.out = (float*)d_out; a.p.ws = (unsigned char*)d_ws;
    for (int li = 0; li < N_LAUNCHES; ++li) {
        a.ph_lo = (N_LAUNCHES == 1) ? 0 : li; a.ph_hi = (N_LAUNCHES == 1) ? N_PHASES : li + 1;
        hipLaunchKernelGGL(mega_fwd, dim3(grid), dim3(512), LDS_BYTES, stream, a);
        const hipError_t le = hipPeekAtLastError();
        if (le != hipSuccess) { fprintf(stderr, "kernel_launch: launch %d failed: %s\n", li, hipGetErrorName(le)); break; }
    }
}
```
